# Optimizing an MI355X kernel written in HIP

```python
import math
import jax, jax.numpy as jnp
from jax import lax
import numpy as np


D_MODEL = 1024
BATCH = 4
SEQ = 4096
DEPTH = 2

CTX_LEN = 256
GRID_W = 64

HA = 8
DH_A = 64
DV_A = 2 * DH_A
D_A = HA * DV_A
ROPE_BASE = 10000.0
Q_BLOCK = 128
F_GROUPS = 4
F_GROUP_W = 128
D_F = F_GROUPS * F_GROUP_W
HC = 8
HS_C = 64
D_C = HC * HS_C
LORA_W = 64
LORA_A = 64
LORA_G = 128
D_CS = 2 * D_C + 2 * LORA_W + 2 * LORA_A
D_CO = D_C + LORA_G
N_BRANCH = 3
D_FF = 2816
CONV_W = 3
LN_EPS = 1e-5
GN_EPS = HS_C * 1e-5
HEAD_NORM_EPS = 1e-5

IN_GROUPS = (('q', HA * 2 * DH_A), ('k', HA * 2 * DH_A), ('v', D_A), ('f', D_F),
             ('cs', D_CS), ('co', D_CO), ('gate', N_BRANCH * D_MODEL))
D_IN = 2 * HA * 2 * DH_A + D_A + D_F + D_CS + D_CO + N_BRANCH * D_MODEL

kernel_name = 'hybrid_diffattn_fnet_rwkv7_prefix_block'


def _ln_plain(x):
    xf = x.astype(jnp.float32)
    mu = jnp.mean(xf, axis=-1, keepdims=True)
    var = jnp.mean(jnp.square(xf - mu), axis=-1, keepdims=True)
    return ((xf - mu) * lax.rsqrt(var + LN_EPS)).astype(x.dtype)


def _layernorm(x, g, b):
    return _ln_plain(x) * g + b


def _modulate(x, shift, scale):
    return _ln_plain(x) * (1.0 + scale) + shift


def _in_proj(h, w_in, names=None):
    out, off = {}, 0
    for name, width in IN_GROUPS:
        if names is None or name in names:
            out[name] = h @ w_in[:, off:off + width]
        off += width
    return out


def _shift_prev(x):
    return jnp.pad(x, ((0, 0), (1, 0), (0, 0)))[:, :-1]


def _shift_next(x):
    return jnp.pad(x, ((0, 0), (0, 1), (0, 0)))[:, 1:]


def _token_shift(p, mu):
    return p + mu[0] * (_shift_prev(p) - p) + mu[1] * (_shift_next(p) - p)


def _dwconv3(x, w, b):
    return w[0] * _shift_prev(x) + w[1] * x + w[2] * _shift_next(x) + b


def _rope_angles(n_tokens):
    rows = n_tokens // GRID_W
    row = jnp.repeat(jnp.arange(rows), GRID_W).astype(jnp.float32)
    col = jnp.tile(jnp.arange(GRID_W), rows).astype(jnp.float32)
    n_freq = DH_A // 4
    inv = ROPE_BASE ** (-jnp.arange(n_freq, dtype=jnp.float32) / n_freq)
    ang = jnp.stack([row[:, None] * inv, col[:, None] * inv], axis=1)
    return jnp.cos(ang), jnp.sin(ang)


def _apply_rope(x, cos, sin):
    sh = x.shape
    xr = x.reshape(sh[:-1] + (2, 2, DH_A // 4))
    x1, x2 = xr[..., 0, :], xr[..., 1, :]
    c = cos[None, :, None, None].astype(x.dtype)
    s = sin[None, :, None, None].astype(x.dtype)
    return jnp.stack([x1 * c - x2 * s, x2 * c + x1 * s], axis=-2).reshape(sh)


def _diff_attend(parts, lam):
    scale = DH_A ** -0.5
    s = jnp.concatenate([jnp.einsum('bqhcd,bkhcd->bhcqk', q, k).astype(jnp.float32) for q, k, _ in parts], axis=-1) * scale
    p = jax.nn.softmax(s, axis=-1)
    a = (p[:, :, 0] - lam * p[:, :, 1]).astype(parts[0][2].dtype)
    out, off = None, 0
    for _, k, v in parts:
        n = k.shape[1]
        t = jnp.einsum('bhqk,bkhe->bqhe', a[..., off:off + n], v)
        out = t if out is None else out + t
        off += n
    return out


def _latent_diff_attn(q, k, v, kc, vc, cos, sin, lam):
    B, T = q.shape[:2]
    qr = _apply_rope(q, cos, sin)
    kr = _apply_rope(k, cos, sin)
    nb = T // Q_BLOCK

    def to_blocks(t):
        return jnp.moveaxis(t.reshape((B, nb, Q_BLOCK) + t.shape[2:]), 1, 0)

    def blk(qs):
        q_rot, q_plain = qs
        return _diff_attend([(q_rot, kr, v), (q_plain, kc, vc)], lam)

    o = lax.map(blk, (to_blocks(qr), to_blocks(q)))
    return jnp.moveaxis(o, 0, 1).reshape((B, T) + o.shape[3:])


def _diff_out(o, subln_g, lam_init):
    B, T = o.shape[:2]
    of = o.astype(jnp.float32)
    of = of * lax.rsqrt(jnp.mean(jnp.square(of), axis=-1, keepdims=True) + HEAD_NORM_EPS) * subln_g * (1.0 - lam_init)
    return of.reshape(B, T, D_A).astype(o.dtype)


def _fourier(pf):
    B, T, _ = pf.shape
    z = jnp.fft.fftn(pf.astype(jnp.float32).reshape(B, T, F_GROUPS, F_GROUP_W), axes=(1, 3), norm='ortho')
    return z.real.reshape(B, T, D_F).astype(pf.dtype)


def _heads(t):
    return t.reshape(t.shape[:-1] + (HC, HS_C))


def _l2norm_heads(t):
    th = _heads(t).astype(jnp.float32)
    th = th / jnp.maximum(jnp.sqrt(jnp.sum(jnp.square(th), axis=-1, keepdims=True)), 1e-12)
    return th.reshape(t.shape).astype(t.dtype)


def _two(t):
    return jnp.broadcast_to(t, (2,) + t.shape)


def _dir_stack(t):
    return _heads(jnp.stack([t[0], jnp.flip(t[1], axis=1)]))


def _wkv_scan(decay, kd, v, kk, b, s0, r=None):
    xs = [decay, kd, v, kk, b] + ([r] if r is not None else [])
    xs = tuple(jnp.moveaxis(t.astype(jnp.float32), 2, 0) for t in xs)

    def step(s, inp):
        w_t, k_t, v_t, kk_t, b_t = inp[:5]
        sk = jnp.einsum('dbhvk,dbhk->dbhv', s, kk_t)
        s = s * w_t[..., None, :] - sk[..., None] * b_t[..., None, :] + v_t[..., None] * k_t[..., None, :]
        y = jnp.einsum('dbhvk,dbhk->dbhv', s, inp[5]) if len(inp) == 6 else None
        return s, y

    s_fin, y = lax.scan(step, s0.astype(jnp.float32), xs)
    return s_fin, (None if y is None else jnp.moveaxis(y, 0, 2))


def _rwkv_state_inputs(cs, lp):
    B, T, _ = cs.shape
    k, v, wd, ad = jnp.split(cs, [D_C, 2 * D_C, 2 * D_C + 2 * LORA_W], axis=-1)
    wd = wd.reshape(B, T, 2, LORA_W)
    ad = ad.reshape(B, T, 2, LORA_A)
    wlog = -jax.nn.softplus(-(lp['w0'][:, None, None, :] + jnp.einsum('btdr,drc->dbtc', jnp.tanh(wd), lp['w2'])).astype(jnp.float32)) - 0.5
    decay = jnp.exp(-jnp.exp(wlog))
    a = jax.nn.sigmoid(lp['a0'][:, None, None, :] + jnp.einsum('btdr,drc->dbtc', ad, lp['a2']))
    kk = _l2norm_heads(k * lp['k_k'])
    kd = k * (1.0 + (a - 1.0) * lp['k_a'])
    b = kk * a
    return v, decay, kd, kk, b


def _rwkv_branch(cs, co, s0, lp, want_out):
    B, T, _ = cs.shape
    v, decay, kd, kk, b = _rwkv_state_inputs(cs, lp)
    scan_in = [_dir_stack(t) for t in (decay, kd, _two(v), _two(kk), b)]
    if not want_out:
        s_fin, _ = _wkv_scan(*scan_in, s0)
        return s_fin, None
    r, gd = jnp.split(co, [D_C], axis=-1)
    s_fin, y = _wkv_scan(*scan_in, s0, r=_dir_stack(_two(r)))
    y = y[0] + jnp.flip(y[1], axis=1)
    mu = jnp.mean(y, axis=-1, keepdims=True)
    var = jnp.mean(jnp.square(y - mu), axis=-1, keepdims=True)
    yn = (y - mu) * lax.rsqrt(var + GN_EPS) * _heads(lp['ln_w']) + _heads(lp['ln_b'])
    bonus = jnp.sum(_heads(r)[None] * _heads(kd) * lp['r_k'], axis=(0, -1))[..., None] * _heads(v)
    g = jax.nn.sigmoid(gd) @ lp['g2']
    return s_fin, (yn.astype(v.dtype) + bonus).reshape(B, T, D_C) * g


def _merge(gate_pre, o_a, o_f, o_c, lp):
    g = jax.nn.sigmoid(gate_pre).reshape(gate_pre.shape[:-1] + (N_BRANCH, D_MODEL))
    y = g[..., 0, :] * (o_a @ lp['w_pa']) + g[..., 1, :] * (o_f @ lp['w_pf']) + g[..., 2, :] * (o_c @ lp['w_pc'])
    return y @ lp['w_o']


def _ctx_mixer(hc, lp, lam, lam_init, want_out):
    B, L, _ = hc.shape
    P = _in_proj(hc, lp['w_in'], None if want_out else ('k', 'v', 'cs'))
    k = P['k'].reshape(B, L, HA, 2, DH_A)
    v = P['v'].reshape(B, L, HA, DV_A)
    cs = _token_shift(P['cs'], lp['mu'][:, :D_CS])
    s0 = jnp.zeros((2, B, HC, HS_C, HS_C), jnp.float32)
    if not want_out:
        s_fin, _ = _rwkv_branch(cs, None, s0, lp, False)
        return (k, v, s_fin), None
    co = _token_shift(P['co'], lp['mu'][:, D_CS:])
    s_fin, o_c = _rwkv_branch(cs, co, s0, lp, True)
    q = P['q'].reshape(B, L, HA, 2, DH_A)
    o_a = _diff_out(_diff_attend([(q, k, v)], lam), lp['subln'], lam_init)
    o_f = _fourier(P['f'])
    return (k, v, s_fin), _merge(P['gate'], o_a, o_f, o_c, lp)


def _latent_mixer(h, lp, lam, lam_init, cache, cos, sin):
    kc, vc, s_ctx = cache
    B, T, _ = h.shape
    P = _in_proj(h, lp['w_in'])
    q = P['q'].reshape(B, T, HA, 2, DH_A)
    k = P['k'].reshape(B, T, HA, 2, DH_A)
    v = P['v'].reshape(B, T, HA, DV_A)
    o_a = _diff_out(_latent_diff_attn(q, k, v, kc, vc, cos, sin, lam), lp['subln'], lam_init)
    o_f = _fourier(P['f'])
    cs = _token_shift(P['cs'], lp['mu'][:, :D_CS])
    co = _token_shift(P['co'], lp['mu'][:, D_CS:])
    _, o_c = _rwkv_branch(cs, co, s_ctx, lp, True)
    return _merge(P['gate'], o_a, o_f, o_c, lp)


def _conv_ffn(h, lp):
    u, g = jnp.split(h @ lp['ffn_up'], 2, axis=-1)
    g = _dwconv3(g, lp['ffn_conv'], lp['ffn_conv_b'])
    return (jax.nn.gelu(g, approximate=False) * u) @ lp['ffn_down']


def setup_inputs(seed: int = 0) -> dict:
    key = jax.random.key(seed)
    ks = iter(jax.random.split(key, 40))
    f32 = jnp.float32
    L, D = DEPTH, D_MODEL
    beta = (8.0 * DEPTH) ** -0.25

    def nrm(shape, scale):
        return scale * jax.random.normal(next(ks), shape, f32)

    def unif(shape, lo, hi):
        return jax.random.uniform(next(ks), shape, f32, lo, hi)

    return {
        'x': nrm((BATCH, SEQ, D), 1.0),
        'c': nrm((BATCH, D), 1.0),
        'ctx': nrm((BATCH, CTX_LEN, D), 1.0),
        'c_ctx': nrm((D,), 1.0),
        'ada_w': nrm((L, D, 6 * D), 0.5 * D ** -0.5),
        'ada_b': nrm((L, 6 * D), 0.01),
        'w_in': nrm((L, D, D_IN), D ** -0.5),
        'lam_qk': nrm((L, 4, DH_A), 0.1),
        'subln_g': 1.0 + nrm((L, DV_A), 0.02),
        'tshift_mu': unif((L, 2, D_CS + D_CO), 0.0, 0.5),
        'rw_w0': unif((L, 2, D_C), -5.0, 0.0),
        'rw_w2': nrm((L, 2, LORA_W, D_C), 0.5 * LORA_W ** -0.5),
        'rw_a0': nrm((L, 2, D_C), 0.5),
        'rw_a2': nrm((L, 2, LORA_A, D_C), 0.5 * LORA_A ** -0.5),
        'rw_g2': nrm((L, LORA_G, D_C), LORA_G ** -0.5),
        'rw_kk': 1.0 + nrm((L, D_C), 0.1),
        'rw_ka': 1.0 + nrm((L, D_C), 0.1),
        'rw_rk': nrm((L, HC, HS_C), 0.1),
        'rw_lnw': 1.0 + nrm((L, D_C), 0.02),
        'rw_lnb': nrm((L, D_C), 0.02),
        'w_pa': nrm((L, D_A, D), D_A ** -0.5),
        'w_pf': nrm((L, D_F, D), D_F ** -0.5),
        'w_pc': nrm((L, D_C, D), D_C ** -0.5),
        'w_o': nrm((L, D, D), beta * D ** -0.5),
        'ln1_g': 1.0 + nrm((L, D), 0.02),
        'ln1_b': nrm((L, D), 0.02),
        'ffn_up': nrm((L, D, 2 * D_FF), D ** -0.5),
        'ffn_conv': nrm((L, CONV_W, D_FF), CONV_W ** -0.5),
        'ffn_conv_b': nrm((L, D_FF), 0.02),
        'ffn_down': nrm((L, D_FF, D), beta * D_FF ** -0.5),
        'ln2_g': 1.0 + nrm((L, D), 0.02),
        'ln2_b': nrm((L, D), 0.02),
    }


def reference(x, c, ctx, c_ctx, ada_w, ada_b, w_in, lam_qk, subln_g, tshift_mu,
              rw_w0, rw_w2, rw_a0, rw_a2, rw_g2, rw_kk, rw_ka, rw_rk, rw_lnw, rw_lnb,
              w_pa, w_pf, w_pc, w_o, ln1_g, ln1_b, ffn_up, ffn_conv, ffn_conv_b, ffn_down,
              ln2_g, ln2_b):
    alpha = (2.0 * DEPTH) ** 0.25
    cos, sin = _rope_angles(x.shape[1])
    xc = ctx
    for i in range(DEPTH):
        last = i == DEPTH - 1
        lam_init = 0.8 - 0.6 * math.exp(-0.3 * i)
        lq = lam_qk[i].astype(jnp.float32)
        lam = jnp.exp(jnp.sum(lq[0] * lq[1])) - jnp.exp(jnp.sum(lq[2] * lq[3])) + lam_init
        lp = {'w_in': w_in[i], 'subln': subln_g[i], 'mu': tshift_mu[i],
              'w0': rw_w0[i], 'w2': rw_w2[i], 'a0': rw_a0[i], 'a2': rw_a2[i], 'g2': rw_g2[i],
              'k_k': rw_kk[i], 'k_a': rw_ka[i], 'r_k': rw_rk[i], 'ln_w': rw_lnw[i], 'ln_b': rw_lnb[i],
              'w_pa': w_pa[i], 'w_pf': w_pf[i], 'w_pc': w_pc[i], 'w_o': w_o[i],
              'ffn_up': ffn_up[i], 'ffn_conv': ffn_conv[i], 'ffn_conv_b': ffn_conv_b[i], 'ffn_down': ffn_down[i]}
        mod = [m[:, None, :] for m in jnp.split(jax.nn.silu(c) @ ada_w[i] + ada_b[i], 6, axis=-1)]
        mod_c = jnp.split(jax.nn.silu(c_ctx) @ ada_w[i] + ada_b[i], 6, axis=-1)
        cache, ctx_mix = _ctx_mixer(_modulate(xc, mod_c[0], mod_c[1]), lp, lam, lam_init, not last)
        lat_mix = _latent_mixer(_modulate(x, mod[0], mod[1]), lp, lam, lam_init, cache, cos, sin)
        x = _layernorm(alpha * x + mod[2] * lat_mix, ln1_g[i], ln1_b[i])
        x = _layernorm(alpha * x + mod[5] * _conv_ffn(_modulate(x, mod[3], mod[4]), lp), ln2_g[i], ln2_b[i])
        if not last:
            xc = _layernorm(alpha * xc + mod_c[2] * ctx_mix, ln1_g[i], ln1_b[i])
            xc = _layernorm(alpha * xc + mod_c[5] * _conv_ffn(_modulate(xc, mod_c[3], mod_c[4]), lp), ln2_g[i], ln2_b[i])
    return x
```

```cpp
#include <hip/hip_runtime.h>
#include <hip/hip_bf16.h>
#include <cstdio>
#include <cstdint>
#include <cmath>

#ifndef DBG_ZERO_MIX
#define DBG_ZERO_MIX 0
#endif
#ifndef DBG_ZERO_FFN
#define DBG_ZERO_FFN 0
#endif
#ifndef DBG_BR
#define DBG_BR 7
#endif
#define GAS __attribute__((address_space(1)))
#define LAS __attribute__((address_space(3)))
typedef unsigned short bf16_t;
typedef short bf16x8 __attribute__((ext_vector_type(8)));
typedef short s16x4 __attribute__((ext_vector_type(4)));
typedef float f32x4 __attribute__((ext_vector_type(4)));
typedef float f32x2 __attribute__((ext_vector_type(2)));
typedef float f32x16 __attribute__((ext_vector_type(16)));
typedef unsigned u32x4 __attribute__((ext_vector_type(4)));
typedef unsigned u32x2 __attribute__((ext_vector_type(2)));
typedef GAS unsigned gu32;

constexpr int DM = 1024, NBATCH = 4, SEQ = 4096, CTXL = 256, NLAYER = 2;
constexpr int ML = NBATCH * SEQ, MC = NBATCH * CTXL, MT = ML + MC;
constexpr int D_IN_SRC = 8576, NP = 5632, NGATE = 3072, DFF = 2816, DCS = 1280, DCO = 640, DCOP = 768;
constexpr float LN_EPS = 1e-5f, ALPHA = 1.4142135623730951f;
constexpr int NWAVES = 8, NTHREADS = 512;

constexpr size_t MiB = 1u << 20;
constexpr size_t WS_CTL = 0, CTL_ZERO_BYTES = 1 * MiB;
constexpr size_t WS_TAB = 1 * MiB;
constexpr size_t TAB_MOD = WS_TAB + 0;
constexpr size_t TAB_LAM = WS_TAB + 256 * 1024;
constexpr size_t TAB_ROPE = WS_TAB + 260 * 1024;
constexpr size_t TAB_TW = WS_TAB + 272 * 1024;
constexpr size_t TAB_W0 = WS_TAB + 320 * 1024;
constexpr size_t TAB_F1 = WS_TAB + 384 * 1024;
constexpr size_t TAB_F2 = WS_TAB + 512 * 1024;
constexpr size_t TAB_DC = WS_TAB + 768 * 1024;
constexpr size_t WS_XC = 3 * MiB;
constexpr size_t WS_BON = 7 * MiB;
constexpr size_t WS_W = 9 * MiB;
constexpr size_t W_IN = WS_W, W_PA = WS_W + 17 * MiB, W_PF = WS_W + 19 * MiB, W_PC = WS_W + 20 * MiB, W_O = WS_W + 21 * MiB,
                 W_UP = WS_W + 23 * MiB, W_DN = WS_W + 34 * MiB, W_G2T = WS_W + 39 * MiB + 512 * 1024;
constexpr size_t WS_P = 49 * MiB;
constexpr size_t P_Q = WS_P, P_K = P_Q + (size_t)MT * 1024 * 2, P_F = P_K + (size_t)MT * 1024 * 2, P_V = P_F + (size_t)MT * 512 * 2,
                 P_CS = P_V + (size_t)MT * 1024 * 2, P_CO = P_CS + (size_t)MT * DCS * 2, P_END = P_CO + (size_t)MT * DCOP * 2;
constexpr size_t WS_HY = 236 * MiB, WS_END = 270 * MiB;
static_assert(P_END == WS_HY, "P region is exactly 187 MiB");
static_assert(P_END - P_V == (size_t)MT * NGATE * 2, "gate buffer == v|cs|co");
static_assert(WS_HY + (size_t)MT * 1024 * 2 == WS_END, "HY region 34 MiB");
constexpr int CW_TMO = 0, CW_QUEUE = 64  , CW_BAR = 4096;

constexpr int RING_BYTES = 131072, LDSCTL_OFF = RING_BYTES, MISC_OFF = LDSCTL_OFF + 320, LDS_BYTES = 147456;

#define LDS_WAIT() asm volatile("s_waitcnt lgkmcnt(0)" ::: "memory")
#define VM_WAIT() asm volatile("s_waitcnt vmcnt(0)" ::: "memory")
#define RLX_AGENT __ATOMIC_RELAXED, __HIP_MEMORY_SCOPE_AGENT

typedef __bf16 bf16x2_t __attribute__((ext_vector_type(2)));
__device__ __forceinline__ unsigned cvt_pk_bf16(float lo, float hi) { f32x2 v = {lo, hi}; bf16x2_t b = __builtin_convertvector(v, bf16x2_t); return __builtin_bit_cast(unsigned, b); }
__device__ __forceinline__ float bf2f(unsigned short h) { return __uint_as_float((unsigned)h << 16); }
__device__ __forceinline__ float bflo(unsigned w) { return __uint_as_float(w << 16); }
__device__ __forceinline__ float bfhi(unsigned w) { return __uint_as_float(w & 0xffff0000u); }
__device__ __forceinline__ float sigmoidf_(float x) { return 1.f / (1.f + __expf(-x)); }
__device__ __forceinline__ float wave_sum(float v) {
#pragma unroll
    for (int o = 1; o < 64; o <<= 1) v += __shfl_xor(v, o);
    return v;
}

#define XB_TMO      128
#define XB_XCNT(j)  (256  + 64 * (j))
#define XB_XSUB(j)  (1280 + 64 * (j))
#define XB_XGEN(j)  (2304 + 64 * (j))
#define XB_TOP      3328
#define XB_TOPGEN   3392
#define XCD_BAR_WORDS 3456
#define XB_SPIN_CAP (1u << 22)
__device__ __forceinline__ unsigned xb_ld(unsigned* p)              { return __hip_atomic_load(p, __ATOMIC_RELAXED, __HIP_MEMORY_SCOPE_AGENT); }
__device__ __forceinline__ unsigned xb_add(unsigned* p, unsigned v) { return __hip_atomic_fetch_add(p, v, __ATOMIC_RELAXED, __HIP_MEMORY_SCOPE_AGENT); }
__device__ __forceinline__ unsigned xb_xcc_id() { return (unsigned)__builtin_amdgcn_s_getreg((3 << 11) | 20) & 0xFu; }
#define XB_SPIN(cond, bar) do { unsigned _sp = 0; while (cond) { __builtin_amdgcn_s_sleep(1); \
    if ((++_sp & 255u) == 0u) { if (xb_ld(&(bar)[XB_TMO])) break; if (_sp > XB_SPIN_CAP) { atomicAdd(&(bar)[XB_TMO], 1u); break; } } } } while (0)
struct XcdBarrier { unsigned* bar; unsigned x; volatile LAS unsigned* st; };
__device__ __forceinline__ XcdBarrier xcd_barrier_post(unsigned* bar, volatile LAS unsigned* st) {
    XcdBarrier b; b.bar = bar; b.x = xb_xcc_id(); b.st = st;
    if (threadIdx.x == 0) (void)xb_add(&bar[XB_XCNT(b.x)], 1u);
    return b;
}
__device__ __forceinline__ void xcd_barrier_complete(unsigned* bar, unsigned x, unsigned& nloc, unsigned& nx) {
    const unsigned G = gridDim.x * gridDim.y * gridDim.z;
    unsigned sum, cnt, mine, sp = 0u;
    for (;;) {
        sum = 0u; cnt = 0u; mine = 0u;
#pragma unroll
        for (unsigned j = 0; j < 16; ++j) { const unsigned c = xb_ld(&bar[XB_XCNT(j)]); sum += c; cnt += (c > 0u) ? 1u : 0u; mine = (j == x) ? c : mine; }
        if (sum == G) break;
        __builtin_amdgcn_s_sleep(1);
        if ((++sp & 255u) == 0u) { if (xb_ld(&bar[XB_TMO])) break; if (sp > XB_SPIN_CAP) { atomicAdd(&bar[XB_TMO], 1u); break; } }
    }
    nloc = mine > 0u ? mine : 1u; nx = cnt > 0u ? cnt : 1u;
}
__device__ __attribute__((noinline)) void xcd_barrier(unsigned* bar_, unsigned bx_, volatile LAS unsigned* st_) {
    XcdBarrier b; b.bar = bar_; b.x = bx_; b.st = st_;
    asm volatile("s_waitcnt vmcnt(0)" ::: "memory");
    __syncthreads();
    if (threadIdx.x == 0) {
        unsigned* bar = b.bar;
        __builtin_amdgcn_s_waitcnt(0);
        unsigned nloc = b.st[0], nx = b.st[1];
        if (nloc == 0u) { xcd_barrier_complete(bar, b.x, nloc, nx); b.st[0] = nloc; b.st[1] = nx; }
        const unsigned old = xb_add(&bar[XB_XSUB(b.x)], 1u);
        const unsigned gen = old / nloc;
        if (old + 1u == (gen + 1u) * nloc) {
            __builtin_amdgcn_fence(__ATOMIC_RELEASE, "agent");
            asm volatile("s_waitcnt vmcnt(0)" ::: "memory");
            const unsigned og = xb_add(&bar[XB_TOP], 1u);
            const unsigned tg = og / nx;
            if (og + 1u == (tg + 1u) * nx) xb_add(&bar[XB_TOPGEN], 1u);
            else XB_SPIN(xb_ld(&bar[XB_TOPGEN]) == tg, bar);
            __builtin_amdgcn_fence(__ATOMIC_ACQUIRE, "agent");
            xb_add(&bar[XB_XGEN(b.x)], 1u);
            asm volatile("s_waitcnt vmcnt(0)" ::: "memory");
        } else {
            XB_SPIN(xb_ld(&bar[XB_XGEN(b.x)]) == gen, bar);
            __builtin_amdgcn_fence(__ATOMIC_ACQUIRE, "agent");
            asm volatile("s_waitcnt vmcnt(0)" ::: "memory");
        }
    }
    __syncthreads();
}

namespace pg8 {
#define PG8_LAS __attribute__((address_space(3)))
constexpr int BM = 256, BK = 64, HALF = 128, HTB = HALF * BK * 2, STAGE_BYTES = 8 * HTB, NXCD = 8, WGM = 8;
__host__ __device__ __forceinline__ int lds_byte(int r, int c) { const int st = (r >> 4) * 2 + (c >> 5), rr = r & 15, cc = c & 31, ob = rr * 64 + cc * 2; return st * 1024 + (ob ^ (((ob >> 9) & 1) << 5)); }
__host__ __device__ __forceinline__ void stage_rc(int b, int& R, int& C) { const int st = b / 1024, sb = b % 1024, swz = sb ^ (((sb >> 9) & 1) << 5); R = (st >> 1) * 16 + swz / 64; C = (st & 1) * 32 + (swz % 64) / 2; }
__host__ __device__ __forceinline__ int perm32(int rho) { const int n = rho >> 4, i = rho & 15; return 8 * (i >> 2) + 4 * n + (i & 3); }
struct Unit { int pm, pn; };
struct Operand { const char* base; long tM, tN, tN2; int nshift; long rstride; long hstep; long kstep;
    __device__ __forceinline__ long tile(const Unit& u) const { return (long)u.pm * tM + (long)(u.pn & ((1 << nshift) - 1)) * tN + (long)(u.pn >> nshift) * tN2; }
    __device__ __forceinline__ unsigned row(int R) const { return (unsigned)((long)R * rstride); } };
struct StaticOrder {
    int nM, nN, nwg, G, c;
    __host__ __device__ void init(int M, int N, int G_, int c_) { nM = M / BM; nN = N / BM; nwg = nM * nN; G = G_; c = c_; }
    __host__ __device__ bool next(int i, Unit& u) const {
        const long L = (long)i * G + c; if (L >= nwg) return false;
        int wgid = (int)L; { const int q = nwg / NXCD, r = nwg % NXCD, xcd = wgid % NXCD, off = wgid / NXCD; wgid = (xcd < r ? xcd * (q + 1) : r * (q + 1) + (xcd - r) * q) + off; }
        const int nig = WGM * nN, gid = wgid / nig, fm = gid * WGM, gsz = (nM - fm) < WGM ? (nM - fm) : WGM;
        u.pm = fm + ((wgid % nig) % gsz); u.pn = (wgid % nig) / gsz; return true;
    }
};

template <class Epi, class RowMapB, bool ALIGN_EPI>
__device__ __forceinline__ void gemm_phase(PG8_LAS unsigned char* lds, const Operand A, const Operand B, const RowMapB bmap, const int nt, const StaticOrder& S, const Epi& E) {
    int tid = threadIdx.x; asm volatile("" : "+v"(tid));
    const int wid = __builtin_amdgcn_readfirstlane(tid >> 6), lane = tid & 63, wr = wid >> 2, wc = wid & 3, fr = lane & 15, fq = lane >> 4;
    unsigned voffA[2], voffB[2];
#pragma unroll
    for (int i = 0; i < 2; ++i) { int R, C; stage_rc(tid * 16 + i * 8192, R, C); const int Rb = Epi::PERM ? ((R & ~31) + perm32(R & 31)) : R;
        voffA[i] = A.row(R) + (unsigned)C * 2u; voffB[i] = bmap(Rb) + (unsigned)C * 2u; }
    const long kA = A.kstep, kB = B.kstep, hA = A.hstep, hB = B.hstep;
    const unsigned ldsw = (unsigned)wid * 1024u;
    const int aoff = lds_byte(wr * 64 + fr, fq * 8), boff = lds_byte(wc * 32 + fr, fq * 8);
#define PG8_SA(b, h) (((b) * 2 + (h)) * HTB)
#define PG8_SB(b, h) ((4 + (b) * 2 + (h)) * HTB)
#define PG8_STAGE(bufoff, gbase, voff) do { _Pragma("unroll") for (int _i = 0; _i < 2; ++_i) \
        __builtin_amdgcn_global_load_lds((const unsigned*)((const char*)(gbase) + (voff)[_i]), (PG8_LAS unsigned*)(lds + (bufoff) + ldsw + _i * 8192), 16, 0, 0); } while (0)
#define PG8_LDA(dst, b, h) do { _Pragma("unroll") for (int m = 0; m < 4; ++m) _Pragma("unroll") for (int k = 0; k < 2; ++k) dst[m][k] = *(const PG8_LAS bf16x8*)(lds + PG8_SA(b, h) + aoff + m * 2048 + k * 1024); } while (0)
#define PG8_LDB(dst, b, h) do { _Pragma("unroll") for (int n = 0; n < 2; ++n) _Pragma("unroll") for (int k = 0; k < 2; ++k) dst[n][k] = *(const PG8_LAS bf16x8*)(lds + PG8_SB(b, h) + boff + n * 2048 + k * 1024); } while (0)
#define PG8_MMA(ai, bj, At, Bt) do { __builtin_amdgcn_s_setprio(1); _Pragma("unroll") for (int m = 0; m < 4; ++m) _Pragma("unroll") for (int n = 0; n < 2; ++n) _Pragma("unroll") for (int k = 0; k < 2; ++k) \
        acc[ai][bj][m][n] = __builtin_amdgcn_mfma_f32_16x16x32_bf16(Bt[n][k], At[m][k], acc[ai][bj][m][n], 0, 0, 0); __builtin_amdgcn_s_setprio(0); } while (0)
#define PG8_WAIT_V(n) asm volatile("s_waitcnt vmcnt(" #n ")" ::: "memory")
#define PG8_WAIT_L(n) asm volatile("s_waitcnt lgkmcnt(" #n ")" ::: "memory")
#define PG8_BAR __builtin_amdgcn_s_barrier()
#define PG8_SCHED __builtin_amdgcn_sched_barrier(0)
    Unit cur, nxt; int ui = 0;
    if (!S.next(0, cur)) return;
    f32x4 acc[2][2][4][2];
#pragma unroll
    for (int a = 0; a < 2; ++a)
#pragma unroll
        for (int b = 0; b < 2; ++b)
#pragma unroll
            for (int m = 0; m < 4; ++m)
#pragma unroll
                for (int n = 0; n < 2; ++n) acc[a][b][m][n] = (f32x4){0.f, 0.f, 0.f, 0.f};
    bf16x8 At[4][2], B0[2][2], B1[2][2];
    const char* cA = A.base + A.tile(cur); const char* cB = B.base + B.tile(cur);
    PG8_STAGE(PG8_SB(0, 0), cB, voffB); PG8_STAGE(PG8_SB(0, 1), cB + hB, voffB); PG8_STAGE(PG8_SA(0, 0), cA, voffA); PG8_STAGE(PG8_SA(0, 1), cA + hA, voffA);
    if (wr == 1) PG8_BAR;
    PG8_WAIT_V(2); PG8_BAR;
    PG8_STAGE(PG8_SB(1, 0), cB + kB, voffB); PG8_STAGE(PG8_SA(1, 0), cA + kA, voffA); PG8_STAGE(PG8_SB(1, 1), cB + hB + kB, voffB);
    PG8_WAIT_V(6); PG8_BAR;
    for (;;) {
        const bool has_next = S.next(ui + 1, nxt);
        const char* nA = has_next ? A.base + A.tile(nxt) : cA; const char* nB = has_next ? B.base + B.tile(nxt) : cB;
        for (int t = 0; t < nt; t += 2) {
            const bool last = (t == nt - 2);
            asm volatile("" : "+v"(voffA[0]), "+v"(voffA[1]), "+v"(voffB[0]), "+v"(voffB[1]));
            const char* a1 = cA + (long)(t + 1) * kA;
            const char* a2 = last ? nA : cA + (long)(t + 2) * kA; const char* b2 = last ? nB : cB + (long)(t + 2) * kB;
            const char* a3 = a2 + kA; const char* b3 = b2 + kB;
            PG8_LDB(B0, 0, 0); PG8_LDB(B1, 0, 1); PG8_SCHED; PG8_LDA(At, 0, 0); PG8_STAGE(PG8_SA(1, 1), a1 + hA, voffA);
            PG8_WAIT_V(8); PG8_WAIT_L(0); PG8_BAR; PG8_MMA(0, 0, At, B0); PG8_MMA(0, 1, At, B1); PG8_BAR; PG8_SCHED;
            PG8_LDA(At, 0, 1); PG8_STAGE(PG8_SB(0, 0), b2, voffB); PG8_STAGE(PG8_SB(0, 1), b2 + hB, voffB); PG8_STAGE(PG8_SA(0, 0), a2, voffA);
            PG8_WAIT_V(8); PG8_WAIT_L(0); PG8_BAR; PG8_MMA(1, 0, At, B0); PG8_MMA(1, 1, At, B1); PG8_BAR; PG8_SCHED;
            PG8_LDB(B0, 1, 0); PG8_LDB(B1, 1, 1); PG8_SCHED; PG8_LDA(At, 1, 0); PG8_STAGE(PG8_SA(0, 1), a2 + hA, voffA);
            PG8_WAIT_V(8); PG8_WAIT_L(0); PG8_BAR; PG8_MMA(0, 0, At, B0); PG8_MMA(0, 1, At, B1); PG8_BAR; PG8_SCHED;
            PG8_LDA(At, 1, 1); PG8_STAGE(PG8_SB(1, 0), b3, voffB); PG8_STAGE(PG8_SB(1, 1), b3 + hB, voffB); PG8_STAGE(PG8_SA(1, 0), a3, voffA);
            PG8_WAIT_V(8); PG8_WAIT_L(0); PG8_BAR; PG8_MMA(1, 0, At, B0); PG8_MMA(1, 1, At, B1); PG8_BAR; PG8_SCHED;
        }
        if constexpr (ALIGN_EPI) { if (wr == 0) PG8_BAR; }
        if constexpr (!Epi::AFTER_DRAIN) { E(acc, cur, wr, wc, fr, fq); }
        if (!has_next) break;
#pragma unroll
        for (int a = 0; a < 2; ++a)
#pragma unroll
            for (int b = 0; b < 2; ++b)
#pragma unroll
                for (int m = 0; m < 4; ++m)
#pragma unroll
                    for (int n = 0; n < 2; ++n) acc[a][b][m][n] = (f32x4){0.f, 0.f, 0.f, 0.f};
        cur = nxt; cA = nA; cB = nB; ++ui;
        if constexpr (ALIGN_EPI) { if (wr == 1) PG8_BAR; }
    }
    PG8_WAIT_V(0);
    if constexpr (!ALIGN_EPI) { if (wr == 0) PG8_BAR; }
    PG8_BAR;
    if constexpr (Epi::AFTER_DRAIN) { E.fused(acc, cur, wr, wc, fr, fq, lds, wid, lane); }
#undef PG8_SA
#undef PG8_SB
#undef PG8_STAGE
#undef PG8_LDA
#undef PG8_LDB
#undef PG8_MMA
#undef PG8_WAIT_V
#undef PG8_WAIT_L
#undef PG8_BAR
#undef PG8_SCHED
}
struct RowLin { long rstride; __device__ __forceinline__ unsigned operator()(int R) const { return (unsigned)((long)R * rstride); } };
}
namespace pg8 {
__device__ __forceinline__ u32x2 pk4(f32x4 v) { u32x2 w; w.x = cvt_pk_bf16(v[0], v[1]); w.y = cvt_pk_bf16(v[2], v[3]); return w; }
__device__ __forceinline__ f32x4 up4(u32x2 w) { return (f32x4){bflo(w.x), bfhi(w.x), bflo(w.y), bfhi(w.y)}; }
__device__ __forceinline__ float fast_sigmoid(float x) { return __builtin_amdgcn_rcpf(1.f + __expf(-x)); }
#define EPI_ROWS(ai, m) _Pragma("unroll") for (int ai = 0; ai < 2; ++ai) _Pragma("unroll") for (int m = 0; m < 4; ++m)

struct EpiInProj {
    static constexpr bool PERM = false, AFTER_DRAIN = false;
    unsigned char* ws; const float* rope;
    __device__ __forceinline__ void operator()(const f32x4 (&acc)[2][2][4][2], const Unit& u, int wr, int wc, int fr, int fq) const {
        asm volatile("" : "+v"(fr), "+v"(fq));
        const int pn = u.pn; size_t boff; int pitch, c0;
        if (pn < 4) { boff = P_Q; pitch = 1024; c0 = 256 * pn; }
        else if (pn < 8) { boff = P_K; pitch = 1024; c0 = 256 * (pn - 4); }
        else if (pn < 12) { boff = P_V; pitch = 1024; c0 = 256 * (pn - 8); }
        else if (pn < 14) { boff = P_F; pitch = 512; c0 = 256 * (pn - 12); }
        else if (pn < 19) { boff = P_CS; pitch = DCS; c0 = 256 * (pn - 14); }
        else { boff = P_CO; pitch = DCOP; c0 = 256 * (pn - 19); }
        bf16_t* base = (bf16_t*)(ws + boff);
        const bool dorope = (pn >= 4 && pn < 8 && u.pm < ML / 256);
        EPI_ROWS(ai, m) {
            const int R = 128 * ai + 64 * wr + 16 * m + fr; const size_t grow = (size_t)u.pm * 256 + R;
            f32x4 cc = (f32x4){1.f, 1.f, 1.f, 1.f}, ss = (f32x4){0.f, 0.f, 0.f, 0.f};
            if (dorope) { const int t = (int)(grow & 4095); const int pos = (wc & 1) ? (t & 63) : (t >> 6);
                const f32x4 a = *(const f32x4*)(rope + (pos * 16 + 4 * fq) * 2), b = *(const f32x4*)(rope + (pos * 16 + 4 * fq) * 2 + 4);
                cc = (f32x4){a[0], a[2], b[0], b[2]}; ss = (f32x4){a[1], a[3], b[1], b[3]}; }
            bf16_t* rowp = base + grow * pitch + c0 + 32 * wc + 4 * fq;
#pragma unroll
            for (int bj = 0; bj < 2; ++bj) { const f32x4 x1 = acc[ai][bj][m][0], x2 = acc[ai][bj][m][1];
                const f32x4 y1 = x1 * cc - x2 * ss, y2 = x2 * cc + x1 * ss;
                *(u32x2*)(rowp + 128 * bj) = pk4(y1); *(u32x2*)(rowp + 128 * bj + 16) = pk4(y2); }
        }
    }
};
struct EpiGate {
    static constexpr bool PERM = true, AFTER_DRAIN = false;
    bf16_t* gate;
    __device__ __forceinline__ void operator()(const f32x4 (&acc)[2][2][4][2], const Unit& u, int wr, int wc, int fr, int fq) const {
        asm volatile("" : "+v"(fr), "+v"(fq));
        EPI_ROWS(ai, m) {
            const int R = 128 * ai + 64 * wr + 16 * m + fr; const size_t grow = (size_t)u.pm * 256 + R;
            bf16_t* rowp = gate + grow * NGATE + 256 * u.pn + 32 * wc + 8 * fq;
#pragma unroll
            for (int bj = 0; bj < 2; ++bj) { f32x4 v0 = acc[ai][bj][m][0], v1 = acc[ai][bj][m][1];
#pragma unroll
                for (int e = 0; e < 4; ++e) { v0[e] = fast_sigmoid(v0[e]); v1[e] = fast_sigmoid(v1[e]); }
                u32x4 w; w.x = cvt_pk_bf16(v0[0], v0[1]); w.y = cvt_pk_bf16(v0[2], v0[3]); w.z = cvt_pk_bf16(v1[0], v1[1]); w.w = cvt_pk_bf16(v1[2], v1[3]);
                *(u32x4*)(rowp + 128 * bj) = w; }
        }
    }
};
template <bool FIRST> struct EpiBranch {
    static constexpr bool PERM = true, AFTER_DRAIN = false;
    const bf16_t* gate; bf16_t* ym; float sc;
    __device__ __forceinline__ void operator()(const f32x4 (&acc)[2][2][4][2], const Unit& u, int wr, int wc, int fr, int fq) const {
        asm volatile("" : "+v"(fr), "+v"(fq));
        EPI_ROWS(ai, m) {
            const int R = 128 * ai + 64 * wr + 16 * m + fr; const size_t grow = (size_t)u.pm * 256 + R;
            const int col = 256 * u.pn + 32 * wc + 8 * fq;
#pragma unroll
            for (int bj = 0; bj < 2; ++bj) {
                const u32x4 g = *(const u32x4*)(gate + grow * NGATE + col + 128 * bj);
                f32x4 v0 = acc[ai][bj][m][0], v1 = acc[ai][bj][m][1];
                v0 = v0 * (f32x4){bflo(g.x), bfhi(g.x), bflo(g.y), bfhi(g.y)} * sc; v1 = v1 * (f32x4){bflo(g.z), bfhi(g.z), bflo(g.w), bfhi(g.w)} * sc;
                bf16_t* op = ym + grow * 1024 + col + 128 * bj;
                if (!FIRST) { const u32x4 o = *(const u32x4*)op; v0 = v0 + (f32x4){bflo(o.x), bfhi(o.x), bflo(o.y), bfhi(o.y)}; v1 = v1 + (f32x4){bflo(o.z), bfhi(o.z), bflo(o.w), bfhi(o.w)}; }
                u32x4 w; w.x = cvt_pk_bf16(v0[0], v0[1]); w.y = cvt_pk_bf16(v0[2], v0[3]); w.z = cvt_pk_bf16(v1[0], v1[1]); w.w = cvt_pk_bf16(v1[2], v1[3]);
                *(u32x4*)op = w; }
        }
    }
};
struct EpiF32 {
    static constexpr bool PERM = false, AFTER_DRAIN = false;
    float* out; int ldc;
    __device__ __forceinline__ void operator()(const f32x4 (&acc)[2][2][4][2], const Unit& u, int wr, int wc, int fr, int fq) const {
        asm volatile("" : "+v"(fr), "+v"(fq));
        EPI_ROWS(ai, m) {
            const int R = 128 * ai + 64 * wr + 16 * m + fr; const size_t grow = (size_t)u.pm * 256 + R;
            float* rowp = out + grow * ldc + 256 * u.pn + 32 * wc + 4 * fq;
#pragma unroll
            for (int bj = 0; bj < 2; ++bj)
#pragma unroll
                for (int n = 0; n < 2; ++n) *(f32x4*)(rowp + 128 * bj + 16 * n) = acc[ai][bj][m][n];
        }
    }
};
struct EpiBf16 {
    static constexpr bool PERM = true, AFTER_DRAIN = false;
    bf16_t* out; int ldc;
    __device__ __forceinline__ void operator()(const f32x4 (&acc)[2][2][4][2], const Unit& u, int wr, int wc, int fr, int fq) const {
        asm volatile("" : "+v"(fr), "+v"(fq));
        EPI_ROWS(ai, m) {
            const int R = 128 * ai + 64 * wr + 16 * m + fr; const size_t grow = (size_t)u.pm * 256 + R;
            bf16_t* rowp = out + grow * ldc + 256 * u.pn + 32 * wc + 8 * fq;
#pragma unroll
            for (int bj = 0; bj < 2; ++bj) { const f32x4 v0 = acc[ai][bj][m][0], v1 = acc[ai][bj][m][1];
                u32x4 w; w.x = cvt_pk_bf16(v0[0], v0[1]); w.y = cvt_pk_bf16(v0[2], v0[3]); w.z = cvt_pk_bf16(v1[0], v1[1]); w.w = cvt_pk_bf16(v1[2], v1[3]);
                *(u32x4*)(rowp + 128 * bj) = w; }
        }
    }
};
struct EpiF0 {
    static constexpr bool PERM = false, AFTER_DRAIN = false;
    bf16_t* yt;
    __device__ __forceinline__ void operator()(const f32x4 (&acc)[2][2][4][2], const Unit& u, int wr, int wc, int fr, int fq) const {
        asm volatile("" : "+v"(fr), "+v"(fq));
        EPI_ROWS(ai, m) {
            const int R = 128 * ai + 64 * wr + 16 * m + fr; const int ri = R >> 7, mch = R & 127;
            bf16_t* rowp = yt + (size_t)((ri * 4 + u.pm) * 128 + mch) * ML + 256 * u.pn + 32 * wc + 4 * fq;
#pragma unroll
            for (int bj = 0; bj < 2; ++bj)
#pragma unroll
                for (int n = 0; n < 2; ++n) *(u32x2*)(rowp + 128 * bj + 16 * n) = pk4(acc[ai][bj][m][n]);
        }
    }
};
struct EpiF0c {
    static constexpr bool PERM = false, AFTER_DRAIN = false;
    bf16_t* ytc;
    __device__ __forceinline__ void operator()(const f32x4 (&acc)[2][2][4][2], const Unit& u, int wr, int wc, int fr, int fq) const {
        asm volatile("" : "+v"(fr), "+v"(fq));
        EPI_ROWS(ai, m) {
            const int R = 128 * ai + 64 * wr + 16 * m + fr; const int ri = R >> 7, mch = R & 127;
            bf16_t* rowp = ytc + (size_t)((((u.pn * 4 + u.pm) * 128 + mch) * 2 + ri)) * 256 + 32 * wc + 4 * fq;
#pragma unroll
            for (int bj = 0; bj < 2; ++bj)
#pragma unroll
                for (int n = 0; n < 2; ++n) *(u32x2*)(rowp + 128 * bj + 16 * n) = pk4(acc[ai][bj][m][n]);
        }
    }
};
struct EpiF1 {
    static constexpr bool PERM = false, AFTER_DRAIN = false;
    bf16_t* x1; const float* tw;
    __device__ __forceinline__ void operator()(const f32x4 (&acc)[2][2][4][2], const Unit& u, int wr, int wc, int fr, int fq) const {
        asm volatile("" : "+v"(fr), "+v"(fq));
        const int gp = u.pn >> 7, mch = u.pn & 127, g = 2 * wr + gp;
#pragma unroll
        for (int m = 0; m < 4; ++m) {
            const int kl = 16 * m + fr;
#pragma unroll
            for (int bj = 0; bj < 2; ++bj)
#pragma unroll
                for (int n = 0; n < 2; ++n) {
                    const int colL = 128 * bj + 32 * wc + 16 * n + 4 * fq, tl = colL & 63, bb = colL >> 6;
                    const f32x4 a = *(const f32x4*)(tw + (kl * 64 + tl) * 2), b = *(const f32x4*)(tw + (kl * 64 + tl) * 2 + 4);
                    const f32x4 cc = (f32x4){a[0], a[2], b[0], b[2]}, ss = (f32x4){a[1], a[3], b[1], b[3]};
                    const f32x4 re = acc[0][bj][m][n], im = acc[1][bj][m][n];
                    const f32x4 re2 = re * cc + im * ss, im2 = im * cc - re * ss;
                    const size_t o = ((size_t)bb * 32768 + kl * 512 + g * 128 + mch) * 64 + tl;
                    *(u32x2*)(x1 + o) = pk4(re2); *(u32x2*)(x1 + (size_t)4 * 32768 * 64 + o) = pk4(im2);
                }
        }
    }
};
struct EpiF2 {
    static constexpr bool PERM = false, AFTER_DRAIN = false;
    bf16_t* of;
    __device__ __forceinline__ void operator()(const f32x4 (&acc)[2][2][4][2], const Unit& u, int wr, int wc, int fr, int fq) const {
        asm volatile("" : "+v"(fr), "+v"(fq));
        const int kl = u.pn >> 1, gm0 = (u.pn & 1) * 256;
        EPI_ROWS(ai, m) {
            const int R = 128 * ai + 64 * wr + 16 * m + fr; const int b = R >> 6, kh = R & 63;
            bf16_t* rowp = of + (size_t)(b * 4096 + 64 * kh + kl) * 512 + gm0 + 32 * wc + 4 * fq;
#pragma unroll
            for (int bj = 0; bj < 2; ++bj)
#pragma unroll
                for (int n = 0; n < 2; ++n) *(u32x2*)(rowp + 128 * bj + 16 * n) = pk4(acc[ai][bj][m][n]);
        }
    }
};
struct EpiFc {
    static constexpr bool PERM = false, AFTER_DRAIN = false;
    bf16_t* of;
    __device__ __forceinline__ void operator()(const f32x4 (&acc)[2][2][4][2], const Unit& u, int wr, int wc, int fr, int fq) const {
        asm volatile("" : "+v"(fr), "+v"(fq));
        const int b = u.pn >> 1, gm0 = (u.pn & 1) * 256;
        EPI_ROWS(ai, m) {
            const int R = 128 * ai + 64 * wr + 16 * m + fr;
            bf16_t* rowp = of + (size_t)(ML + b * 256 + R) * 512 + gm0 + 32 * wc + 4 * fq;
#pragma unroll
            for (int bj = 0; bj < 2; ++bj)
#pragma unroll
                for (int n = 0; n < 2; ++n) *(u32x2*)(rowp + 128 * bj + 16 * n) = pk4(acc[ai][bj][m][n]);
        }
    }
};
struct EpiRwkvPost {
    static constexpr bool PERM = false, AFTER_DRAIN = true;
    const bf16_t* y0; const bf16_t* y1; const bf16_t* cs; const float* bon; const float* mu; const float* lnw; const float* lnb; bf16_t* oc;
    __device__ __forceinline__ void fused(f32x4 (&acc)[2][2][4][2], const Unit& u, int wr, int wc, int fr, int fq, PG8_LAS unsigned char* lds, int wid, int lane) const {
        asm volatile("" : "+v"(fr), "+v"(fq));
        PG8_LAS f32x2* P = (PG8_LAS f32x2*)lds;
        EPI_ROWS(ai, m) {
            const int R = 128 * ai + 64 * wr + 16 * m + fr; const size_t grow = (size_t)u.pm * 256 + R;
#pragma unroll
            for (int bj = 0; bj < 2; ++bj) {
                const size_t o = grow * 512 + 256 * u.pn + 128 * bj + 32 * wc + 4 * fq;
                const f32x4 a = up4(*(const u32x2*)(y0 + o)) + up4(*(const u32x2*)(y1 + o)), b = up4(*(const u32x2*)(y0 + o + 16)) + up4(*(const u32x2*)(y1 + o + 16));
                float s = (a[0] + a[1]) + (a[2] + a[3]) + (b[0] + b[1]) + (b[2] + b[3]);
                s += __shfl_xor(s, 16); s += __shfl_xor(s, 32);
                const float mw = s * (1.f / 32.f); const f32x4 da = a - mw, db = b - mw;
                float q = (da[0] * da[0] + da[1] * da[1]) + (da[2] * da[2] + da[3] * da[3]) + (db[0] * db[0] + db[1] * db[1]) + (db[2] * db[2] + db[3] * db[3]);
                q += __shfl_xor(q, 16); q += __shfl_xor(q, 32);
                if (fq == 0) P[(R * 4 + 2 * bj + (wc >> 1)) * 2 + (wc & 1)] = (f32x2){mw, q};
            }
        }
        asm volatile("s_waitcnt lgkmcnt(0)" ::: "memory"); __builtin_amdgcn_s_barrier(); asm volatile("" ::: "memory");
        EPI_ROWS(ai, m) {
            const int R = 128 * ai + 64 * wr + 16 * m + fr; const size_t grow = (size_t)u.pm * 256 + R;
            int pos, len; if (grow < (size_t)ML) { pos = (int)(grow & 4095); len = SEQ; } else { pos = (int)((grow - ML) & 255); len = CTXL; }
            const bool hp = pos > 0, hn = pos < len - 1;
            const size_t rp = hp ? grow - 1 : grow, rn = hn ? grow + 1 : grow;
#pragma unroll
            for (int bj = 0; bj < 2; ++bj) {
                const int hl = 2 * bj + (wc >> 1), head = 4 * u.pn + hl;
                const f32x2 pa = P[(R * 4 + hl) * 2 + 0], pb = P[(R * 4 + hl) * 2 + 1];
                const float mean = 0.5f * (pa.x + pb.x), dm = pa.x - pb.x, var = (pa.y + pb.y + 16.f * dm * dm) * (1.f / 64.f);
                const float rstd = 1.0f / sqrtf(var + 64.f * 1e-5f);
                const float bsum = bon[grow * 8 + head] + bon[(size_t)MT * 8 + grow * 8 + head];
#pragma unroll
                for (int n = 0; n < 2; ++n) {
                    const int c = 256 * u.pn + 128 * bj + 32 * wc + 16 * n + 4 * fq;
                    const size_t o = grow * 512 + c;
                    const f32x4 yv = up4(*(const u32x2*)(y0 + o)) + up4(*(const u32x2*)(y1 + o));
                    const f32x4 w4 = *(const f32x4*)(lnw + c), b4 = *(const f32x4*)(lnb + c);
                    const f32x4 m0 = *(const f32x4*)(mu + 512 + c), m1 = *(const f32x4*)(mu + 1920 + 512 + c);
                    const f32x4 vc = up4(*(const u32x2*)(cs + grow * DCS + 512 + c));
                    f32x4 vp = up4(*(const u32x2*)(cs + rp * DCS + 512 + c)), vn = up4(*(const u32x2*)(cs + rn * DCS + 512 + c));
                    if (!hp) vp = (f32x4){0.f, 0.f, 0.f, 0.f}; if (!hn) vn = (f32x4){0.f, 0.f, 0.f, 0.f};
                    const f32x4 vs = vc + m0 * (vp - vc) + m1 * (vn - vc);
                    const f32x4 yn = (yv - mean) * rstd * w4 + b4;
                    const f32x4 r = (yn + bsum * vs) * acc[ai][bj][m][n];
                    *(u32x2*)(oc + o) = pk4(r);
                }
            }
        }
    }
};
}
namespace attn {
#define SBAR() __builtin_amdgcn_sched_barrier(0)
constexpr int QBLK = 32, KVBLK = 64;
constexpr float SCALE = 0.125f;
constexpr int SHM_V = KVBLK * 128 * 2, SHM_K = KVBLK * 64 * 2;
constexpr int LDS_V = 0, LDS_K = 2 * SHM_V, LDS_WS = LDS_K + 2 * SHM_K, LDS_STASH = LDS_WS + NWAVES * 64 * 4, LDS_END = LDS_STASH + NWAVES * 8192;
static_assert(LDS_END <= RING_BYTES, "attention LDS");
__device__ __forceinline__ int crow(int r, int hi) { return (r & 3) + 8 * (r >> 2) + 4 * hi; }
__device__ __forceinline__ int kswz(int row, int chunk) { return row * 128 + ((chunk ^ ((row >> 1) & 7)) << 4); }

__device__ __forceinline__ void partialSM(f32x16& p0, f32x16& p1, float& m_reg, float& mn, float& alpha) {
    constexpr float C = SCALE * 1.4426950408889634f;
    float pmax = p0[0];
#pragma unroll
    for (int r = 1; r < 16; ++r) pmax = fmaxf(pmax, p0[r]);
#pragma unroll
    for (int r = 0; r < 16; ++r) pmax = fmaxf(pmax, p1[r]);
    { auto rr = __builtin_amdgcn_permlane32_swap(__float_as_uint(pmax), __float_as_uint(pmax), false, false);
      pmax = fmaxf(__uint_as_float(rr[0]), __uint_as_float(rr[1])); }
    if (__builtin_expect(__all(pmax <= m_reg), 1)) { mn = m_reg; alpha = 1.f; }
    else { mn = fmaxf(m_reg, pmax); alpha = __builtin_amdgcn_exp2f((m_reg - mn) * C); m_reg = mn; }
    const float mnC = -mn * C;
#pragma unroll
    for (int r = 0; r < 16; ++r) p0[r] = fmaf(p0[r], C, mnC);
#pragma unroll
    for (int r = 0; r < 16; ++r) p1[r] = fmaf(p1[r], C, mnC);
#pragma unroll
    for (int r = 0; r < 16; ++r) p0[r] = __builtin_amdgcn_exp2f(p0[r]);
}
__device__ __forceinline__ void finishSM(f32x16& p0, f32x16& p1, float alpha, float& l_reg, bf16x8& pa0, bf16x8& pa1, bf16x8& pa2, bf16x8& pa3) {
#pragma unroll
    for (int r = 0; r < 16; ++r) p1[r] = __builtin_amdgcn_exp2f(p1[r]);
    float ps = 0;
#pragma unroll
    for (int r = 0; r < 16; ++r) ps += p0[r];
#pragma unroll
    for (int r = 0; r < 16; ++r) ps += p1[r];
    { auto rr = __builtin_amdgcn_permlane32_swap(__float_as_uint(ps), __float_as_uint(ps), false, false);
      ps = __uint_as_float(rr[0]) + __uint_as_float(rr[1]); }
    l_reg = l_reg * alpha + ps;
#define PK4(P, BASE, OUT) do { unsigned a0 = cvt_pk_bf16(P[BASE + 0], P[BASE + 1]), a1 = cvt_pk_bf16(P[BASE + 2], P[BASE + 3]);   \
    unsigned b0 = cvt_pk_bf16(P[BASE + 4], P[BASE + 5]), b1 = cvt_pk_bf16(P[BASE + 6], P[BASE + 7]);                              \
    auto r0 = __builtin_amdgcn_permlane32_swap(a0, b0, false, false); auto r1 = __builtin_amdgcn_permlane32_swap(a1, b1, false, false); \
    u32x4 w = {r0[0], r1[0], r0[1], r1[1]}; OUT = *reinterpret_cast<bf16x8*>(&w); } while (0)
    PK4(p0, 0, pa0); PK4(p0, 8, pa1); PK4(p1, 0, pa2); PK4(p1, 8, pa3);
#undef PK4
}
__device__ __forceinline__ void qkt(f32x16& p0, f32x16& p1, const LAS char* Ks, const bf16x8 q0, const bf16x8 q1, const bf16x8 q2, const bf16x8 q3, int r32, int hi) {
    p0 = f32x16{}; p1 = f32x16{};
#define QK1(d0, Q) do { const bf16x8 b0 = *(const LAS bf16x8*)(Ks + kswz(r32, 2 * (d0) + hi)); const bf16x8 b1 = *(const LAS bf16x8*)(Ks + kswz(32 + r32, 2 * (d0) + hi)); \
    p0 = __builtin_amdgcn_mfma_f32_32x32x16_bf16(b0, Q, p0, 0, 0, 0); p1 = __builtin_amdgcn_mfma_f32_32x32x16_bf16(b1, Q, p1, 0, 0, 0); } while (0)
    QK1(0, q0); QK1(1, q1); QK1(2, q2); QK1(3, q3);
#undef QK1
}
__device__ __forceinline__ int v_st(int k, int c) { const int kk = (k & ~0xC) | ((k & 4) << 1) | ((k & 8) >> 1); return ((kk >> 3) * 4 + (c >> 5)) * 512 + ((kk & 7) * 32 + (c & 31)) * 2; }
__device__ __forceinline__ int v_rd_base(int lane) { return ((lane & 3) << 3) | (((lane >> 2) & 3) << 6) | (((lane >> 4) & 1) << 5) | (((lane >> 5) & 1) << 8); }
constexpr int v_rd_off(int d0, int ks, int half) { return d0 * 512 + ks * 4096 + half * 2048; }
template <int OFF> __device__ __forceinline__ s16x4 tr_read(int vb) {
    s16x4 r; asm volatile("ds_read_b64_tr_b16 %0, %1 offset:%2" : "=&v"(r) : "v"(vb), "i"(OFF) : "memory"); return r;
}
template <int D0> __device__ __forceinline__ void pv_one(f32x16& od, int vb, bf16x8 pa0, bf16x8 pa1, bf16x8 pa2, bf16x8 pa3) {
    const s16x4 l0 = tr_read<v_rd_off(D0, 0, 0)>(vb), h0 = tr_read<v_rd_off(D0, 0, 1)>(vb), l1 = tr_read<v_rd_off(D0, 1, 0)>(vb), h1 = tr_read<v_rd_off(D0, 1, 1)>(vb);
    const s16x4 l2 = tr_read<v_rd_off(D0, 2, 0)>(vb), h2 = tr_read<v_rd_off(D0, 2, 1)>(vb), l3 = tr_read<v_rd_off(D0, 3, 0)>(vb), h3 = tr_read<v_rd_off(D0, 3, 1)>(vb);
    asm volatile("s_waitcnt lgkmcnt(0)" ::: "memory"); SBAR();
#define PK(L, H) (bf16x8){L[0], L[1], L[2], L[3], H[0], H[1], H[2], H[3]}
    od = __builtin_amdgcn_mfma_f32_32x32x16_bf16(pa0, PK(l0, h0), od, 0, 0, 0);
    od = __builtin_amdgcn_mfma_f32_32x32x16_bf16(pa1, PK(l1, h1), od, 0, 0, 0);
    od = __builtin_amdgcn_mfma_f32_32x32x16_bf16(pa2, PK(l2, h2), od, 0, 0, 0);
    od = __builtin_amdgcn_mfma_f32_32x32x16_bf16(pa3, PK(l3, h3), od, 0, 0, 0);
#undef PK
}
__device__ __forceinline__ void pv_d0(f32x16* o, int vb, bf16x8 pa0, bf16x8 pa1, bf16x8 pa2, bf16x8 pa3) {
    pv_one<0>(o[0], vb, pa0, pa1, pa2, pa3); pv_one<1>(o[1], vb, pa0, pa1, pa2, pa3); pv_one<2>(o[2], vb, pa0, pa1, pa2, pa3); pv_one<3>(o[3], vb, pa0, pa1, pa2, pa3);
}

template <bool LATENT>
__device__ __forceinline__ void attn_unit(const bf16_t* Qb, const bf16_t* Kb, const bf16_t* Vb, bf16_t* Ob, int qrow0, int b, int hh,
                                          float lam, float oscale, const float* __restrict__ subln, const float* __restrict__ rope, LAS char* lds) {
    int tid = threadIdx.x; asm volatile("" : "+v"(tid));
    const int wid = __builtin_amdgcn_readfirstlane(tid >> 6), lane = tid & 63, r32 = lane & 31, hi = lane >> 5;
    LAS char* V_lds = lds + LDS_V; LAS char* K_lds = lds + LDS_K;
    LAS float* wsf = (LAS float*)(lds + LDS_WS) + wid * 64; LAS float* li_l = wsf; LAS float* al_l = wsf + 32;
    LAS unsigned* stash = (LAS unsigned*)(lds + LDS_STASH + wid * 8192);
    constexpr int NT = 64;
    const int ctx0 = ML + b * CTXL, lat0 = b * SEQ;
    const int myrow = qrow0 + wid * QBLK + r32;
    const int ksr = tid >> 3, ksc = tid & 7, kst = kswz(ksr, ksc);
    const int sr = tid >> 4, sc = (tid & 15) * 8, vst0 = v_st(sr, sc), vst1 = v_st(32 + sr, sc);
    const int vb0 = (int)(uintptr_t)V_lds + v_rd_base(lane);
    f32x16 o[4];
#pragma unroll 1
    for (int c = 0; c < 2; ++c) {
        bf16x8 q0, q1, q2, q3;
        { const bf16_t* Qw = Qb + (size_t)myrow * 1024 + hh * 128 + c * 64 + hi * 8;
          q0 = *(const bf16x8*)(Qw); q1 = *(const bf16x8*)(Qw + 16); q2 = *(const bf16x8*)(Qw + 32); q3 = *(const bf16x8*)(Qw + 48); }
        const unsigned voV0 = (unsigned)(sr * 1024 + hh * 128 + sc) * 2u, voK = (unsigned)(ksr * 1024 + hh * 128 + c * 64 + ksc * 8) * 2u;
        float m_reg = -1e30f, l_reg = 0.f;
#pragma unroll
        for (int d = 0; d < 4; ++d) o[d] = f32x16{};
        bf16x8 sv0[1], sv1[1], sk0[1];
#define SLOAD(i, kr) do { unsigned a_ = voV0, b_ = voV0 + 32u * 2048u, c_ = voK; asm volatile("" : "+v"(a_), "+v"(b_), "+v"(c_)); \
        const char* vb_ = (const char*)Vb + (size_t)(kr) * 2048; const char* kb_ = (const char*)Kb + (size_t)(kr) * 2048; \
        sv0[i] = *(const bf16x8*)(vb_ + a_); sv1[i] = *(const bf16x8*)(vb_ + b_); sk0[i] = *(const bf16x8*)(kb_ + c_); } while (0)
#define SWRITE(bb, i) do { *(LAS bf16x8*)(V_lds + (bb) * SHM_V + vst0) = sv0[i]; *(LAS bf16x8*)(V_lds + (bb) * SHM_V + vst1) = sv1[i]; *(LAS bf16x8*)(K_lds + (bb) * SHM_K + kst) = sk0[i]; } while (0)
#define SWAIT() asm volatile("s_waitcnt vmcnt(3)" ::: "memory")
#define RESC(a) do { if (__any((a) < 1.f)) { if (hi == 0) al_l[r32] = (a); asm volatile("s_waitcnt lgkmcnt(0)" ::: "memory"); \
        _Pragma("unroll") for (int d = 0; d < 4; ++d) _Pragma("unroll") for (int r = 0; r < 16; ++r) o[d][r] *= al_l[crow(r, hi)]; } } while (0)
        f32x16 pA0, pA1; float mnA, alA; bf16x8 pa0, pa1, pa2, pa3;
#pragma unroll 1
        for (int j = 0; j < 4; ++j) {
            __syncthreads();
            SLOAD(0, ctx0 + 64 * j); asm volatile("s_waitcnt vmcnt(0)" ::: "memory"); SWRITE(0, 0); __syncthreads();
            qkt(pA0, pA1, K_lds, q0, q1, q2, q3, r32, hi); partialSM(pA0, pA1, m_reg, mnA, alA);
            RESC(alA);
            finishSM(pA0, pA1, alA, l_reg, pa0, pa1, pa2, pa3); SBAR();
            pv_d0(o, vb0, pa0, pa1, pa2, pa3);
        }
        if (LATENT) {
            {
                const int t = myrow & 4095, pos0 = t >> 6, pos1 = t & 63;
                const float* r0p = rope + (pos0 * 16 + 8 * hi) * 2; const float* r1p = rope + (pos1 * 16 + 8 * hi) * 2;
#pragma unroll
                for (int j = 0; j < 8; ++j) {
                    const float c0 = r0p[2 * j], s0 = r0p[2 * j + 1], c1 = r1p[2 * j], s1 = r1p[2 * j + 1];
                    const float x1 = bf2f((unsigned short)q0[j]), x2 = bf2f((unsigned short)q1[j]), z1 = bf2f((unsigned short)q2[j]), z2 = bf2f((unsigned short)q3[j]);
                    const unsigned w0 = cvt_pk_bf16(x1 * c0 - x2 * s0, x2 * c0 + x1 * s0), w1 = cvt_pk_bf16(z1 * c1 - z2 * s1, z2 * c1 + z1 * s1);
                    q0[j] = (short)(w0 & 0xffffu); q1[j] = (short)(w0 >> 16); q2[j] = (short)(w1 & 0xffffu); q3[j] = (short)(w1 >> 16);
                }
            }
            f32x16 pB0, pB1; float mnB, alB;
            __syncthreads();
            SLOAD(0, lat0); asm volatile("s_waitcnt vmcnt(0)" ::: "memory"); SWRITE(0, 0); __syncthreads();
            qkt(pA0, pA1, K_lds, q0, q1, q2, q3, r32, hi); partialSM(pA0, pA1, m_reg, mnA, alA);
            RESC(alA);
            SLOAD(0, lat0 + 64);
            asm volatile("s_waitcnt vmcnt(0)" ::: "memory"); SWRITE(1, 0); __syncthreads();
#pragma unroll 1
            for (int j = 1; j + 1 < NT; j += 2) {
                SBAR(); qkt(pB0, pB1, K_lds + SHM_K, q0, q1, q2, q3, r32, hi);
                finishSM(pA0, pA1, alA, l_reg, pa0, pa1, pa2, pa3); SBAR();
                SLOAD(0, lat0 + 64 * (j + 1)); SBAR();
                pv_d0(o, vb0, pa0, pa1, pa2, pa3); partialSM(pB0, pB1, m_reg, mnB, alB);
                __syncthreads(); asm volatile("s_waitcnt vmcnt(0)" ::: "memory"); SWRITE(0, 0);
                RESC(alB); __syncthreads();
                SBAR(); qkt(pA0, pA1, K_lds, q0, q1, q2, q3, r32, hi);
                finishSM(pB0, pB1, alB, l_reg, pa0, pa1, pa2, pa3); SBAR();
                SLOAD(0, lat0 + 64 * (j + 2)); SBAR();
                pv_d0(o, vb0 + SHM_V, pa0, pa1, pa2, pa3); partialSM(pA0, pA1, m_reg, mnA, alA);
                __syncthreads(); asm volatile("s_waitcnt vmcnt(0)" ::: "memory"); SWRITE(1, 0);
                RESC(alA); __syncthreads();
            }
            SBAR(); qkt(pB0, pB1, K_lds + SHM_K, q0, q1, q2, q3, r32, hi);
            finishSM(pA0, pA1, alA, l_reg, pa0, pa1, pa2, pa3); SBAR();
            pv_d0(o, vb0, pa0, pa1, pa2, pa3); partialSM(pB0, pB1, m_reg, mnB, alB);
            __syncthreads(); RESC(alB);
            finishSM(pB0, pB1, alB, l_reg, pa0, pa1, pa2, pa3); SBAR();
            pv_d0(o, vb0 + SHM_V, pa0, pa1, pa2, pa3);
        }
        if (hi == 0) li_l[r32] = l_reg; asm volatile("s_waitcnt lgkmcnt(0)" ::: "memory");
        if (c == 0) {
#pragma unroll
            for (int r = 0; r < 16; ++r) { const float rl = 1.0f / li_l[crow(r, hi)];
#pragma unroll
                for (int d = 0; d < 4; d += 2) stash[(r * 2 + (d >> 1)) * 64 + lane] = cvt_pk_bf16(o[d][r] * rl, o[d + 1][r] * rl); }
        } else {
            bf16_t* Ow = Ob + (size_t)(qrow0 + wid * QBLK) * 1024 + hh * 128;
            float gsub[4];
#pragma unroll
            for (int d = 0; d < 4; ++d) gsub[d] = subln[d * 32 + r32] * oscale;
#pragma unroll
            for (int r = 0; r < 16; ++r) {
                const float rl = lam / li_l[crow(r, hi)]; float acc2 = 0.f;
#pragma unroll
                for (int d = 0; d < 4; d += 2) { const unsigned w = stash[(r * 2 + (d >> 1)) * 64 + lane];
                    const float a0 = bflo(w) - o[d][r] * rl, a1 = bfhi(w) - o[d + 1][r] * rl;
                    o[d][r] = a0; o[d + 1][r] = a1; acc2 += a0 * a0 + a1 * a1; }
#pragma unroll
                for (int off = 1; off < 32; off <<= 1) acc2 += __shfl_xor(acc2, off);
                const float rs = 1.0f / sqrtf(acc2 * (1.f / 128.f) + 1e-5f);
                const int orow = crow(r, hi);
#pragma unroll
                for (int d = 0; d < 4; ++d) Ow[(size_t)orow * 1024 + d * 32 + r32] = (bf16_t)(cvt_pk_bf16(o[d][r] * rs * gsub[d], 0.f) & 0xffffu);
            }
        }
    }
#undef SLOAD
#undef SWRITE
#undef SWAIT
#undef RESC
}
#undef SBAR
}
namespace rwkv {
constexpr int A_W = 0, A_KK = 16384, A_B = 32768, A_KD = 49152, A_R = 65536, A_V = 81920, A_Y = 98304, A_TW = A_Y, A_TA = A_Y + 8192, A_PRM = 114688, A_END = A_PRM + 15 * 256;
static_assert(A_END <= RING_BYTES, "scan LDS");
struct Params { const bf16_t* cs; bf16_t* co; bf16_t* y; float* bon; const float* mu; const float* w0; const float* w2; const float* a0; const float* a2; const float* kk; const float* ka; const float* rk; };
__device__ __forceinline__ float dpp_ror_add(float x, int) { return x; }
#define ROR_ADD(x, n) do { const int t_ = __builtin_amdgcn_update_dpp(0, __builtin_bit_cast(int, x), 0x120 + (n), 0xf, 0xf, false); x += __builtin_bit_cast(float, t_); } while (0)
__device__ __forceinline__ float row16_sum(float x) { ROR_ADD(x, 8); ROR_ADD(x, 4); ROR_ADD(x, 2); ROR_ADD(x, 1); return x; }
__device__ __forceinline__ void ld8(const bf16_t* p, float (&o)[8]) { const u32x4 w = *(const u32x4*)p; o[0] = bflo(w.x); o[1] = bfhi(w.x); o[2] = bflo(w.y); o[3] = bfhi(w.y); o[4] = bflo(w.z); o[5] = bfhi(w.z); o[6] = bflo(w.w); o[7] = bfhi(w.w); }
template <class MP> __device__ __forceinline__ void shift8(const bf16_t* base, size_t pitch, size_t row, int col, bool hp, bool hn, MP m0, MP m1, float (&o)[8]) {
    float c[8], p[8], n[8]; ld8(base + row * pitch + col, c); ld8(base + (hp ? row - 1 : row) * pitch + col, p); ld8(base + (hn ? row + 1 : row) * pitch + col, n);
#pragma unroll
    for (int i = 0; i < 8; ++i) { const float pv = hp ? p[i] : 0.f, nv = hn ? n[i] : 0.f; o[i] = c[i] + m0[i] * (pv - c[i]) + m1[i] * (nv - c[i]); }
}
__device__ __forceinline__ void scan_wg(const Params& P, int d, int b, int hh, LAS char* lds) {
    int tid = threadIdx.x; asm volatile("" : "+v"(tid));
    const int wid = __builtin_amdgcn_readfirstlane(tid >> 6), lane = tid & 63, r32 = lane & 31, hi = lane >> 5;
    LAS float* W = (LAS float*)(lds + A_W); LAS float* KK = (LAS float*)(lds + A_KK); LAS float* Bv = (LAS float*)(lds + A_B); LAS float* KD = (LAS float*)(lds + A_KD);
    LAS float* Rv = (LAS float*)(lds + A_R); LAS float* Vv = (LAS float*)(lds + A_V); LAS float* Y = (LAS float*)(lds + A_Y);
    LAS bf16_t* TW = (LAS bf16_t*)(lds + A_TW); LAS bf16_t* TA = (LAS bf16_t*)(lds + A_TA); LAS float* PRM = (LAS float*)(lds + A_PRM);
    __syncthreads();
    for (int i = tid; i < 15 * 64; i += NTHREADS) { const int p = i >> 6, c = i & 63; float v;
        switch (p) {
            case 0: v = P.mu[hh * 64 + c]; break;             case 1: v = P.mu[1920 + hh * 64 + c]; break;
            case 2: v = P.mu[512 + hh * 64 + c]; break;       case 3: v = P.mu[1920 + 512 + hh * 64 + c]; break;
            case 4: v = P.mu[1024 + d * 64 + c]; break;       case 5: v = P.mu[1920 + 1024 + d * 64 + c]; break;
            case 6: v = P.mu[1152 + d * 64 + c]; break;       case 7: v = P.mu[1920 + 1152 + d * 64 + c]; break;
            case 8: v = P.mu[1280 + hh * 64 + c]; break;      case 9: v = P.mu[1920 + 1280 + hh * 64 + c]; break;
            case 10: v = P.w0[d * 512 + hh * 64 + c]; break;  case 11: v = P.a0[d * 512 + hh * 64 + c]; break;
            case 12: v = P.kk[hh * 64 + c]; break;            case 13: v = P.ka[hh * 64 + c]; break;
            default: v = P.rk[hh * 64 + c]; break; }
        PRM[i] = v; }
    const int mtx = wid >> 2, ti = (wid >> 1) & 1, tj = wid & 1;
    bf16x8 bw[4];
    { const float* src = (mtx == 0 ? P.w2 : P.a2) + (size_t)d * 64 * 512 + hh * 64 + 32 * tj + r32;
#pragma unroll
      for (int s = 0; s < 4; ++s) {
          u32x4 w;
          w.x = cvt_pk_bf16(src[(size_t)(16 * s + 8 * hi + 0) * 512], src[(size_t)(16 * s + 8 * hi + 1) * 512]);
          w.y = cvt_pk_bf16(src[(size_t)(16 * s + 8 * hi + 2) * 512], src[(size_t)(16 * s + 8 * hi + 3) * 512]);
          w.z = cvt_pk_bf16(src[(size_t)(16 * s + 8 * hi + 4) * 512], src[(size_t)(16 * s + 8 * hi + 5) * 512]);
          w.w = cvt_pk_bf16(src[(size_t)(16 * s + 8 * hi + 6) * 512], src[(size_t)(16 * s + 8 * hi + 7) * 512]);
          bw[s] = __builtin_bit_cast(bf16x8, w); } }
    float gm0[8], gm1[8];
    const int pj = tid >> 3, cg = tid & 7;
#pragma unroll
    for (int i = 0; i < 8; ++i) { gm0[i] = P.mu[1280 + 512 + hh * 16 + 8 * (cg & 1) + i]; gm1[i] = P.mu[1920 + 1280 + 512 + hh * 16 + 8 * (cg & 1) + i]; }
    const int vp = tid >> 4, kq = tid & 15;
    f32x4 S0 = (f32x4){0.f, 0.f, 0.f, 0.f}, S1 = (f32x4){0.f, 0.f, 0.f, 0.f};
    __syncthreads();
#pragma unroll 1
    for (int blk = 0; blk < 68; ++blk) {
        const bool isctx = blk < 4; const int bb = isctx ? blk : blk - 4;
        const int segbase = isctx ? ML + b * CTXL : b * SEQ, seglen = isctx ? CTXL : SEQ;
        const int r0 = d == 0 ? segbase + 64 * bb : segbase + seglen - 64 * (bb + 1);
        __syncthreads();
        {
            const int row = d == 0 ? r0 + pj : r0 + 63 - pj; const int pos = row - segbase; const bool hp = pos > 0, hn = pos < seglen - 1;
            float ks[8], xs[8], ssq = 0.f;
            shift8(P.cs, DCS, row, hh * 64 + 8 * cg, hp, hn, PRM + 0 * 64 + 8 * cg, PRM + 1 * 64 + 8 * cg, ks);
#pragma unroll
            for (int i = 0; i < 8; ++i) { KD[pj * 64 + 8 * cg + i] = ks[i]; const float t = ks[i] * PRM[12 * 64 + 8 * cg + i]; ks[i] = t; ssq += t * t; }
            ssq += __shfl_xor(ssq, 1); ssq += __shfl_xor(ssq, 2); ssq += __shfl_xor(ssq, 4);
            const float inv = 1.0f / fmaxf(sqrtf(ssq), 1e-12f);
#pragma unroll
            for (int i = 0; i < 8; ++i) KK[pj * 64 + 8 * cg + i] = ks[i] * inv;
            shift8(P.cs, DCS, row, 512 + hh * 64 + 8 * cg, hp, hn, PRM + 2 * 64 + 8 * cg, PRM + 3 * 64 + 8 * cg, xs);
#pragma unroll
            for (int i = 0; i < 8; ++i) Vv[pj * 64 + 8 * cg + i] = xs[i];
            shift8(P.co, DCOP, row, hh * 64 + 8 * cg, hp, hn, PRM + 8 * 64 + 8 * cg, PRM + 9 * 64 + 8 * cg, xs);
#pragma unroll
            for (int i = 0; i < 8; ++i) Rv[pj * 64 + 8 * cg + i] = xs[i];
            shift8(P.cs, DCS, row, 1024 + d * 64 + 8 * cg, hp, hn, PRM + 4 * 64 + 8 * cg, PRM + 5 * 64 + 8 * cg, xs);
            { u32x4 w; w.x = cvt_pk_bf16(tanhf(xs[0]), tanhf(xs[1])); w.y = cvt_pk_bf16(tanhf(xs[2]), tanhf(xs[3])); w.z = cvt_pk_bf16(tanhf(xs[4]), tanhf(xs[5])); w.w = cvt_pk_bf16(tanhf(xs[6]), tanhf(xs[7]));
              *(LAS u32x4*)(TW + pj * 64 + 8 * cg) = w; }
            shift8(P.cs, DCS, row, 1152 + d * 64 + 8 * cg, hp, hn, PRM + 6 * 64 + 8 * cg, PRM + 7 * 64 + 8 * cg, xs);
            { u32x4 w; w.x = cvt_pk_bf16(xs[0], xs[1]); w.y = cvt_pk_bf16(xs[2], xs[3]); w.z = cvt_pk_bf16(xs[4], xs[5]); w.w = cvt_pk_bf16(xs[6], xs[7]);
              *(LAS u32x4*)(TA + pj * 64 + 8 * cg) = w; }
            if (d == 0 && cg < 2) {
                shift8(P.co, DCOP, row, 512 + hh * 16 + 8 * cg, hp, hn, gm0, gm1, xs);
                u32x4 w; w.x = cvt_pk_bf16(sigmoidf_(xs[0]), sigmoidf_(xs[1])); w.y = cvt_pk_bf16(sigmoidf_(xs[2]), sigmoidf_(xs[3]));
                w.z = cvt_pk_bf16(sigmoidf_(xs[4]), sigmoidf_(xs[5])); w.w = cvt_pk_bf16(sigmoidf_(xs[6]), sigmoidf_(xs[7]));
                *(u32x4*)(P.co + (size_t)row * DCOP + DCO + hh * 16 + 8 * cg) = w;
            }
        }
        __syncthreads();
        {
            const LAS bf16_t* T = mtx == 0 ? TW : TA; LAS float* dst = mtx == 0 ? W : Bv;
            f32x16 cacc = f32x16{};
#pragma unroll
            for (int s = 0; s < 4; ++s) { const bf16x8 af = *(const LAS bf16x8*)(T + (32 * ti + r32) * 64 + 16 * s + 8 * hi);
                cacc = __builtin_amdgcn_mfma_f32_32x32x16_bf16(af, bw[s], cacc, 0, 0, 0); }
#pragma unroll
            for (int r = 0; r < 16; ++r) dst[(32 * ti + (r & 3) + 8 * (r >> 2) + 4 * hi) * 64 + 32 * tj + r32] = cacc[r];
        }
        __syncthreads();
        {
            const int row = d == 0 ? r0 + pj : r0 + 63 - pj; float bsum = 0.f;
#pragma unroll
            for (int i = 0; i < 8; ++i) { const int c = 8 * cg + i, o = pj * 64 + c;
                const float x = PRM[10 * 64 + c] + W[o]; const float dec = expf(-0.60653065971263342f * sigmoidf_(x));
                const float a = sigmoidf_(PRM[11 * 64 + c] + Bv[o]);
                const float kd = KD[o] * (1.f + (a - 1.f) * PRM[13 * 64 + c]);
                W[o] = dec; KD[o] = kd; Bv[o] = KK[o] * a; bsum += Rv[o] * kd * PRM[14 * 64 + c]; }
            bsum += __shfl_xor(bsum, 1); bsum += __shfl_xor(bsum, 2); bsum += __shfl_xor(bsum, 4);
            if (cg == 0) P.bon[(size_t)d * MT * 8 + (size_t)row * 8 + hh] = bsum;
        }
        __syncthreads();
#pragma unroll 2
        for (int j = 0; j < 64; ++j) {
            const f32x4 w4 = *(const LAS f32x4*)(W + j * 64 + 4 * kq), k4 = *(const LAS f32x4*)(KK + j * 64 + 4 * kq), b4 = *(const LAS f32x4*)(Bv + j * 64 + 4 * kq);
            const f32x4 d4 = *(const LAS f32x4*)(KD + j * 64 + 4 * kq), r4 = *(const LAS f32x4*)(Rv + j * 64 + 4 * kq); const f32x2 v2 = *(const LAS f32x2*)(Vv + j * 64 + 2 * vp);
            float sk0 = (S0[0] * k4[0] + S0[1] * k4[1]) + (S0[2] * k4[2] + S0[3] * k4[3]), sk1 = (S1[0] * k4[0] + S1[1] * k4[1]) + (S1[2] * k4[2] + S1[3] * k4[3]);
            sk0 = row16_sum(sk0); sk1 = row16_sum(sk1);
            S0 = S0 * w4 + (v2.x * d4 - sk0 * b4); S1 = S1 * w4 + (v2.y * d4 - sk1 * b4);
            float y0 = (S0[0] * r4[0] + S0[1] * r4[1]) + (S0[2] * r4[2] + S0[3] * r4[3]), y1 = (S1[0] * r4[0] + S1[1] * r4[1]) + (S1[2] * r4[2] + S1[3] * r4[3]);
            y0 = row16_sum(y0); y1 = row16_sum(y1);
            if (kq == 0) *(LAS f32x2*)(Y + j * 64 + 2 * vp) = (f32x2){y0, y1};
        }
        __syncthreads();
        {
            const int row = d == 0 ? r0 + pj : r0 + 63 - pj; const LAS float* ys = Y + pj * 64 + 8 * cg;
            u32x4 w; w.x = cvt_pk_bf16(ys[0], ys[1]); w.y = cvt_pk_bf16(ys[2], ys[3]); w.z = cvt_pk_bf16(ys[4], ys[5]); w.w = cvt_pk_bf16(ys[6], ys[7]);
            *(u32x4*)(P.y + (size_t)d * MT * 512 + (size_t)row * 512 + hh * 64 + 8 * cg) = w;
        }
    }
    __syncthreads();
}
#undef ROR_ADD
}
struct Frame {
    LAS unsigned char* lds; char* ldsg; volatile LAS unsigned* MISC; gu32* ctl;
    int tid, lane, wave, G, gw, NGW;
    const float* x_in; const float* ctx_in; float* out; unsigned char* ws;
};
enum { I_X = 0, I_C, I_CTX, I_CCTX, I_ADAW, I_ADAB, I_WIN, I_LAMQK, I_SUBLN, I_MU, I_W0, I_W2, I_A0, I_A2, I_G2, I_KK, I_KA, I_RK, I_LNW, I_LNB,
       I_WPA, I_WPF, I_WPC, I_WO, I_LN1G, I_LN1B, I_FUP, I_FCONV, I_FCONVB, I_FDN, I_LN2G, I_LN2B };

struct Row16 { f32x4 v[4]; };
__device__ __forceinline__ void row_load_f32(Row16& r, const float* p, int lane) {
#pragma unroll
    for (int j = 0; j < 4; ++j) r.v[j] = *(const f32x4*)(p + 256 * j + 4 * lane);
}
__device__ __forceinline__ void row_load_bf16(Row16& r, const bf16_t* p, int lane) {
#pragma unroll
    for (int j = 0; j < 4; ++j) { const u32x2 w = *(const u32x2*)(p + 256 * j + 4 * lane); r.v[j] = (f32x4){bflo(w.x), bfhi(w.x), bflo(w.y), bfhi(w.y)}; }
}
__device__ __forceinline__ void row_store_f32(const Row16& r, float* p, int lane) {
#pragma unroll
    for (int j = 0; j < 4; ++j) *(f32x4*)(p + 256 * j + 4 * lane) = r.v[j];
}
__device__ __forceinline__ void row_store_bf16(const Row16& r, bf16_t* p, int lane) {
#pragma unroll
    for (int j = 0; j < 4; ++j) { u32x2 w; w.x = cvt_pk_bf16(r.v[j][0], r.v[j][1]); w.y = cvt_pk_bf16(r.v[j][2], r.v[j][3]); *(u32x2*)(p + 256 * j + 4 * lane) = w; }
}
__device__ __forceinline__ void row_ln_plain(Row16& r) {
    float s = 0.f;
#pragma unroll
    for (int j = 0; j < 4; ++j) s += (r.v[j][0] + r.v[j][1]) + (r.v[j][2] + r.v[j][3]);
    const float mean = wave_sum(s) * (1.f / DM); float q = 0.f;
#pragma unroll
    for (int j = 0; j < 4; ++j) { r.v[j] = r.v[j] - mean; q += (r.v[j][0] * r.v[j][0] + r.v[j][1] * r.v[j][1]) + (r.v[j][2] * r.v[j][2] + r.v[j][3] * r.v[j][3]); }
    const float rstd = 1.0f / sqrtf(wave_sum(q) * (1.f / DM) + LN_EPS);
#pragma unroll
    for (int j = 0; j < 4; ++j) r.v[j] = r.v[j] * rstd;
}
__device__ __forceinline__ void row_affine(Row16& r, const float* g, const float* b, int lane, float gadd) {
#pragma unroll
    for (int j = 0; j < 4; ++j) { const f32x4 gg = *(const f32x4*)(g + 256 * j + 4 * lane), bb = *(const f32x4*)(b + 256 * j + 4 * lane); r.v[j] = r.v[j] * (gg + gadd) + bb; }
}
__device__ __forceinline__ const float* modrow(const Frame& F, int layer, int row) { return (const float*)(F.ws + TAB_MOD) + ((size_t)layer * 5 + (row < ML ? (row >> 12) : 4)) * 6144; }
__device__ __forceinline__ const float* xrow_in(const Frame& F, int layer, int row) {
    if (layer == 0) return row < ML ? F.x_in + (size_t)row * DM : F.ctx_in + (size_t)(row - ML) * DM;
    return row < ML ? F.out + (size_t)row * DM : (const float*)(F.ws + WS_XC) + (size_t)(row - ML) * DM;
}
__device__ __forceinline__ float* xrow_out(const Frame& F, int row) { return row < ML ? F.out + (size_t)row * DM : (float*)(F.ws + WS_XC) + (size_t)(row - ML) * DM; }

__device__ __forceinline__ void pass_modulate(const Frame& F0, int layer, bf16_t* dst, int nrows) {
    Frame F = F0; asm volatile("" : "+v"(F.lane), "+v"(F.tid));
    for (int row = F.gw; row < nrows; row += F.NGW) {
        Row16 r; row_load_f32(r, xrow_in(F, layer, row), F.lane); row_ln_plain(r);
        const float* mv = modrow(F, layer, row); row_affine(r, mv + 1024, mv, F.lane, 1.f);
        row_store_bf16(r, dst + (size_t)row * DM, F.lane);
    }
}
__device__ __forceinline__ void pass_ln1(Frame F, int layer, const float* mix, bf16_t* h2, int nrows, const float* g, const float* bt) {
    asm volatile("" : "+v"(F.lane), "+v"(F.tid));
    for (int row = F.gw; row < nrows; row += F.NGW) {
        Row16 r, m; row_load_f32(r, xrow_in(F, layer, row), F.lane); row_load_f32(m, mix + (size_t)row * DM, F.lane);
        const float* mv = modrow(F, layer, row);
#pragma unroll
        for (int j = 0; j < 4; ++j) { f32x4 gt = *(const f32x4*)(mv + 2048 + 256 * j + 4 * F.lane); if (DBG_ZERO_MIX) gt = gt * 0.f; r.v[j] = r.v[j] * ALPHA + gt * m.v[j]; }
        row_ln_plain(r); row_affine(r, g, bt, F.lane, 0.f);
        row_store_f32(r, xrow_out(F, row), F.lane);
        row_ln_plain(r); row_affine(r, mv + 4096, mv + 3072, F.lane, 1.f);
        row_store_bf16(r, h2 + (size_t)row * DM, F.lane);
    }
}
__device__ __forceinline__ void pass_ln2(Frame F, int layer, bf16_t* ffn_h, int nrows, bool next_h, const float* g, const float* bt) {
    asm volatile("" : "+v"(F.lane), "+v"(F.tid));
    for (int row = F.gw; row < nrows; row += F.NGW) {
        Row16 r, m; float* xp = xrow_out(F, row); row_load_f32(r, xp, F.lane); row_load_bf16(m, ffn_h + (size_t)row * DM, F.lane);
        const float* mv = modrow(F, layer, row);
#pragma unroll
        for (int j = 0; j < 4; ++j) { f32x4 gt = *(const f32x4*)(mv + 5120 + 256 * j + 4 * F.lane); if (DBG_ZERO_FFN) gt = gt * 0.f; r.v[j] = r.v[j] * ALPHA + gt * m.v[j]; }
        row_ln_plain(r); row_affine(r, g, bt, F.lane, 0.f);
        row_store_f32(r, xp, F.lane);
        if (next_h) { const float* mn = modrow(F, layer + 1, row); row_ln_plain(r); row_affine(r, mn + 1024, mn, F.lane, 1.f); row_store_bf16(r, ffn_h + (size_t)row * DM, F.lane); }
    }
}
__device__ __forceinline__ void pass_conv(Frame F, bf16_t* ug, int nrows, const float* cw, const float* cb) {
    asm volatile("" : "+v"(F.lane), "+v"(F.tid));
    const long total = (long)nrows * (DFF / 8), stride = (long)F.G * NTHREADS;
    for (long it = (long)blockIdx.x * NTHREADS + F.tid; it < total; it += stride) {
        const int row = (int)(it / (DFF / 8)), c = (int)(it % (DFF / 8)) * 8;
        int pos, len; if (row < ML) { pos = row & 4095; len = SEQ; } else { pos = (row - ML) & 255; len = CTXL; }
        const bool hp = pos > 0, hn = pos < len - 1;
        bf16_t* up = ug + (size_t)row * NP + c;
        float u[8], gc[8], gp[8], gn[8];
        rwkv::ld8(up, u); rwkv::ld8(up + DFF, gc); rwkv::ld8(up + DFF - (hp ? NP : 0), gp); rwkv::ld8(up + DFF + (hn ? NP : 0), gn);
        float o[8];
#pragma unroll
        for (int i = 0; i < 8; ++i) {
            const float x = cw[c + i] * (hp ? gp[i] : 0.f) + cw[DFF + c + i] * gc[i] + cw[2 * DFF + c + i] * (hn ? gn[i] : 0.f) + cb[c + i];
            o[i] = 0.5f * x * (1.f + erff(x * 0.70710678118654752f)) * u[i];
        }
        u32x4 w; w.x = cvt_pk_bf16(o[0], o[1]); w.y = cvt_pk_bf16(o[2], o[3]); w.z = cvt_pk_bf16(o[4], o[5]); w.w = cvt_pk_bf16(o[6], o[7]);
        *(u32x4*)up = w;
    }
}

__device__ __forceinline__ unsigned f2bf(float f) { unsigned u = __builtin_bit_cast(unsigned, f); return (u + 0x7fffu + ((u >> 16) & 1u)) >> 16; }
__device__ __forceinline__ unsigned pk2(float lo, float hi) { return f2bf(lo) | (f2bf(hi) << 16); }
__device__ __forceinline__ void transpose_item(const float* W, int K, int N, bf16_t* WT, int item, LAS float* scr, int lane, int rowadd_from, int rowadd) {
    const int nblk = N / 32, kb = item / nblk, nb = item % nblk, k0 = 64 * kb, n0 = 32 * nb;
    const int row_off = n0 >= rowadd_from ? rowadd : 0;
#pragma unroll 8
    for (int i = 0; i < 32; ++i) { const int kk = 2 * i + (lane >> 5); scr[kk * 33 + (lane & 31)] = W[(size_t)(k0 + kk) * N + n0 + (lane & 31)]; }
    LDS_WAIT(); asm volatile("" ::: "memory");
    const int c = lane & 7;
#pragma unroll
    for (int j = 0; j < 4; ++j) { const int n = (lane >> 3) + 8 * j; const LAS float* s = scr + (8 * c) * 33 + n;
        u32x4 o; o.x = pk2(s[0 * 33], s[1 * 33]); o.y = pk2(s[2 * 33], s[3 * 33]); o.z = pk2(s[4 * 33], s[5 * 33]); o.w = pk2(s[6 * 33], s[7 * 33]);
        *(GAS u32x4*)(WT + (size_t)(row_off + n0 + n) * K + k0 + 8 * c) = o; }
    LDS_WAIT(); asm volatile("" ::: "memory");
}
#define CONVERT_WEIGHTS(F, layer, INP) do { \
    convert_weights_((F), (layer), INP(I_WIN), INP(I_WPA), INP(I_WPF), INP(I_WPC), INP(I_WO), INP(I_FUP), INP(I_FDN), INP(I_G2)); } while (0)
__device__ __forceinline__ void convert_weights_(const Frame& F_, int layer, const float* p_win, const float* p_wpa, const float* p_wpf, const float* p_wpc, const float* p_wo, const float* p_fup, const float* p_fdn, const float* p_g2) {
    Frame F = F_; asm volatile("" : "+v"(F.lane), "+v"(F.tid));
    LAS float* scr = (LAS float*)(F.lds + F.wave * 16384);
    constexpr int N_IN = 16 * (D_IN_SRC / 32), N_PA = 16 * 32, N_PF = 8 * 32, N_PC = 8 * 32, N_O = 16 * 32, N_UP = 16 * (2 * DFF / 32), N_DN = (DFF / 64) * 32, N_G2 = 2 * 16;
    constexpr int NITEMS = N_IN + N_PA + N_PF + N_PC + N_O + N_UP + N_DN + N_G2;
    unsigned char* ws = F.ws;
    for (int it = F.gw; it < NITEMS; it += F.NGW) {
        int r = it;
        if (r < N_IN) { transpose_item(p_win + (size_t)layer * DM * D_IN_SRC, DM, D_IN_SRC, (bf16_t*)(ws + W_IN), r, scr, F.lane, 5504, 128); continue; } r -= N_IN;
        if (r < N_PA) { transpose_item(p_wpa + (size_t)layer * 1024 * DM, 1024, DM, (bf16_t*)(ws + W_PA), r, scr, F.lane, 1 << 30, 0); continue; } r -= N_PA;
        if (r < N_PF) { transpose_item(p_wpf + (size_t)layer * 512 * DM, 512, DM, (bf16_t*)(ws + W_PF), r, scr, F.lane, 1 << 30, 0); continue; } r -= N_PF;
        if (r < N_PC) { transpose_item(p_wpc + (size_t)layer * 512 * DM, 512, DM, (bf16_t*)(ws + W_PC), r, scr, F.lane, 1 << 30, 0); continue; } r -= N_PC;
        if (r < N_O) { transpose_item(p_wo + (size_t)layer * DM * DM, DM, DM, (bf16_t*)(ws + W_O), r, scr, F.lane, 1 << 30, 0); continue; } r -= N_O;
        if (r < N_UP) { transpose_item(p_fup + (size_t)layer * DM * 2 * DFF, DM, 2 * DFF, (bf16_t*)(ws + W_UP), r, scr, F.lane, 1 << 30, 0); continue; } r -= N_UP;
        if (r < N_DN) { transpose_item(p_fdn + (size_t)layer * DFF * DM, DFF, DM, (bf16_t*)(ws + W_DN), r, scr, F.lane, 1 << 30, 0); continue; } r -= N_DN;
        transpose_item(p_g2 + (size_t)layer * 128 * 512, 128, 512, (bf16_t*)(ws + W_G2T), r, scr, F.lane, 1 << 30, 0);
    }
    { u32x4* z = (u32x4*)(ws + W_IN + (size_t)5504 * DM * 2); const int n16 = 128 * DM * 2 / 16;
      unsigned zz = 0u; asm volatile("" : "+v"(zz));
      for (int i = blockIdx.x * NTHREADS + F.tid; i < n16; i += F.G * NTHREADS) z[i] = (u32x4){zz, zz, zz, zz}; }
}
__device__ __forceinline__ void build_tables(Frame F, const float* lamqk) {
    asm volatile("" : "+v"(F.lane), "+v"(F.tid));
    const int gt = blockIdx.x * NTHREADS + F.tid, NT_ = F.G * NTHREADS;
    float* rope = (float*)(F.ws + TAB_ROPE); float* tw = (float*)(F.ws + TAB_TW);
    bf16_t* w0 = (bf16_t*)(F.ws + TAB_W0); bf16_t* f1 = (bf16_t*)(F.ws + TAB_F1); bf16_t* f2 = (bf16_t*)(F.ws + TAB_F2); bf16_t* dc = (bf16_t*)(F.ws + TAB_DC);
    for (int i = gt; i < 1024; i += NT_) { const int pos = i >> 4, f = i & 15; const float inv = powf(10000.f, -(float)f / 16.f); const float ang = (float)pos * inv;
        rope[2 * i] = (float)cos((double)ang); rope[2 * i + 1] = (float)sin((double)ang); }
    for (int i = gt; i < 4096; i += NT_) { const int kl = i >> 6, tl = i & 63; float s, c; sincospif(2.f * (float)(kl * tl) / 4096.f, &s, &c); tw[2 * i] = c; tw[2 * i + 1] = s; }
    for (int i = gt; i < 256 * 128; i += NT_) { const int r = i >> 7, c = i & 127, ri = r >> 7, m = r & 127; float s, co; sincospif(2.f * (float)((m * c) & 127) / 128.f, &s, &co);
        w0[i] = (bf16_t)f2bf((ri == 0 ? co : -s) * 0.088388347648318f); }
    for (int i = gt; i < 256 * 256; i += NT_) { const int r = i >> 8, k = i & 255; const int rip = r >> 7, p = (r >> 6) & 1, kl = r & 63, ri = k >> 7, p2 = (k >> 6) & 1, th = k & 63;
        float s, co; sincospif(2.f * (float)((kl * th) & 63) / 64.f, &s, &co);
        float v = 0.f; if (p == p2) v = (rip == ri) ? co : (rip == 0 ? s : -s);
        f1[i] = (bf16_t)f2bf(v * 0.125f); }
    for (int i = gt; i < 256 * 512; i += NT_) { const int r = i >> 9, k = i & 511; const int pp = r >> 6, kh = r & 63, rip = k >> 8, p2 = (k >> 6) & 3, tl = k & 63;
        float s, co; sincospif(2.f * (float)((kh * tl) & 63) / 64.f, &s, &co);
        const float v = (pp == p2) ? (rip == 0 ? co : s) : 0.f;
        f2[i] = (bf16_t)f2bf(v * 0.125f); }
    for (int i = gt; i < 256 * 512; i += NT_) { const int k = i >> 9, kk = i & 511, ri = kk >> 8, t = kk & 255;
        float s, co; sincospif(2.f * (float)((k * t) & 255) / 256.f, &s, &co);
        dc[i] = (bf16_t)f2bf((ri == 0 ? co : s) * 0.0625f); }
    if (gt < NLAYER) {
        const float* lq = lamqk + gt * 256; float s1 = 0.f, s2 = 0.f;
        for (int i = 0; i < 64; ++i) { s1 += lq[i] * lq[64 + i]; s2 += lq[128 + i] * lq[192 + i]; }
        const float lam_init = 0.8f - 0.6f * expf(-0.3f * (float)gt);
        float* lamv = (float*)(F.ws + TAB_LAM); lamv[2 * gt] = expf(s1) - expf(s2) + lam_init; lamv[2 * gt + 1] = 1.f - lam_init;
    }
}
__device__ __forceinline__ void build_mod(Frame F, const float* cvec, const float* cctx, const float* adaw, const float* adab) {
    asm volatile("" : "+v"(F.lane), "+v"(F.tid));
    LAS float* sil = (LAS float*)F.lds;
    LAS float* part = sil + 5 * 1024;
    for (int i = F.tid; i < 5 * 1024; i += NTHREADS) { const int s = i >> 10, k = i & 1023; const float c = s < 4 ? cvec[s * 1024 + k] : cctx[k]; sil[i] = c / (1.f + expf(-c)); }
    __syncthreads();
    for (int cgid = blockIdx.x; cgid < 256; cgid += F.G) {
        const int l = cgid >> 7, j0 = (cgid & 127) * 48;
        if (F.tid < 384) { const int col = F.tid % 48, kg = F.tid / 48; const float* w = adaw + ((size_t)l * 1024 + 128 * kg) * 6144 + j0 + col;
            float a0 = 0.f, a1 = 0.f, a2 = 0.f, a3 = 0.f, a4 = 0.f;
            for (int k = 0; k < 128; ++k) { const float wv = w[(size_t)k * 6144]; const int kk = 128 * kg + k;
                a0 += sil[kk] * wv; a1 += sil[1024 + kk] * wv; a2 += sil[2048 + kk] * wv; a3 += sil[3072 + kk] * wv; a4 += sil[4096 + kk] * wv; }
            part[(kg * 5 + 0) * 48 + col] = a0; part[(kg * 5 + 1) * 48 + col] = a1; part[(kg * 5 + 2) * 48 + col] = a2; part[(kg * 5 + 3) * 48 + col] = a3; part[(kg * 5 + 4) * 48 + col] = a4; }
        __syncthreads();
        if (F.tid < 240) { const int s = F.tid / 48, col = F.tid % 48; float a = adab[l * 6144 + j0 + col];
            for (int kg = 0; kg < 8; ++kg) a += part[(kg * 5 + s) * 48 + col];
            ((float*)(F.ws + TAB_MOD))[((size_t)l * 5 + s) * 6144 + j0 + col] = a; }
        __syncthreads();
    }
}
#if defined(DBG_CHECK)
#ifndef DBG_LAYER
#define DBG_LAYER 0
#endif
#ifndef DBG_SUB
#define DBG_SUB 0
#endif
#ifndef DBG_TWO
#define DBG_TWO 0
#endif
constexpr size_t WS_DBG = WS_CTL + 512 * 1024;
__device__ const int dbg_rows[9] = {0, 1, 255, 256, 2047, 4095, 4096, 8192 + 77, 16383};
__device__ __forceinline__ float dbg_bf(const bf16_t* p) { return bf2f(*p); }
__device__ __forceinline__ void dbg_max(unsigned char* ws, float e) { if (!(e == e)) e = 1e9f; atomicMax((unsigned*)(ws + WS_DBG), __float_as_uint(fabsf(e))); }
__device__ __forceinline__ int dbg_arow(int s) { return s < 9 ? dbg_rows[s] : (int)(((unsigned)s * 7919u + 13u) % 16384u); }
__global__ void dbg_pre(unsigned char* ws, float* scratch) {
    const int s = blockIdx.x; const int row = dbg_arow(s);
    bf16_t* dst = (bf16_t*)scratch + (size_t)s * 1024; const bf16_t* src = (const bf16_t*)(ws + P_Q) + (size_t)row * 1024;
    for (int i = threadIdx.x; i < 1024; i += blockDim.x) dst[i] = src[i];
}
__global__ void dbg_attn(unsigned char* ws, const float* subln, int layer, const float* scratch) {
    __shared__ float sc[2][4352]; __shared__ float red[512]; __shared__ float ov[128];
    const int s = blockIdx.x, hh = blockIdx.x & 7; const int row = dbg_arow(s), b = row >> 12, t = row & 4095, tid = threadIdx.x;
    const bf16_t* q = (const bf16_t*)scratch + (size_t)s * 1024 + hh * 128;
    const bf16_t* K = (const bf16_t*)(ws + P_K); const bf16_t* V = (const bf16_t*)(ws + P_V);
    const float lam = ((const float*)(ws + TAB_LAM))[2 * layer], osc = ((const float*)(ws + TAB_LAM))[2 * layer + 1];
    __shared__ float qp[2][64], qr[2][64];
    if (tid < 128) qp[tid >> 6][tid & 63] = dbg_bf(q + tid);
    __syncthreads();
    if (tid < 64) { const int c = tid >> 5, ax = (tid >> 4) & 1, f = tid & 15;
        const float inv = powf(10000.f, -(float)f / 16.f), ang = (float)(ax == 0 ? (t >> 6) : (t & 63)) * inv, cs = cosf(ang), sn = sinf(ang);
        const float x1 = qp[c][ax * 32 + f], x2 = qp[c][ax * 32 + 16 + f]; qr[c][ax * 32 + f] = bf2f((unsigned short)(cvt_pk_bf16(x1 * cs - x2 * sn, 0.f) & 0xffff)); qr[c][ax * 32 + 16 + f] = bf2f((unsigned short)(cvt_pk_bf16(x2 * cs + x1 * sn, 0.f) & 0xffff)); }
    __syncthreads();
    for (int key = tid; key < 4352; key += 512) {
        const bool ctx = key < 256; const size_t kr = ctx ? (size_t)ML + b * 256 + key : (size_t)b * 4096 + (key - 256);
        for (int c = 0; c < 2; ++c) { float a = 0.f; for (int d = 0; d < 64; ++d) a += (ctx ? qp[c][d] : qr[c][d]) * dbg_bf(K + kr * 1024 + hh * 128 + c * 64 + d); sc[c][key] = a * 0.125f; } }
    __syncthreads();
    float mx[2], sm[2];
    for (int c = 0; c < 2; ++c) { float m = -1e30f; for (int key = tid; key < 4352; key += 512) m = fmaxf(m, sc[c][key]); red[tid] = m; __syncthreads();
        for (int o = 256; o > 0; o >>= 1) { if (tid < o) red[tid] = fmaxf(red[tid], red[tid + o]); __syncthreads(); } mx[c] = red[0]; __syncthreads();
        float su = 0.f; for (int key = tid; key < 4352; key += 512) su += expf(sc[c][key] - mx[c]); red[tid] = su; __syncthreads();
        for (int o = 256; o > 0; o >>= 1) { if (tid < o) red[tid] += red[tid + o]; __syncthreads(); } sm[c] = red[0]; __syncthreads(); }
    for (int key = tid; key < 4352; key += 512) sc[0][key] = expf(sc[0][key] - mx[0]) / sm[0] - lam * expf(sc[1][key] - mx[1]) / sm[1];
    __syncthreads();
    if (tid < 128) { float o = 0.f; for (int key = 0; key < 4352; ++key) { const size_t kr = key < 256 ? (size_t)ML + b * 256 + key : (size_t)b * 4096 + (key - 256); o += sc[0][key] * dbg_bf(V + kr * 1024 + hh * 128 + tid); } ov[tid] = o; }
    __syncthreads();
    if (tid == 0) { float ss = 0.f; for (int d = 0; d < 128; ++d) ss += ov[d] * ov[d]; const float rs = 1.0f / sqrtf(ss / 128.f + 1e-5f); float emax = 0.f, vmax = 1e-6f;
        for (int d = 0; d < 128; ++d) { const float ref = ov[d] * rs * subln[layer * 128 + d] * osc, got = dbg_bf((const bf16_t*)(ws + P_Q) + (size_t)row * 1024 + hh * 128 + d); emax = fmaxf(emax, fabsf(ref - got)); vmax = fmaxf(vmax, fabsf(ref)); }
        dbg_max(ws, emax / vmax); }
}
__global__ void dbg_inproj(unsigned char* ws, const float* w_in) {
    const int rows9[9] = {0, 1, 255, 256, 2047, 4095, 4096, 16383, 16384 + 300};
    const int rowsB[9] = {180, 244, 436, 500, 179, 181, 4096 + 180, 16384 + 244, 52}; const int row = DBG_SUB == 3 ? rowsB[blockIdx.x] : (blockIdx.x == 8 ? 16384 + 300 : (blockIdx.x == 7 ? 16383 : dbg_rows[blockIdx.x])); (void)rows9;
    const bf16_t* h = (const bf16_t*)(ws + WS_HY) + (size_t)row * 1024;
    for (int col = threadIdx.x * (DBG_SUB == 3 ? 3 : 11) + (blockIdx.x % 7); col < 5504; col += blockDim.x * (DBG_SUB == 3 ? 3 : 11)) {
        float x = 0.f, xo = 0.f; int sec, lc; size_t boff; int pitch;
        if (col < 1024) { boff = P_Q; pitch = 1024; lc = col; sec = 0; } else if (col < 2048) { boff = P_K; pitch = 1024; lc = col - 1024; sec = 1; }
        else if (col < 3072) { boff = P_V; pitch = 1024; lc = col - 2048; sec = 2; } else if (col < 3584) { boff = P_F; pitch = 512; lc = col - 3072; sec = 3; }
        else if (col < 4864) { boff = P_CS; pitch = DCS; lc = col - 3584; sec = 4; } else { boff = P_CO; pitch = DCOP; lc = col - 4864; sec = 5; }
        const int d = lc & 63, half = (d >> 4) & 1, ax = d >> 5, f = d & 15; const int oc = half ? col - 16 : col + 16;
        for (int k = 0; k < 1024; ++k) { const float hv = dbg_bf(h + k); x += hv * w_in[(size_t)k * D_IN_SRC + col]; if (sec == 1) xo += hv * w_in[(size_t)k * D_IN_SRC + oc]; }
        float ref = x;
        if (sec == 1 && row < ML) { const int t = row & 4095; const float inv = powf(10000.f, -(float)f / 16.f), ang = (float)(ax == 0 ? (t >> 6) : (t & 63)) * inv, cs = cosf(ang), sn = sinf(ang);
            ref = half ? x * cs + xo * sn : x * cs - xo * sn; }
        const float got = dbg_bf((const bf16_t*)(ws + boff) + (size_t)row * pitch + lc);
        dbg_max(ws, fabsf(ref - got) / (fabsf(ref) + 0.25f));
    }
}
__device__ __forceinline__ void dbg_fsample(int s, int& b, int& k, int& g, int& m) { const int ks[8] = {0, 1, 63, 64, 65, 2048, 4095, 1234}; const int ms[4] = {0, 1, 77, 127};
    k = ks[s & 7]; m = ms[(s >> 3) & 3]; g = (s >> 5) & 3; b = (s * 7 + 1) & 3; }
__global__ void dbg_fourier_ref(unsigned char* ws) {
    __shared__ float red[512];
    int b, k, g, m; dbg_fsample(blockIdx.x, b, k, g, m); const int tid = threadIdx.x;
    const bf16_t* f = (const bf16_t*)(ws + P_F); float acc = 0.f;
    for (int i = tid; i < 4096 * 128; i += 512) { const int t = i >> 7, c = i & 127; float sn, cs; sincospif(2.f * (float)((k * t) & 4095) / 4096.f + 2.f * (float)((m * c) & 127) / 128.f, &sn, &cs);
        acc += dbg_bf(f + (size_t)(b * 4096 + t) * 512 + g * 128 + c) * cs; }
    red[tid] = acc; __syncthreads();
    for (int o = 256; o > 0; o >>= 1) { if (tid < o) red[tid] += red[tid + o]; __syncthreads(); }
    if (tid == 0) ((float*)(ws + WS_DBG + 65536))[blockIdx.x] = red[0] * 0.00138106793f;
}
__global__ void dbg_fourier_cmp(unsigned char* ws) {
    const int s = threadIdx.x; int b, k, g, m; dbg_fsample(s, b, k, g, m);
    const float ref = ((const float*)(ws + WS_DBG + 65536))[s], got = dbg_bf((const bf16_t*)(ws + P_F) + (size_t)(b * 4096 + k) * 512 + g * 128 + m);
    dbg_max(ws, fabsf(ref - got) / (fabsf(ref) + 0.25f));
}
__device__ __forceinline__ float dbg_shift(const bf16_t* base, int pitch, int row, int col, bool hp, bool hn, float m0, float m1) {
    const float c = dbg_bf(base + (size_t)row * pitch + col), p = hp ? dbg_bf(base + (size_t)(row - 1) * pitch + col) : 0.f, n = hn ? dbg_bf(base + (size_t)(row + 1) * pitch + col) : 0.f;
    return c + m0 * (p - c) + m1 * (n - c); }
__global__ void __launch_bounds__(64) dbg_scan(unsigned char* ws, float* scratch, const float* mu, const float* w0, const float* w2, const float* a0, const float* a2, const float* kkp, const float* kap, const float* rkp) {
    __shared__ float s_kk[64], s_w[64], s_b[64], s_kd[64], s_r[64], s_v[64], s_tw[64], s_ad[64], s_red[64];
    const int d = blockIdx.x & 1, hh = (blockIdx.x >> 1) & 7, b = blockIdx.x >> 4, c = threadIdx.x;
    const bf16_t* cs = (const bf16_t*)(ws + P_CS); const bf16_t* co = (const bf16_t*)(ws + P_CO);
    float S[64];
#pragma unroll
    for (int k = 0; k < 64; ++k) S[k] = 0.f;
    float emax = 0.f;
    for (int step = 0; step < 4352; ++step) {
        const bool isctx = step < 256; const int segbase = isctx ? ML + b * 256 : b * 4096, seglen = isctx ? 256 : 4096, st = isctx ? step : step - 256;
        const int pos = d == 0 ? st : seglen - 1 - st, row = segbase + pos; const bool hp = pos > 0, hn = pos < seglen - 1;
        const float ks = dbg_shift(cs, DCS, row, hh * 64 + c, hp, hn, mu[hh * 64 + c], mu[1920 + hh * 64 + c]);
        const float vs = dbg_shift(cs, DCS, row, 512 + hh * 64 + c, hp, hn, mu[512 + hh * 64 + c], mu[1920 + 512 + hh * 64 + c]);
        const float wds = dbg_shift(cs, DCS, row, 1024 + d * 64 + c, hp, hn, mu[1024 + d * 64 + c], mu[1920 + 1024 + d * 64 + c]);
        const float ads = dbg_shift(cs, DCS, row, 1152 + d * 64 + c, hp, hn, mu[1152 + d * 64 + c], mu[1920 + 1152 + d * 64 + c]);
        const float rs = dbg_shift(co, DCOP, row, hh * 64 + c, hp, hn, mu[1280 + hh * 64 + c], mu[1920 + 1280 + hh * 64 + c]);
        __syncthreads();
        s_tw[c] = tanhf(wds); s_ad[c] = ads; const float kt = ks * kkp[hh * 64 + c]; s_red[c] = kt * kt;
        __syncthreads();
        float lw = 0.f, la = 0.f, ssq = 0.f;
        for (int r = 0; r < 64; ++r) { lw += s_tw[r] * w2[((size_t)d * 64 + r) * 512 + hh * 64 + c]; la += s_ad[r] * a2[((size_t)d * 64 + r) * 512 + hh * 64 + c]; ssq += s_red[r]; }
        const float x = w0[d * 512 + hh * 64 + c] + lw, wlog = -log1pf(expf(-x)) - 0.5f, dec = expf(-expf(wlog));
        const float a = 1.f / (1.f + expf(-(a0[d * 512 + hh * 64 + c] + la)));
        const float kk = kt / fmaxf(sqrtf(ssq), 1e-12f), kd = ks * (1.f + (a - 1.f) * kap[hh * 64 + c]);
        __syncthreads();
        s_kk[c] = kk; s_w[c] = dec; s_b[c] = kk * a; s_kd[c] = kd; s_r[c] = rs; s_v[c] = vs; s_red[c] = rs * kd * rkp[hh * 64 + c];
        __syncthreads();
        float sk = 0.f;
#pragma unroll
        for (int k = 0; k < 64; ++k) sk += S[k] * s_kk[k];
        float y = 0.f; const float vv = s_v[c];
#pragma unroll
        for (int k = 0; k < 64; ++k) { S[k] = S[k] * s_w[k] - sk * s_b[k] + vv * s_kd[k]; y += S[k] * s_r[k]; }
        const float got = dbg_bf((const bf16_t*)(ws + WS_HY) + (size_t)d * MT * 512 + (size_t)row * 512 + hh * 64 + c);
        emax = fmaxf(emax, fabsf(y - got) / (fabsf(y) + 0.25f));
        if (c == 0) { float bs = 0.f; for (int k = 0; k < 64; ++k) bs += s_red[k]; const float gb = ((const float*)(ws + WS_BON))[(size_t)d * MT * 8 + (size_t)row * 8 + hh]; emax = fmaxf(emax, fabsf(bs - gb) / (fabsf(bs) + 0.25f)); }
    }
    dbg_max(ws, emax);
}
__global__ void dbg_merge_ref(unsigned char* ws, float* scratch, const float* w_in, const float* w_pa, const float* w_pf, const float* w_pc, const float* w_o) {
    __shared__ float yv[1024];
    const int row = blockIdx.x < 6 ? (blockIdx.x == 0 ? 0 : blockIdx.x == 1 ? 1 : blockIdx.x == 2 ? 4095 : blockIdx.x == 3 ? 4096 : blockIdx.x == 4 ? 9000 : (DBG_LAYER ? 12000 : 16384 + 5)) : (int)(((unsigned)blockIdx.x * 7919u + 11u) % (unsigned)(DBG_LAYER ? ML : MT)), tid = threadIdx.x;
    const bf16_t* h = (const bf16_t*)(ws + P_K) + (size_t)row * 1024; const bf16_t* oa = (const bf16_t*)(ws + P_Q) + (size_t)row * 1024;
    const bf16_t* of = (const bf16_t*)(ws + P_F) + (size_t)row * 512; const bf16_t* oc = (const bf16_t*)(ws + WS_HY) + (size_t)row * 512;
    for (int j = tid; j < 1024; j += 512) {
        float g0 = 0.f, g1 = 0.f, g2 = 0.f, za = 0.f, zf = 0.f, zc = 0.f;
        for (int k = 0; k < 1024; ++k) { const float hv = dbg_bf(h + k); g0 += hv * w_in[(size_t)k * D_IN_SRC + 5504 + j]; g1 += hv * w_in[(size_t)k * D_IN_SRC + 5504 + 1024 + j]; g2 += hv * w_in[(size_t)k * D_IN_SRC + 5504 + 2048 + j];
            za += dbg_bf(oa + k) * w_pa[(size_t)k * 1024 + j]; }
        for (int k = 0; k < 512; ++k) { zf += dbg_bf(of + k) * w_pf[(size_t)k * 1024 + j]; zc += dbg_bf(oc + k) * w_pc[(size_t)k * 1024 + j]; }
        yv[j] = za / (1.f + expf(-g0)) + zf / (1.f + expf(-g1)) + zc / (1.f + expf(-g2));
    }
    __syncthreads();
    for (int n = tid; n < 1024; n += 512) { float a = 0.f; for (int j = 0; j < 1024; ++j) a += yv[j] * w_o[(size_t)j * 1024 + n]; scratch[blockIdx.x * 1024 + n] = a; }
}
__global__ void dbg_merge_cmp(unsigned char* ws, const float* scratch) {
    const int row = blockIdx.x < 6 ? (blockIdx.x == 0 ? 0 : blockIdx.x == 1 ? 1 : blockIdx.x == 2 ? 4095 : blockIdx.x == 3 ? 4096 : blockIdx.x == 4 ? 9000 : (DBG_LAYER ? 12000 : 16384 + 5)) : (int)(((unsigned)blockIdx.x * 7919u + 11u) % (unsigned)(DBG_LAYER ? ML : MT));
    float e = 0.f, vm = 1e-6f;
    for (int n = threadIdx.x; n < 1024; n += blockDim.x) { const float ref = scratch[blockIdx.x * 1024 + n], got = ((const float*)(ws + P_V))[(size_t)row * 1024 + n]; e = fmaxf(e, fabsf(ref - got)); vm = fmaxf(vm, fabsf(ref)); }
    __shared__ float re[64], rv[64]; re[threadIdx.x] = e; rv[threadIdx.x] = vm; __syncthreads();
    if (threadIdx.x == 0) { for (int i = 1; i < 64; ++i) { e = fmaxf(e, re[i]); vm = fmaxf(vm, rv[i]); } if (DBG_SUB == 0) dbg_max(ws, e / vm); else if (e / vm > 0.1f) dbg_max(ws, 0.1f + 0.01f * (float)(DBG_SUB == 1 ? (row >> 8) : 67 - (row >> 8))); }
}
__global__ void dbg_post_ref(unsigned char* ws, float* scratch, const float* mu, const float* g2, const float* lnw, const float* lnb) {
    __shared__ float sg[128], yv[512];
    const int row = blockIdx.x < 6 ? (blockIdx.x == 0 ? 0 : blockIdx.x == 1 ? 1 : blockIdx.x == 2 ? 4095 : blockIdx.x == 3 ? 4096 : blockIdx.x == 4 ? 9000 : (DBG_LAYER ? 12000 : 16384 + 5)) : (int)(((unsigned)blockIdx.x * 7919u + 11u) % (unsigned)(DBG_LAYER ? ML : MT)), c = threadIdx.x;
    int pos, len; if (row < ML) { pos = row & 4095; len = 4096; } else { pos = (row - ML) & 255; len = 256; } const bool hp = pos > 0, hn = pos < len - 1;
    const bf16_t* cs = (const bf16_t*)(ws + P_CS); const bf16_t* co = (const bf16_t*)(ws + P_CO); const bf16_t* y0 = (const bf16_t*)(ws + WS_HY); const bf16_t* y1 = y0 + (size_t)MT * 512;
    if (c < 128) sg[c] = 1.f / (1.f + expf(-dbg_shift(co, DCOP, row, 512 + c, hp, hn, mu[1280 + 512 + c], mu[1920 + 1280 + 512 + c])));
    yv[c] = dbg_bf(y0 + (size_t)row * 512 + c) + dbg_bf(y1 + (size_t)row * 512 + c);
    __syncthreads();
    float g = 0.f; for (int j = 0; j < 128; ++j) g += sg[j] * g2[j * 512 + c];
    const int hh = c >> 6; float m = 0.f, q = 0.f; for (int i = 0; i < 64; ++i) m += yv[hh * 64 + i]; m *= (1.f / 64.f); for (int i = 0; i < 64; ++i) { const float dd = yv[hh * 64 + i] - m; q += dd * dd; } q *= (1.f / 64.f);
    const float yn = (yv[c] - m) / sqrtf(q + 64e-5f) * lnw[c] + lnb[c];
    const float vs = dbg_shift(cs, DCS, row, 512 + c, hp, hn, mu[512 + c], mu[1920 + 512 + c]);
    const float* bon = (const float*)(ws + WS_BON); const float bs = bon[(size_t)row * 8 + hh] + bon[(size_t)MT * 8 + (size_t)row * 8 + hh];
    scratch[blockIdx.x * 512 + c] = (yn + bs * vs) * g;
}
__global__ void dbg_post_cmp(unsigned char* ws, const float* scratch) {
    const int row = blockIdx.x < 6 ? (blockIdx.x == 0 ? 0 : blockIdx.x == 1 ? 1 : blockIdx.x == 2 ? 4095 : blockIdx.x == 3 ? 4096 : blockIdx.x == 4 ? 9000 : (DBG_LAYER ? 12000 : 16384 + 5)) : (int)(((unsigned)blockIdx.x * 7919u + 11u) % (unsigned)(DBG_LAYER ? ML : MT)), c = threadIdx.x;
    const float ref = scratch[blockIdx.x * 512 + c], got = dbg_bf((const bf16_t*)(ws + WS_HY) + (size_t)row * 512 + c);
    dbg_max(ws, fabsf(ref - got) / (fabsf(ref) + 0.25f));
}
__global__ void dbg_mod(unsigned char* ws, const float* cvec, const float* cctx, const float* adaw, const float* adab, const float* x, const float* ctxin) {
    const int l = blockIdx.x / 5, sidx = blockIdx.x % 5, tid = threadIdx.x; const float* cv = sidx < 4 ? cvec + sidx * 1024 : cctx;
    const float* modv = (const float*)(ws + TAB_MOD) + ((size_t)l * 5 + sidx) * 6144;
    for (int j = tid * 3 + sidx; j < 6144; j += 64 * 3) { float a = adab[l * 6144 + j]; for (int k = 0; k < 1024; ++k) { const float c = cv[k]; a += c / (1.f + expf(-c)) * adaw[((size_t)l * 1024 + k) * 6144 + j]; }
        dbg_max(ws, fabsf(a - modv[j]) / (fabsf(a) + 0.05f)); }
    if (l == 0 && tid == 0) {
        const int rows[5] = {3, 4099, 8200, 12300, 16384 + 600}; const int row = rows[sidx]; const float* xr = row < ML ? x + (size_t)row * 1024 : ctxin + (size_t)(row - ML) * 1024;
        const float* mv = (const float*)(ws + TAB_MOD) + (size_t)(row < ML ? (row >> 12) : 4) * 6144;
        float m = 0.f, q = 0.f; for (int i = 0; i < 1024; ++i) m += xr[i]; m /= 1024.f; for (int i = 0; i < 1024; ++i) q += (xr[i] - m) * (xr[i] - m); q /= 1024.f; const float rs = 1.f / sqrtf(q + 1e-5f);
        for (int i = 0; i < 1024; i += 7) { const float ref = (xr[i] - m) * rs * (1.f + mv[1024 + i]) + mv[i], got = dbg_bf((const bf16_t*)(ws + WS_HY) + (size_t)row * 1024 + i); dbg_max(ws, fabsf(ref - got) / (fabsf(ref) + 0.25f)); }
    }
}
__global__ void dbg_ffn_ref(unsigned char* ws, const float* fup, const float* fconv, const float* fconvb, const float* fdn) {
    __shared__ float av[2816];
    const int row = blockIdx.x < 6 ? (blockIdx.x == 0 ? 0 : blockIdx.x == 1 ? 1 : blockIdx.x == 2 ? 4095 : blockIdx.x == 3 ? 4096 : blockIdx.x == 4 ? 9000 : (DBG_LAYER ? 12000 : 16384 + 5)) : (int)(((unsigned)blockIdx.x * 7919u + 11u) % (unsigned)(DBG_LAYER ? ML : MT)), tid = threadIdx.x;
    int pos, len; if (row < ML) { pos = row & 4095; len = 4096; } else { pos = (row - ML) & 255; len = 256; } const bool hp = pos > 0, hn = pos < len - 1;
    const bf16_t* h = (const bf16_t*)(ws + WS_HY) + (size_t)row * 1024;
    for (int j = tid; j < 2816; j += 512) { float u = 0.f, gc = 0.f, gp = 0.f, gn = 0.f;
        for (int k = 0; k < 1024; ++k) { const float wu = fup[(size_t)k * 5632 + j], wg = fup[(size_t)k * 5632 + 2816 + j]; u += dbg_bf(h + k) * wu; gc += dbg_bf(h + k) * wg; if (hp) gp += dbg_bf(h - 1024 + k) * wg; if (hn) gn += dbg_bf(h + 1024 + k) * wg; }
        const float x = fconv[j] * gp + fconv[2816 + j] * gc + fconv[2 * 2816 + j] * gn + fconvb[j];
        av[j] = 0.5f * x * (1.f + erff(x * 0.70710678f)) * u; }
    __syncthreads();
    for (int n = tid; n < 1024; n += 512) { float a = 0.f; for (int j = 0; j < 2816; ++j) a += av[j] * fdn[(size_t)j * 1024 + n]; ((float*)(ws + WS_DBG + 131072))[blockIdx.x * 1024 + n] = a; }
}
__global__ void dbg_ffn_cmp(unsigned char* ws) {
    const int row = blockIdx.x < 6 ? (blockIdx.x == 0 ? 0 : blockIdx.x == 1 ? 1 : blockIdx.x == 2 ? 4095 : blockIdx.x == 3 ? 4096 : blockIdx.x == 4 ? 9000 : (DBG_LAYER ? 12000 : 16384 + 5)) : (int)(((unsigned)blockIdx.x * 7919u + 11u) % (unsigned)(DBG_LAYER ? ML : MT));
    float e = 0.f, vm = 1e-6f;
    for (int n = threadIdx.x; n < 1024; n += blockDim.x) { const float ref = ((const float*)(ws + WS_DBG + 131072))[blockIdx.x * 1024 + n], got = dbg_bf((const bf16_t*)(ws + WS_HY) + (size_t)row * 1024 + n); e = fmaxf(e, fabsf(ref - got)); vm = fmaxf(vm, fabsf(ref)); }
    __shared__ float re[64], rv[64]; re[threadIdx.x] = e; rv[threadIdx.x] = vm; __syncthreads();
    if (threadIdx.x == 0) { for (int i = 1; i < 64; ++i) { e = fmaxf(e, re[i]); vm = fmaxf(vm, rv[i]); } dbg_max(ws, e / vm); }
}
__global__ void dbg_ln1(unsigned char* ws, const float* x, const float* ctxin, const float* out, const float* g, const float* bt) {
    const int row = blockIdx.x < 6 ? (blockIdx.x == 0 ? 0 : blockIdx.x == 1 ? 1 : blockIdx.x == 2 ? 4095 : blockIdx.x == 3 ? 4096 : blockIdx.x == 4 ? 9000 : (DBG_LAYER ? 12000 : 16384 + 5)) : (int)(((unsigned)blockIdx.x * 7919u + 11u) % (unsigned)(DBG_LAYER ? ML : MT));
    const float* xr = row < ML ? x + (size_t)row * 1024 : ctxin + (size_t)(row - ML) * 1024; const float* mix = (const float*)(ws + P_V) + (size_t)row * 1024;
    const float* mv = (const float*)(ws + TAB_MOD) + (size_t)(row < ML ? (row >> 12) : 4) * 6144;
    const float* got = row < ML ? out + (size_t)row * 1024 : (const float*)(ws + WS_XC) + (size_t)(row - ML) * 1024;
    __shared__ float z[1024], red[2];
    if (threadIdx.x == 0) { float m = 0.f, q = 0.f; for (int i = 0; i < 1024; ++i) { z[i] = 1.41421356f * xr[i] + mv[2048 + i] * mix[i]; m += z[i]; } m /= 1024.f; for (int i = 0; i < 1024; ++i) q += (z[i] - m) * (z[i] - m); q /= 1024.f; red[0] = m; red[1] = 1.f / sqrtf(q + 1e-5f);
        float e = 0.f; for (int i = 0; i < 1024; ++i) { const float ref = (z[i] - m) * red[1] * g[i] + bt[i]; e = fmaxf(e, fabsf(ref - got[i])); z[i] = ref; }
        float m2 = 0.f, q2 = 0.f; for (int i = 0; i < 1024; ++i) m2 += z[i]; m2 /= 1024.f; for (int i = 0; i < 1024; ++i) q2 += (z[i] - m2) * (z[i] - m2); q2 /= 1024.f; const float rs2 = 1.f / sqrtf(q2 + 1e-5f);
        for (int i = 0; i < 1024; ++i) { const float ref = (z[i] - m2) * rs2 * (1.f + mv[4096 + i]) + mv[3072 + i]; e = fmaxf(e, fabsf(ref - dbg_bf((const bf16_t*)(ws + WS_HY) + (size_t)row * 1024 + i)) / (fabsf(ref) + 0.25f)); }
        dbg_max(ws, e); }
}
__global__ void dbg_ln2_ref(unsigned char* ws, const float* out, const float* g, const float* bt, int layer) {
    const int row = (int)(((unsigned)blockIdx.x * 7919u + 5u) % (unsigned)(layer ? ML : MT));
    const float* xr = row < ML ? out + (size_t)row * 1024 : (const float*)(ws + WS_XC) + (size_t)(row - ML) * 1024; const bf16_t* ff = (const bf16_t*)(ws + WS_HY) + (size_t)row * 1024;
    const float* mv = (const float*)(ws + TAB_MOD) + ((size_t)layer * 5 + (row < ML ? (row >> 12) : 4)) * 6144;
    __shared__ float z[1024]; float* dst = (float*)(ws + WS_DBG + 131072) + blockIdx.x * 1024;
    if (threadIdx.x == 0) { float m = 0.f, q = 0.f; for (int i = 0; i < 1024; ++i) { z[i] = 1.41421356f * xr[i] + mv[5120 + i] * dbg_bf(ff + i); m += z[i]; } m /= 1024.f; for (int i = 0; i < 1024; ++i) q += (z[i] - m) * (z[i] - m); q /= 1024.f; const float rs = 1.f / sqrtf(q + 1e-5f);
        for (int i = 0; i < 1024; ++i) dst[i] = (z[i] - m) * rs * g[i] + bt[i]; }
}
__global__ void dbg_ln2_cmp(unsigned char* ws, const float* out, int layer) {
    const int row = (int)(((unsigned)blockIdx.x * 7919u + 5u) % (unsigned)(layer ? ML : MT));
    const float* got = row < ML ? out + (size_t)row * 1024 : (const float*)(ws + WS_XC) + (size_t)(row - ML) * 1024; const float* ref = (const float*)(ws + WS_DBG + 131072) + blockIdx.x * 1024;
    float e = 0.f; for (int i = threadIdx.x; i < 1024; i += 64) e = fmaxf(e, fabsf(ref[i] - got[i])); dbg_max(ws, e);
}
__global__ void dbg_report(unsigned char* ws, float* out) { const float e = __uint_as_float(*(const unsigned*)(ws + WS_DBG)); const float b2 = __uint_as_float(*(const unsigned*)(ws + WS_DBG + 4));
    const int i = blockIdx.x * blockDim.x + threadIdx.x; if (i == 0) out[0] = 100.f + 1e4f * fminf(e, 50.f); else if (DBG_TWO) out[i] = 10.f + b2; }
__device__ __forceinline__ void dbg_max2(unsigned char* ws, float e) { atomicMax((unsigned*)(ws + WS_DBG + 4), __float_as_uint(fabsf(e))); }
__global__ void dbg_gate2(unsigned char* ws, const float* w_in) {
    const int tile = blockIdx.x * blockDim.x + threadIdx.x; if (tile >= 68 * 12) return; const int pm = tile / 12, pn = tile % 12; bool bad = false;
    for (int p = 0; p < 4; ++p) { const int row = 256 * pm + 7 + 61 * p, col = 256 * pn + 9 + 59 * p; const bf16_t* h = (const bf16_t*)(ws + P_K) + (size_t)row * 1024;
        float g = 0.f; for (int k = 0; k < 1024; ++k) g += dbg_bf(h + k) * w_in[(size_t)k * D_IN_SRC + 5504 + col];
        const float ref = 1.f / (1.f + expf(-g)), got = dbg_bf((const bf16_t*)(ws + P_V) + (size_t)row * NGATE + col); if (!(fabsf(ref - got) < 0.02f)) bad = true; }
    if (bad) { atomicAdd((unsigned*)(ws + WS_DBG + 16), 1u); atomicMin((unsigned*)(ws + WS_DBG + 20), (unsigned)tile); atomicMax((unsigned*)(ws + WS_DBG + 24), (unsigned)tile); }
}
__global__ void dbg_gate2_init(unsigned char* ws) { *(unsigned*)(ws + WS_DBG + 20) = 0xffffffffu; }
__global__ void dbg_gate2_fin(unsigned char* ws) { const unsigned cnt = *(const unsigned*)(ws + WS_DBG + 16), mn = *(const unsigned*)(ws + WS_DBG + 20), mx = *(const unsigned*)(ws + WS_DBG + 24);
    const float v = DBG_SUB == 0 ? (float)cnt : DBG_SUB == 1 ? (float)mn : (float)mx; *(unsigned*)(ws + WS_DBG) = __float_as_uint(v * 0.01f); }
__global__ void dbg_gate3(unsigned char* ws) {
    const bf16_t* g = (const bf16_t*)(ws + P_V); unsigned* w = (unsigned*)(ws + WS_DBG);
    for (size_t i = (size_t)blockIdx.x * blockDim.x + threadIdx.x; i < (size_t)MT * NGATE; i += (size_t)gridDim.x * blockDim.x) {
        const float v = dbg_bf(g + i); if (!(v >= -0.001f && v <= 1.001f)) { const unsigned row = (unsigned)(i / NGATE), col = (unsigned)(i % NGATE);
            atomicAdd(w + 4, 1u); atomicMin(w + 5, row & 255u); atomicMax(w + 6, row & 255u); atomicMin(w + 7, col & 255u); atomicMax(w + 8, col & 255u); atomicMin(w + 9, row); atomicMax(w + 10, row); atomicMin(w + 11, col); atomicMax(w + 12, col); atomicAdd(w + 13, row & 255u); atomicAdd(w + 14, col & 255u); if ((row & 255u) == 180u) atomicAdd(w + 15, 1u); if ((row & 63u) == 52u) atomicAdd(w + 16, 1u); if ((col & 255u) >= 128u) atomicAdd(w + 17, 1u); if (v != v) atomicAdd(w + 18, 1u); if (fabsf(v) > 2.f) atomicAdd(w + 19, 1u); if (v < 0.f) atomicAdd(w + 20, 1u); if (((row >> 4) & 3u) == 3u) atomicAdd(w + 21, 1u); if ((row & 255u) >= 128u) atomicAdd(w + 22, 1u); atomicMax(w + 23, __float_as_uint(fabsf(v))); } }
}
__global__ void dbg_fill(unsigned char* ws) { unsigned* g = (unsigned*)(ws + P_V); for (size_t i = (size_t)blockIdx.x * blockDim.x + threadIdx.x; i < (size_t)MT * NGATE / 2; i += (size_t)gridDim.x * blockDim.x) g[i] = 0x3f003f00u; }
__global__ void dbg_gate3_init(unsigned char* ws) { unsigned* w = (unsigned*)(ws + WS_DBG); w[5] = 0xffffffffu; w[7] = 0xffffffffu; w[9] = 0xffffffffu; w[11] = 0xffffffffu; }
__global__ void dbg_gate3_fin(unsigned char* ws) { unsigned* w = (unsigned*)(ws + WS_DBG); const float sc[20] = {1e-5f, 0.01f, 0.01f, 0.01f, 0.01f, 1e-3f, 1e-3f, 1e-2f, 1e-2f, 1e-7f, 1e-7f, 1e-5f, 1e-5f, 1e-5f, 1e-5f, 1e-5f, 1e-5f, 1e-5f, 1e-5f, 0.f};
    w[0] = DBG_SUB == 19 ? __float_as_uint(__uint_as_float(w[23]) * 0.01f) : __float_as_uint((float)w[4 + DBG_SUB] * sc[DBG_SUB]); }
__global__ void dbg_gate(unsigned char* ws, const float* w_in, int pass) {
    const int row = (int)(((unsigned)blockIdx.x * 7919u + 11u) % (unsigned)MT); const bf16_t* h = (const bf16_t*)(ws + P_K) + (size_t)row * 1024;
    const float emax = __uint_as_float(*(const unsigned*)(ws + WS_DBG));
    for (int col = threadIdx.x * 5 + (blockIdx.x & 3); col < 3072; col += blockDim.x * 5) {
        float g = 0.f; for (int k = 0; k < 1024; ++k) g += dbg_bf(h + k) * w_in[(size_t)k * D_IN_SRC + 5504 + col];
        const float ref = 1.f / (1.f + expf(-g)), got = dbg_bf((const bf16_t*)(ws + P_V) + (size_t)row * NGATE + col), e = fabsf(ref - got);
        if (pass == 0) dbg_max(ws, e); else if (e >= emax * 0.999f && emax > 0.02f) dbg_max2(ws, (float)(row >> 8) + 0.01f * (float)(col >> 8));
    }
}
#endif
#ifndef MK_PER_PHASE
#define MK_PER_PHASE 1
#endif
constexpr int N_PHASES = 2 + 13 * NLAYER;
struct Args { const float* in[32]; float* out; unsigned char* ws; int ph_lo, ph_hi; };

__device__ __forceinline__ pg8::Operand opnd(const void* base, long tM, long tN, long rstride, long kstep) {
    pg8::Operand o; o.base = (const char*)base; o.tM = tM; o.tN = tN; o.tN2 = 0; o.nshift = 30; o.rstride = rstride; o.hstep = 128 * rstride; o.kstep = kstep; return o; }
struct RowF0 { __device__ __forceinline__ unsigned operator()(int R) const { return (unsigned)(((R & 63) * 64 + (R >> 6)) * 1024); } };

__global__ void __launch_bounds__(NTHREADS, 2) mk_fwd(Args args) {
    extern __shared__ __attribute__((aligned(16))) unsigned char lds[];
    Frame F;
    F.lds = (LAS unsigned char*)lds; F.ldsg = (char*)lds;
    F.MISC = (volatile LAS unsigned*)(F.lds + MISC_OFF);
    F.tid = threadIdx.x; F.lane = F.tid & 63; F.wave = __builtin_amdgcn_readfirstlane(F.tid >> 6);
    F.G = gridDim.x; F.gw = blockIdx.x * NWAVES + F.wave; F.NGW = F.G * NWAVES;
    F.x_in = args.in[I_X]; F.ctx_in = args.in[I_CTX];
    F.out = args.out; F.ws = args.ws; F.ctl = (gu32*)(args.ws + WS_CTL);
    unsigned char* ws0 = args.ws;
#define LWS size_t wo_ = 0; int bx = bx0, G = G0; asm volatile("" : "+s"(wo_), "+s"(bx), "+s"(G)); unsigned char* ws = ws0 + wo_
    for (int u = F.tid; u < (LDS_BYTES - LDSCTL_OFF) / 4; u += NTHREADS) ((LAS unsigned*)(F.lds + LDSCTL_OFF))[u] = 0u;
    __syncthreads();
    XcdBarrier bar; bar.bar = (unsigned*)(F.ctl + CW_BAR); bar.x = 0; bar.st = nullptr;
    if (!MK_PER_PHASE) bar = xcd_barrier_post((unsigned*)(F.ctl + CW_BAR), F.MISC + 8);
    const int lo = args.ph_lo, hi = args.ph_hi;
#ifndef PHMASK
#define PHMASK 0x7fff
#endif
#define IN(k) (lo <= (k) && (k) < hi)
#define KIND(b) ((PHMASK >> (b)) & 1)
#define INP(i) (args.in[i])
#define SEAM(k) do { if (!MK_PER_PHASE && IN((k) + 1)) xcd_barrier(bar.bar, bar.x, bar.st); } while (0)
    const int bx0 = blockIdx.x, G0 = F.G;
    pg8::StaticOrder S;
    const pg8::RowLin rl2048{2048}, rl1024{1024}, rl128{128}, rl256{256}, rl11264{11264}, rl5632{5632};

    if (KIND(0) && IN(0)) { LWS; build_mod(F, INP(I_C), INP(I_CCTX), INP(I_ADAW), INP(I_ADAB)); __syncthreads(); build_tables(F, INP(I_LAMQK)); CONVERT_WEIGHTS(F, 0, INP); SEAM(0); }
    if (KIND(1) && IN(1)) { LWS; pass_modulate(F, 0, (bf16_t*)(ws + WS_HY), MT); SEAM(1); }

#pragma unroll 1
    for (int layer = 0; layer < NLAYER; ++layer) {
        const int pb = 2 + 13 * layer;
        const bool last = layer == NLAYER - 1;
        const int MR = last ? ML : MT;

        if (KIND(2) && IN(pb + 0)) { LWS;
            S.init(MT, NP, G, bx);
            pg8::EpiInProj E{ws, (const float*)(ws + TAB_ROPE)};
            pg8::gemm_phase<pg8::EpiInProj, pg8::RowLin, true>(F.lds, opnd(ws + WS_HY, 256 * 2048, 0, 2048, 128), opnd(ws + W_IN, 0, 256 * 2048, 2048, 128), rl2048, 16, S, E);
            SEAM(pb + 0);
        }
        if (KIND(3) && IN(pb + 1)) { LWS;
#ifndef DBG_NO_SCAN
            if (((bx >> 3) & 3) == 0 && (bx >> 5) < 8) {
                const int sid = (bx >> 5) * 8 + (bx & 7);
                rwkv::Params P; P.cs = (const bf16_t*)(ws + P_CS); P.co = (bf16_t*)(ws + P_CO); P.y = (bf16_t*)(ws + WS_HY); P.bon = (float*)(ws + WS_BON);
                P.mu = INP(I_MU) + layer * 2 * 1920; P.w0 = INP(I_W0) + layer * 1024; P.w2 = INP(I_W2) + (size_t)layer * 2 * 64 * 512; P.a0 = INP(I_A0) + layer * 1024;
                P.a2 = INP(I_A2) + (size_t)layer * 2 * 64 * 512; P.kk = INP(I_KK) + layer * 512; P.ka = INP(I_KA) + layer * 512; P.rk = INP(I_RK) + layer * 512;
                rwkv::scan_wg(P, sid >> 5, (sid >> 3) & 3, sid & 7, (LAS char*)F.lds);
            }
#endif
            const float* tabf = (const float*)(ws + TAB_LAM); const float lam = tabf[2 * layer], osc = tabf[2 * layer + 1];
            const int x = bx & 7, nun = last ? 64 : 68;
            gu32* qw = F.ctl + CW_QUEUE + 64 * (layer * 8 + x);
#ifndef DBG_NO_ATTN
            for (;;) {
                __syncthreads();
                if (F.tid == 0) F.MISC[0] = __hip_atomic_fetch_add(qw, 1u, RLX_AGENT);
                __syncthreads();
                const int i = (int)F.MISC[0];
                if (i >= nun) break;
                const bf16_t* Q = (const bf16_t*)(ws + P_Q); const bf16_t* K = (const bf16_t*)(ws + P_K); const bf16_t* V = (const bf16_t*)(ws + P_V);
                const float* sub = INP(I_SUBLN) + layer * 128; const float* rope = (const float*)(ws + TAB_ROPE);
                if (i < 64) { const int pair = x + 8 * (i >> 4), qb = i & 15, b = pair >> 3, hh = pair & 7;
                    attn::attn_unit<true>(Q, K, V, (bf16_t*)(ws + P_Q), b * SEQ + 256 * qb, b, hh, lam, osc, sub, rope, (LAS char*)F.lds); }
                else { const int pair = x + 8 * (i - 64), b = pair >> 3, hh = pair & 7;
#ifndef DBG_NO_ATTNC
                    attn::attn_unit<false>(Q, K, V, (bf16_t*)(ws + P_Q), ML + b * CTXL, b, hh, lam, osc, sub, rope, (LAS char*)F.lds);
#endif
                }
            }
#endif
            SEAM(pb + 1);
        }
        if (KIND(4) && IN(pb + 2)) { LWS;
            { S.init(1024, ML, G, bx); pg8::EpiF0 E{(bf16_t*)(ws + P_K)};
              pg8::Operand B = opnd(ws + P_F, 256, 4 * 1024, 1024, 128); B.nshift = 4; B.tN2 = 4096L * 1024; B.hstep = 2 * 1024;
              pg8::gemm_phase<pg8::EpiF0, RowF0, true>(F.lds, opnd(ws + TAB_W0, 0, 0, 256, 128), B, RowF0{}, 2, S, E); }
            if (!last) { S.init(1024, MC, G, (bx + G - 16) % G); pg8::EpiF0c E{(bf16_t*)(ws + P_K + 32 * MiB)};
              pg8::gemm_phase<pg8::EpiF0c, pg8::RowLin, true>(F.lds, opnd(ws + TAB_W0, 0, 0, 256, 128), opnd(ws + P_F + (size_t)ML * 1024, 256, 256 * 1024, 1024, 128), rl1024, 2, S, E); }
            SEAM(pb + 2);
        }
        if (KIND(5) && IN(pb + 3)) { LWS;
            { S.init(256, 65536, G, bx); pg8::EpiF1 E{(bf16_t*)(ws + P_V), (const float*)(ws + TAB_TW)};
              pg8::gemm_phase<pg8::EpiF1, pg8::RowLin, true>(F.lds, opnd(ws + TAB_F1, 0, 0, 512, 128), opnd(ws + P_K, 0, 256 * 128, 128, 8 * MiB), rl128, 4, S, E); }
            if (!last) { S.init(256, 2048, G, (bx + G - 8) % G); pg8::EpiFc E{(bf16_t*)(ws + P_F)};
              pg8::gemm_phase<pg8::EpiFc, pg8::RowLin, true>(F.lds, opnd(ws + TAB_DC, 0, 0, 1024, 128), opnd(ws + P_K + 32 * MiB, 0, 256 * 1024, 1024, 128), rl1024, 8, S, E); }
            SEAM(pb + 3);
        }
        if (KIND(6) && IN(pb + 4)) { LWS;
            { S.init(256, 32768, G, bx); pg8::EpiF2 E{(bf16_t*)(ws + P_F)};
              pg8::gemm_phase<pg8::EpiF2, pg8::RowLin, true>(F.lds, opnd(ws + TAB_F2, 0, 0, 1024, 128), opnd(ws + P_V, 0, 256 * 128, 128, 4 * MiB), rl128, 8, S, E); }
            { S.init(MR, 512, G, (bx + G - 120) % G);
              pg8::EpiRwkvPost E{(const bf16_t*)(ws + WS_HY), (const bf16_t*)(ws + WS_HY) + (size_t)MT * 512, (const bf16_t*)(ws + P_CS), (const float*)(ws + WS_BON),
                                 INP(I_MU) + layer * 2 * 1920, INP(I_LNW) + layer * 512, INP(I_LNB) + layer * 512, (bf16_t*)(ws + WS_HY)};
              pg8::gemm_phase<pg8::EpiRwkvPost, pg8::RowLin, false>(F.lds, opnd(ws + P_CO + DCO * 2, 256 * 1536, 0, 1536, 128), opnd(ws + W_G2T, 0, 256 * 256, 256, 128), rl256, 2, S, E); }
            pass_modulate(F, layer, (bf16_t*)(ws + P_K), MR);
            SEAM(pb + 4);
        }
        if (KIND(7) && IN(pb + 5)) { LWS;
            S.init(MR, NGATE, G, bx); pg8::EpiGate E{(bf16_t*)(ws + P_V)};
            pg8::gemm_phase<pg8::EpiGate, pg8::RowLin, true>(F.lds, opnd(ws + P_K, 256 * 2048, 0, 2048, 128), opnd(ws + W_IN + (size_t)NP * 2048, 0, 256 * 2048, 2048, 128), rl2048, 16, S, E);
            SEAM(pb + 5);
        }
        if (KIND(8) && IN(pb + 6)) { LWS;
            S.init(MR, 1024, G, bx);
            { pg8::EpiBranch<true> E{(const bf16_t*)(ws + P_V), (bf16_t*)(ws + P_K), (DBG_BR & 1) ? 1.f : 0.f};
              pg8::gemm_phase<pg8::EpiBranch<true>, pg8::RowLin, true>(F.lds, opnd(ws + P_Q, 256 * 2048, 0, 2048, 128), opnd(ws + W_PA, 0, 256 * 2048, 2048, 128), rl2048, 16, S, E); }
            VM_WAIT();
            { pg8::EpiBranch<false> E{(const bf16_t*)(ws + P_V) + 1024, (bf16_t*)(ws + P_K), (DBG_BR & 2) ? 1.f : 0.f};
              pg8::gemm_phase<pg8::EpiBranch<false>, pg8::RowLin, true>(F.lds, opnd(ws + P_F, 256 * 1024, 0, 1024, 128), opnd(ws + W_PF, 0, 256 * 1024, 1024, 128), rl1024, 8, S, E); }
            VM_WAIT();
            { pg8::EpiBranch<false> E{(const bf16_t*)(ws + P_V) + 2048, (bf16_t*)(ws + P_K), (DBG_BR & 4) ? 1.f : 0.f};
              pg8::gemm_phase<pg8::EpiBranch<false>, pg8::RowLin, true>(F.lds, opnd(ws + WS_HY, 256 * 1024, 0, 1024, 128), opnd(ws + W_PC, 0, 256 * 1024, 1024, 128), rl1024, 8, S, E); }
            SEAM(pb + 6);
        }
        if (KIND(9) && IN(pb + 7)) { LWS;
            S.init(MR, 1024, G, bx); pg8::EpiF32 E{(float*)(ws + P_V), 1024};
            pg8::gemm_phase<pg8::EpiF32, pg8::RowLin, true>(F.lds, opnd(ws + P_K, 256 * 2048, 0, 2048, 128), opnd(ws + W_O, 0, 256 * 2048, 2048, 128), rl2048, 16, S, E);
            SEAM(pb + 7);
        }
        if (KIND(10) && IN(pb + 8)) { LWS; pass_ln1(F, layer, (const float*)(ws + P_V), (bf16_t*)(ws + WS_HY), MR, INP(I_LN1G) + layer * DM, INP(I_LN1B) + layer * DM); SEAM(pb + 8); }
        if (KIND(11) && IN(pb + 9)) { LWS;
            S.init(MR, NP, G, bx); pg8::EpiBf16 E{(bf16_t*)(ws + WS_P), NP};
            pg8::gemm_phase<pg8::EpiBf16, pg8::RowLin, true>(F.lds, opnd(ws + WS_HY, 256 * 2048, 0, 2048, 128), opnd(ws + W_UP, 0, 256 * 2048, 2048, 128), rl2048, 16, S, E);
            SEAM(pb + 9);
        }
        if (KIND(12) && IN(pb + 10)) { LWS; pass_conv(F, (bf16_t*)(ws + WS_P), MR, INP(I_FCONV) + (size_t)layer * 3 * DFF, INP(I_FCONVB) + (size_t)layer * DFF); SEAM(pb + 10); }
        if (KIND(13) && IN(pb + 11)) { LWS;
            S.init(MR, 1024, G, bx); pg8::EpiBf16 E{(bf16_t*)(ws + WS_HY), 1024};
            pg8::gemm_phase<pg8::EpiBf16, pg8::RowLin, true>(F.lds, opnd(ws + WS_P, 256 * 11264, 0, 11264, 128), opnd(ws + W_DN, 0, 256 * 5632, 5632, 128), rl5632, 44, S, E);
            SEAM(pb + 11);
        }
        if (KIND(14) && IN(pb + 12)) { LWS;
            pass_ln2(F, layer, (bf16_t*)(ws + WS_HY), MR, !last, INP(I_LN2G) + layer * DM, INP(I_LN2B) + layer * DM);
            if (!last) { __syncthreads(); CONVERT_WEIGHTS(F, layer + 1, INP); }
            SEAM(pb + 12);
        }
    }
#undef IN
#undef SEAM
}

extern "C" void kernel_launch(void* const* d_in, const int* in_sizes, int n_in, void* d_out, int out_size, void* d_ws, size_t ws_size, hipStream_t stream) {
    static int grid = 0;
    if (grid == 0) {
        if (n_in != 32 || in_sizes[0] != ML * DM || out_size != ML * DM || ws_size < WS_END) { fprintf(stderr, "kernel_launch: unexpected shapes (n_in %d, ws %zu)\n", n_in, ws_size); grid = -1; return; }
        int dev = 0, cus = 0, per_cu = 0;
        if (hipGetDevice(&dev) != hipSuccess || hipDeviceGetAttribute(&cus, hipDeviceAttributeMultiprocessorCount, dev) != hipSuccess) { grid = -1; return; }
        if (hipFuncSetAttribute((const void*)mk_fwd, hipFuncAttributeMaxDynamicSharedMemorySize, LDS_BYTES) != hipSuccess) { fprintf(stderr, "kernel_launch: hipFuncSetAttribute failed\n"); grid = -1; return; }
        if (hipOccupancyMaxActiveBlocksPerMultiprocessor(&per_cu, (const void*)mk_fwd, NTHREADS, LDS_BYTES) != hipSuccess || per_cu < 1) { fprintf(stderr, "kernel_launch: occupancy query says %d\n", per_cu); per_cu = 1; }
        (void)hipGetLastError();
        grid = cus;
        if (grid < 256 || (grid % 8) != 0) fprintf(stderr, "kernel_launch: grid %d\n", grid);
    }
    if (grid < 0) return;
    (void)hipMemsetAsync((char*)d_ws + WS_CTL, 0, CTL_ZERO_BYTES, stream);
    Args a{};
    for (int i = 0; i < 32; ++i) a.in[i] = (const float*)d_in[i];
    a.out = (float*)d_out; a.ws = (unsigned char*)d_ws;
#if MK_PER_PHASE
    unsigned char* ws8 = (unsigned char*)d_ws; (void)ws8;
    for (int p = 0; p < N_PHASES; ++p) {
#if defined(DBG_CHECK)
        if (DBG_CHECK == 14 && p == 7 + 13 * DBG_LAYER) hipLaunchKernelGGL(dbg_fill, dim3(2048), dim3(256), 0, stream, (unsigned char*)d_ws);
        if (DBG_CHECK == 1 && p == 3 + 13 * DBG_LAYER) hipLaunchKernelGGL(dbg_pre, dim3(2048), dim3(256), 0, stream, (unsigned char*)d_ws, (float*)d_out);
#endif
        a.ph_lo = p; a.ph_hi = p + 1; hipLaunchKernelGGL(mk_fwd, dim3(grid), dim3(NTHREADS), LDS_BYTES, stream, a);
#if defined(DBG_CHECK)
#ifndef DBG_LAYER
#define DBG_LAYER 0
#endif
        if (DBG_CHECK == 2 && p == 2 + 13 * DBG_LAYER) hipLaunchKernelGGL(dbg_inproj, dim3(9), dim3(64), 0, stream, (unsigned char*)d_ws, (const float*)d_in[I_WIN] + (size_t)DBG_LAYER * 1024 * D_IN_SRC);
        if (DBG_CHECK == 3 && p == 4 + 13 * DBG_LAYER) hipLaunchKernelGGL(dbg_fourier_ref, dim3(128), dim3(512), 0, stream, (unsigned char*)d_ws);
        if (DBG_CHECK == 3 && p == 6 + 13 * DBG_LAYER) hipLaunchKernelGGL(dbg_fourier_cmp, dim3(1), dim3(128), 0, stream, (unsigned char*)d_ws);
        if (DBG_CHECK == 4 && p == 3 + 13 * DBG_LAYER) hipLaunchKernelGGL(dbg_scan, dim3(64), dim3(64), 0, stream, (unsigned char*)d_ws, (float*)d_out, (const float*)d_in[I_MU] + DBG_LAYER * 3840, (const float*)d_in[I_W0] + DBG_LAYER * 1024, (const float*)d_in[I_W2] + DBG_LAYER * 65536, (const float*)d_in[I_A0] + DBG_LAYER * 1024, (const float*)d_in[I_A2] + DBG_LAYER * 65536, (const float*)d_in[I_KK] + DBG_LAYER * 512, (const float*)d_in[I_KA] + DBG_LAYER * 512, (const float*)d_in[I_RK] + DBG_LAYER * 512);
        if (DBG_CHECK == 5 && p == 7 + 13 * DBG_LAYER) hipLaunchKernelGGL(dbg_merge_ref, dim3(48), dim3(512), 0, stream, (unsigned char*)d_ws, (float*)(ws8 + WS_DBG + 262144), (const float*)d_in[I_WIN] + (size_t)DBG_LAYER * 1024 * D_IN_SRC, (const float*)d_in[I_WPA] + DBG_LAYER * 1048576, (const float*)d_in[I_WPF] + DBG_LAYER * 524288, (const float*)d_in[I_WPC] + DBG_LAYER * 524288, (const float*)d_in[I_WO] + DBG_LAYER * 1048576);
        if (DBG_CHECK == 5 && p == 9 + 13 * DBG_LAYER) hipLaunchKernelGGL(dbg_merge_cmp, dim3(48), dim3(64), 0, stream, (unsigned char*)d_ws, (const float*)(ws8 + WS_DBG + 262144));
        if (DBG_CHECK == 6 && p == 5 + 13 * DBG_LAYER) hipLaunchKernelGGL(dbg_post_ref, dim3(96), dim3(512), 0, stream, (unsigned char*)d_ws, (float*)(ws8 + WS_DBG + 262144), (const float*)d_in[I_MU] + DBG_LAYER * 3840, (const float*)d_in[I_G2] + DBG_LAYER * 65536, (const float*)d_in[I_LNW] + DBG_LAYER * 512, (const float*)d_in[I_LNB] + DBG_LAYER * 512);
        if (DBG_CHECK == 6 && p == 6 + 13 * DBG_LAYER) hipLaunchKernelGGL(dbg_post_cmp, dim3(96), dim3(512), 0, stream, (unsigned char*)d_ws, (const float*)(ws8 + WS_DBG + 262144));
        if (DBG_CHECK == 7 && p == 1) hipLaunchKernelGGL(dbg_mod, dim3(10), dim3(64), 0, stream, (unsigned char*)d_ws, (const float*)d_in[I_C], (const float*)d_in[I_CCTX], (const float*)d_in[I_ADAW], (const float*)d_in[I_ADAB], (const float*)d_in[I_X], (const float*)d_in[I_CTX]);
        if (DBG_CHECK == 8 && p == 10 + 13 * DBG_LAYER) hipLaunchKernelGGL(dbg_ffn_ref, dim3(48), dim3(512), 0, stream, (unsigned char*)d_ws, (const float*)d_in[I_FUP] + (size_t)DBG_LAYER * 1024 * 5632, (const float*)d_in[I_FCONV] + DBG_LAYER * 3 * 2816, (const float*)d_in[I_FCONVB] + DBG_LAYER * 2816, (const float*)d_in[I_FDN] + (size_t)DBG_LAYER * 2816 * 1024);
        if (DBG_CHECK == 8 && p == 13 + 13 * DBG_LAYER) hipLaunchKernelGGL(dbg_ffn_cmp, dim3(48), dim3(64), 0, stream, (unsigned char*)d_ws);
        if (DBG_CHECK == 9 && p == 10) hipLaunchKernelGGL(dbg_ln1, dim3(6), dim3(64), 0, stream, (unsigned char*)d_ws, (const float*)d_in[I_X], (const float*)d_in[I_CTX], (const float*)d_out, (const float*)d_in[I_LN1G], (const float*)d_in[I_LN1B]);
        if (DBG_CHECK == 10 && p == 13 + 13 * DBG_LAYER) hipLaunchKernelGGL(dbg_ln2_ref, dim3(64), dim3(64), 0, stream, (unsigned char*)d_ws, (const float*)d_out, (const float*)d_in[I_LN2G] + DBG_LAYER * 1024, (const float*)d_in[I_LN2B] + DBG_LAYER * 1024, DBG_LAYER);
        if (DBG_CHECK == 10 && p == 14 + 13 * DBG_LAYER) hipLaunchKernelGGL(dbg_ln2_cmp, dim3(64), dim3(64), 0, stream, (unsigned char*)d_ws, (const float*)d_out, DBG_LAYER);
        if (DBG_CHECK == 11 && p == 7 + 13 * DBG_LAYER) { hipLaunchKernelGGL(dbg_gate, dim3(256), dim3(64), 0, stream, (unsigned char*)d_ws, (const float*)d_in[I_WIN] + (size_t)DBG_LAYER * 1024 * D_IN_SRC, 0); hipLaunchKernelGGL(dbg_gate, dim3(256), dim3(64), 0, stream, (unsigned char*)d_ws, (const float*)d_in[I_WIN] + (size_t)DBG_LAYER * 1024 * D_IN_SRC, 1); }
        if (DBG_CHECK == 12 && p == 7 + 13 * DBG_LAYER) { hipLaunchKernelGGL(dbg_gate2_init, dim3(1), dim3(1), 0, stream, (unsigned char*)d_ws); hipLaunchKernelGGL(dbg_gate2, dim3(13), dim3(64), 0, stream, (unsigned char*)d_ws, (const float*)d_in[I_WIN] + (size_t)DBG_LAYER * 1024 * D_IN_SRC); hipLaunchKernelGGL(dbg_gate2_fin, dim3(1), dim3(1), 0, stream, (unsigned char*)d_ws); }
        if ((DBG_CHECK == 13 || DBG_CHECK == 14) && p == 7 + 13 * DBG_LAYER) { hipLaunchKernelGGL(dbg_gate3_init, dim3(1), dim3(1), 0, stream, (unsigned char*)d_ws); hipLaunchKernelGGL(dbg_gate3, dim3(2048), dim3(256), 0, stream, (unsigned char*)d_ws); hipLaunchKernelGGL(dbg_gate3_fin, dim3(1), dim3(1), 0, stream, (unsigned char*)d_ws); }
        if (DBG_CHECK == 1 && p == 3 + 13 * DBG_LAYER) hipLaunchKernelGGL(dbg_attn, dim3(2048), dim3(512), 0, stream, (unsigned char*)d_ws, (const float*)d_in[I_SUBLN], DBG_LAYER, (const float*)d_out);
#endif
    }
#if defined(DBG_CHECK)
    hipLaunchKernelGGL(dbg_report, dim3(DBG_TWO ? 4096 : 1), dim3(DBG_TWO ? 256 : 1), 0, stream, (unsigned char*)d_ws, (float*)d_out);
#endif
#else
    a.ph_lo = 0; a.ph_hi = N_PHASES;
    hipLaunchKernelGGL(mk_fwd, dim3(grid), dim3(NTHREADS), LDS_BYTES, stream, a);
#endif
}
```

```cpp
#include <hip/hip_runtime.h>
#include <hip/hip_bf16.h>
#include <cstdio>
#include <cstdint>
#include <cmath>

#ifndef DBG_ZERO_MIX
#define DBG_ZERO_MIX 0
#endif
#ifndef DBG_ZERO_FFN
#define DBG_ZERO_FFN 0
#endif
#ifndef DBG_BR
#define DBG_BR 7
#endif
#define GAS __attribute__((address_space(1)))
#define LAS __attribute__((address_space(3)))
typedef unsigned short bf16_t;
typedef short bf16x8 __attribute__((ext_vector_type(8)));
typedef short s16x4 __attribute__((ext_vector_type(4)));
typedef float f32x4 __attribute__((ext_vector_type(4)));
typedef float f32x2 __attribute__((ext_vector_type(2)));
typedef float f32x16 __attribute__((ext_vector_type(16)));
typedef unsigned u32x4 __attribute__((ext_vector_type(4)));
typedef unsigned u32x2 __attribute__((ext_vector_type(2)));
typedef GAS unsigned gu32;

constexpr int DM = 1024, NBATCH = 4, SEQ = 4096, CTXL = 256, NLAYER = 2;
constexpr int ML = NBATCH * SEQ, MC = NBATCH * CTXL, MT = ML + MC;
constexpr int D_IN_SRC = 8576, NP = 5632, NGATE = 3072, DFF = 2816, DCS = 1280, DCO = 640, DCOP = 768;
constexpr float LN_EPS = 1e-5f, ALPHA = 1.4142135623730951f;
constexpr int NWAVES = 8, NTHREADS = 512;

constexpr size_t MiB = 1u << 20;
constexpr size_t WS_CTL = 0, CTL_ZERO_BYTES = 1 * MiB;
constexpr size_t WS_TAB = 1 * MiB;
constexpr size_t TAB_MOD = WS_TAB + 0;
constexpr size_t TAB_LAM = WS_TAB + 256 * 1024;
constexpr size_t TAB_ROPE = WS_TAB + 260 * 1024;
constexpr size_t TAB_TW = WS_TAB + 272 * 1024;
constexpr size_t TAB_W0 = WS_TAB + 320 * 1024;
constexpr size_t TAB_F1 = WS_TAB + 384 * 1024;
constexpr size_t TAB_F2 = WS_TAB + 512 * 1024;
constexpr size_t TAB_DC = WS_TAB + 768 * 1024;
constexpr size_t WS_XC = 3 * MiB;
constexpr size_t WS_BON = 7 * MiB;
constexpr size_t WS_W = 9 * MiB;
constexpr size_t W_IN = WS_W, W_PA = WS_W + 17 * MiB, W_PF = WS_W + 19 * MiB, W_PC = WS_W + 20 * MiB, W_O = WS_W + 21 * MiB,
                 W_UP = WS_W + 23 * MiB, W_DN = WS_W + 34 * MiB, W_G2T = WS_W + 39 * MiB + 512 * 1024;
constexpr size_t WS_P = 49 * MiB;
constexpr size_t P_Q = WS_P, P_K = P_Q + (size_t)MT * 1024 * 2, P_F = P_K + (size_t)MT * 1024 * 2, P_V = P_F + (size_t)MT * 512 * 2,
                 P_CS = P_V + (size_t)MT * 1024 * 2, P_CO = P_CS + (size_t)MT * DCS * 2, P_END = P_CO + (size_t)MT * DCOP * 2;
constexpr size_t WS_HY = 236 * MiB, WS_END = 270 * MiB;
static_assert(P_END == WS_HY, "P region is exactly 187 MiB");
static_assert(P_END - P_V == (size_t)MT * NGATE * 2, "gate buffer == v|cs|co");
static_assert(WS_HY + (size_t)MT * 1024 * 2 == WS_END, "HY region 34 MiB");
constexpr int CW_TMO = 0, CW_QUEUE = 64  , CW_BAR = 4096;

constexpr int RING_BYTES = 131072, LDSCTL_OFF = RING_BYTES, MISC_OFF = LDSCTL_OFF + 320, LDS_BYTES = 147456;

#define LDS_WAIT() asm volatile("s_waitcnt lgkmcnt(0)" ::: "memory")
#define VM_WAIT() asm volatile("s_waitcnt vmcnt(0)" ::: "memory")
#define RLX_AGENT __ATOMIC_RELAXED, __HIP_MEMORY_SCOPE_AGENT

typedef __bf16 bf16x2_t __attribute__((ext_vector_type(2)));
__device__ __forceinline__ unsigned cvt_pk_bf16(float lo, float hi) { f32x2 v = {lo, hi}; bf16x2_t b = __builtin_convertvector(v, bf16x2_t); return __builtin_bit_cast(unsigned, b); }
__device__ __forceinline__ float bf2f(unsigned short h) { return __uint_as_float((unsigned)h << 16); }
__device__ __forceinline__ float bflo(unsigned w) { return __uint_as_float(w << 16); }
__device__ __forceinline__ float bfhi(unsigned w) { return __uint_as_float(w & 0xffff0000u); }
__device__ __forceinline__ float sigmoidf_(float x) { return __builtin_amdgcn_rcpf(1.f + __expf(-x)); }
__device__ __forceinline__ int fresh_lane() { unsigned z = 0u; asm volatile("" : "+v"(z)); return (int)__builtin_amdgcn_mbcnt_hi(~0u, __builtin_amdgcn_mbcnt_lo(~0u, z)); }
__device__ __forceinline__ int fresh_tid(int wave) { return (wave << 6) | fresh_lane(); }
__device__ __forceinline__ float wave_sum(float v) {
#pragma unroll
    for (int o = 1; o < 64; o <<= 1) v += __shfl_xor(v, o);
    return v;
}

#define XB_TMO      128
#define XB_XCNT(j)  (256  + 64 * (j))
#define XB_XSUB(j)  (1280 + 64 * (j))
#define XB_XGEN(j)  (2304 + 64 * (j))
#define XB_TOP      3328
#define XB_TOPGEN   3392
#define XCD_BAR_WORDS 3456
#define XB_SPIN_CAP (1u << 22)
__device__ __forceinline__ unsigned xb_ld(unsigned* p)              { return __hip_atomic_load(p, __ATOMIC_RELAXED, __HIP_MEMORY_SCOPE_AGENT); }
__device__ __forceinline__ unsigned xb_add(unsigned* p, unsigned v) { return __hip_atomic_fetch_add(p, v, __ATOMIC_RELAXED, __HIP_MEMORY_SCOPE_AGENT); }
__device__ __forceinline__ unsigned xb_xcc_id() { return (unsigned)__builtin_amdgcn_s_getreg((3 << 11) | 20) & 0xFu; }
#define XB_SPIN(cond, bar) do { unsigned _sp = 0; while (cond) { __builtin_amdgcn_s_sleep(1); \
    if ((++_sp & 255u) == 0u) { if (xb_ld(&(bar)[XB_TMO])) break; if (_sp > XB_SPIN_CAP) { atomicAdd(&(bar)[XB_TMO], 1u); break; } } } } while (0)
struct XcdBarrier { unsigned* bar; unsigned x; volatile LAS unsigned* st; };
__device__ __forceinline__ XcdBarrier xcd_barrier_post(unsigned* bar, volatile LAS unsigned* st) {
    XcdBarrier b; b.bar = bar; b.x = xb_xcc_id(); b.st = st;
    if (threadIdx.x == 0) (void)xb_add(&bar[XB_XCNT(b.x)], 1u);
    return b;
}
__device__ __forceinline__ void xcd_barrier_complete(unsigned* bar, unsigned x, unsigned& nloc, unsigned& nx) {
    const unsigned G = gridDim.x * gridDim.y * gridDim.z;
    unsigned sum, cnt, mine, sp = 0u;
    for (;;) {
        sum = 0u; cnt = 0u; mine = 0u;
#pragma unroll
        for (unsigned j = 0; j < 16; ++j) { const unsigned c = xb_ld(&bar[XB_XCNT(j)]); sum += c; cnt += (c > 0u) ? 1u : 0u; mine = (j == x) ? c : mine; }
        if (sum == G) break;
        __builtin_amdgcn_s_sleep(1);
        if ((++sp & 255u) == 0u) { if (xb_ld(&bar[XB_TMO])) break; if (sp > XB_SPIN_CAP) { atomicAdd(&bar[XB_TMO], 1u); break; } }
    }
    nloc = mine > 0u ? mine : 1u; nx = cnt > 0u ? cnt : 1u;
}
__device__ __attribute__((noinline)) void xcd_barrier(unsigned* bar_, unsigned bx_, volatile LAS unsigned* st_, unsigned t0_) {
    XcdBarrier b; b.bar = bar_; b.x = bx_; b.st = st_;
    asm volatile("s_waitcnt vmcnt(0)" ::: "memory");
    __syncthreads();
    if (t0_) {
        unsigned* bar = b.bar;
        __builtin_amdgcn_s_waitcnt(0);
        unsigned nloc = b.st[0], nx = b.st[1];
        if (nloc == 0u) { xcd_barrier_complete(bar, b.x, nloc, nx); b.st[0] = nloc; b.st[1] = nx; }
        const unsigned old = xb_add(&bar[XB_XSUB(b.x)], 1u);
        const unsigned gen = old / nloc;
        if (old + 1u == (gen + 1u) * nloc) {
            __builtin_amdgcn_fence(__ATOMIC_RELEASE, "agent");
            asm volatile("s_waitcnt vmcnt(0)" ::: "memory");
            const unsigned og = xb_add(&bar[XB_TOP], 1u);
            const unsigned tg = og / nx;
            if (og + 1u == (tg + 1u) * nx) xb_add(&bar[XB_TOPGEN], 1u);
            else XB_SPIN(xb_ld(&bar[XB_TOPGEN]) == tg, bar);
            __builtin_amdgcn_fence(__ATOMIC_ACQUIRE, "agent");
            xb_add(&bar[XB_XGEN(b.x)], 1u);
            asm volatile("s_waitcnt vmcnt(0)" ::: "memory");
        } else {
            XB_SPIN(xb_ld(&bar[XB_XGEN(b.x)]) == gen, bar);
            __builtin_amdgcn_fence(__ATOMIC_ACQUIRE, "agent");
            asm volatile("s_waitcnt vmcnt(0)" ::: "memory");
        }
    }
    __syncthreads();
}

namespace pg8 {
#define PG8_LAS __attribute__((address_space(3)))
constexpr int BM = 256, BK = 64, HALF = 128, HTB = HALF * BK * 2, STAGE_BYTES = 8 * HTB, NXCD = 8, WGM = 8;
__host__ __device__ __forceinline__ int lds_byte(int r, int c) { const int st = (r >> 4) * 2 + (c >> 5), rr = r & 15, cc = c & 31, ob = rr * 64 + cc * 2; return st * 1024 + (ob ^ (((ob >> 9) & 1) << 5)); }
__host__ __device__ __forceinline__ void stage_rc(int b, int& R, int& C) { const int st = b / 1024, sb = b % 1024, swz = sb ^ (((sb >> 9) & 1) << 5); R = (st >> 1) * 16 + swz / 64; C = (st & 1) * 32 + (swz % 64) / 2; }
__host__ __device__ __forceinline__ int perm32(int rho) { const int n = rho >> 4, i = rho & 15; return 8 * (i >> 2) + 4 * n + (i & 3); }
struct Unit { int pm, pn; };
struct Operand { const char* base; long tM, tN, tN2; int nshift; long rstride; long hstep; long kstep;
    __device__ __forceinline__ long tile(const Unit& u) const { return (long)u.pm * tM + (long)(u.pn & ((1 << nshift) - 1)) * tN + (long)(u.pn >> nshift) * tN2; }
    __device__ __forceinline__ unsigned row(int R) const { return (unsigned)((long)R * rstride); } };
struct StaticOrder {
    int nM, nN, nwg, G, c, wave;
    __host__ __device__ void init(int M, int N, int G_, int c_) { nM = M / BM; nN = N / BM; nwg = nM * nN; G = G_; c = c_; }
    __host__ __device__ bool next(int i, Unit& u) const {
        const long L = (long)i * G + c; if (L >= nwg) return false;
        int wgid = (int)L; { const int q = nwg / NXCD, r = nwg % NXCD, xcd = wgid % NXCD, off = wgid / NXCD; wgid = (xcd < r ? xcd * (q + 1) : r * (q + 1) + (xcd - r) * q) + off; }
        const int nig = WGM * nN, gid = wgid / nig, fm = gid * WGM, gsz = (nM - fm) < WGM ? (nM - fm) : WGM;
        u.pm = fm + ((wgid % nig) % gsz); u.pn = (wgid % nig) / gsz; return true;
    }
};

template <class Epi, class RowMapB, bool ALIGN_EPI>
__device__ __forceinline__ void gemm_phase(PG8_LAS unsigned char* lds, const Operand A, const Operand B, const RowMapB bmap, const int nt, const StaticOrder& S, const Epi& E) {
    int wid = S.wave; asm volatile("" : "+s"(wid));
    const int lane = fresh_lane(), tid = (wid << 6) | lane, wr = wid >> 2, wc = wid & 3, fr = lane & 15, fq = lane >> 4;
    unsigned voffA[2], voffB[2];
#pragma unroll
    for (int i = 0; i < 2; ++i) { int R, C; stage_rc(tid * 16 + i * 8192, R, C); const int Rb = Epi::PERM ? ((R & ~31) + perm32(R & 31)) : R;
        voffA[i] = A.row(R) + (unsigned)C * 2u; voffB[i] = bmap(Rb) + (unsigned)C * 2u; }
    const long kA = A.kstep, kB = B.kstep, hA = A.hstep, hB = B.hstep;
    const unsigned ldsw = (unsigned)wid * 1024u;
    const int aoff = lds_byte(wr * 64 + fr, fq * 8), boff = lds_byte(wc * 32 + fr, fq * 8);
#define PG8_SA(b, h) (((b) * 2 + (h)) * HTB)
#define PG8_SB(b, h) ((4 + (b) * 2 + (h)) * HTB)
#define PG8_STAGE(bufoff, gbase, voff) do { _Pragma("unroll") for (int _i = 0; _i < 2; ++_i) \
        __builtin_amdgcn_global_load_lds((const unsigned*)((const char*)(gbase) + (voff)[_i]), (PG8_LAS unsigned*)(lds + (bufoff) + ldsw + _i * 8192), 16, 0, 0); } while (0)
#define PG8_LDA(dst, b, h) do { _Pragma("unroll") for (int m = 0; m < 4; ++m) _Pragma("unroll") for (int k = 0; k < 2; ++k) dst[m][k] = *(const PG8_LAS bf16x8*)(lds + PG8_SA(b, h) + aoff + m * 2048 + k * 1024); } while (0)
#define PG8_LDB(dst, b, h) do { _Pragma("unroll") for (int n = 0; n < 2; ++n) _Pragma("unroll") for (int k = 0; k < 2; ++k) dst[n][k] = *(const PG8_LAS bf16x8*)(lds + PG8_SB(b, h) + boff + n * 2048 + k * 1024); } while (0)
#define PG8_MMA(ai, bj, At, Bt) do { __builtin_amdgcn_s_setprio(1); _Pragma("unroll") for (int m = 0; m < 4; ++m) _Pragma("unroll") for (int n = 0; n < 2; ++n) _Pragma("unroll") for (int k = 0; k < 2; ++k) \
        acc[ai][bj][m][n] = __builtin_amdgcn_mfma_f32_16x16x32_bf16(Bt[n][k], At[m][k], acc[ai][bj][m][n], 0, 0, 0); __builtin_amdgcn_s_setprio(0); } while (0)
#define PG8_WAIT_V(n) asm volatile("s_waitcnt vmcnt(" #n ")" ::: "memory")
#define PG8_WAIT_L(n) asm volatile("s_waitcnt lgkmcnt(" #n ")" ::: "memory")
#define PG8_BAR __builtin_amdgcn_s_barrier()
#define PG8_SCHED __builtin_amdgcn_sched_barrier(0)
    Unit cur, nxt; int ui = 0;
    if (!S.next(0, cur)) return;
    f32x4 acc[2][2][4][2];
#pragma unroll
    for (int a = 0; a < 2; ++a)
#pragma unroll
        for (int b = 0; b < 2; ++b)
#pragma unroll
            for (int m = 0; m < 4; ++m)
#pragma unroll
                for (int n = 0; n < 2; ++n) acc[a][b][m][n] = (f32x4){0.f, 0.f, 0.f, 0.f};
    bf16x8 At[4][2], B0[2][2], B1[2][2];
    const char* cA = A.base + A.tile(cur); const char* cB = B.base + B.tile(cur);
    PG8_STAGE(PG8_SB(0, 0), cB, voffB); PG8_STAGE(PG8_SB(0, 1), cB + hB, voffB); PG8_STAGE(PG8_SA(0, 0), cA, voffA); PG8_STAGE(PG8_SA(0, 1), cA + hA, voffA);
    if (wr == 1) PG8_BAR;
    PG8_WAIT_V(2); PG8_BAR;
    PG8_STAGE(PG8_SB(1, 0), cB + kB, voffB); PG8_STAGE(PG8_SA(1, 0), cA + kA, voffA); PG8_STAGE(PG8_SB(1, 1), cB + hB + kB, voffB);
    PG8_WAIT_V(6); PG8_BAR;
    for (;;) {
        const bool has_next = S.next(ui + 1, nxt);
        const char* nA = has_next ? A.base + A.tile(nxt) : cA; const char* nB = has_next ? B.base + B.tile(nxt) : cB;
        for (int t = 0; t < nt; t += 2) {
            const bool last = (t == nt - 2);
            asm volatile("" : "+v"(voffA[0]), "+v"(voffA[1]), "+v"(voffB[0]), "+v"(voffB[1]));
            const char* a1 = cA + (long)(t + 1) * kA;
            const char* a2 = last ? nA : cA + (long)(t + 2) * kA; const char* b2 = last ? nB : cB + (long)(t + 2) * kB;
            const char* a3 = a2 + kA; const char* b3 = b2 + kB;
            PG8_LDB(B0, 0, 0); PG8_LDB(B1, 0, 1); PG8_SCHED; PG8_LDA(At, 0, 0); PG8_STAGE(PG8_SA(1, 1), a1 + hA, voffA);
            PG8_WAIT_V(8); PG8_WAIT_L(0); PG8_BAR; PG8_MMA(0, 0, At, B0); PG8_MMA(0, 1, At, B1); PG8_BAR; PG8_SCHED;
            PG8_LDA(At, 0, 1); PG8_STAGE(PG8_SB(0, 0), b2, voffB); PG8_STAGE(PG8_SB(0, 1), b2 + hB, voffB); PG8_STAGE(PG8_SA(0, 0), a2, voffA);
            PG8_WAIT_V(8); PG8_WAIT_L(0); PG8_BAR; PG8_MMA(1, 0, At, B0); PG8_MMA(1, 1, At, B1); PG8_BAR; PG8_SCHED;
            PG8_LDB(B0, 1, 0); PG8_LDB(B1, 1, 1); PG8_SCHED; PG8_LDA(At, 1, 0); PG8_STAGE(PG8_SA(0, 1), a2 + hA, voffA);
            PG8_WAIT_V(8); PG8_WAIT_L(0); PG8_BAR; PG8_MMA(0, 0, At, B0); PG8_MMA(0, 1, At, B1); PG8_BAR; PG8_SCHED;
            PG8_LDA(At, 1, 1); PG8_STAGE(PG8_SB(1, 0), b3, voffB); PG8_STAGE(PG8_SB(1, 1), b3 + hB, voffB); PG8_STAGE(PG8_SA(1, 0), a3, voffA);
            PG8_WAIT_V(8); PG8_WAIT_L(0); PG8_BAR; PG8_MMA(1, 0, At, B0); PG8_MMA(1, 1, At, B1); PG8_BAR; PG8_SCHED;
        }
        if constexpr (ALIGN_EPI) { if (wr == 0) PG8_BAR; }
        if constexpr (!Epi::AFTER_DRAIN) { const int le = fresh_lane(); E(acc, cur, wr, wc, le & 15, le >> 4); }
        if (!has_next) break;
#pragma unroll
        for (int a = 0; a < 2; ++a)
#pragma unroll
            for (int b = 0; b < 2; ++b)
#pragma unroll
                for (int m = 0; m < 4; ++m)
#pragma unroll
                    for (int n = 0; n < 2; ++n) acc[a][b][m][n] = (f32x4){0.f, 0.f, 0.f, 0.f};
        cur = nxt; cA = nA; cB = nB; ++ui;
        if constexpr (ALIGN_EPI) { if (wr == 1) PG8_BAR; }
    }
    PG8_WAIT_V(0);
    if constexpr (!ALIGN_EPI) { if (wr == 0) PG8_BAR; }
    PG8_BAR;
    if constexpr (Epi::AFTER_DRAIN) { const int le = fresh_lane(); E.fused(acc, cur, wr, wc, le & 15, le >> 4, lds, wid, le); }
#undef PG8_SA
#undef PG8_SB
#undef PG8_STAGE
#undef PG8_LDA
#undef PG8_LDB
#undef PG8_MMA
#undef PG8_WAIT_V
#undef PG8_WAIT_L
#undef PG8_BAR
#undef PG8_SCHED
}
struct RowLin { long rstride; __device__ __forceinline__ unsigned operator()(int R) const { return (unsigned)((long)R * rstride); } };
}
namespace pg8 {
__device__ __forceinline__ u32x2 pk4(f32x4 v) { u32x2 w; w.x = cvt_pk_bf16(v[0], v[1]); w.y = cvt_pk_bf16(v[2], v[3]); return w; }
__device__ __forceinline__ f32x4 up4(u32x2 w) { return (f32x4){bflo(w.x), bfhi(w.x), bflo(w.y), bfhi(w.y)}; }
__device__ __forceinline__ float fast_sigmoid(float x) { return __builtin_amdgcn_rcpf(1.f + __expf(-x)); }
#define EPI_ROWS(ai, m) _Pragma("unroll") for (int ai = 0; ai < 2; ++ai) _Pragma("unroll") for (int m = 0; m < 4; ++m)

struct EpiInProj {
    static constexpr bool PERM = false, AFTER_DRAIN = false;
    unsigned char* ws; const float* rope;
    __device__ __forceinline__ void operator()(const f32x4 (&acc)[2][2][4][2], const Unit& u, int wr, int wc, int fr, int fq) const {
        asm volatile("" : "+v"(fr), "+v"(fq));
        const int pn = u.pn; size_t boff; int pitch, c0;
        if (pn < 4) { boff = P_Q; pitch = 1024; c0 = 256 * pn; }
        else if (pn < 8) { boff = P_K; pitch = 1024; c0 = 256 * (pn - 4); }
        else if (pn < 12) { boff = P_V; pitch = 1024; c0 = 256 * (pn - 8); }
        else if (pn < 14) { boff = P_F; pitch = 512; c0 = 256 * (pn - 12); }
        else if (pn < 19) { boff = P_CS; pitch = DCS; c0 = 256 * (pn - 14); }
        else { boff = P_CO; pitch = DCOP; c0 = 256 * (pn - 19); }
        bf16_t* base = (bf16_t*)(ws + boff);
        const bool dorope = (pn >= 4 && pn < 8 && u.pm < ML / 256);
        EPI_ROWS(ai, m) {
            const int R = 128 * ai + 64 * wr + 16 * m + fr; const size_t grow = (size_t)u.pm * 256 + R;
            f32x4 cc = (f32x4){1.f, 1.f, 1.f, 1.f}, ss = (f32x4){0.f, 0.f, 0.f, 0.f};
            if (dorope) { const int t = (int)(grow & 4095); const int pos = (wc & 1) ? (t & 63) : (t >> 6);
                const f32x4 a = *(const f32x4*)(rope + (pos * 16 + 4 * fq) * 2), b = *(const f32x4*)(rope + (pos * 16 + 4 * fq) * 2 + 4);
                cc = (f32x4){a[0], a[2], b[0], b[2]}; ss = (f32x4){a[1], a[3], b[1], b[3]}; }
            bf16_t* rowp = base + grow * pitch + c0 + 32 * wc + 4 * fq;
#pragma unroll
            for (int bj = 0; bj < 2; ++bj) { const f32x4 x1 = acc[ai][bj][m][0], x2 = acc[ai][bj][m][1];
                const f32x4 y1 = x1 * cc - x2 * ss, y2 = x2 * cc + x1 * ss;
                *(u32x2*)(rowp + 128 * bj) = pk4(y1); *(u32x2*)(rowp + 128 * bj + 16) = pk4(y2); }
        }
    }
};
struct EpiGate {
    static constexpr bool PERM = true, AFTER_DRAIN = false;
    bf16_t* gate;
    __device__ __forceinline__ void operator()(const f32x4 (&acc)[2][2][4][2], const Unit& u, int wr, int wc, int fr, int fq) const {
        asm volatile("" : "+v"(fr), "+v"(fq));
        EPI_ROWS(ai, m) {
            const int R = 128 * ai + 64 * wr + 16 * m + fr; const size_t grow = (size_t)u.pm * 256 + R;
            bf16_t* rowp = gate + grow * NGATE + 256 * u.pn + 32 * wc + 8 * fq;
#pragma unroll
            for (int bj = 0; bj < 2; ++bj) { f32x4 v0 = acc[ai][bj][m][0], v1 = acc[ai][bj][m][1];
#pragma unroll
                for (int e = 0; e < 4; ++e) { v0[e] = fast_sigmoid(v0[e]); v1[e] = fast_sigmoid(v1[e]); }
                u32x4 w; w.x = cvt_pk_bf16(v0[0], v0[1]); w.y = cvt_pk_bf16(v0[2], v0[3]); w.z = cvt_pk_bf16(v1[0], v1[1]); w.w = cvt_pk_bf16(v1[2], v1[3]);
                *(u32x4*)(rowp + 128 * bj) = w; }
        }
    }
};
template <bool FIRST> struct EpiBranch {
    static constexpr bool PERM = true, AFTER_DRAIN = false;
    const bf16_t* gate; bf16_t* ym; float sc;
    __device__ __forceinline__ void operator()(const f32x4 (&acc)[2][2][4][2], const Unit& u, int wr, int wc, int fr, int fq) const {
        asm volatile("" : "+v"(fr), "+v"(fq));
        EPI_ROWS(ai, m) {
            const int R = 128 * ai + 64 * wr + 16 * m + fr; const size_t grow = (size_t)u.pm * 256 + R;
            const int col = 256 * u.pn + 32 * wc + 8 * fq;
#pragma unroll
            for (int bj = 0; bj < 2; ++bj) {
                const u32x4 g = *(const u32x4*)(gate + grow * NGATE + col + 128 * bj);
                f32x4 v0 = acc[ai][bj][m][0], v1 = acc[ai][bj][m][1];
                v0 = v0 * (f32x4){bflo(g.x), bfhi(g.x), bflo(g.y), bfhi(g.y)} * sc; v1 = v1 * (f32x4){bflo(g.z), bfhi(g.z), bflo(g.w), bfhi(g.w)} * sc;
                bf16_t* op = ym + grow * 1024 + col + 128 * bj;
                if (!FIRST) { const u32x4 o = *(const u32x4*)op; v0 = v0 + (f32x4){bflo(o.x), bfhi(o.x), bflo(o.y), bfhi(o.y)}; v1 = v1 + (f32x4){bflo(o.z), bfhi(o.z), bflo(o.w), bfhi(o.w)}; }
                u32x4 w; w.x = cvt_pk_bf16(v0[0], v0[1]); w.y = cvt_pk_bf16(v0[2], v0[3]); w.z = cvt_pk_bf16(v1[0], v1[1]); w.w = cvt_pk_bf16(v1[2], v1[3]);
                *(u32x4*)op = w; }
        }
    }
};
struct EpiF32 {
    static constexpr bool PERM = false, AFTER_DRAIN = false;
    float* out; int ldc;
    __device__ __forceinline__ void operator()(const f32x4 (&acc)[2][2][4][2], const Unit& u, int wr, int wc, int fr, int fq) const {
        asm volatile("" : "+v"(fr), "+v"(fq));
        EPI_ROWS(ai, m) {
            const int R = 128 * ai + 64 * wr + 16 * m + fr; const size_t grow = (size_t)u.pm * 256 + R;
            float* rowp = out + grow * ldc + 256 * u.pn + 32 * wc + 4 * fq;
#pragma unroll
            for (int bj = 0; bj < 2; ++bj)
#pragma unroll
                for (int n = 0; n < 2; ++n) *(f32x4*)(rowp + 128 * bj + 16 * n) = acc[ai][bj][m][n];
        }
    }
};
struct EpiBf16 {
    static constexpr bool PERM = true, AFTER_DRAIN = false;
    bf16_t* out; int ldc;
    __device__ __forceinline__ void operator()(const f32x4 (&acc)[2][2][4][2], const Unit& u, int wr, int wc, int fr, int fq) const {
        asm volatile("" : "+v"(fr), "+v"(fq));
        EPI_ROWS(ai, m) {
            const int R = 128 * ai + 64 * wr + 16 * m + fr; const size_t grow = (size_t)u.pm * 256 + R;
            bf16_t* rowp = out + grow * ldc + 256 * u.pn + 32 * wc + 8 * fq;
#pragma unroll
            for (int bj = 0; bj < 2; ++bj) { const f32x4 v0 = acc[ai][bj][m][0], v1 = acc[ai][bj][m][1];
                u32x4 w; w.x = cvt_pk_bf16(v0[0], v0[1]); w.y = cvt_pk_bf16(v0[2], v0[3]); w.z = cvt_pk_bf16(v1[0], v1[1]); w.w = cvt_pk_bf16(v1[2], v1[3]);
                *(u32x4*)(rowp + 128 * bj) = w; }
        }
    }
};
struct EpiF0 {
    static constexpr bool PERM = false, AFTER_DRAIN = false;
    bf16_t* yt;
    __device__ __forceinline__ void operator()(const f32x4 (&acc)[2][2][4][2], const Unit& u, int wr, int wc, int fr, int fq) const {
        asm volatile("" : "+v"(fr), "+v"(fq));
        EPI_ROWS(ai, m) {
            const int R = 128 * ai + 64 * wr + 16 * m + fr; const int ri = R >> 7, mch = R & 127;
            bf16_t* rowp = yt + (size_t)((ri * 4 + u.pm) * 128 + mch) * ML + 256 * u.pn + 32 * wc + 4 * fq;
#pragma unroll
            for (int bj = 0; bj < 2; ++bj)
#pragma unroll
                for (int n = 0; n < 2; ++n) *(u32x2*)(rowp + 128 * bj + 16 * n) = pk4(acc[ai][bj][m][n]);
        }
    }
};
struct EpiF0c {
    static constexpr bool PERM = false, AFTER_DRAIN = false;
    bf16_t* ytc;
    __device__ __forceinline__ void operator()(const f32x4 (&acc)[2][2][4][2], const Unit& u, int wr, int wc, int fr, int fq) const {
        asm volatile("" : "+v"(fr), "+v"(fq));
        EPI_ROWS(ai, m) {
            const int R = 128 * ai + 64 * wr + 16 * m + fr; const int ri = R >> 7, mch = R & 127;
            bf16_t* rowp = ytc + (size_t)((((u.pn * 4 + u.pm) * 128 + mch) * 2 + ri)) * 256 + 32 * wc + 4 * fq;
#pragma unroll
            for (int bj = 0; bj < 2; ++bj)
#pragma unroll
                for (int n = 0; n < 2; ++n) *(u32x2*)(rowp + 128 * bj + 16 * n) = pk4(acc[ai][bj][m][n]);
        }
    }
};
struct EpiF1 {
    static constexpr bool PERM = false, AFTER_DRAIN = false;
    bf16_t* x1; const float* tw;
    __device__ __forceinline__ void operator()(const f32x4 (&acc)[2][2][4][2], const Unit& u, int wr, int wc, int fr, int fq) const {
        asm volatile("" : "+v"(fr), "+v"(fq));
        const int gp = u.pn >> 7, mch = u.pn & 127, g = 2 * wr + gp;
#pragma unroll
        for (int m = 0; m < 4; ++m) {
            const int kl = 16 * m + fr;
#pragma unroll
            for (int bj = 0; bj < 2; ++bj)
#pragma unroll
                for (int n = 0; n < 2; ++n) {
                    const int colL = 128 * bj + 32 * wc + 16 * n + 4 * fq, tl = colL & 63, bb = colL >> 6;
                    const f32x4 a = *(const f32x4*)(tw + (kl * 64 + tl) * 2), b = *(const f32x4*)(tw + (kl * 64 + tl) * 2 + 4);
                    const f32x4 cc = (f32x4){a[0], a[2], b[0], b[2]}, ss = (f32x4){a[1], a[3], b[1], b[3]};
                    const f32x4 re = acc[0][bj][m][n], im = acc[1][bj][m][n];
                    const f32x4 re2 = re * cc + im * ss, im2 = im * cc - re * ss;
                    const size_t o = ((size_t)bb * 32768 + kl * 512 + g * 128 + mch) * 64 + tl;
                    *(u32x2*)(x1 + o) = pk4(re2); *(u32x2*)(x1 + (size_t)4 * 32768 * 64 + o) = pk4(im2);
                }
        }
    }
};
struct EpiF2 {
    static constexpr bool PERM = false, AFTER_DRAIN = false;
    bf16_t* of;
    __device__ __forceinline__ void operator()(const f32x4 (&acc)[2][2][4][2], const Unit& u, int wr, int wc, int fr, int fq) const {
        asm volatile("" : "+v"(fr), "+v"(fq));
        const int kl = u.pn >> 1, gm0 = (u.pn & 1) * 256;
        EPI_ROWS(ai, m) {
            const int R = 128 * ai + 64 * wr + 16 * m + fr; const int b = R >> 6, kh = R & 63;
            bf16_t* rowp = of + (size_t)(b * 4096 + 64 * kh + kl) * 512 + gm0 + 32 * wc + 4 * fq;
#pragma unroll
            for (int bj = 0; bj < 2; ++bj)
#pragma unroll
                for (int n = 0; n < 2; ++n) *(u32x2*)(rowp + 128 * bj + 16 * n) = pk4(acc[ai][bj][m][n]);
        }
    }
};
struct EpiFc {
    static constexpr bool PERM = false, AFTER_DRAIN = false;
    bf16_t* of;
    __device__ __forceinline__ void operator()(const f32x4 (&acc)[2][2][4][2], const Unit& u, int wr, int wc, int fr, int fq) const {
        asm volatile("" : "+v"(fr), "+v"(fq));
        const int b = u.pn >> 1, gm0 = (u.pn & 1) * 256;
        EPI_ROWS(ai, m) {
            const int R = 128 * ai + 64 * wr + 16 * m + fr;
            bf16_t* rowp = of + (size_t)(ML + b * 256 + R) * 512 + gm0 + 32 * wc + 4 * fq;
#pragma unroll
            for (int bj = 0; bj < 2; ++bj)
#pragma unroll
                for (int n = 0; n < 2; ++n) *(u32x2*)(rowp + 128 * bj + 16 * n) = pk4(acc[ai][bj][m][n]);
        }
    }
};
struct EpiRwkvPost {
    static constexpr bool PERM = false, AFTER_DRAIN = true;
    const bf16_t* y0; const bf16_t* y1; const bf16_t* cs; const float* bon; const float* mu; const float* lnw; const float* lnb; bf16_t* oc;
    __device__ __forceinline__ void fused(f32x4 (&acc)[2][2][4][2], const Unit& u, int wr, int wc, int fr, int fq, PG8_LAS unsigned char* lds, int wid, int lane) const {
        asm volatile("" : "+v"(fr), "+v"(fq));
        PG8_LAS f32x2* P = (PG8_LAS f32x2*)lds;
        EPI_ROWS(ai, m) {
            const int R = 128 * ai + 64 * wr + 16 * m + fr; const size_t grow = (size_t)u.pm * 256 + R;
#pragma unroll
            for (int bj = 0; bj < 2; ++bj) {
                const size_t o = grow * 512 + 256 * u.pn + 128 * bj + 32 * wc + 4 * fq;
                const f32x4 a = up4(*(const u32x2*)(y0 + o)) + up4(*(const u32x2*)(y1 + o)), b = up4(*(const u32x2*)(y0 + o + 16)) + up4(*(const u32x2*)(y1 + o + 16));
                float s = (a[0] + a[1]) + (a[2] + a[3]) + (b[0] + b[1]) + (b[2] + b[3]);
                s += __shfl_xor(s, 16); s += __shfl_xor(s, 32);
                const float mw = s * (1.f / 32.f); const f32x4 da = a - mw, db = b - mw;
                float q = (da[0] * da[0] + da[1] * da[1]) + (da[2] * da[2] + da[3] * da[3]) + (db[0] * db[0] + db[1] * db[1]) + (db[2] * db[2] + db[3] * db[3]);
                q += __shfl_xor(q, 16); q += __shfl_xor(q, 32);
                if (fq == 0) P[(R * 4 + 2 * bj + (wc >> 1)) * 2 + (wc & 1)] = (f32x2){mw, q};
            }
        }
        asm volatile("s_waitcnt lgkmcnt(0)" ::: "memory"); __builtin_amdgcn_s_barrier(); asm volatile("" ::: "memory");
        EPI_ROWS(ai, m) {
            const int R = 128 * ai + 64 * wr + 16 * m + fr; const size_t grow = (size_t)u.pm * 256 + R;
            int pos, len; if (grow < (size_t)ML) { pos = (int)(grow & 4095); len = SEQ; } else { pos = (int)((grow - ML) & 255); len = CTXL; }
            const bool hp = pos > 0, hn = pos < len - 1;
            const size_t rp = hp ? grow - 1 : grow, rn = hn ? grow + 1 : grow;
#pragma unroll
            for (int bj = 0; bj < 2; ++bj) {
                const int hl = 2 * bj + (wc >> 1), head = 4 * u.pn + hl;
                const f32x2 pa = P[(R * 4 + hl) * 2 + 0], pb = P[(R * 4 + hl) * 2 + 1];
                const float mean = 0.5f * (pa.x + pb.x), dm = pa.x - pb.x, var = (pa.y + pb.y + 16.f * dm * dm) * (1.f / 64.f);
                const float rstd = 1.0f / sqrtf(var + 64.f * 1e-5f);
                const float bsum = bon[grow * 8 + head] + bon[(size_t)MT * 8 + grow * 8 + head];
#pragma unroll
                for (int n = 0; n < 2; ++n) {
                    const int c = 256 * u.pn + 128 * bj + 32 * wc + 16 * n + 4 * fq;
                    const size_t o = grow * 512 + c;
                    const f32x4 yv = up4(*(const u32x2*)(y0 + o)) + up4(*(const u32x2*)(y1 + o));
                    const f32x4 w4 = *(const f32x4*)(lnw + c), b4 = *(const f32x4*)(lnb + c);
                    const f32x4 m0 = *(const f32x4*)(mu + 512 + c), m1 = *(const f32x4*)(mu + 1920 + 512 + c);
                    const f32x4 vc = up4(*(const u32x2*)(cs + grow * DCS + 512 + c));
                    f32x4 vp = up4(*(const u32x2*)(cs + rp * DCS + 512 + c)), vn = up4(*(const u32x2*)(cs + rn * DCS + 512 + c));
                    if (!hp) vp = (f32x4){0.f, 0.f, 0.f, 0.f}; if (!hn) vn = (f32x4){0.f, 0.f, 0.f, 0.f};
                    const f32x4 vs = vc + m0 * (vp - vc) + m1 * (vn - vc);
                    const f32x4 yn = (yv - mean) * rstd * w4 + b4;
                    const f32x4 r = (yn + bsum * vs) * acc[ai][bj][m][n];
                    *(u32x2*)(oc + o) = pk4(r);
                }
            }
        }
    }
};
}
namespace attn {
#define SBAR() __builtin_amdgcn_sched_barrier(0)
constexpr int QBLK = 32, KVBLK = 64;
constexpr float SCALE = 0.125f;
#ifndef ATTN_THR
#define ATTN_THR 6.f
#endif
constexpr int SHM_V = KVBLK * 128 * 2, SHM_K = KVBLK * 64 * 2;
constexpr int LDS_V = 0, LDS_K = 2 * SHM_V, LDS_WS = LDS_K + 2 * SHM_K, LDS_STASH = LDS_WS + NWAVES * 64 * 4, LDS_END = LDS_STASH + NWAVES * 8192;
static_assert(LDS_END <= RING_BYTES, "attention LDS");
__device__ __forceinline__ int crow(int r, int hi) { return (r & 3) + 8 * (r >> 2) + 4 * hi; }
__device__ __forceinline__ int kswz(int row, int chunk) { return row * 128 + ((chunk ^ ((row >> 1) & 7)) << 4); }

__device__ __forceinline__ void partialSM(f32x16& p0, f32x16& p1, float& m_reg, float& mn, float& alpha) {
    constexpr float C = SCALE * 1.4426950408889634f;
    float pmax = p0[0];
#pragma unroll
    for (int r = 1; r < 16; ++r) pmax = fmaxf(pmax, p0[r]);
#pragma unroll
    for (int r = 0; r < 16; ++r) pmax = fmaxf(pmax, p1[r]);
    { auto rr = __builtin_amdgcn_permlane32_swap(__float_as_uint(pmax), __float_as_uint(pmax), false, false);
      pmax = fmaxf(__uint_as_float(rr[0]), __uint_as_float(rr[1])); }
    if (__builtin_expect(__all(pmax - m_reg <= ATTN_THR / SCALE), 1)) { mn = m_reg; alpha = 1.f; }
    else { mn = fmaxf(m_reg, pmax); alpha = __builtin_amdgcn_exp2f((m_reg - mn) * C); m_reg = mn; }
    const float mnC = -mn * C; const f32x2 C2 = {C, C}, mnC2 = {mnC, mnC};
#pragma unroll
    for (int r = 0; r < 16; r += 2) { const f32x2 t = (f32x2){p0[r], p0[r + 1]} * C2 + mnC2; p0[r] = t.x; p0[r + 1] = t.y; }
#pragma unroll
    for (int r = 0; r < 16; r += 2) { const f32x2 t = (f32x2){p1[r], p1[r + 1]} * C2 + mnC2; p1[r] = t.x; p1[r + 1] = t.y; }
#pragma unroll
    for (int r = 0; r < 16; ++r) p0[r] = __builtin_amdgcn_exp2f(p0[r]);
}
__device__ __forceinline__ void finishSM(f32x16& p0, f32x16& p1, float alpha, float& l_reg, bf16x8& pa0, bf16x8& pa1, bf16x8& pa2, bf16x8& pa3) {
#pragma unroll
    for (int r = 0; r < 16; ++r) p1[r] = __builtin_amdgcn_exp2f(p1[r]);
    f32x2 ps2 = (f32x2){p0[0], p0[1]} + (f32x2){p1[0], p1[1]};
#pragma unroll
    for (int r = 2; r < 16; r += 2) { ps2 += (f32x2){p0[r], p0[r + 1]}; ps2 += (f32x2){p1[r], p1[r + 1]}; }
    float ps = ps2.x + ps2.y;
    { auto rr = __builtin_amdgcn_permlane32_swap(__float_as_uint(ps), __float_as_uint(ps), false, false);
      ps = __uint_as_float(rr[0]) + __uint_as_float(rr[1]); }
    l_reg = l_reg * alpha + ps;
#define PK4(P, BASE, OUT) do { unsigned a0 = cvt_pk_bf16(P[BASE + 0], P[BASE + 1]), a1 = cvt_pk_bf16(P[BASE + 2], P[BASE + 3]);   \
    unsigned b0 = cvt_pk_bf16(P[BASE + 4], P[BASE + 5]), b1 = cvt_pk_bf16(P[BASE + 6], P[BASE + 7]);                              \
    auto r0 = __builtin_amdgcn_permlane32_swap(a0, b0, false, false); auto r1 = __builtin_amdgcn_permlane32_swap(a1, b1, false, false); \
    u32x4 w = {r0[0], r1[0], r0[1], r1[1]}; OUT = *reinterpret_cast<bf16x8*>(&w); } while (0)
    PK4(p0, 0, pa0); PK4(p0, 8, pa1); PK4(p1, 0, pa2); PK4(p1, 8, pa3);
#undef PK4
}
__device__ __forceinline__ void qkt(f32x16& p0, f32x16& p1, const LAS char* Ks, const bf16x8 q0, const bf16x8 q1, const bf16x8 q2, const bf16x8 q3, int r32, int hi) {
    p0 = f32x16{}; p1 = f32x16{};
#define QK1(d0, Q) do { const bf16x8 b0 = *(const LAS bf16x8*)(Ks + kswz(r32, 2 * (d0) + hi)); const bf16x8 b1 = *(const LAS bf16x8*)(Ks + kswz(32 + r32, 2 * (d0) + hi)); \
    p0 = __builtin_amdgcn_mfma_f32_32x32x16_bf16(b0, Q, p0, 0, 0, 0); p1 = __builtin_amdgcn_mfma_f32_32x32x16_bf16(b1, Q, p1, 0, 0, 0); } while (0)
    QK1(0, q0); QK1(1, q1); QK1(2, q2); QK1(3, q3);
#undef QK1
}
__device__ __forceinline__ int v_st(int k, int c) { const int kk = (k & ~0xC) | ((k & 4) << 1) | ((k & 8) >> 1); return ((kk >> 3) * 4 + (c >> 5)) * 512 + ((kk & 7) * 32 + (c & 31)) * 2; }
__device__ __forceinline__ int v_rd_base(int lane) { return ((lane & 3) << 3) | (((lane >> 2) & 3) << 6) | (((lane >> 4) & 1) << 5) | (((lane >> 5) & 1) << 8); }
constexpr int v_rd_off(int d0, int ks, int half) { return d0 * 512 + ks * 4096 + half * 2048; }
template <int OFF> __device__ __forceinline__ s16x4 tr_read(int vb) {
    s16x4 r; asm volatile("ds_read_b64_tr_b16 %0, %1 offset:%2" : "=&v"(r) : "v"(vb), "i"(OFF) : "memory"); return r;
}
template <int D0> __device__ __forceinline__ void pv_one(f32x16& od, int vb, bf16x8 pa0, bf16x8 pa1, bf16x8 pa2, bf16x8 pa3) {
    const s16x4 l0 = tr_read<v_rd_off(D0, 0, 0)>(vb), h0 = tr_read<v_rd_off(D0, 0, 1)>(vb), l1 = tr_read<v_rd_off(D0, 1, 0)>(vb), h1 = tr_read<v_rd_off(D0, 1, 1)>(vb);
    const s16x4 l2 = tr_read<v_rd_off(D0, 2, 0)>(vb), h2 = tr_read<v_rd_off(D0, 2, 1)>(vb), l3 = tr_read<v_rd_off(D0, 3, 0)>(vb), h3 = tr_read<v_rd_off(D0, 3, 1)>(vb);
    asm volatile("s_waitcnt lgkmcnt(0)" ::: "memory"); SBAR();
#define PK(L, H) (bf16x8){L[0], L[1], L[2], L[3], H[0], H[1], H[2], H[3]}
    od = __builtin_amdgcn_mfma_f32_32x32x16_bf16(pa0, PK(l0, h0), od, 0, 0, 0);
    od = __builtin_amdgcn_mfma_f32_32x32x16_bf16(pa1, PK(l1, h1), od, 0, 0, 0);
    od = __builtin_amdgcn_mfma_f32_32x32x16_bf16(pa2, PK(l2, h2), od, 0, 0, 0);
    od = __builtin_amdgcn_mfma_f32_32x32x16_bf16(pa3, PK(l3, h3), od, 0, 0, 0);
#undef PK
}
__device__ __forceinline__ void pv_d0(f32x16* o, int vb, bf16x8 pa0, bf16x8 pa1, bf16x8 pa2, bf16x8 pa3) {
    pv_one<0>(o[0], vb, pa0, pa1, pa2, pa3); pv_one<1>(o[1], vb, pa0, pa1, pa2, pa3); pv_one<2>(o[2], vb, pa0, pa1, pa2, pa3); pv_one<3>(o[3], vb, pa0, pa1, pa2, pa3);
}

template <bool LATENT>
__device__ __forceinline__ void attn_unit(const bf16_t* Qb, const bf16_t* Kb, const bf16_t* Vb, bf16_t* Ob, int qrow0, int b, int hh,
                                          float lam, float oscale, const float* __restrict__ subln, const float* __restrict__ rope, LAS char* lds, int wave_) {
    int wid = wave_; asm volatile("" : "+s"(wid));
    const int lane = fresh_lane(), tid = (wid << 6) | lane, r32 = lane & 31, hi = lane >> 5;
    LAS char* V_lds = lds + LDS_V; LAS char* K_lds = lds + LDS_K;
    LAS float* wsf = (LAS float*)(lds + LDS_WS) + wid * 64; LAS float* li_l = wsf; LAS float* al_l = wsf + 32;
    LAS unsigned* stash = (LAS unsigned*)(lds + LDS_STASH + wid * 8192);
    constexpr int NT = 64;
    const int ctx0 = ML + b * CTXL, lat0 = b * SEQ;
    const int myrow = qrow0 + wid * QBLK + r32;
    const int ksr = tid >> 3, ksc = tid & 7, kst = kswz(ksr, ksc);
    const int sr = tid >> 4, sc = (tid & 15) * 8, vst0 = v_st(sr, sc), vst1 = v_st(32 + sr, sc);
    const int vb0 = (int)(uintptr_t)V_lds + v_rd_base(lane);
    f32x16 o[4];
#pragma unroll 1
    for (int c = 0; c < 2; ++c) {
        bf16x8 q0, q1, q2, q3;
        { const bf16_t* Qw = Qb + (size_t)myrow * 1024 + hh * 128 + c * 64 + hi * 8;
          q0 = *(const bf16x8*)(Qw); q1 = *(const bf16x8*)(Qw + 16); q2 = *(const bf16x8*)(Qw + 32); q3 = *(const bf16x8*)(Qw + 48); }
        const unsigned voV0 = (unsigned)(sr * 1024 + hh * 128 + sc) * 2u, voK = (unsigned)(ksr * 1024 + hh * 128 + c * 64 + ksc * 8) * 2u;
        float m_reg = -1e30f, l_reg = 0.f;
#pragma unroll
        for (int d = 0; d < 4; ++d) o[d] = f32x16{};
        bf16x8 sv0[1], sv1[1], sk0[1];
#define SLOAD(i, kr) do { unsigned a_ = voV0, b_ = voV0 + 32u * 2048u, c_ = voK; asm volatile("" : "+v"(a_), "+v"(b_), "+v"(c_)); \
        const char* vb_ = (const char*)Vb + (size_t)(kr) * 2048; const char* kb_ = (const char*)Kb + (size_t)(kr) * 2048; \
        sv0[i] = *(const bf16x8*)(vb_ + a_); sv1[i] = *(const bf16x8*)(vb_ + b_); sk0[i] = *(const bf16x8*)(kb_ + c_); } while (0)
#define SWRITE(bb, i) do { *(LAS bf16x8*)(V_lds + (bb) * SHM_V + vst0) = sv0[i]; *(LAS bf16x8*)(V_lds + (bb) * SHM_V + vst1) = sv1[i]; *(LAS bf16x8*)(K_lds + (bb) * SHM_K + kst) = sk0[i]; } while (0)
#define SWAIT() asm volatile("s_waitcnt vmcnt(3)" ::: "memory")
#define RESC(a) do { if (__any((a) < 1.f)) { if (hi == 0) al_l[r32] = (a); asm volatile("s_waitcnt lgkmcnt(0)" ::: "memory"); \
        _Pragma("unroll") for (int d = 0; d < 4; ++d) _Pragma("unroll") for (int r = 0; r < 16; ++r) o[d][r] *= al_l[crow(r, hi)]; } } while (0)
        f32x16 pA0, pA1; float mnA, alA; bf16x8 pa0, pa1, pa2, pa3;
        SLOAD(0, ctx0);
#pragma unroll 1
        for (int j = 0; j < 4; ++j) {
            __syncthreads();
            asm volatile("s_waitcnt vmcnt(0)" ::: "memory"); SWRITE(0, 0);
            { const int nr = j < 3 ? ctx0 + 64 * (j + 1) : (LATENT ? lat0 : ctx0); SLOAD(0, nr); }
            __syncthreads();
            qkt(pA0, pA1, K_lds, q0, q1, q2, q3, r32, hi); partialSM(pA0, pA1, m_reg, mnA, alA);
            RESC(alA);
            finishSM(pA0, pA1, alA, l_reg, pa0, pa1, pa2, pa3); SBAR();
            pv_d0(o, vb0, pa0, pa1, pa2, pa3);
        }
        if (LATENT) {
            {
                const int t = myrow & 4095, pos0 = t >> 6, pos1 = t & 63;
                const float* r0p = rope + (pos0 * 16 + 8 * hi) * 2; const float* r1p = rope + (pos1 * 16 + 8 * hi) * 2;
#pragma unroll
                for (int j = 0; j < 8; ++j) {
                    const float c0 = r0p[2 * j], s0 = r0p[2 * j + 1], c1 = r1p[2 * j], s1 = r1p[2 * j + 1];
                    const float x1 = bf2f((unsigned short)q0[j]), x2 = bf2f((unsigned short)q1[j]), z1 = bf2f((unsigned short)q2[j]), z2 = bf2f((unsigned short)q3[j]);
                    const unsigned w0 = cvt_pk_bf16(x1 * c0 - x2 * s0, x2 * c0 + x1 * s0), w1 = cvt_pk_bf16(z1 * c1 - z2 * s1, z2 * c1 + z1 * s1);
                    q0[j] = (short)(w0 & 0xffffu); q1[j] = (short)(w0 >> 16); q2[j] = (short)(w1 & 0xffffu); q3[j] = (short)(w1 >> 16);
                }
            }
            f32x16 pB0, pB1; float mnB, alB;
            __syncthreads();
            asm volatile("s_waitcnt vmcnt(0)" ::: "memory"); SWRITE(0, 0);
            SLOAD(0, lat0 + 64); __syncthreads();
            qkt(pA0, pA1, K_lds, q0, q1, q2, q3, r32, hi); partialSM(pA0, pA1, m_reg, mnA, alA);
            RESC(alA);
            asm volatile("s_waitcnt vmcnt(0)" ::: "memory"); SWRITE(1, 0); SLOAD(0, lat0 + 128); __syncthreads();
#pragma unroll 1
            for (int j = 1; j + 1 < NT; j += 2) {
                SBAR(); qkt(pB0, pB1, K_lds + SHM_K, q0, q1, q2, q3, r32, hi);
                finishSM(pA0, pA1, alA, l_reg, pa0, pa1, pa2, pa3); SBAR();
                pv_d0(o, vb0, pa0, pa1, pa2, pa3); partialSM(pB0, pB1, m_reg, mnB, alB);
                __syncthreads(); asm volatile("s_waitcnt vmcnt(0)" ::: "memory"); SWRITE(0, 0);
                SLOAD(0, lat0 + 64 * (j + 2 < NT ? j + 2 : NT - 1));
                RESC(alB); __syncthreads();
                SBAR(); qkt(pA0, pA1, K_lds, q0, q1, q2, q3, r32, hi);
                finishSM(pB0, pB1, alB, l_reg, pa0, pa1, pa2, pa3); SBAR();
                pv_d0(o, vb0 + SHM_V, pa0, pa1, pa2, pa3); partialSM(pA0, pA1, m_reg, mnA, alA);
                __syncthreads(); asm volatile("s_waitcnt vmcnt(0)" ::: "memory"); SWRITE(1, 0);
                SLOAD(0, lat0 + 64 * (j + 3 < NT ? j + 3 : NT - 1));
                RESC(alA); __syncthreads();
            }
            SBAR(); qkt(pB0, pB1, K_lds + SHM_K, q0, q1, q2, q3, r32, hi);
            finishSM(pA0, pA1, alA, l_reg, pa0, pa1, pa2, pa3); SBAR();
            pv_d0(o, vb0, pa0, pa1, pa2, pa3); partialSM(pB0, pB1, m_reg, mnB, alB);
            __syncthreads(); RESC(alB);
            finishSM(pB0, pB1, alB, l_reg, pa0, pa1, pa2, pa3); SBAR();
            pv_d0(o, vb0 + SHM_V, pa0, pa1, pa2, pa3);
        }
        if (hi == 0) li_l[r32] = l_reg; asm volatile("s_waitcnt lgkmcnt(0)" ::: "memory");
        if (c == 0) {
#pragma unroll
            for (int r = 0; r < 16; ++r) { const float rl = 1.0f / li_l[crow(r, hi)];
#pragma unroll
                for (int d = 0; d < 4; d += 2) stash[(r * 2 + (d >> 1)) * 64 + lane] = cvt_pk_bf16(o[d][r] * rl, o[d + 1][r] * rl); }
        } else {
            bf16_t* Ow = Ob + (size_t)(qrow0 + wid * QBLK) * 1024 + hh * 128;
            float gsub[4];
#pragma unroll
            for (int d = 0; d < 4; ++d) gsub[d] = subln[d * 32 + r32] * oscale;
#pragma unroll
            for (int r = 0; r < 16; ++r) {
                const float rl = lam / li_l[crow(r, hi)]; float acc2 = 0.f;
#pragma unroll
                for (int d = 0; d < 4; d += 2) { const unsigned w = stash[(r * 2 + (d >> 1)) * 64 + lane];
                    const float a0 = bflo(w) - o[d][r] * rl, a1 = bfhi(w) - o[d + 1][r] * rl;
                    o[d][r] = a0; o[d + 1][r] = a1; acc2 += a0 * a0 + a1 * a1; }
#pragma unroll
                for (int off = 1; off < 32; off <<= 1) acc2 += __shfl_xor(acc2, off);
                const float rs = 1.0f / sqrtf(acc2 * (1.f / 128.f) + 1e-5f);
                const int orow = crow(r, hi);
#pragma unroll
                for (int d = 0; d < 4; ++d) Ow[(size_t)orow * 1024 + d * 32 + r32] = (bf16_t)(cvt_pk_bf16(o[d][r] * rs * gsub[d], 0.f) & 0xffffu);
            }
        }
    }
#undef SLOAD
#undef SWRITE
#undef SWAIT
#undef RESC
}
#undef SBAR
}
#ifndef SCAN_TSEL
#define SCAN_TSEL 0
#endif
namespace rwkv {
constexpr int A_W = 0, A_KK = 16384, A_B = 32768, A_KD = 49152, A_R = 65536, A_V = 81920, A_Y = 98304, A_TW = A_Y, A_TA = A_Y + 8192, A_PRM = 133120, A_GC = A_PRM + 15 * 256, A_GT = A_GC + 256, A_END = A_GT + 2048;
constexpr int C_AT = 0, C_RT = 8192, C_BT = 16384, C_KT = 24576, C_KHT = 32768, C_BHT = 40960, C_VT = 49152, C_LAK = 57344, C_LAB = 65536  , C_RHS = 82944  , C_MRK = 100352, C_MRB = 108544, C_ZN = 116736, C_S0B = 139264;
constexpr int RHSP = 68;
constexpr int LABP = 68;
static_assert(A_END <= C_S0B && C_S0B + 8192 <= LDS_BYTES && C_ZN + 8192 <= RING_BYTES && C_RHS >= C_LAB + 64 * LABP * 4 && C_MRK >= C_RHS + 64 * RHSP * 4 && A_END <= LDS_BYTES && A_PRM >= MISC_OFF + 512, "scan LDS");
struct Params { const bf16_t* cs; bf16_t* co; bf16_t* y; float* bon; const float* mu; const float* w0; const float* w2; const float* a0; const float* a2; const float* kk; const float* ka; const float* rk; };
__device__ __forceinline__ float dpp_ror_add(float x, int) { return x; }
#define ROR_ADD(x, n) do { const int t_ = __builtin_amdgcn_update_dpp(0, __builtin_bit_cast(int, x), 0x120 + (n), 0xf, 0xf, false); x += __builtin_bit_cast(float, t_); } while (0)
__device__ __forceinline__ float row16_sum(float x) { ROR_ADD(x, 8); ROR_ADD(x, 4); ROR_ADD(x, 2); ROR_ADD(x, 1); return x; }
__device__ __forceinline__ void ld8(const bf16_t* p, float (&o)[8]) { const u32x4 w = *(const u32x4*)p; o[0] = bflo(w.x); o[1] = bfhi(w.x); o[2] = bflo(w.y); o[3] = bfhi(w.y); o[4] = bflo(w.z); o[5] = bfhi(w.z); o[6] = bflo(w.w); o[7] = bfhi(w.w); }
template <class MP> __device__ __forceinline__ void shift8(const bf16_t* base, size_t pitch, size_t row, int col, bool hp, bool hn, MP m0, MP m1, float (&o)[8]) {
    float c[8], p[8], n[8]; ld8(base + row * pitch + col, c); ld8(base + (hp ? row - 1 : row) * pitch + col, p); ld8(base + (hn ? row + 1 : row) * pitch + col, n);
#pragma unroll
    for (int i = 0; i < 8; ++i) { const float pv = hp ? p[i] : 0.f, nv = hn ? n[i] : 0.f; o[i] = c[i] + m0[i] * (pv - c[i]) + m1[i] * (nv - c[i]); }
}
__device__ __forceinline__ void lds_ld8(const LAS float* p, float (&o)[8]) { const f32x4 a = *(const LAS f32x4*)p, b = *(const LAS f32x4*)(p + 4); o[0] = a[0]; o[1] = a[1]; o[2] = a[2]; o[3] = a[3]; o[4] = b[0]; o[5] = b[1]; o[6] = b[2]; o[7] = b[3]; }
__device__ __forceinline__ void lds_st8(LAS float* p, const float (&o)[8]) { *(LAS f32x4*)p = (f32x4){o[0], o[1], o[2], o[3]}; *(LAS f32x4*)(p + 4) = (f32x4){o[4], o[5], o[6], o[7]}; }
__device__ __forceinline__ void scan_wg(const Params& P, int d, int b, int hh, LAS char* lds, int wave_) {
    unsigned long long tprev_ = 0;
#define SC_T(k) do { if (SCAN_TSEL != 0) { if (blockIdx.x == 0 && tid == 0) { const unsigned long long tn_ = __builtin_amdgcn_s_memrealtime(); if ((SCAN_TSEL >> (k)) & 1) { volatile LAS unsigned* M_ = (volatile LAS unsigned*)(lds + MISC_OFF); const unsigned long long ac_ = (((unsigned long long)M_[19] << 32) | M_[18]) + (tn_ - tprev_); M_[18] = (unsigned)ac_; M_[19] = (unsigned)(ac_ >> 32); } tprev_ = tn_; } } } while (0)
    int wid = wave_; asm volatile("" : "+s"(wid));
    const int lane0 = fresh_lane(), tid = (wid << 6) | lane0, r32o = lane0 & 31, hio = lane0 >> 5;
    LAS float* W = (LAS float*)(lds + A_W); LAS float* KK = (LAS float*)(lds + A_KK); LAS float* Bv = (LAS float*)(lds + A_B); LAS float* KD = (LAS float*)(lds + A_KD);
    LAS float* Rv = (LAS float*)(lds + A_R); LAS float* Vv = (LAS float*)(lds + A_V); LAS float* Y = (LAS float*)(lds + A_Y);
    LAS bf16_t* TW = (LAS bf16_t*)(lds + A_TW); LAS bf16_t* TA = (LAS bf16_t*)(lds + A_TA); LAS float* PRM = (LAS float*)(lds + A_PRM);
    __syncthreads();
    for (int i = tid; i < 15 * 64; i += NTHREADS) { const int p = i >> 6, c = i & 63; float v;
        switch (p) {
            case 0: v = P.mu[hh * 64 + c]; break;             case 1: v = P.mu[1920 + hh * 64 + c]; break;
            case 2: v = P.mu[512 + hh * 64 + c]; break;       case 3: v = P.mu[1920 + 512 + hh * 64 + c]; break;
            case 4: v = P.mu[1024 + d * 64 + c]; break;       case 5: v = P.mu[1920 + 1024 + d * 64 + c]; break;
            case 6: v = P.mu[1152 + d * 64 + c]; break;       case 7: v = P.mu[1920 + 1152 + d * 64 + c]; break;
            case 8: v = P.mu[1280 + hh * 64 + c]; break;      case 9: v = P.mu[1920 + 1280 + hh * 64 + c]; break;
            case 10: v = P.w0[d * 512 + hh * 64 + c]; break;  case 11: v = P.a0[d * 512 + hh * 64 + c]; break;
            case 12: v = P.kk[hh * 64 + c]; break;            case 13: v = P.ka[hh * 64 + c]; break;
            default: v = P.rk[hh * 64 + c]; break; }
        PRM[i] = v; }
    const int mtx = wid >> 2, ti = (wid >> 1) & 1, tj = wid & 1;
    bf16x8 bw[4];
    { const int r32 = r32o, hi = hio; const float* src = (mtx == 0 ? P.w2 : P.a2) + (size_t)d * 64 * 512 + hh * 64 + 32 * tj + r32;
#pragma unroll
      for (int s = 0; s < 4; ++s) {
          u32x4 w;
          w.x = cvt_pk_bf16(src[(size_t)(16 * s + 8 * hi + 0) * 512], src[(size_t)(16 * s + 8 * hi + 1) * 512]);
          w.y = cvt_pk_bf16(src[(size_t)(16 * s + 8 * hi + 2) * 512], src[(size_t)(16 * s + 8 * hi + 3) * 512]);
          w.z = cvt_pk_bf16(src[(size_t)(16 * s + 8 * hi + 4) * 512], src[(size_t)(16 * s + 8 * hi + 5) * 512]);
          w.w = cvt_pk_bf16(src[(size_t)(16 * s + 8 * hi + 6) * 512], src[(size_t)(16 * s + 8 * hi + 7) * 512]);
          bw[s] = __builtin_bit_cast(bf16x8, w); } }
    LAS float* GC = (LAS float*)(lds + A_GC); LAS float* GT = (LAS float*)(lds + A_GT);
    f32x16 Sreg = f32x16{};
    for (int i = tid; i < 2048; i += NTHREADS) ((LAS unsigned*)(lds + C_S0B))[i] = 0u;
    __syncthreads();
    u32x4 rc[5], rpv[5], rnv[5];
#define LOADRAW(BLK) do { const bool ic_ = (BLK) < 4; const int bb_ = ic_ ? (BLK) : (BLK) - 4; const int sb_ = ic_ ? ML + b * CTXL : b * SEQ, sl_ = ic_ ? CTXL : SEQ; \
        const int r0_ = d == 0 ? sb_ + 64 * bb_ : sb_ + sl_ - 64 * (bb_ + 1); int tq_ = tid; asm volatile("" : "+v"(tq_)); const int pj_ = tq_ >> 3, cg_ = tq_ & 7; \
        const int row_ = d == 0 ? r0_ + pj_ : r0_ + 63 - pj_; const int pos_ = row_ - sb_; const size_t rp_ = pos_ > 0 ? row_ - 1 : row_, rn_ = pos_ < sl_ - 1 ? row_ + 1 : row_; \
        const int cs_[5] = {hh * 64 + 8 * cg_, 512 + hh * 64 + 8 * cg_, 1024 + d * 64 + 8 * cg_, 1152 + d * 64 + 8 * cg_, hh * 64 + 8 * cg_}; \
        _Pragma("unroll") for (int sgi = 0; sgi < 5; ++sgi) { const bf16_t* base_ = sgi < 4 ? P.cs : (const bf16_t*)P.co; const size_t pitch_ = sgi < 4 ? DCS : DCOP; \
            rc[sgi] = *(const u32x4*)(base_ + (size_t)row_ * pitch_ + cs_[sgi]); rpv[sgi] = *(const u32x4*)(base_ + rp_ * pitch_ + cs_[sgi]); rnv[sgi] = *(const u32x4*)(base_ + rn_ * pitch_ + cs_[sgi]); \
            } } while (0)
    LOADRAW(0);
#pragma unroll 1
    for (int blk = 0; blk < 68; ++blk) {
        const bool isctx = blk < 4; const int bb = isctx ? blk : blk - 4;
        const int segbase = isctx ? ML + b * CTXL : b * SEQ, seglen = isctx ? CTXL : SEQ;
        const int r0 = d == 0 ? segbase + 64 * bb : segbase + seglen - 64 * (bb + 1);
        int tl_ = tid; asm volatile("" : "+v"(tl_));
        const int lane = tl_ & 63, r32 = lane & 31, hi = lane >> 5, pj = tl_ >> 3, cg = tl_ & 7;
        SC_T(0);
        {
            const int row = d == 0 ? r0 + pj : r0 + 63 - pj; const int pos = row - segbase; const unsigned pmk = pos > 0 ? 0xffffffffu : 0u, nmk = pos < seglen - 1 ? 0xffffffffu : 0u;
#define SHIFT8(sgi, M0, M1, OUT) do { const unsigned cw_[4] = {rc[sgi].x, rc[sgi].y, rc[sgi].z, rc[sgi].w}, pw_[4] = {rpv[sgi].x & pmk, rpv[sgi].y & pmk, rpv[sgi].z & pmk, rpv[sgi].w & pmk}, nw_[4] = {rnv[sgi].x & nmk, rnv[sgi].y & nmk, rnv[sgi].z & nmk, rnv[sgi].w & nmk}; \
                _Pragma("unroll") for (int i = 0; i < 4; ++i) { const f32x2 c_ = {bflo(cw_[i]), bfhi(cw_[i])}, p_ = {bflo(pw_[i]), bfhi(pw_[i])}, n_ = {bflo(nw_[i]), bfhi(nw_[i])}; \
                    const f32x2 a0_ = {(M0)[2 * i], (M0)[2 * i + 1]}, a1_ = {(M1)[2 * i], (M1)[2 * i + 1]}; const f32x2 o_ = c_ + a0_ * (p_ - c_) + a1_ * (n_ - c_); OUT[2 * i] = o_.x; OUT[2 * i + 1] = o_.y; } } while (0)
            float ks[8], xs[8], ssq = 0.f;
            float m0[8], m1[8];
            lds_ld8(PRM + 0 * 64 + 8 * cg, m0); lds_ld8(PRM + 1 * 64 + 8 * cg, m1); SHIFT8(0, m0, m1, ks);
            lds_st8(KD + pj * 64 + 8 * cg, ks);
            lds_ld8(PRM + 12 * 64 + 8 * cg, m0);
#pragma unroll
            for (int i = 0; i < 8; ++i) { const float t = ks[i] * m0[i]; ks[i] = t; ssq += t * t; }
            ssq += __shfl_xor(ssq, 1); ssq += __shfl_xor(ssq, 2); ssq += __shfl_xor(ssq, 4);
            const float inv = __builtin_amdgcn_rcpf(fmaxf(sqrtf(ssq), 1e-12f));
#pragma unroll
            for (int i = 0; i < 8; ++i) ks[i] *= inv;
            lds_st8(KK + pj * 64 + 8 * cg, ks);
            lds_ld8(PRM + 2 * 64 + 8 * cg, m0); lds_ld8(PRM + 3 * 64 + 8 * cg, m1); SHIFT8(1, m0, m1, xs);
            lds_st8(Vv + pj * 64 + 8 * cg, xs);
            lds_ld8(PRM + 8 * 64 + 8 * cg, m0); lds_ld8(PRM + 9 * 64 + 8 * cg, m1); SHIFT8(4, m0, m1, xs);
            lds_st8(Rv + pj * 64 + 8 * cg, xs);
            lds_ld8(PRM + 4 * 64 + 8 * cg, m0); lds_ld8(PRM + 5 * 64 + 8 * cg, m1); SHIFT8(2, m0, m1, xs);
            { u32x4 w;
#pragma unroll
              for (int i = 0; i < 8; ++i) { const float e2 = __expf(2.f * xs[i]); xs[i] = 1.f - 2.f / (e2 + 1.f); }
              w.x = cvt_pk_bf16(xs[0], xs[1]); w.y = cvt_pk_bf16(xs[2], xs[3]); w.z = cvt_pk_bf16(xs[4], xs[5]); w.w = cvt_pk_bf16(xs[6], xs[7]);
              *(LAS u32x4*)(TW + pj * 64 + 8 * cg) = w; }
            lds_ld8(PRM + 6 * 64 + 8 * cg, m0); lds_ld8(PRM + 7 * 64 + 8 * cg, m1); SHIFT8(3, m0, m1, xs);
            { u32x4 w; w.x = cvt_pk_bf16(xs[0], xs[1]); w.y = cvt_pk_bf16(xs[2], xs[3]); w.z = cvt_pk_bf16(xs[4], xs[5]); w.w = cvt_pk_bf16(xs[6], xs[7]);
              *(LAS u32x4*)(TA + pj * 64 + 8 * cg) = w; }
#undef SHIFT8
        }
        if (blk + 1 < 68) LOADRAW(blk + 1);
        __syncthreads(); SC_T(1);
        {
            const LAS bf16_t* T = mtx == 0 ? TW : TA; LAS float* dst = mtx == 0 ? W : Bv;
            f32x16 cacc = f32x16{};
#pragma unroll
            for (int s = 0; s < 4; ++s) { const bf16x8 af = *(const LAS bf16x8*)(T + (32 * ti + r32) * 64 + 16 * s + 8 * hi);
                cacc = __builtin_amdgcn_mfma_f32_32x32x16_bf16(af, bw[s], cacc, 0, 0, 0); }
#pragma unroll
            for (int r = 0; r < 16; ++r) dst[(32 * ti + (r & 3) + 8 * (r >> 2) + 4 * hi) * 64 + 32 * tj + r32] = cacc[r];
        }
        __syncthreads(); SC_T(2);
        {
            const int row = d == 0 ? r0 + pj : r0 + 63 - pj; float bsum = 0.f; const int o8 = pj * 64 + 8 * cg;
            float lw[8], la[8], kdv[8], kkv[8], rv[8], p10[8], p11[8], p13[8], p14[8];
            lds_ld8(W + o8, lw); lds_ld8(Bv + o8, la); lds_ld8(KD + o8, kdv); lds_ld8(KK + o8, kkv); lds_ld8(Rv + o8, rv);
            lds_ld8(PRM + 10 * 64 + 8 * cg, p10); lds_ld8(PRM + 11 * 64 + 8 * cg, p11); lds_ld8(PRM + 13 * 64 + 8 * cg, p13); lds_ld8(PRM + 14 * 64 + 8 * cg, p14);
#pragma unroll
            for (int i = 0; i < 8; ++i) {
                const float x = p10[i] + lw[i]; const float dec = __expf(-0.60653065971263342f * sigmoidf_(x));
                const float a = sigmoidf_(p11[i] + la[i]);
                const float kd = kdv[i] * (1.f + (a - 1.f) * p13[i]);
                lw[i] = dec; kdv[i] = kd; la[i] = kkv[i] * a; bsum += rv[i] * kd * p14[i]; }
            lds_st8(W + o8, lw); lds_st8(KD + o8, kdv); lds_st8(Bv + o8, la);
            bsum += __shfl_xor(bsum, 1); bsum += __shfl_xor(bsum, 2); bsum += __shfl_xor(bsum, 4);
            if (cg == 0) P.bon[(size_t)d * MT * 8 + (size_t)row * 8 + hh] = bsum;
        }
        __syncthreads(); SC_T(3);
        {
            const int kcol = tl_ & 63, seg = wid; float p[8], run = 1.f;
#pragma unroll
            for (int i = 0; i < 8; ++i) { run *= W[(8 * seg + i) * 64 + kcol]; p[i] = run; }
            GT[seg * 64 + kcol] = run;
            __syncthreads();
            float pre = 1.f;
#pragma unroll
            for (int sg2 = 0; sg2 < 7; ++sg2) { const float tv = GT[sg2 * 64 + kcol]; if (sg2 < seg) pre *= tv; }
#pragma unroll
            for (int i = 0; i < 8; ++i) W[(8 * seg + i) * 64 + kcol] = pre * p[i];
        }
        __syncthreads();
        {
            const int o8 = pj * 64 + 8 * cg;
            float g[8], gx[8], kk[8], rr[8], bb[8], kd[8];
            lds_ld8(W + o8, g); if (pj > 0) lds_ld8(W + o8 - 64, gx); else {
#pragma unroll
                for (int i = 0; i < 8; ++i) gx[i] = 1.f; }
            lds_ld8(KK + o8, kk); lds_ld8(Rv + o8, rr); lds_ld8(Bv + o8, bb); lds_ld8(KD + o8, kd);
            const int kc2 = tl_ & 63, tc2 = wid;
            float g2[8], kd2[8], bb2[8], vv2[8]; const float gc2 = W[63 * 64 + kc2];
#pragma unroll
            for (int i = 0; i < 8; ++i) { const int o = (8 * tc2 + i) * 64 + kc2; g2[i] = W[o]; kd2[i] = KD[o]; bb2[i] = Bv[o]; vv2[i] = Vv[o]; }
            __syncthreads();
            u32x4 w;
#define PK8(EXPR) do { float e_[8]; _Pragma("unroll") for (int i = 0; i < 8; ++i) e_[i] = (EXPR); w.x = cvt_pk_bf16(e_[0], e_[1]); w.y = cvt_pk_bf16(e_[2], e_[3]); w.z = cvt_pk_bf16(e_[4], e_[5]); w.w = cvt_pk_bf16(e_[6], e_[7]); } while (0)
            const int ao = attn::kswz(pj, cg);
            PK8(kk[i] * gx[i]); *(LAS u32x4*)(lds + C_AT + ao) = w;
            PK8(rr[i] * g[i]);  *(LAS u32x4*)(lds + C_RT + ao) = w;
            float ig[8];
#pragma unroll
            for (int i = 0; i < 8; ++i) ig[i] = __builtin_amdgcn_rcpf(g[i]);
            PK8(bb[i] * ig[i]); *(LAS u32x4*)(lds + C_BT + ao) = w;
            PK8(kd[i] * ig[i]); *(LAS u32x4*)(lds + C_KT + ao) = w;
            const int ao2 = attn::kswz(kc2, tc2);
#pragma unroll
            for (int i = 0; i < 8; ++i) ig[i] = gc2 * __builtin_amdgcn_rcpf(g2[i]);
            PK8(kd2[i] * ig[i]); *(LAS u32x4*)(lds + C_KHT + ao2) = w;
            PK8(bb2[i] * ig[i]); *(LAS u32x4*)(lds + C_BHT + ao2) = w;
            PK8(vv2[i]);               *(LAS u32x4*)(lds + C_VT + ao2) = w;
            if (tc2 == 7) GC[kc2] = gc2;
#undef PK8
        }
        __syncthreads(); SC_T(4);
#define FRAG(ARR, ROW, CH) (*(const LAS bf16x8*)(lds + (ARR) + attn::kswz((ROW), (CH))))
        {
            const int tr = wid >> 1, ti = tr & 1; const int Aarr = tr < 2 ? C_AT : C_RT;
#pragma unroll
            for (int h2 = 0; h2 < 2; ++h2) { const int tc = 2 * (wid & 1) + h2, tj = tc & 1; const int Barr = tc < 2 ? C_BT : C_KT;
                f32x16 acc = f32x16{};
#pragma unroll
                for (int q = 0; q < 4; ++q) acc = __builtin_amdgcn_mfma_f32_32x32x16_bf16(FRAG(Barr, 32 * tj + r32, 2 * q + hi), FRAG(Aarr, 32 * ti + r32, 2 * q + hi), acc, 0, 0, 0);
                const int t = 32 * ti + r32;
                const int d0 = 32 * tj + 4 * hi - t - (tr < 2 ? 0 : 1);
                if (tr < 2 && tc < 2) {
                    LAS float* lp = (LAS float*)(lds + C_LAB) + (32 * tj + 4 * hi) * LABP + (t & 3) * 16 + (t >> 2);
#pragma unroll
                    for (int r = 0; r < 16; ++r) { const int e = (r & 3) + 8 * (r >> 2); const unsigned mk = (unsigned)((d0 + e) >> 31);
                        lp[e * LABP] = __uint_as_float(__float_as_uint(acc[r]) & mk); }
                } else {
                    const int dst = tr < 2 ? C_LAK : (tc < 2 ? C_MRB : C_MRK);
#pragma unroll
                    for (int gq = 0; gq < 4; ++gq) { const int tp0 = 32 * tj + 8 * gq + 4 * hi; float vv4[4];
#pragma unroll
                        for (int e = 0; e < 4; ++e) { const unsigned mk = (unsigned)((d0 + 8 * gq + e) >> 31); vv4[e] = __uint_as_float(__float_as_uint(acc[4 * gq + e]) & mk); }
                        u32x2 w2; w2.x = cvt_pk_bf16(vv4[0], vv4[1]); w2.y = cvt_pk_bf16(vv4[2], vv4[3]);
                        *(LAS u32x2*)(lds + dst + attn::kswz(t, tp0 >> 3) + (tp0 & 7) * 2) = w2; }
                }
            }
        }
        __syncthreads(); SC_T(5);
        if (wid < 4) {
            const int ti = wid >> 1, tj = wid & 1; f32x16 acc = f32x16{};
#pragma unroll
            for (int q = 0; q < 4; ++q) acc = __builtin_amdgcn_mfma_f32_32x32x16_bf16(FRAG(C_S0B, 32 * tj + r32, 2 * q + hi), FRAG(C_AT, 32 * ti + r32, 2 * q + hi), acc, 0, 0, 0);
#pragma unroll
            for (int q = 0; q < 4; ++q) acc = __builtin_amdgcn_mfma_f32_32x32x16_bf16(FRAG(C_VT, 32 * tj + r32, 2 * q + hi), FRAG(C_LAK, 32 * ti + r32, 2 * q + hi), acc, 0, 0, 0);
            const int t = 32 * ti + r32;
#pragma unroll
            for (int r = 0; r < 16; ++r) { const int v = 32 * tj + (r & 3) + 8 * (r >> 2) + 4 * hi; *(LAS float*)(lds + C_RHS + (v * RHSP + (t & 3) * 16 + (t >> 2)) * 4) = acc[r]; }
        }
        else {
                const int ti = (wid >> 1) & 1, tj = wid & 1; const float gcv = GC[32 * tj + r32];
#pragma unroll
                for (int r = 0; r < 16; ++r) Sreg[r] *= gcv;
#pragma unroll
                for (int q = 0; q < 4; ++q) Sreg = __builtin_amdgcn_mfma_f32_32x32x16_bf16(FRAG(C_VT, 32 * ti + r32, 2 * q + hi), FRAG(C_KHT, 32 * tj + r32, 2 * q + hi), Sreg, 0, 0, 0);
        }
        __syncthreads(); SC_T(6);
        f32x16 Yacc = f32x16{}; bf16x8 mrb[4] = {};
        if (wid >= 4) {
            const int q = lane & 3, v = 16 * (wid - 4) + (lane >> 2);
            const LAS float* LT = (const LAS float*)(lds + C_LAB) + q * 16;
            f32x2 sa[8]; float zo[16];
            { const LAS f32x4* rp = (const LAS f32x4*)(lds + C_RHS + (v * RHSP + q * 16) * 4);
#pragma unroll
              for (int g4 = 0; g4 < 4; ++g4) { const f32x4 x = rp[g4]; sa[2 * g4] = (f32x2){x[0], x[1]}; sa[2 * g4 + 1] = (f32x2){x[2], x[3]}; } }
#pragma unroll
            for (int i = 0; i < 16; ++i) zo[i] = 0.f;
            f32x4 la[4], lb[4];
#define LLOAD(t, A) do { const LAS f32x4* lp_ = (const LAS f32x4*)(LT + (t) * LABP); _Pragma("unroll") for (int g_ = (t) >> 4; g_ < 4; ++g_) A[g_] = lp_[g_]; } while (0)
#define SOLVE_STEP(t, A, N) do { if ((t) < 63) LLOAD((t) + 1, N); const float zown_ = (((t) >> 2) & 1) ? sa[(t) >> 3].y : sa[(t) >> 3].x; \
                const float zt_ = __builtin_bit_cast(float, __builtin_amdgcn_update_dpp(0, __builtin_bit_cast(int, zown_), ((t) & 3) * 0x55, 0xf, 0xf, true)); \
                if (q == ((t) & 3)) zo[(t) >> 2] = zt_; const f32x2 nz_ = {-zt_, -zt_}; \
                _Pragma("unroll") for (int p_ = (t) >> 3; p_ < 8; ++p_) { const f32x2 l2_ = (p_ & 1) ? (f32x2){A[p_ >> 1][2], A[p_ >> 1][3]} : (f32x2){A[p_ >> 1][0], A[p_ >> 1][1]}; sa[p_] = l2_ * nz_ + sa[p_]; } } while (0)
#define SOLVE2(t) SOLVE_STEP(t, la, lb); SOLVE_STEP((t) + 1, lb, la)
#define SOLVE8(t) SOLVE2(t); SOLVE2((t) + 2); SOLVE2((t) + 4); SOLVE2((t) + 6)
            LLOAD(0, la);
            SOLVE8(0); SOLVE8(8); SOLVE8(16); SOLVE8(24); SOLVE8(32); SOLVE8(40); SOLVE8(48); SOLVE8(56);
#undef SOLVE8
#undef SOLVE2
#undef SOLVE_STEP
#undef LLOAD
#pragma unroll
            for (int i = 0; i < 16; ++i) { const int t = 4 * i + q; *(LAS bf16_t*)(lds + C_ZN + attn::kswz(v, t >> 3) + (t & 7) * 2) = (bf16_t)(cvt_pk_bf16(-zo[i], 0.f) & 0xffffu); }
        } else {
            const int ti = wid >> 1, tj = wid & 1;
#pragma unroll
            for (int q = 0; q < 4; ++q) mrb[q] = FRAG(C_MRB, 32 * ti + r32, 2 * q + hi);
#pragma unroll
            for (int q = 0; q < 4; ++q) Yacc = __builtin_amdgcn_mfma_f32_32x32x16_bf16(FRAG(C_RT, 32 * ti + r32, 2 * q + hi), FRAG(C_S0B, 32 * tj + r32, 2 * q + hi), Yacc, 0, 0, 0);
#pragma unroll
            for (int q = 0; q < 4; ++q) Yacc = __builtin_amdgcn_mfma_f32_32x32x16_bf16(FRAG(C_MRK, 32 * ti + r32, 2 * q + hi), FRAG(C_VT, 32 * tj + r32, 2 * q + hi), Yacc, 0, 0, 0);
        }
        __syncthreads(); SC_T(7);
        if (wid < 4) {
            const int ti = wid >> 1, tj = wid & 1;
#pragma unroll
            for (int q = 0; q < 4; ++q) Yacc = __builtin_amdgcn_mfma_f32_32x32x16_bf16(mrb[q], FRAG(C_ZN, 32 * tj + r32, 2 * q + hi), Yacc, 0, 0, 0);
            bf16_t* yb = P.y + (size_t)d * MT * 512 + hh * 64 + 32 * tj + r32;
#pragma unroll
            for (int r = 0; r < 16; ++r) { const int t = 32 * ti + (r & 3) + 8 * (r >> 2) + 4 * hi; const int row = d == 0 ? r0 + t : r0 + 63 - t;
                yb[(size_t)row * 512] = (bf16_t)(cvt_pk_bf16(Yacc[r], 0.f) & 0xffffu); }
            SC_T(8);
        } else {
            const int ti = (wid >> 1) & 1, tj = wid & 1; const int k = 32 * tj + r32;
#pragma unroll
            for (int q = 0; q < 4; ++q) Sreg = __builtin_amdgcn_mfma_f32_32x32x16_bf16(FRAG(C_ZN, 32 * ti + r32, 2 * q + hi), FRAG(C_BHT, 32 * tj + r32, 2 * q + hi), Sreg, 0, 0, 0);
#pragma unroll
            for (int r = 0; r < 16; ++r) { const int v = 32 * ti + (r & 3) + 8 * (r >> 2) + 4 * hi;
                *(LAS bf16_t*)(lds + C_S0B + attn::kswz(v, k >> 3) + (k & 7) * 2) = (bf16_t)(cvt_pk_bf16(Sreg[r], 0.f) & 0xffffu); }
        }
#undef FRAG
    }
    __syncthreads();
}
#undef ROR_ADD
}
struct Frame {
    LAS unsigned char* lds; char* ldsg; volatile LAS unsigned* MISC; gu32* ctl;
    int tid, lane, wave, G, gw, NGW;
    const float* x_in; const float* ctx_in; float* out; unsigned char* ws;
};
enum { I_X = 0, I_C, I_CTX, I_CCTX, I_ADAW, I_ADAB, I_WIN, I_LAMQK, I_SUBLN, I_MU, I_W0, I_W2, I_A0, I_A2, I_G2, I_KK, I_KA, I_RK, I_LNW, I_LNB,
       I_WPA, I_WPF, I_WPC, I_WO, I_LN1G, I_LN1B, I_FUP, I_FCONV, I_FCONVB, I_FDN, I_LN2G, I_LN2B };

struct Row16 { f32x4 v[4]; };
__device__ __forceinline__ void row_load_f32(Row16& r, const float* p, int lane) {
#pragma unroll
    for (int j = 0; j < 4; ++j) r.v[j] = *(const f32x4*)(p + 256 * j + 4 * lane);
}
__device__ __forceinline__ void row_load_bf16(Row16& r, const bf16_t* p, int lane) {
#pragma unroll
    for (int j = 0; j < 4; ++j) { const u32x2 w = *(const u32x2*)(p + 256 * j + 4 * lane); r.v[j] = (f32x4){bflo(w.x), bfhi(w.x), bflo(w.y), bfhi(w.y)}; }
}
__device__ __forceinline__ void row_store_f32(const Row16& r, float* p, int lane) {
#pragma unroll
    for (int j = 0; j < 4; ++j) *(f32x4*)(p + 256 * j + 4 * lane) = r.v[j];
}
__device__ __forceinline__ void row_store_bf16(const Row16& r, bf16_t* p, int lane) {
#pragma unroll
    for (int j = 0; j < 4; ++j) { u32x2 w; w.x = cvt_pk_bf16(r.v[j][0], r.v[j][1]); w.y = cvt_pk_bf16(r.v[j][2], r.v[j][3]); *(u32x2*)(p + 256 * j + 4 * lane) = w; }
}
__device__ __forceinline__ void row_ln_plain(Row16& r) {
    float s = 0.f;
#pragma unroll
    for (int j = 0; j < 4; ++j) s += (r.v[j][0] + r.v[j][1]) + (r.v[j][2] + r.v[j][3]);
    const float mean = wave_sum(s) * (1.f / DM); float q = 0.f;
#pragma unroll
    for (int j = 0; j < 4; ++j) { r.v[j] = r.v[j] - mean; q += (r.v[j][0] * r.v[j][0] + r.v[j][1] * r.v[j][1]) + (r.v[j][2] * r.v[j][2] + r.v[j][3] * r.v[j][3]); }
    const float rstd = 1.0f / sqrtf(wave_sum(q) * (1.f / DM) + LN_EPS);
#pragma unroll
    for (int j = 0; j < 4; ++j) r.v[j] = r.v[j] * rstd;
}
__device__ __forceinline__ void row_affine(Row16& r, const float* g, const float* b, int lane, float gadd) {
#pragma unroll
    for (int j = 0; j < 4; ++j) { const f32x4 gg = *(const f32x4*)(g + 256 * j + 4 * lane), bb = *(const f32x4*)(b + 256 * j + 4 * lane); r.v[j] = r.v[j] * (gg + gadd) + bb; }
}
__device__ __forceinline__ const float* modrow(const Frame& F, int layer, int row) { return (const float*)(F.ws + TAB_MOD) + ((size_t)layer * 5 + (row < ML ? (row >> 12) : 4)) * 6144; }
__device__ __forceinline__ const float* xrow_in(const Frame& F, int layer, int row) {
    if (layer == 0) return row < ML ? F.x_in + (size_t)row * DM : F.ctx_in + (size_t)(row - ML) * DM;
    return row < ML ? F.out + (size_t)row * DM : (const float*)(F.ws + WS_XC) + (size_t)(row - ML) * DM;
}
__device__ __forceinline__ float* xrow_out(const Frame& F, int row) { return row < ML ? F.out + (size_t)row * DM : (float*)(F.ws + WS_XC) + (size_t)(row - ML) * DM; }

__device__ __forceinline__ void pass_modulate(const Frame& F0, int layer, bf16_t* dst, int nrows) {
    Frame F = F0; F.lane = fresh_lane(); F.tid = (F.wave << 6) | F.lane;
    for (int row = F.gw; row < nrows; row += F.NGW) {
        Row16 r; row_load_f32(r, xrow_in(F, layer, row), F.lane); row_ln_plain(r);
        const float* mv = modrow(F, layer, row); row_affine(r, mv + 1024, mv, F.lane, 1.f);
        row_store_bf16(r, dst + (size_t)row * DM, F.lane);
    }
}
__device__ __forceinline__ void pass_ln1(Frame F, int layer, const bf16_t* mix, bf16_t* h2, int nrows, const float* g, const float* bt) {
    F.lane = fresh_lane(); F.tid = (F.wave << 6) | F.lane;
    for (int row0 = F.gw; row0 < nrows; row0 += 2 * F.NGW) {
        const int row1 = row0 + F.NGW; const bool two = row1 < nrows; const int rowb = two ? row1 : row0;
        Row16 ra, ma, rb, mb; row_load_f32(ra, xrow_in(F, layer, row0), F.lane); row_load_bf16(ma, mix + (size_t)row0 * DM, F.lane);
        row_load_f32(rb, xrow_in(F, layer, rowb), F.lane); row_load_bf16(mb, mix + (size_t)rowb * DM, F.lane);
        const float* mva = modrow(F, layer, row0); const float* mvb = modrow(F, layer, rowb);
#pragma unroll
        for (int j = 0; j < 4; ++j) { f32x4 gt = *(const f32x4*)(mva + 2048 + 256 * j + 4 * F.lane); if (DBG_ZERO_MIX) gt = gt * 0.f; ra.v[j] = ra.v[j] * ALPHA + gt * ma.v[j];
            f32x4 gu = *(const f32x4*)(mvb + 2048 + 256 * j + 4 * F.lane); if (DBG_ZERO_MIX) gu = gu * 0.f; rb.v[j] = rb.v[j] * ALPHA + gu * mb.v[j]; }
        row_ln_plain(ra); row_ln_plain(rb); row_affine(ra, g, bt, F.lane, 0.f); row_affine(rb, g, bt, F.lane, 0.f);
        row_store_f32(ra, xrow_out(F, row0), F.lane); if (two) row_store_f32(rb, xrow_out(F, row1), F.lane);
        row_ln_plain(ra); row_ln_plain(rb); row_affine(ra, mva + 4096, mva + 3072, F.lane, 1.f); row_affine(rb, mvb + 4096, mvb + 3072, F.lane, 1.f);
        row_store_bf16(ra, h2 + (size_t)row0 * DM, F.lane); if (two) row_store_bf16(rb, h2 + (size_t)row1 * DM, F.lane);
    }
}
__device__ __forceinline__ void pass_ln2(Frame F, int layer, bf16_t* ffn_h, int nrows, bool next_h, const float* g, const float* bt) {
    F.lane = fresh_lane(); F.tid = (F.wave << 6) | F.lane;
    for (int row0 = F.gw; row0 < nrows; row0 += 2 * F.NGW) {
        const int row1 = row0 + F.NGW; const bool two = row1 < nrows; const int rowb = two ? row1 : row0;
        Row16 ra, ma, rb, mb; float* xa = xrow_out(F, row0); float* xb = xrow_out(F, rowb);
        row_load_f32(ra, xa, F.lane); row_load_bf16(ma, ffn_h + (size_t)row0 * DM, F.lane); row_load_f32(rb, xb, F.lane); row_load_bf16(mb, ffn_h + (size_t)rowb * DM, F.lane);
        const float* mva = modrow(F, layer, row0); const float* mvb = modrow(F, layer, rowb);
#pragma unroll
        for (int j = 0; j < 4; ++j) { f32x4 gt = *(const f32x4*)(mva + 5120 + 256 * j + 4 * F.lane); if (DBG_ZERO_FFN) gt = gt * 0.f; ra.v[j] = ra.v[j] * ALPHA + gt * ma.v[j];
            f32x4 gu = *(const f32x4*)(mvb + 5120 + 256 * j + 4 * F.lane); if (DBG_ZERO_FFN) gu = gu * 0.f; rb.v[j] = rb.v[j] * ALPHA + gu * mb.v[j]; }
        row_ln_plain(ra); row_ln_plain(rb); row_affine(ra, g, bt, F.lane, 0.f); row_affine(rb, g, bt, F.lane, 0.f);
        row_store_f32(ra, xa, F.lane); if (two) row_store_f32(rb, xb, F.lane);
        if (next_h) { const float* mna = modrow(F, layer + 1, row0); const float* mnb = modrow(F, layer + 1, rowb);
            row_ln_plain(ra); row_ln_plain(rb); row_affine(ra, mna + 1024, mna, F.lane, 1.f); row_affine(rb, mnb + 1024, mnb, F.lane, 1.f);
            row_store_bf16(ra, ffn_h + (size_t)row0 * DM, F.lane); if (two) row_store_bf16(rb, ffn_h + (size_t)row1 * DM, F.lane); }
    }
}
__device__ __forceinline__ float gelu_fast(float v) {
    const float av = fabsf(v), t = __builtin_amdgcn_rcpf(av * 0.2316418882f + 1.0f);
    float q = t * 0.5307027145f + (-0.7265760135f); q = q * t + 0.7107068705f; q = q * t + (-0.142248368f); q = q * t + 0.127414796f; q = q * t;
    const float e = __builtin_amdgcn_exp2f((v * v) * (-0.72134752044f)); const float m = v * (q * e);
    return v < 0.f ? m : v - m;
}
__device__ __forceinline__ void pass_conv(Frame F, bf16_t* ug, int nrows, const float* cw, const float* cb) {
    F.lane = fresh_lane(); F.tid = (F.wave << 6) | F.lane;
    const long total = (long)nrows * (DFF / 8), stride = (long)F.G * NTHREADS;
    for (long it = (long)blockIdx.x * NTHREADS + F.tid; it < total; it += stride) {
        const int row = (int)(it / (DFF / 8)), c = (int)(it % (DFF / 8)) * 8;
        int pos, len; if (row < ML) { pos = row & 4095; len = SEQ; } else { pos = (row - ML) & 255; len = CTXL; }
        const bool hp = pos > 0, hn = pos < len - 1;
        bf16_t* up = ug + (size_t)row * NP + c;
        float u[8], gc[8], gp[8], gn[8];
        rwkv::ld8(up, u); rwkv::ld8(up + DFF, gc); rwkv::ld8(up + DFF - (hp ? NP : 0), gp); rwkv::ld8(up + DFF + (hn ? NP : 0), gn);
        float o[8];
        float w0[8], w1[8], w2[8], bb[8];
        { const f32x4 a = *(const f32x4*)(cw + c), b = *(const f32x4*)(cw + c + 4); w0[0]=a[0];w0[1]=a[1];w0[2]=a[2];w0[3]=a[3];w0[4]=b[0];w0[5]=b[1];w0[6]=b[2];w0[7]=b[3]; }
        { const f32x4 a = *(const f32x4*)(cw + DFF + c), b = *(const f32x4*)(cw + DFF + c + 4); w1[0]=a[0];w1[1]=a[1];w1[2]=a[2];w1[3]=a[3];w1[4]=b[0];w1[5]=b[1];w1[6]=b[2];w1[7]=b[3]; }
        { const f32x4 a = *(const f32x4*)(cw + 2 * DFF + c), b = *(const f32x4*)(cw + 2 * DFF + c + 4); w2[0]=a[0];w2[1]=a[1];w2[2]=a[2];w2[3]=a[3];w2[4]=b[0];w2[5]=b[1];w2[6]=b[2];w2[7]=b[3]; }
        { const f32x4 a = *(const f32x4*)(cb + c), b = *(const f32x4*)(cb + c + 4); bb[0]=a[0];bb[1]=a[1];bb[2]=a[2];bb[3]=a[3];bb[4]=b[0];bb[5]=b[1];bb[6]=b[2];bb[7]=b[3]; }
#pragma unroll
        for (int i = 0; i < 8; ++i) {
            const float x = w0[i] * (hp ? gp[i] : 0.f) + w1[i] * gc[i] + w2[i] * (hn ? gn[i] : 0.f) + bb[i];
            o[i] = gelu_fast(x) * u[i];
        }
        u32x4 w; w.x = cvt_pk_bf16(o[0], o[1]); w.y = cvt_pk_bf16(o[2], o[3]); w.z = cvt_pk_bf16(o[4], o[5]); w.w = cvt_pk_bf16(o[6], o[7]);
        *(u32x4*)up = w;
    }
}

__device__ __forceinline__ void ldf8(const float* p, float (&o)[8]) { const f32x4 a = *(const f32x4*)p, b = *(const f32x4*)(p + 4); o[0]=a[0];o[1]=a[1];o[2]=a[2];o[3]=a[3];o[4]=b[0];o[5]=b[1];o[6]=b[2];o[7]=b[3]; }
__device__ __forceinline__ void pass_sg(Frame F, bf16_t* co, int nrows, const float* mu) {
    F.lane = fresh_lane(); F.tid = (F.wave << 6) | F.lane;
    const int sub = F.lane >> 4, cl = (F.lane & 15) * 8;
    float m0[8], m1[8]; ldf8(mu + 1280 + 512 + cl, m0); ldf8(mu + 1920 + 1280 + 512 + cl, m1);
    for (int row = 4 * F.gw + sub; row < nrows; row += 4 * F.NGW) {
        int pos, len; if (row < ML) { pos = row & 4095; len = SEQ; } else { pos = (row - ML) & 255; len = CTXL; }
        const bool hp = pos > 0, hn = pos < len - 1;
        bf16_t* p = co + (size_t)row * DCOP + 512 + cl;
        float c[8], pv[8], nv[8], o[8]; rwkv::ld8(p, c); rwkv::ld8(p - (hp ? DCOP : 0), pv); rwkv::ld8(p + (hn ? DCOP : 0), nv);
#pragma unroll
        for (int i = 0; i < 8; ++i) { const float a = hp ? pv[i] : 0.f, b = hn ? nv[i] : 0.f; o[i] = sigmoidf_(c[i] + m0[i] * (a - c[i]) + m1[i] * (b - c[i])); }
        u32x4 w; w.x = cvt_pk_bf16(o[0], o[1]); w.y = cvt_pk_bf16(o[2], o[3]); w.z = cvt_pk_bf16(o[4], o[5]); w.w = cvt_pk_bf16(o[6], o[7]);
        *(u32x4*)(p + (DCO - 512)) = w;
    }
}
struct PostRow { u32x4 a0, a1, gg, vc, vp, vn; float bsum; };
__device__ __forceinline__ void post_load(PostRow& R, int row, int c, int head, const bf16_t* y0, const bf16_t* y1, const bf16_t* g, const bf16_t* cs, const float* bon) {
    int pos, len; if (row < ML) { pos = row & 4095; len = SEQ; } else { pos = (row - ML) & 255; len = CTXL; }
    const bool hp = pos > 0, hn = pos < len - 1; const size_t o = (size_t)row * 512 + c;
    R.a0 = *(const u32x4*)(y0 + o); R.a1 = *(const u32x4*)(y1 + o); R.gg = *(const u32x4*)(g + o);
    const bf16_t* vq = cs + (size_t)row * DCS + 512 + c;
    R.vc = *(const u32x4*)vq; R.vp = *(const u32x4*)(vq - (hp ? DCS : 0)); R.vn = *(const u32x4*)(vq + (hn ? DCS : 0));
    if (!hp) R.vp = (u32x4){0u, 0u, 0u, 0u}; if (!hn) R.vn = (u32x4){0u, 0u, 0u, 0u};
    R.bsum = bon[(size_t)row * 8 + head] + bon[(size_t)MT * 8 + (size_t)row * 8 + head];
}
__device__ __forceinline__ void up8(const u32x4 w, float (&o)[8]) { o[0] = bflo(w.x); o[1] = bfhi(w.x); o[2] = bflo(w.y); o[3] = bfhi(w.y); o[4] = bflo(w.z); o[5] = bfhi(w.z); o[6] = bflo(w.w); o[7] = bfhi(w.w); }
__device__ __forceinline__ u32x4 post_finish(const PostRow& R, const float (&lw)[8], const float (&lb)[8], const float (&m0)[8], const float (&m1)[8]) {
    float y[8], t[8], gv[8], vc[8], vp[8], vn[8]; up8(R.a0, y); up8(R.a1, t); up8(R.gg, gv); up8(R.vc, vc); up8(R.vp, vp); up8(R.vn, vn);
    float s = 0.f;
#pragma unroll
    for (int i = 0; i < 8; ++i) { y[i] += t[i]; s += y[i]; }
    s += __shfl_xor(s, 1); s += __shfl_xor(s, 2); s += __shfl_xor(s, 4);
    const float mean = s * (1.f / 64.f); float q = 0.f;
#pragma unroll
    for (int i = 0; i < 8; ++i) { y[i] -= mean; q += y[i] * y[i]; }
    q += __shfl_xor(q, 1); q += __shfl_xor(q, 2); q += __shfl_xor(q, 4);
    const float rstd = 1.0f / sqrtf(q * (1.f / 64.f) + 64.f * 1e-5f);
#pragma unroll
    for (int i = 0; i < 8; ++i) { const float vs = vc[i] + m0[i] * (vp[i] - vc[i]) + m1[i] * (vn[i] - vc[i]); y[i] = (y[i] * rstd * lw[i] + lb[i] + R.bsum * vs) * gv[i]; }
    u32x4 w; w.x = cvt_pk_bf16(y[0], y[1]); w.y = cvt_pk_bf16(y[2], y[3]); w.z = cvt_pk_bf16(y[4], y[5]); w.w = cvt_pk_bf16(y[6], y[7]);
    return w;
}
__device__ __forceinline__ void pass_post(Frame F, int nrows, bf16_t* y0, const bf16_t* y1, const bf16_t* g, const bf16_t* cs, const float* bon, const float* mu, const float* lnw, const float* lnb) {
    F.lane = fresh_lane(); F.tid = (F.wave << 6) | F.lane;
    const int c = 8 * F.lane, head = F.lane >> 3;
    float lw[8], lb[8], m0[8], m1[8]; ldf8(lnw + c, lw); ldf8(lnb + c, lb); ldf8(mu + 512 + c, m0); ldf8(mu + 1920 + 512 + c, m1);
    for (int row0 = F.gw; row0 < nrows; row0 += 2 * F.NGW) {
        const int row1 = row0 + F.NGW; const bool two = row1 < nrows; const int rowb = two ? row1 : row0;
        PostRow A, B; post_load(A, row0, c, head, y0, y1, g, cs, bon); post_load(B, rowb, c, head, y0, y1, g, cs, bon);
        const u32x4 wa = post_finish(A, lw, lb, m0, m1), wb = post_finish(B, lw, lb, m0, m1);
        *(u32x4*)(y0 + (size_t)row0 * 512 + c) = wa; if (two) *(u32x4*)(y0 + (size_t)row1 * 512 + c) = wb;
    }
}

__device__ __forceinline__ unsigned f2bf(float f) { unsigned u = __builtin_bit_cast(unsigned, f); return (u + 0x7fffu + ((u >> 16) & 1u)) >> 16; }
__device__ __forceinline__ unsigned pk2(float lo, float hi) { return f2bf(lo) | (f2bf(hi) << 16); }
__device__ __forceinline__ void transpose_item(const float* W, int K, int N, bf16_t* WT, int item, LAS float* scr, int lane, int rowadd_from, int rowadd) {
    const int nblk = N / 32, kb = item / nblk, nb = item % nblk, k0 = 64 * kb, n0 = 32 * nb;
    const int row_off = n0 >= rowadd_from ? rowadd : 0;
    float wv[32];
#pragma unroll
    for (int i = 0; i < 32; ++i) { const int kk = 2 * i + (lane >> 5); wv[i] = W[(size_t)(k0 + kk) * N + n0 + (lane & 31)]; }
#pragma unroll
    for (int i = 0; i < 32; ++i) { const int kk = 2 * i + (lane >> 5); scr[kk * 33 + (lane & 31)] = wv[i]; }
    LDS_WAIT(); asm volatile("" ::: "memory");
    const int c = lane & 7;
#pragma unroll
    for (int j = 0; j < 4; ++j) { const int n = (lane >> 3) + 8 * j; const LAS float* s = scr + (8 * c) * 33 + n;
        u32x4 o; o.x = pk2(s[0 * 33], s[1 * 33]); o.y = pk2(s[2 * 33], s[3 * 33]); o.z = pk2(s[4 * 33], s[5 * 33]); o.w = pk2(s[6 * 33], s[7 * 33]);
        *(GAS u32x4*)(WT + (size_t)(row_off + n0 + n) * K + k0 + 8 * c) = o; }
    LDS_WAIT(); asm volatile("" ::: "memory");
}
#define CONVERT_WEIGHTS(F, layer, INP) CONVERT_WEIGHTS_PART(F, layer, INP, 0)
#define CONVERT_WEIGHTS_PART(F, layer, INP, part) do { \
    convert_weights_((F), (layer), INP(I_WIN), INP(I_WPA), INP(I_WPF), INP(I_WPC), INP(I_WO), INP(I_FUP), INP(I_FDN), INP(I_G2), (part)); } while (0)
__device__ __forceinline__ void convert_weights_(const Frame& F_, int layer, const float* p_win, const float* p_wpa, const float* p_wpf, const float* p_wpc, const float* p_wo, const float* p_fup, const float* p_fdn, const float* p_g2, int part) {
    Frame F = F_; F.lane = fresh_lane(); F.tid = (F.wave << 6) | F.lane;
    LAS float* scr = (LAS float*)(F.lds + F.wave * 16384);
    constexpr int N_IN = 16 * (D_IN_SRC / 32), N_PA = 16 * 32, N_PF = 8 * 32, N_PC = 8 * 32, N_O = 16 * 32, N_UP = 16 * (2 * DFF / 32), N_DN = (DFF / 64) * 32, N_G2 = 2 * 16;
    constexpr int NITEMS = N_IN + N_PA + N_PF + N_PC + N_O + N_UP + N_DN + N_G2;
    unsigned char* ws = F.ws;
    const int it_lo = part == 2 ? N_IN + N_PA + N_PF + N_PC : (part == 3 ? N_IN + N_PA + N_PF + N_PC + N_O + N_UP : 0);
    const int it_hi = part == 1 ? N_IN + N_PA + N_PF + N_PC : (part == 2 ? N_IN + N_PA + N_PF + N_PC + N_O + N_UP : NITEMS);
    for (int it = it_lo + F.gw; it < it_hi; it += F.NGW) {
        int r = it;
        if (r < N_IN) { transpose_item(p_win + (size_t)layer * DM * D_IN_SRC, DM, D_IN_SRC, (bf16_t*)(ws + W_IN), r, scr, F.lane, 5504, 128); continue; } r -= N_IN;
        if (r < N_PA) { transpose_item(p_wpa + (size_t)layer * 1024 * DM, 1024, DM, (bf16_t*)(ws + W_PA), r, scr, F.lane, 1 << 30, 0); continue; } r -= N_PA;
        if (r < N_PF) { transpose_item(p_wpf + (size_t)layer * 512 * DM, 512, DM, (bf16_t*)(ws + W_PF), r, scr, F.lane, 1 << 30, 0); continue; } r -= N_PF;
        if (r < N_PC) { transpose_item(p_wpc + (size_t)layer * 512 * DM, 512, DM, (bf16_t*)(ws + W_PC), r, scr, F.lane, 1 << 30, 0); continue; } r -= N_PC;
        if (r < N_O) { transpose_item(p_wo + (size_t)layer * DM * DM, DM, DM, (bf16_t*)(ws + W_O), r, scr, F.lane, 1 << 30, 0); continue; } r -= N_O;
        if (r < N_UP) { transpose_item(p_fup + (size_t)layer * DM * 2 * DFF, DM, 2 * DFF, (bf16_t*)(ws + W_UP), r, scr, F.lane, 1 << 30, 0); continue; } r -= N_UP;
        if (r < N_DN) { transpose_item(p_fdn + (size_t)layer * DFF * DM, DFF, DM, (bf16_t*)(ws + W_DN), r, scr, F.lane, 1 << 30, 0); continue; } r -= N_DN;
        transpose_item(p_g2 + (size_t)layer * 128 * 512, 128, 512, (bf16_t*)(ws + W_G2T), r, scr, F.lane, 1 << 30, 0);
    }
    if (part <= 1) { u32x4* z = (u32x4*)(ws + W_IN + (size_t)5504 * DM * 2); const int n16 = 128 * DM * 2 / 16;
      unsigned zz = 0u; asm volatile("" : "+v"(zz));
      for (int i = F.gw * 64 + F.lane; i < n16; i += F.NGW * 64) z[i] = (u32x4){zz, zz, zz, zz}; }
}
__device__ __forceinline__ void build_tables(Frame F, const float* lamqk) {
    F.lane = fresh_lane(); F.tid = (F.wave << 6) | F.lane;
    const int gt = blockIdx.x * NTHREADS + F.tid, NT_ = F.G * NTHREADS;
    float* rope = (float*)(F.ws + TAB_ROPE); float* tw = (float*)(F.ws + TAB_TW);
    bf16_t* w0 = (bf16_t*)(F.ws + TAB_W0); bf16_t* f1 = (bf16_t*)(F.ws + TAB_F1); bf16_t* f2 = (bf16_t*)(F.ws + TAB_F2); bf16_t* dc = (bf16_t*)(F.ws + TAB_DC);
    for (int i = gt; i < 1024; i += NT_) { const int pos = i >> 4, f = i & 15; const float inv = powf(10000.f, -(float)f / 16.f); const float ang = (float)pos * inv;
        rope[2 * i] = (float)cos((double)ang); rope[2 * i + 1] = (float)sin((double)ang); }
    for (int i = gt; i < 4096; i += NT_) { const int kl = i >> 6, tl = i & 63; float s, c; sincospif(2.f * (float)(kl * tl) / 4096.f, &s, &c); tw[2 * i] = c; tw[2 * i + 1] = s; }
    for (int i = gt; i < 256 * 128; i += NT_) { const int r = i >> 7, c = i & 127, ri = r >> 7, m = r & 127; float s, co; sincospif(2.f * (float)((m * c) & 127) / 128.f, &s, &co);
        w0[i] = (bf16_t)f2bf((ri == 0 ? co : -s) * 0.088388347648318f); }
    for (int i = gt; i < 256 * 256; i += NT_) { const int r = i >> 8, k = i & 255; const int rip = r >> 7, p = (r >> 6) & 1, kl = r & 63, ri = k >> 7, p2 = (k >> 6) & 1, th = k & 63;
        float s, co; sincospif(2.f * (float)((kl * th) & 63) / 64.f, &s, &co);
        float v = 0.f; if (p == p2) v = (rip == ri) ? co : (rip == 0 ? s : -s);
        f1[i] = (bf16_t)f2bf(v * 0.125f); }
    for (int i = gt; i < 256 * 512; i += NT_) { const int r = i >> 9, k = i & 511; const int pp = r >> 6, kh = r & 63, rip = k >> 8, p2 = (k >> 6) & 3, tl = k & 63;
        float s, co; sincospif(2.f * (float)((kh * tl) & 63) / 64.f, &s, &co);
        const float v = (pp == p2) ? (rip == 0 ? co : s) : 0.f;
        f2[i] = (bf16_t)f2bf(v * 0.125f); }
    for (int i = gt; i < 256 * 512; i += NT_) { const int k = i >> 9, kk = i & 511, ri = kk >> 8, t = kk & 255;
        float s, co; sincospif(2.f * (float)((k * t) & 255) / 256.f, &s, &co);
        dc[i] = (bf16_t)f2bf((ri == 0 ? co : s) * 0.0625f); }
    if (gt < NLAYER) {
        const float* lq = lamqk + gt * 256; float s1 = 0.f, s2 = 0.f;
        for (int i = 0; i < 64; ++i) { s1 += lq[i] * lq[64 + i]; s2 += lq[128 + i] * lq[192 + i]; }
        const float lam_init = 0.8f - 0.6f * expf(-0.3f * (float)gt);
        float* lamv = (float*)(F.ws + TAB_LAM); lamv[2 * gt] = expf(s1) - expf(s2) + lam_init; lamv[2 * gt + 1] = 1.f - lam_init;
    }
}
__device__ __forceinline__ void build_mod(Frame F, const float* cvec, const float* cctx, const float* adaw, const float* adab) {
    F.lane = fresh_lane(); F.tid = (F.wave << 6) | F.lane;
    LAS float* sil = (LAS float*)F.lds;
    LAS float* part = sil + 5 * 1024;
    for (int i = F.tid; i < 5 * 1024; i += NTHREADS) { const int s = i >> 10, k = i & 1023; const float c = s < 4 ? cvec[s * 1024 + k] : cctx[k]; sil[i] = c / (1.f + expf(-c)); }
    __syncthreads();
    for (int cgid = blockIdx.x; cgid < 256; cgid += F.G) {
        const int l = cgid >> 7, j0 = (cgid & 127) * 48;
        if (F.tid < 384) { const int col = F.tid % 48, kg = F.tid / 48; const float* w = adaw + ((size_t)l * 1024 + 128 * kg) * 6144 + j0 + col;
            float a0 = 0.f, a1 = 0.f, a2 = 0.f, a3 = 0.f, a4 = 0.f;
            for (int k = 0; k < 128; ++k) { const float wv = w[(size_t)k * 6144]; const int kk = 128 * kg + k;
                a0 += sil[kk] * wv; a1 += sil[1024 + kk] * wv; a2 += sil[2048 + kk] * wv; a3 += sil[3072 + kk] * wv; a4 += sil[4096 + kk] * wv; }
            part[(kg * 5 + 0) * 48 + col] = a0; part[(kg * 5 + 1) * 48 + col] = a1; part[(kg * 5 + 2) * 48 + col] = a2; part[(kg * 5 + 3) * 48 + col] = a3; part[(kg * 5 + 4) * 48 + col] = a4; }
        __syncthreads();
        if (F.tid < 240) { const int s = F.tid / 48, col = F.tid % 48; float a = adab[l * 6144 + j0 + col];
            for (int kg = 0; kg < 8; ++kg) a += part[(kg * 5 + s) * 48 + col];
            ((float*)(F.ws + TAB_MOD))[((size_t)l * 5 + s) * 6144 + j0 + col] = a; }
        __syncthreads();
    }
}
#ifndef MK_PER_PHASE
#define MK_PER_PHASE 0
#endif
#ifndef TIME_SEL
#define TIME_SEL 0
#endif
constexpr int N_PHASES = 2 + 13 * NLAYER;
#ifndef SCAN_SEL
#define SCAN_SEL(bx) ((((bx) >> 3) & 3) == 0 && ((bx) >> 5) < 8)
#define SCAN_SID(bx) (((bx) >> 5) * 8 + ((bx) & 7))
#define SCAN_RANK(bx) ((bx) - 8 * (((bx) >> 5) + 1))
#endif
struct Args { const float* in[32]; float* out; unsigned char* ws; int ph_lo, ph_hi; };

__device__ __forceinline__ pg8::Operand opnd(const void* base, long tM, long tN, long rstride, long kstep) {
    pg8::Operand o; o.base = (const char*)base; o.tM = tM; o.tN = tN; o.tN2 = 0; o.nshift = 30; o.rstride = rstride; o.hstep = 128 * rstride; o.kstep = kstep; return o; }
constexpr int CW_SUB = 2048;
__device__ __forceinline__ void sub_arrive_wait(gu32* cnt, unsigned add, unsigned target, bool t0) {
    asm volatile("s_waitcnt vmcnt(0)" ::: "memory"); __syncthreads();
    if (t0) {
        __builtin_amdgcn_fence(__ATOMIC_RELEASE, "agent"); asm volatile("s_waitcnt vmcnt(0)" ::: "memory");
        if (add) (void)__hip_atomic_fetch_add(cnt, add, RLX_AGENT);
        unsigned sp = 0; while (__hip_atomic_load(cnt, RLX_AGENT) < target) { __builtin_amdgcn_s_sleep(2); if (++sp > (1u << 24)) break; }
        __builtin_amdgcn_fence(__ATOMIC_ACQUIRE, "agent"); asm volatile("s_waitcnt vmcnt(0)" ::: "memory");
    }
    __syncthreads();
}
struct RowF0 { __device__ __forceinline__ unsigned operator()(int R) const { return (unsigned)(((R & 63) * 64 + (R >> 6)) * 1024); } };

__global__ void __launch_bounds__(NTHREADS, 2) mk_fwd(Args args) {
    extern __shared__ __attribute__((aligned(16))) unsigned char lds[];
    Frame F;
    F.lds = (LAS unsigned char*)lds; F.ldsg = (char*)lds;
    F.MISC = (volatile LAS unsigned*)(F.lds + MISC_OFF);
    F.tid = threadIdx.x; F.lane = F.tid & 63; F.wave = __builtin_amdgcn_readfirstlane(F.tid >> 6);
    F.G = gridDim.x; F.gw = blockIdx.x * NWAVES + F.wave; F.NGW = F.G * NWAVES;
    F.x_in = args.in[I_X]; F.ctx_in = args.in[I_CTX];
    F.out = args.out; F.ws = args.ws; F.ctl = (gu32*)(args.ws + WS_CTL);
    unsigned char* ws0 = args.ws;
#define T0 (fresh_tid(F.wave) == 0)
#ifndef CH_WG
#define CH_WG 8
#endif
#define CH_T(k) do { if ((TIME_SEL >> 20) != 0) { if (blockIdx.x == CH_WG && T0) { const unsigned long long tn_ = __builtin_amdgcn_s_memrealtime(); const unsigned long long tp_ = ((unsigned long long)F.MISC[21] << 32) | F.MISC[20]; if ((TIME_SEL >> (20 + (k))) & 1) { const unsigned long long ac_ = (((unsigned long long)F.MISC[19] << 32) | F.MISC[18]) + (tn_ - tp_); F.MISC[18] = (unsigned)ac_; F.MISC[19] = (unsigned)(ac_ >> 32); } F.MISC[20] = (unsigned)tn_; F.MISC[21] = (unsigned)(tn_ >> 32); } } } while (0)
#define LWS size_t wo_ = 0; int bx = bx0, G = G0; asm volatile("" : "+s"(wo_), "+s"(bx), "+s"(G)); unsigned char* ws = ws0 + wo_
    for (int u = F.tid; u < (LDS_BYTES - LDSCTL_OFF) / 4; u += NTHREADS) ((LAS unsigned*)(F.lds + LDSCTL_OFF))[u] = 0u;
    __syncthreads();
    XcdBarrier bar; bar.bar = (unsigned*)(F.ctl + CW_BAR); bar.x = 0; bar.st = nullptr;
    if (!MK_PER_PHASE) bar = xcd_barrier_post((unsigned*)(F.ctl + CW_BAR), F.MISC + 8);
    const int lo = args.ph_lo, hi = args.ph_hi;
    if (TIME_SEL) { if (blockIdx.x == 0 && T0) { const unsigned long long tn_ = __builtin_amdgcn_s_memrealtime(); F.MISC[16] = (unsigned)tn_; F.MISC[17] = (unsigned)(tn_ >> 32); } }
#ifndef PHMASK
#define PHMASK 0x7fff
#endif
#define IN(k) (lo <= (k) && (k) < hi)
#define KIND(b) ((PHMASK >> (b)) & 1)
#define INP(i) (args.in[i])
#define SEAM(k) do { if (!MK_PER_PHASE && IN((k) + 1)) xcd_barrier(bar.bar, bar.x, bar.st, T0 ? 1u : 0u); \
    if (TIME_SEL) { if (blockIdx.x == 0 && T0) { const unsigned long long tn_ = __builtin_amdgcn_s_memrealtime(); const unsigned long long tp_ = ((unsigned long long)F.MISC[17] << 32) | F.MISC[16]; \
        const int kind_ = (k) < 2 ? (k) : 2 + ((k) - 2) % 13; if ((TIME_SEL >> kind_) & 1) { const unsigned long long ac_ = (((unsigned long long)F.MISC[19] << 32) | F.MISC[18]) + (tn_ - tp_); F.MISC[18] = (unsigned)ac_; F.MISC[19] = (unsigned)(ac_ >> 32); } \
        F.MISC[16] = (unsigned)tn_; F.MISC[17] = (unsigned)(tn_ >> 32); } } } while (0)
    const int bx0 = blockIdx.x, G0 = F.G;
    pg8::StaticOrder S; S.wave = F.wave;
    const pg8::RowLin rl2048{2048}, rl1024{1024}, rl128{128}, rl256{256}, rl11264{11264}, rl5632{5632};

    if (KIND(0) && IN(0)) { LWS; build_mod(F, INP(I_C), INP(I_CCTX), INP(I_ADAW), INP(I_ADAB)); __syncthreads(); build_tables(F, INP(I_LAMQK)); CONVERT_WEIGHTS(F, 0, INP); SEAM(0); }
    if (KIND(1) && IN(1)) { LWS; pass_modulate(F, 0, (bf16_t*)(ws + WS_HY), MT); SEAM(1); }

#pragma unroll 1
    for (int layer = 0; layer < NLAYER; ++layer) {
        const int pb = 2 + 13 * layer;
        const bool last = layer == NLAYER - 1;
        const int MR = last ? ML : MT;

        if (KIND(2) && IN(pb + 0)) { LWS;
            S.init(MT, NP, G, bx);
            pg8::EpiInProj E{ws, (const float*)(ws + TAB_ROPE)};
            pg8::gemm_phase<pg8::EpiInProj, pg8::RowLin, true>(F.lds, opnd(ws + WS_HY, 256 * 2048, 0, 2048, 128), opnd(ws + W_IN, 0, 256 * 2048, 2048, 128), rl2048, 16, S, E);
            SEAM(pb + 0);
        }
        if (KIND(3) && IN(pb + 1)) { LWS;
#ifndef DBG_NO_SCAN
            if (SCAN_SEL(bx)) {
                const int sid = SCAN_SID(bx);
                rwkv::Params P; P.cs = (const bf16_t*)(ws + P_CS); P.co = (bf16_t*)(ws + P_CO); P.y = (bf16_t*)(ws + WS_HY); P.bon = (float*)(ws + WS_BON);
                P.mu = INP(I_MU) + layer * 2 * 1920; P.w0 = INP(I_W0) + layer * 1024; P.w2 = INP(I_W2) + (size_t)layer * 2 * 64 * 512; P.a0 = INP(I_A0) + layer * 1024;
                P.a2 = INP(I_A2) + (size_t)layer * 2 * 64 * 512; P.kk = INP(I_KK) + layer * 512; P.ka = INP(I_KA) + layer * 512; P.rk = INP(I_RK) + layer * 512;
                unsigned long long ts0_ = 0; if ((TIME_SEL >> 16) & 1) ts0_ = __builtin_amdgcn_s_memrealtime();
                rwkv::scan_wg(P, sid >> 5, (sid >> 3) & 3, sid & 7, (LAS char*)F.lds, F.wave);
                if ((TIME_SEL >> 16) & 1) { if (blockIdx.x == 0 && T0) { const unsigned long long ac_ = (((unsigned long long)F.MISC[19] << 32) | F.MISC[18]) + (__builtin_amdgcn_s_memrealtime() - ts0_); F.MISC[18] = (unsigned)ac_; F.MISC[19] = (unsigned)(ac_ >> 32); } }
            }
#endif
            unsigned long long ta0_ = 0; if ((TIME_SEL >> 17) & 1) ta0_ = __builtin_amdgcn_s_memrealtime();
            if ((TIME_SEL >> 20) != 0) { if (blockIdx.x == CH_WG && T0) { const unsigned long long tn_ = __builtin_amdgcn_s_memrealtime(); F.MISC[20] = (unsigned)tn_; F.MISC[21] = (unsigned)(tn_ >> 32); } }
#if 0
#endif
            const float* tabf = (const float*)(ws + TAB_LAM); const float lam = tabf[2 * layer], osc = tabf[2 * layer + 1];
            const int x = bx & 7, nun = last ? 64 : 68;
            gu32* qw = F.ctl + CW_QUEUE + 64 * (layer * 8 + x);
#ifndef DBG_NO_ATTN
            unsigned ndone = 0;
            for (;;) {
                __syncthreads();
                if (T0) F.MISC[0] = __hip_atomic_fetch_add(qw, 1u, RLX_AGENT);
                __syncthreads();
                const int i = (int)F.MISC[0];
                if (i >= nun) break;
                ++ndone;
                const bf16_t* Q = (const bf16_t*)(ws + P_Q); const bf16_t* K = (const bf16_t*)(ws + P_K); const bf16_t* V = (const bf16_t*)(ws + P_V);
                const float* sub = INP(I_SUBLN) + layer * 128; const float* rope = (const float*)(ws + TAB_ROPE);
                if (i < 64) { const int pair = x + 8 * (i >> 4), qb = i & 15, b = pair >> 3, hh = pair & 7;
                    attn::attn_unit<true>(Q, K, V, (bf16_t*)(ws + P_Q), b * SEQ + 256 * qb, b, hh, lam, osc, sub, rope, (LAS char*)F.lds, F.wave); }
                else { const int pair = x + 8 * (i - 64), b = pair >> 3, hh = pair & 7;
#ifndef DBG_NO_ATTNC
                    attn::attn_unit<false>(Q, K, V, (bf16_t*)(ws + P_Q), ML + b * CTXL, b, hh, lam, osc, sub, rope, (LAS char*)F.lds, F.wave);
#endif
                }
            }
#endif
            CH_T(0);
            {
                const bool is_scan = SCAN_SEL(bx);
                gu32* dcnt = F.ctl + CW_SUB + 64 * (layer * 4 + 0);
                const unsigned total = 8u * (unsigned)nun;
                if (is_scan || G != 256) { sub_arrive_wait(dcnt, ndone, 0u, T0); }
                else {
                    const int rank = SCAN_RANK(bx), GF = 192;
                    { Frame F2 = F; F2.gw = rank * NWAVES + F.wave; F2.NGW = GF * NWAVES;
                      pass_sg(F2, (bf16_t*)(ws + P_CO), MR, INP(I_MU) + layer * 2 * 1920); }
                    sub_arrive_wait(dcnt, ndone, total, T0); CH_T(1);
                    { S.init(1024, ML, GF, rank); pg8::EpiF0 E{(bf16_t*)(ws + P_K)};
                      pg8::Operand B = opnd(ws + P_F, 256, 4 * 1024, 1024, 128); B.nshift = 4; B.tN2 = 4096L * 1024; B.hstep = 2 * 1024;
                      pg8::gemm_phase<pg8::EpiF0, RowF0, true>(F.lds, opnd(ws + TAB_W0, 0, 0, 256, 128), B, RowF0{}, 2, S, E); }
                    if (!last) { S.init(1024, MC, GF, (rank + GF - 64) % GF); pg8::EpiF0c E{(bf16_t*)(ws + P_K + 32 * MiB)};
                      pg8::gemm_phase<pg8::EpiF0c, pg8::RowLin, true>(F.lds, opnd(ws + TAB_W0, 0, 0, 256, 128), opnd(ws + P_F + (size_t)ML * 1024, 256, 256 * 1024, 1024, 128), rl1024, 2, S, E); }
                    sub_arrive_wait(F.ctl + CW_SUB + 64 * (layer * 4 + 1), 1u, (unsigned)GF, T0); CH_T(4);
                    { S.init(256, 65536, GF, rank); pg8::EpiF1 E{(bf16_t*)(ws + P_V), (const float*)(ws + TAB_TW)};
                      pg8::gemm_phase<pg8::EpiF1, pg8::RowLin, true>(F.lds, opnd(ws + TAB_F1, 0, 0, 512, 128), opnd(ws + P_K, 0, 256 * 128, 128, 8 * MiB), rl128, 4, S, E); }
                    if (!last) { S.init(256, 2048, GF, (rank + GF - 72) % GF); pg8::EpiFc E{(bf16_t*)(ws + P_F)};
                      pg8::gemm_phase<pg8::EpiFc, pg8::RowLin, true>(F.lds, opnd(ws + TAB_DC, 0, 0, 1024, 128), opnd(ws + P_K + 32 * MiB, 0, 256 * 1024, 1024, 128), rl1024, 8, S, E); }
                    sub_arrive_wait(F.ctl + CW_SUB + 64 * (layer * 4 + 2), 1u, (unsigned)GF, T0); CH_T(5);
                    { S.init(256, 32768, GF, rank); pg8::EpiF2 E{(bf16_t*)(ws + P_F)};
                      pg8::gemm_phase<pg8::EpiF2, pg8::RowLin, true>(F.lds, opnd(ws + TAB_F2, 0, 0, 1024, 128), opnd(ws + P_V, 0, 256 * 128, 128, 4 * MiB), rl128, 8, S, E); }
                    sub_arrive_wait(F.ctl + CW_SUB + 64 * (layer * 4 + 3), 1u, (unsigned)GF, T0); CH_T(2);
                    { S.init(MR, 512, GF, rank); pg8::EpiBf16 E{(bf16_t*)(ws + P_V), 512};
                      pg8::gemm_phase<pg8::EpiBf16, pg8::RowLin, true>(F.lds, opnd(ws + P_CO + DCO * 2, 256 * 1536, 0, 1536, 128), opnd(ws + W_G2T, 0, 256 * 256, 256, 128), rl256, 2, S, E); }
                    {
                        Frame F2 = F; F2.gw = rank * NWAVES + F.wave; F2.NGW = GF * NWAVES;
                        pass_modulate(F2, layer, (bf16_t*)(ws + P_K), MR); }
                    CH_T(3);
                }
            }
            if ((TIME_SEL >> 17) & 1) { if (blockIdx.x == 8 && T0) { const unsigned long long ac_ = (((unsigned long long)F.MISC[19] << 32) | F.MISC[18]) + (__builtin_amdgcn_s_memrealtime() - ta0_); F.MISC[18] = (unsigned)ac_; F.MISC[19] = (unsigned)(ac_ >> 32); } }
            SEAM(pb + 1); CH_T(6);
        }
        if (KIND(4) && IN(pb + 2)) { LWS;
          if (G != 256) {
            { S.init(1024, ML, G, bx); pg8::EpiF0 E{(bf16_t*)(ws + P_K)};
              pg8::Operand B = opnd(ws + P_F, 256, 4 * 1024, 1024, 128); B.nshift = 4; B.tN2 = 4096L * 1024; B.hstep = 2 * 1024;
              pg8::gemm_phase<pg8::EpiF0, RowF0, true>(F.lds, opnd(ws + TAB_W0, 0, 0, 256, 128), B, RowF0{}, 2, S, E); }
            if (!last) { S.init(1024, MC, G, (bx + G - 16) % G); pg8::EpiF0c E{(bf16_t*)(ws + P_K + 32 * MiB)};
              pg8::gemm_phase<pg8::EpiF0c, pg8::RowLin, true>(F.lds, opnd(ws + TAB_W0, 0, 0, 256, 128), opnd(ws + P_F + (size_t)ML * 1024, 256, 256 * 1024, 1024, 128), rl1024, 2, S, E); }
          }
            if (G != 256) { pass_sg(F, (bf16_t*)(ws + P_CO), MR, INP(I_MU) + layer * 2 * 1920); SEAM(pb + 2); }
        }
        if (KIND(5) && IN(pb + 3)) { LWS;
          if (G != 256) {
            { S.init(256, 65536, G, bx); pg8::EpiF1 E{(bf16_t*)(ws + P_V), (const float*)(ws + TAB_TW)};
              pg8::gemm_phase<pg8::EpiF1, pg8::RowLin, true>(F.lds, opnd(ws + TAB_F1, 0, 0, 512, 128), opnd(ws + P_K, 0, 256 * 128, 128, 8 * MiB), rl128, 4, S, E); }
            if (!last) { S.init(256, 2048, G, (bx + G - 8) % G); pg8::EpiFc E{(bf16_t*)(ws + P_F)};
              pg8::gemm_phase<pg8::EpiFc, pg8::RowLin, true>(F.lds, opnd(ws + TAB_DC, 0, 0, 1024, 128), opnd(ws + P_K + 32 * MiB, 0, 256 * 1024, 1024, 128), rl1024, 8, S, E); }
          }
            if (G != 256) SEAM(pb + 3);
        }
        if (KIND(6) && IN(pb + 4)) { LWS;
            if (G != 256) { S.init(256, 32768, G, bx); pg8::EpiF2 E{(bf16_t*)(ws + P_F)};
              pg8::gemm_phase<pg8::EpiF2, pg8::RowLin, true>(F.lds, opnd(ws + TAB_F2, 0, 0, 1024, 128), opnd(ws + P_V, 0, 256 * 128, 128, 4 * MiB), rl128, 8, S, E); }
            if (G != 256) { S.init(MR, 512, G, bx);
              pg8::EpiRwkvPost E{(const bf16_t*)(ws + WS_HY), (const bf16_t*)(ws + WS_HY) + (size_t)MT * 512, (const bf16_t*)(ws + P_CS), (const float*)(ws + WS_BON),
                                 INP(I_MU) + layer * 2 * 1920, INP(I_LNW) + layer * 512, INP(I_LNB) + layer * 512, (bf16_t*)(ws + WS_HY)};
              pg8::gemm_phase<pg8::EpiRwkvPost, pg8::RowLin, false>(F.lds, opnd(ws + P_CO + DCO * 2, 256 * 1536, 0, 1536, 128), opnd(ws + W_G2T, 0, 256 * 256, 256, 128), rl256, 2, S, E); }
            else pass_post(F, MR, (bf16_t*)(ws + WS_HY), (const bf16_t*)(ws + WS_HY) + (size_t)MT * 512, (const bf16_t*)(ws + P_V), (const bf16_t*)(ws + P_CS), (const float*)(ws + WS_BON),
                           INP(I_MU) + layer * 2 * 1920, INP(I_LNW) + layer * 512, INP(I_LNB) + layer * 512);
            if (G != 256) pass_modulate(F, layer, (bf16_t*)(ws + P_K), MR);
            SEAM(pb + 4);
        }
        if (KIND(7) && IN(pb + 5)) { LWS;
            S.init(MR, NGATE, G, bx); pg8::EpiGate E{(bf16_t*)(ws + P_V)};
            pg8::gemm_phase<pg8::EpiGate, pg8::RowLin, true>(F.lds, opnd(ws + P_K, 256 * 2048, 0, 2048, 128), opnd(ws + W_IN + (size_t)NP * 2048, 0, 256 * 2048, 2048, 128), rl2048, 16, S, E);
            SEAM(pb + 5);
        }
        if (KIND(8) && IN(pb + 6)) { LWS;
            S.init(MR, 1024, G, bx);
            { pg8::EpiBranch<true> E{(const bf16_t*)(ws + P_V), (bf16_t*)(ws + P_K), (DBG_BR & 1) ? 1.f : 0.f};
              pg8::gemm_phase<pg8::EpiBranch<true>, pg8::RowLin, true>(F.lds, opnd(ws + P_Q, 256 * 2048, 0, 2048, 128), opnd(ws + W_PA, 0, 256 * 2048, 2048, 128), rl2048, 16, S, E); }
            VM_WAIT();
            { pg8::EpiBranch<false> E{(const bf16_t*)(ws + P_V) + 1024, (bf16_t*)(ws + P_K), (DBG_BR & 2) ? 1.f : 0.f};
              pg8::gemm_phase<pg8::EpiBranch<false>, pg8::RowLin, true>(F.lds, opnd(ws + P_F, 256 * 1024, 0, 1024, 128), opnd(ws + W_PF, 0, 256 * 1024, 1024, 128), rl1024, 8, S, E); }
            VM_WAIT();
            { pg8::EpiBranch<false> E{(const bf16_t*)(ws + P_V) + 2048, (bf16_t*)(ws + P_K), (DBG_BR & 4) ? 1.f : 0.f};
              pg8::gemm_phase<pg8::EpiBranch<false>, pg8::RowLin, true>(F.lds, opnd(ws + WS_HY, 256 * 1024, 0, 1024, 128), opnd(ws + W_PC, 0, 256 * 1024, 1024, 128), rl1024, 8, S, E); }
            SEAM(pb + 6);
        }
        if (KIND(9) && IN(pb + 7)) { LWS;
            S.init(MR, 1024, G, bx); pg8::EpiBf16 E{(bf16_t*)(ws + P_V), 1024};
            pg8::gemm_phase<pg8::EpiBf16, pg8::RowLin, true>(F.lds, opnd(ws + P_K, 256 * 2048, 0, 2048, 128), opnd(ws + W_O, 0, 256 * 2048, 2048, 128), rl2048, 16, S, E);
            if (!last && G == 256 && bx >= 16) {
                Frame F2 = F; F2.gw = (bx - 16) * NWAVES + F.wave; F2.NGW = 240 * NWAVES; CONVERT_WEIGHTS_PART(F2, layer + 1, INP, 1); }
            SEAM(pb + 7);
        }
        if (KIND(10) && IN(pb + 8)) { LWS; pass_ln1(F, layer, (const bf16_t*)(ws + P_V), (bf16_t*)(ws + WS_HY), MR, INP(I_LN1G) + layer * DM, INP(I_LN1B) + layer * DM); SEAM(pb + 8); }
        if (KIND(11) && IN(pb + 9)) { LWS;
            S.init(MR, NP, G, bx); pg8::EpiBf16 E{(bf16_t*)(ws + WS_P), NP};
            pg8::gemm_phase<pg8::EpiBf16, pg8::RowLin, true>(F.lds, opnd(ws + WS_HY, 256 * 2048, 0, 2048, 128), opnd(ws + W_UP, 0, 256 * 2048, 2048, 128), rl2048, 16, S, E);
            SEAM(pb + 9);
        }
        if (KIND(12) && IN(pb + 10)) { LWS; pass_conv(F, (bf16_t*)(ws + WS_P), MR, INP(I_FCONV) + (size_t)layer * 3 * DFF, INP(I_FCONVB) + (size_t)layer * DFF); SEAM(pb + 10); }
        if (KIND(13) && IN(pb + 11)) { LWS;
            S.init(MR, 1024, G, bx); pg8::EpiBf16 E{(bf16_t*)(ws + WS_HY), 1024};
            pg8::gemm_phase<pg8::EpiBf16, pg8::RowLin, true>(F.lds, opnd(ws + WS_P, 256 * 11264, 0, 11264, 128), opnd(ws + W_DN, 0, 256 * 5632, 5632, 128), rl5632, 44, S, E);
            if (!last && G == 256 && bx >= 16) { Frame F2 = F; F2.gw = (bx - 16) * NWAVES + F.wave; F2.NGW = 240 * NWAVES; CONVERT_WEIGHTS_PART(F2, layer + 1, INP, 2); }
            SEAM(pb + 11);
        }
        if (KIND(14) && IN(pb + 12)) { LWS;
            pass_ln2(F, layer, (bf16_t*)(ws + WS_HY), MR, !last, INP(I_LN2G) + layer * DM, INP(I_LN2B) + layer * DM);
            if (!last) { __syncthreads(); if (G == 256) CONVERT_WEIGHTS_PART(F, layer + 1, INP, 3); else CONVERT_WEIGHTS(F, layer + 1, INP); }
            SEAM(pb + 12);
        }
    }
    if (TIME_SEL || SCAN_TSEL != 0) { if ((blockIdx.x == 0 || blockIdx.x == 8 || blockIdx.x == CH_WG) && T0) { const unsigned long long ac_ = ((unsigned long long)F.MISC[19] << 32) | F.MISC[18]; const unsigned long long t0_ = __builtin_amdgcn_s_memrealtime(); while (__builtin_amdgcn_s_memrealtime() - t0_ < ac_) __builtin_amdgcn_s_sleep(8); } }
#undef IN
#undef SEAM
}

extern "C" void kernel_launch(void* const* d_in, const int* in_sizes, int n_in, void* d_out, int out_size, void* d_ws, size_t ws_size, hipStream_t stream) {
    static int grid = 0;
    if (grid == 0) {
        if (n_in != 32 || in_sizes[0] != ML * DM || out_size != ML * DM || ws_size < WS_END) { fprintf(stderr, "kernel_launch: unexpected shapes (n_in %d, ws %zu)\n", n_in, ws_size); grid = -1; return; }
        int dev = 0, cus = 0, per_cu = 0;
        if (hipGetDevice(&dev) != hipSuccess || hipDeviceGetAttribute(&cus, hipDeviceAttributeMultiprocessorCount, dev) != hipSuccess) { grid = -1; return; }
        if (hipFuncSetAttribute((const void*)mk_fwd, hipFuncAttributeMaxDynamicSharedMemorySize, LDS_BYTES) != hipSuccess) { fprintf(stderr, "kernel_launch: hipFuncSetAttribute failed\n"); grid = -1; return; }
        if (hipOccupancyMaxActiveBlocksPerMultiprocessor(&per_cu, (const void*)mk_fwd, NTHREADS, LDS_BYTES) != hipSuccess || per_cu < 1) { fprintf(stderr, "kernel_launch: occupancy query says %d\n", per_cu); per_cu = 1; }
        (void)hipGetLastError();
        grid = cus;
        if (grid < 256 || (grid % 8) != 0) fprintf(stderr, "kernel_launch: grid %d\n", grid);
    }
    if (grid < 0) return;
    (void)hipMemsetAsync((char*)d_ws + WS_CTL, 0, CTL_ZERO_BYTES, stream);
    Args a{};
    for (int i = 0; i < 32; ++i) a.in[i] = (const float*)d_in[i];
    a.out = (float*)d_out; a.ws = (unsigned char*)d_ws;
#if MK_PER_PHASE
    unsigned char* ws8 = (unsigned char*)d_ws; (void)ws8;
    for (int p = 0; p < N_PHASES; ++p) {
#if defined(DBG_CHECK)
        if (DBG_CHECK == 14 && p == 7 + 13 * DBG_LAYER) hipLaunchKernelGGL(dbg_fill, dim3(2048), dim3(256), 0, stream, (unsigned char*)d_ws);
        if (DBG_CHECK == 1 && p == 3 + 13 * DBG_LAYER) hipLaunchKernelGGL(dbg_pre, dim3(2048), dim3(256), 0, stream, (unsigned char*)d_ws, (float*)d_out);
#endif
        a.ph_lo = p; a.ph_hi = p + 1; hipLaunchKernelGGL(mk_fwd, dim3(grid), dim3(NTHREADS), LDS_BYTES, stream, a);
#if defined(DBG_CHECK)
#ifndef DBG_LAYER
#define DBG_LAYER 0
#endif
        if (DBG_CHECK == 2 && p == 2 + 13 * DBG_LAYER) hipLaunchKernelGGL(dbg_inproj, dim3(9), dim3(64), 0, stream, (unsigned char*)d_ws, (const float*)d_in[I_WIN] + (size_t)DBG_LAYER * 1024 * D_IN_SRC);
        if (DBG_CHECK == 3 && p == 4 + 13 * DBG_LAYER) hipLaunchKernelGGL(dbg_fourier_ref, dim3(128), dim3(512), 0, stream, (unsigned char*)d_ws);
        if (DBG_CHECK == 3 && p == 6 + 13 * DBG_LAYER) hipLaunchKernelGGL(dbg_fourier_cmp, dim3(1), dim3(128), 0, stream, (unsigned char*)d_ws);
        if (DBG_CHECK == 4 && p == 3 + 13 * DBG_LAYER) hipLaunchKernelGGL(dbg_scan, dim3(64), dim3(64), 0, stream, (unsigned char*)d_ws, (float*)d_out, (const float*)d_in[I_MU] + DBG_LAYER * 3840, (const float*)d_in[I_W0] + DBG_LAYER * 1024, (const float*)d_in[I_W2] + DBG_LAYER * 65536, (const float*)d_in[I_A0] + DBG_LAYER * 1024, (const float*)d_in[I_A2] + DBG_LAYER * 65536, (const float*)d_in[I_KK] + DBG_LAYER * 512, (const float*)d_in[I_KA] + DBG_LAYER * 512, (const float*)d_in[I_RK] + DBG_LAYER * 512); if (DBG_CHECK == 4 && DBG_SUB == 10 && p == 3 + 13 * DBG_LAYER) hipLaunchKernelGGL(dbg_scan_fin, dim3(1), dim3(1), 0, stream, (unsigned char*)d_ws);
        if (DBG_CHECK == 5 && p == 7 + 13 * DBG_LAYER) hipLaunchKernelGGL(dbg_merge_ref, dim3(48), dim3(512), 0, stream, (unsigned char*)d_ws, (float*)(ws8 + WS_DBG + 262144), (const float*)d_in[I_WIN] + (size_t)DBG_LAYER * 1024 * D_IN_SRC, (const float*)d_in[I_WPA] + DBG_LAYER * 1048576, (const float*)d_in[I_WPF] + DBG_LAYER * 524288, (const float*)d_in[I_WPC] + DBG_LAYER * 524288, (const float*)d_in[I_WO] + DBG_LAYER * 1048576);
        if (DBG_CHECK == 5 && p == 9 + 13 * DBG_LAYER) hipLaunchKernelGGL(dbg_merge_cmp, dim3(48), dim3(64), 0, stream, (unsigned char*)d_ws, (const float*)(ws8 + WS_DBG + 262144));
        if (DBG_CHECK == 6 && p == 5 + 13 * DBG_LAYER) hipLaunchKernelGGL(dbg_post_ref, dim3(96), dim3(512), 0, stream, (unsigned char*)d_ws, (float*)(ws8 + WS_DBG + 262144), (const float*)d_in[I_MU] + DBG_LAYER * 3840, (const float*)d_in[I_G2] + DBG_LAYER * 65536, (const float*)d_in[I_LNW] + DBG_LAYER * 512, (const float*)d_in[I_LNB] + DBG_LAYER * 512);
        if (DBG_CHECK == 6 && p == 6 + 13 * DBG_LAYER) hipLaunchKernelGGL(dbg_post_cmp, dim3(96), dim3(512), 0, stream, (unsigned char*)d_ws, (const float*)(ws8 + WS_DBG + 262144));
        if (DBG_CHECK == 7 && p == 1) hipLaunchKernelGGL(dbg_mod, dim3(10), dim3(64), 0, stream, (unsigned char*)d_ws, (const float*)d_in[I_C], (const float*)d_in[I_CCTX], (const float*)d_in[I_ADAW], (const float*)d_in[I_ADAB], (const float*)d_in[I_X], (const float*)d_in[I_CTX]);
        if (DBG_CHECK == 8 && p == 10 + 13 * DBG_LAYER) hipLaunchKernelGGL(dbg_ffn_ref, dim3(48), dim3(512), 0, stream, (unsigned char*)d_ws, (const float*)d_in[I_FUP] + (size_t)DBG_LAYER * 1024 * 5632, (const float*)d_in[I_FCONV] + DBG_LAYER * 3 * 2816, (const float*)d_in[I_FCONVB] + DBG_LAYER * 2816, (const float*)d_in[I_FDN] + (size_t)DBG_LAYER * 2816 * 1024);
        if (DBG_CHECK == 8 && p == 13 + 13 * DBG_LAYER) hipLaunchKernelGGL(dbg_ffn_cmp, dim3(48), dim3(64), 0, stream, (unsigned char*)d_ws);
        if (DBG_CHECK == 9 && p == 10) hipLaunchKernelGGL(dbg_ln1, dim3(6), dim3(64), 0, stream, (unsigned char*)d_ws, (const float*)d_in[I_X], (const float*)d_in[I_CTX], (const float*)d_out, (const float*)d_in[I_LN1G], (const float*)d_in[I_LN1B]);
        if (DBG_CHECK == 10 && p == 13 + 13 * DBG_LAYER) hipLaunchKernelGGL(dbg_ln2_ref, dim3(64), dim3(64), 0, stream, (unsigned char*)d_ws, (const float*)d_out, (const float*)d_in[I_LN2G] + DBG_LAYER * 1024, (const float*)d_in[I_LN2B] + DBG_LAYER * 1024, DBG_LAYER);
        if (DBG_CHECK == 10 && p == 14 + 13 * DBG_LAYER) hipLaunchKernelGGL(dbg_ln2_cmp, dim3(64), dim3(64), 0, stream, (unsigned char*)d_ws, (const float*)d_out, DBG_LAYER);
        if (DBG_CHECK == 11 && p == 7 + 13 * DBG_LAYER) { hipLaunchKernelGGL(dbg_gate, dim3(256), dim3(64), 0, stream, (unsigned char*)d_ws, (const float*)d_in[I_WIN] + (size_t)DBG_LAYER * 1024 * D_IN_SRC, 0); hipLaunchKernelGGL(dbg_gate, dim3(256), dim3(64), 0, stream, (unsigned char*)d_ws, (const float*)d_in[I_WIN] + (size_t)DBG_LAYER * 1024 * D_IN_SRC, 1); }
        if (DBG_CHECK == 12 && p == 7 + 13 * DBG_LAYER) { hipLaunchKernelGGL(dbg_gate2_init, dim3(1), dim3(1), 0, stream, (unsigned char*)d_ws); hipLaunchKernelGGL(dbg_gate2, dim3(13), dim3(64), 0, stream, (unsigned char*)d_ws, (const float*)d_in[I_WIN] + (size_t)DBG_LAYER * 1024 * D_IN_SRC); hipLaunchKernelGGL(dbg_gate2_fin, dim3(1), dim3(1), 0, stream, (unsigned char*)d_ws); }
        if ((DBG_CHECK == 13 || DBG_CHECK == 14) && p == 7 + 13 * DBG_LAYER) { hipLaunchKernelGGL(dbg_gate3_init, dim3(1), dim3(1), 0, stream, (unsigned char*)d_ws); hipLaunchKernelGGL(dbg_gate3, dim3(2048), dim3(256), 0, stream, (unsigned char*)d_ws); hipLaunchKernelGGL(dbg_gate3_fin, dim3(1), dim3(1), 0, stream, (unsigned char*)d_ws); }
        if (DBG_CHECK == 1 && p == 3 + 13 * DBG_LAYER) hipLaunchKernelGGL(dbg_attn, dim3(2048), dim3(512), 0, stream, (unsigned char*)d_ws, (const float*)d_in[I_SUBLN], DBG_LAYER, (const float*)d_out);
#endif
    }
#if defined(DBG_CHECK)
    hipLaunchKernelGGL(dbg_report, dim3(DBG_TWO ? 4096 : 1), dim3(DBG_TWO ? 256 : 1), 0, stream, (unsigned char*)d_ws, (float*)d_out);
#endif
#else
    a.ph_lo = 0; a.ph_hi = N_PHASES;
    hipLaunchKernelGGL(mk_fwd, dim3(grid), dim3(NTHREADS), LDS_BYTES, stream, a);
#endif
}
```

```cpp
#include <hip/hip_runtime.h>
#include <hip/hip_bf16.h>
#include <cstdio>
#include <cstdint>
#include <cmath>

#ifndef DBG_ZERO_MIX
#define DBG_ZERO_MIX 0
#endif
#ifndef DBG_ZERO_FFN
#define DBG_ZERO_FFN 0
#endif
#ifndef DBG_BR
#define DBG_BR 7
#endif
#define GAS __attribute__((address_space(1)))
#define LAS __attribute__((address_space(3)))
typedef unsigned short bf16_t;
typedef short bf16x8 __attribute__((ext_vector_type(8)));
typedef short s16x4 __attribute__((ext_vector_type(4)));
typedef float f32x4 __attribute__((ext_vector_type(4)));
typedef float f32x2 __attribute__((ext_vector_type(2)));
typedef float f32x16 __attribute__((ext_vector_type(16)));
typedef unsigned u32x4 __attribute__((ext_vector_type(4)));
typedef unsigned u32x2 __attribute__((ext_vector_type(2)));
typedef GAS unsigned gu32;

constexpr int DM = 1024, NBATCH = 4, SEQ = 4096, CTXL = 256, NLAYER = 2;
constexpr int ML = NBATCH * SEQ, MC = NBATCH * CTXL, MT = ML + MC;
constexpr int D_IN_SRC = 8576, NP = 5632, NGATE = 3072, DFF = 2816, DCS = 1280, DCO = 640, DCOP = 768;
constexpr float LN_EPS = 1e-5f, ALPHA = 1.4142135623730951f;
constexpr int NWAVES = 8, NTHREADS = 512;

constexpr size_t MiB = 1u << 20;
constexpr size_t WS_CTL = 0, CTL_ZERO_BYTES = 1 * MiB;
constexpr size_t WS_TAB = 1 * MiB;
constexpr size_t TAB_MOD = WS_TAB + 0;
constexpr size_t TAB_LAM = WS_TAB + 256 * 1024;
constexpr size_t TAB_ROPE = WS_TAB + 260 * 1024;
constexpr size_t TAB_TW = WS_TAB + 272 * 1024;
constexpr size_t TAB_W0 = WS_TAB + 320 * 1024;
constexpr size_t TAB_F1 = WS_TAB + 384 * 1024;
constexpr size_t TAB_F2 = WS_TAB + 512 * 1024;
constexpr size_t TAB_DC = WS_TAB + 768 * 1024;
constexpr size_t WS_XC = 3 * MiB;
constexpr size_t WS_BON = 7 * MiB;
constexpr size_t WS_W = 9 * MiB;
constexpr size_t W_IN = WS_W, W_PA = WS_W + 17 * MiB, W_PF = WS_W + 19 * MiB, W_PC = WS_W + 20 * MiB, W_O = WS_W + 21 * MiB,
                 W_UP = WS_W + 23 * MiB, W_DN = WS_W + 34 * MiB, W_G2T = WS_W + 39 * MiB + 512 * 1024;
constexpr size_t WS_P = 49 * MiB;
constexpr size_t P_Q = WS_P, P_K = P_Q + (size_t)MT * 1024 * 2, P_F = P_K + (size_t)MT * 1024 * 2, P_V = P_F + (size_t)MT * 512 * 2,
                 P_CS = P_V + (size_t)MT * 1024 * 2, P_CO = P_CS + (size_t)MT * DCS * 2, P_END = P_CO + (size_t)MT * DCOP * 2;
constexpr size_t WS_HY = 236 * MiB, WS_END = 270 * MiB;
static_assert(P_END == WS_HY, "P region is exactly 187 MiB");
static_assert(P_END - P_V == (size_t)MT * NGATE * 2, "gate buffer == v|cs|co");
static_assert(WS_HY + (size_t)MT * 1024 * 2 == WS_END, "HY region 34 MiB");
constexpr int CW_TMO = 0, CW_QUEUE = 64  , CW_BAR = 4096;

constexpr int RING_BYTES = 131072, LDSCTL_OFF = RING_BYTES, MISC_OFF = LDSCTL_OFF + 320, LDS_BYTES = 147456;

#define LDS_WAIT() asm volatile("s_waitcnt lgkmcnt(0)" ::: "memory")
#define VM_WAIT() asm volatile("s_waitcnt vmcnt(0)" ::: "memory")
#define RLX_AGENT __ATOMIC_RELAXED, __HIP_MEMORY_SCOPE_AGENT

typedef __bf16 bf16x2_t __attribute__((ext_vector_type(2)));
__device__ __forceinline__ unsigned cvt_pk_bf16(float lo, float hi) { f32x2 v = {lo, hi}; bf16x2_t b = __builtin_convertvector(v, bf16x2_t); return __builtin_bit_cast(unsigned, b); }
__device__ __forceinline__ float bf2f(unsigned short h) { return __uint_as_float((unsigned)h << 16); }
__device__ __forceinline__ float bflo(unsigned w) { return __uint_as_float(w << 16); }
__device__ __forceinline__ float bfhi(unsigned w) { return __uint_as_float(w & 0xffff0000u); }
__device__ __forceinline__ float sigmoidf_(float x) { return __builtin_amdgcn_rcpf(1.f + __expf(-x)); }
__device__ __forceinline__ int fresh_lane() { unsigned z = 0u; asm volatile("" : "+v"(z)); return (int)__builtin_amdgcn_mbcnt_hi(~0u, __builtin_amdgcn_mbcnt_lo(~0u, z)); }
__device__ __forceinline__ int fresh_tid(int wave) { return (wave << 6) | fresh_lane(); }
__device__ __forceinline__ float wave_sum(float v) {
#pragma unroll
    for (int o = 1; o < 64; o <<= 1) v += __shfl_xor(v, o);
    return v;
}

#define XB_TMO      128
#define XB_XCNT(j)  (256  + 64 * (j))
#define XB_XSUB(j)  (1280 + 64 * (j))
#define XB_XGEN(j)  (2304 + 64 * (j))
#define XB_TOP      3328
#define XB_TOPGEN   3392
#define XCD_BAR_WORDS 3456
#define XB_SPIN_CAP (1u << 22)
__device__ __forceinline__ unsigned xb_ld(unsigned* p)              { return __hip_atomic_load(p, __ATOMIC_RELAXED, __HIP_MEMORY_SCOPE_AGENT); }
__device__ __forceinline__ unsigned xb_add(unsigned* p, unsigned v) { return __hip_atomic_fetch_add(p, v, __ATOMIC_RELAXED, __HIP_MEMORY_SCOPE_AGENT); }
__device__ __forceinline__ unsigned xb_xcc_id() { return (unsigned)__builtin_amdgcn_s_getreg((3 << 11) | 20) & 0xFu; }
#define XB_SPIN(cond, bar) do { unsigned _sp = 0; while (cond) { __builtin_amdgcn_s_sleep(1); \
    if ((++_sp & 255u) == 0u) { if (xb_ld(&(bar)[XB_TMO])) break; if (_sp > XB_SPIN_CAP) { atomicAdd(&(bar)[XB_TMO], 1u); break; } } } } while (0)
struct XcdBarrier { unsigned* bar; unsigned x; volatile LAS unsigned* st; };
__device__ __forceinline__ XcdBarrier xcd_barrier_post(unsigned* bar, volatile LAS unsigned* st) {
    XcdBarrier b; b.bar = bar; b.x = xb_xcc_id(); b.st = st;
    if (threadIdx.x == 0) (void)xb_add(&bar[XB_XCNT(b.x)], 1u);
    return b;
}
__device__ __forceinline__ void xcd_barrier_complete(unsigned* bar, unsigned x, unsigned& nloc, unsigned& nx) {
    const unsigned G = gridDim.x * gridDim.y * gridDim.z;
    unsigned sum, cnt, mine, sp = 0u;
    for (;;) {
        sum = 0u; cnt = 0u; mine = 0u;
#pragma unroll
        for (unsigned j = 0; j < 16; ++j) { const unsigned c = xb_ld(&bar[XB_XCNT(j)]); sum += c; cnt += (c > 0u) ? 1u : 0u; mine = (j == x) ? c : mine; }
        if (sum == G) break;
        __builtin_amdgcn_s_sleep(1);
        if ((++sp & 255u) == 0u) { if (xb_ld(&bar[XB_TMO])) break; if (sp > XB_SPIN_CAP) { atomicAdd(&bar[XB_TMO], 1u); break; } }
    }
    nloc = mine > 0u ? mine : 1u; nx = cnt > 0u ? cnt : 1u;
}
__device__ __attribute__((noinline)) void xcd_barrier(unsigned* bar_, unsigned bx_, volatile LAS unsigned* st_, unsigned t0_) {
    XcdBarrier b; b.bar = bar_; b.x = bx_; b.st = st_;
    asm volatile("s_waitcnt vmcnt(0)" ::: "memory");
    __syncthreads();
    if (t0_) {
        unsigned* bar = b.bar;
        __builtin_amdgcn_s_waitcnt(0);
        unsigned nloc = b.st[0], nx = b.st[1];
        if (nloc == 0u) { xcd_barrier_complete(bar, b.x, nloc, nx); b.st[0] = nloc; b.st[1] = nx; }
        const unsigned old = xb_add(&bar[XB_XSUB(b.x)], 1u);
        const unsigned gen = old / nloc;
        if (old + 1u == (gen + 1u) * nloc) {
            __builtin_amdgcn_fence(__ATOMIC_RELEASE, "agent");
            asm volatile("s_waitcnt vmcnt(0)" ::: "memory");
            const unsigned og = xb_add(&bar[XB_TOP], 1u);
            const unsigned tg = og / nx;
            if (og + 1u == (tg + 1u) * nx) xb_add(&bar[XB_TOPGEN], 1u);
            else XB_SPIN(xb_ld(&bar[XB_TOPGEN]) == tg, bar);
            __builtin_amdgcn_fence(__ATOMIC_ACQUIRE, "agent");
            xb_add(&bar[XB_XGEN(b.x)], 1u);
            asm volatile("s_waitcnt vmcnt(0)" ::: "memory");
        } else {
            XB_SPIN(xb_ld(&bar[XB_XGEN(b.x)]) == gen, bar);
            __builtin_amdgcn_fence(__ATOMIC_ACQUIRE, "agent");
            asm volatile("s_waitcnt vmcnt(0)" ::: "memory");
        }
    }
    __syncthreads();
}

namespace pg8 {
#define PG8_LAS __attribute__((address_space(3)))
constexpr int BM = 256, BK = 64, HALF = 128, HTB = HALF * BK * 2, STAGE_BYTES = 8 * HTB, NXCD = 8, WGM = 8;
__host__ __device__ __forceinline__ int lds_byte(int r, int c) { const int st = (r >> 4) * 2 + (c >> 5), rr = r & 15, cc = c & 31, ob = rr * 64 + cc * 2; return st * 1024 + (ob ^ (((ob >> 9) & 1) << 5)); }
__host__ __device__ __forceinline__ void stage_rc(int b, int& R, int& C) { const int st = b / 1024, sb = b % 1024, swz = sb ^ (((sb >> 9) & 1) << 5); R = (st >> 1) * 16 + swz / 64; C = (st & 1) * 32 + (swz % 64) / 2; }
__host__ __device__ __forceinline__ int perm32(int rho) { const int n = rho >> 4, i = rho & 15; return 8 * (i >> 2) + 4 * n + (i & 3); }
struct Unit { int pm, pn; };
struct Operand { const char* base; long tM, tN, tN2; int nshift; long rstride; long hstep; long kstep;
    __device__ __forceinline__ long tile(const Unit& u) const { return (long)u.pm * tM + (long)(u.pn & ((1 << nshift) - 1)) * tN + (long)(u.pn >> nshift) * tN2; }
    __device__ __forceinline__ unsigned row(int R) const { return (unsigned)((long)R * rstride); } };
struct StaticOrder {
    int nM, nN, nwg, G, c, wave;
    __host__ __device__ void init(int M, int N, int G_, int c_) { nM = M / BM; nN = N / BM; nwg = nM * nN; G = G_; c = c_; }
    __host__ __device__ bool next(int i, Unit& u) const {
        const long L = (long)i * G + c; if (L >= nwg) return false;
        int wgid = (int)L; { const int q = nwg / NXCD, r = nwg % NXCD, xcd = wgid % NXCD, off = wgid / NXCD; wgid = (xcd < r ? xcd * (q + 1) : r * (q + 1) + (xcd - r) * q) + off; }
        const int nig = WGM * nN, gid = wgid / nig, fm = gid * WGM, gsz = (nM - fm) < WGM ? (nM - fm) : WGM;
        u.pm = fm + ((wgid % nig) % gsz); u.pn = (wgid % nig) / gsz; return true;
    }
};

template <class Epi, class RowMapB, bool ALIGN_EPI>
__device__ __forceinline__ void gemm_phase(PG8_LAS unsigned char* lds, const Operand A, const Operand B, const RowMapB bmap, const int nt, const StaticOrder& S, const Epi& E) {
    int wid = S.wave; asm volatile("" : "+s"(wid));
    const int lane = fresh_lane(), tid = (wid << 6) | lane, wr = wid >> 2, wc = wid & 3, fr = lane & 15, fq = lane >> 4;
    unsigned voffA[2], voffB[2];
#pragma unroll
    for (int i = 0; i < 2; ++i) { int R, C; stage_rc(tid * 16 + i * 8192, R, C); const int Rb = Epi::PERM ? ((R & ~31) + perm32(R & 31)) : R;
        voffA[i] = A.row(R) + (unsigned)C * 2u; voffB[i] = bmap(Rb) + (unsigned)C * 2u; }
    const long kA = A.kstep, kB = B.kstep, hA = A.hstep, hB = B.hstep;
    const unsigned ldsw = (unsigned)wid * 1024u;
    const int aoff = lds_byte(wr * 64 + fr, fq * 8), boff = lds_byte(wc * 32 + fr, fq * 8);
#define PG8_SA(b, h) (((b) * 2 + (h)) * HTB)
#define PG8_SB(b, h) ((4 + (b) * 2 + (h)) * HTB)
#define PG8_STAGE(bufoff, gbase, voff) do { _Pragma("unroll") for (int _i = 0; _i < 2; ++_i) \
        __builtin_amdgcn_global_load_lds((const unsigned*)((const char*)(gbase) + (voff)[_i]), (PG8_LAS unsigned*)(lds + (bufoff) + ldsw + _i * 8192), 16, 0, 0); } while (0)
#define PG8_LDA(dst, b, h) do { _Pragma("unroll") for (int m = 0; m < 4; ++m) _Pragma("unroll") for (int k = 0; k < 2; ++k) dst[m][k] = *(const PG8_LAS bf16x8*)(lds + PG8_SA(b, h) + aoff + m * 2048 + k * 1024); } while (0)
#define PG8_LDB(dst, b, h) do { _Pragma("unroll") for (int n = 0; n < 2; ++n) _Pragma("unroll") for (int k = 0; k < 2; ++k) dst[n][k] = *(const PG8_LAS bf16x8*)(lds + PG8_SB(b, h) + boff + n * 2048 + k * 1024); } while (0)
#define PG8_MMA(ai, bj, At, Bt) do { __builtin_amdgcn_s_setprio(1); _Pragma("unroll") for (int m = 0; m < 4; ++m) _Pragma("unroll") for (int n = 0; n < 2; ++n) _Pragma("unroll") for (int k = 0; k < 2; ++k) \
        acc[ai][bj][m][n] = __builtin_amdgcn_mfma_f32_16x16x32_bf16(Bt[n][k], At[m][k], acc[ai][bj][m][n], 0, 0, 0); __builtin_amdgcn_s_setprio(0); } while (0)
#define PG8_WAIT_V(n) asm volatile("s_waitcnt vmcnt(" #n ")" ::: "memory")
#define PG8_WAIT_L(n) asm volatile("s_waitcnt lgkmcnt(" #n ")" ::: "memory")
#define PG8_BAR __builtin_amdgcn_s_barrier()
#define PG8_SCHED __builtin_amdgcn_sched_barrier(0)
    Unit cur, nxt; int ui = 0;
    if (!S.next(0, cur)) return;
    f32x4 acc[2][2][4][2];
#pragma unroll
    for (int a = 0; a < 2; ++a)
#pragma unroll
        for (int b = 0; b < 2; ++b)
#pragma unroll
            for (int m = 0; m < 4; ++m)
#pragma unroll
                for (int n = 0; n < 2; ++n) acc[a][b][m][n] = (f32x4){0.f, 0.f, 0.f, 0.f};
    bf16x8 At[4][2], B0[2][2], B1[2][2];
    const char* cA = A.base + A.tile(cur); const char* cB = B.base + B.tile(cur);
    PG8_STAGE(PG8_SB(0, 0), cB, voffB); PG8_STAGE(PG8_SB(0, 1), cB + hB, voffB); PG8_STAGE(PG8_SA(0, 0), cA, voffA); PG8_STAGE(PG8_SA(0, 1), cA + hA, voffA);
    if (wr == 1) PG8_BAR;
    PG8_WAIT_V(2); PG8_BAR;
    PG8_STAGE(PG8_SB(1, 0), cB + kB, voffB); PG8_STAGE(PG8_SA(1, 0), cA + kA, voffA); PG8_STAGE(PG8_SB(1, 1), cB + hB + kB, voffB);
    PG8_WAIT_V(6); PG8_BAR;
    for (;;) {
        const bool has_next = S.next(ui + 1, nxt);
        const char* nA = has_next ? A.base + A.tile(nxt) : cA; const char* nB = has_next ? B.base + B.tile(nxt) : cB;
        for (int t = 0; t < nt; t += 2) {
            const bool last = (t == nt - 2);
            asm volatile("" : "+v"(voffA[0]), "+v"(voffA[1]), "+v"(voffB[0]), "+v"(voffB[1]));
            const char* a1 = cA + (long)(t + 1) * kA;
            const char* a2 = last ? nA : cA + (long)(t + 2) * kA; const char* b2 = last ? nB : cB + (long)(t + 2) * kB;
            const char* a3 = a2 + kA; const char* b3 = b2 + kB;
            PG8_LDB(B0, 0, 0); PG8_LDB(B1, 0, 1); PG8_SCHED; PG8_LDA(At, 0, 0); PG8_STAGE(PG8_SA(1, 1), a1 + hA, voffA);
            PG8_WAIT_V(8); PG8_WAIT_L(0); PG8_BAR; PG8_MMA(0, 0, At, B0); PG8_MMA(0, 1, At, B1); PG8_BAR; PG8_SCHED;
            PG8_LDA(At, 0, 1); PG8_STAGE(PG8_SB(0, 0), b2, voffB); PG8_STAGE(PG8_SB(0, 1), b2 + hB, voffB); PG8_STAGE(PG8_SA(0, 0), a2, voffA);
            PG8_WAIT_V(8); PG8_WAIT_L(0); PG8_BAR; PG8_MMA(1, 0, At, B0); PG8_MMA(1, 1, At, B1); PG8_BAR; PG8_SCHED;
            PG8_LDB(B0, 1, 0); PG8_LDB(B1, 1, 1); PG8_SCHED; PG8_LDA(At, 1, 0); PG8_STAGE(PG8_SA(0, 1), a2 + hA, voffA);
            PG8_WAIT_V(8); PG8_WAIT_L(0); PG8_BAR; PG8_MMA(0, 0, At, B0); PG8_MMA(0, 1, At, B1); PG8_BAR; PG8_SCHED;
            PG8_LDA(At, 1, 1); PG8_STAGE(PG8_SB(1, 0), b3, voffB); PG8_STAGE(PG8_SB(1, 1), b3 + hB, voffB); PG8_STAGE(PG8_SA(1, 0), a3, voffA);
            PG8_WAIT_V(8); PG8_WAIT_L(0); PG8_BAR; PG8_MMA(1, 0, At, B0); PG8_MMA(1, 1, At, B1); PG8_BAR; PG8_SCHED;
        }
        if constexpr (ALIGN_EPI) { if (wr == 0) PG8_BAR; }
        if constexpr (!Epi::AFTER_DRAIN) { const int le = fresh_lane(); E(acc, cur, wr, wc, le & 15, le >> 4); }
        if (!has_next) break;
#pragma unroll
        for (int a = 0; a < 2; ++a)
#pragma unroll
            for (int b = 0; b < 2; ++b)
#pragma unroll
                for (int m = 0; m < 4; ++m)
#pragma unroll
                    for (int n = 0; n < 2; ++n) acc[a][b][m][n] = (f32x4){0.f, 0.f, 0.f, 0.f};
        cur = nxt; cA = nA; cB = nB; ++ui;
        if constexpr (ALIGN_EPI) { if (wr == 1) PG8_BAR; }
    }
    PG8_WAIT_V(0);
    if constexpr (!ALIGN_EPI) { if (wr == 0) PG8_BAR; }
    PG8_BAR;
    if constexpr (Epi::AFTER_DRAIN) { const int le = fresh_lane(); E.fused(acc, cur, wr, wc, le & 15, le >> 4, lds, wid, le); }
#undef PG8_SA
#undef PG8_SB
#undef PG8_STAGE
#undef PG8_LDA
#undef PG8_LDB
#undef PG8_MMA
#undef PG8_WAIT_V
#undef PG8_WAIT_L
#undef PG8_BAR
#undef PG8_SCHED
}
struct RowLin { long rstride; __device__ __forceinline__ unsigned operator()(int R) const { return (unsigned)((long)R * rstride); } };
}
namespace pg8 {
__device__ __forceinline__ u32x2 pk4(f32x4 v) { u32x2 w; w.x = cvt_pk_bf16(v[0], v[1]); w.y = cvt_pk_bf16(v[2], v[3]); return w; }
__device__ __forceinline__ f32x4 up4(u32x2 w) { return (f32x4){bflo(w.x), bfhi(w.x), bflo(w.y), bfhi(w.y)}; }
__device__ __forceinline__ float fast_sigmoid(float x) { return __builtin_amdgcn_rcpf(1.f + __expf(-x)); }
#define EPI_ROWS(ai, m) _Pragma("unroll") for (int ai = 0; ai < 2; ++ai) _Pragma("unroll") for (int m = 0; m < 4; ++m)

struct EpiInProj {
    static constexpr bool PERM = false, AFTER_DRAIN = false;
    unsigned char* ws; const float* rope;
    __device__ __forceinline__ void operator()(const f32x4 (&acc)[2][2][4][2], const Unit& u, int wr, int wc, int fr, int fq) const {
        asm volatile("" : "+v"(fr), "+v"(fq));
        const int pn = u.pn; size_t boff; int pitch, c0;
        if (pn < 4) { boff = P_Q; pitch = 1024; c0 = 256 * pn; }
        else if (pn < 8) { boff = P_K; pitch = 1024; c0 = 256 * (pn - 4); }
        else if (pn < 12) { boff = P_V; pitch = 1024; c0 = 256 * (pn - 8); }
        else if (pn < 14) { boff = P_F; pitch = 512; c0 = 256 * (pn - 12); }
        else if (pn < 19) { boff = P_CS; pitch = DCS; c0 = 256 * (pn - 14); }
        else { boff = P_CO; pitch = DCOP; c0 = 256 * (pn - 19); }
        bf16_t* base = (bf16_t*)(ws + boff);
        const bool dorope = (pn >= 4 && pn < 8 && u.pm < ML / 256);
        EPI_ROWS(ai, m) {
            const int R = 128 * ai + 64 * wr + 16 * m + fr; const size_t grow = (size_t)u.pm * 256 + R;
            f32x4 cc = (f32x4){1.f, 1.f, 1.f, 1.f}, ss = (f32x4){0.f, 0.f, 0.f, 0.f};
            if (dorope) { const int t = (int)(grow & 4095); const int pos = (wc & 1) ? (t & 63) : (t >> 6);
                const f32x4 a = *(const f32x4*)(rope + (pos * 16 + 4 * fq) * 2), b = *(const f32x4*)(rope + (pos * 16 + 4 * fq) * 2 + 4);
                cc = (f32x4){a[0], a[2], b[0], b[2]}; ss = (f32x4){a[1], a[3], b[1], b[3]}; }
            bf16_t* rowp = base + grow * pitch + c0 + 32 * wc + 4 * fq;
#pragma unroll
            for (int bj = 0; bj < 2; ++bj) { const f32x4 x1 = acc[ai][bj][m][0], x2 = acc[ai][bj][m][1];
                const f32x4 y1 = x1 * cc - x2 * ss, y2 = x2 * cc + x1 * ss;
                *(u32x2*)(rowp + 128 * bj) = pk4(y1); *(u32x2*)(rowp + 128 * bj + 16) = pk4(y2); }
        }
    }
};
struct EpiGate {
    static constexpr bool PERM = true, AFTER_DRAIN = false;
    bf16_t* gate;
    __device__ __forceinline__ void operator()(const f32x4 (&acc)[2][2][4][2], const Unit& u, int wr, int wc, int fr, int fq) const {
        asm volatile("" : "+v"(fr), "+v"(fq));
        EPI_ROWS(ai, m) {
            const int R = 128 * ai + 64 * wr + 16 * m + fr; const size_t grow = (size_t)u.pm * 256 + R;
            bf16_t* rowp = gate + grow * NGATE + 256 * u.pn + 32 * wc + 8 * fq;
#pragma unroll
            for (int bj = 0; bj < 2; ++bj) { f32x4 v0 = acc[ai][bj][m][0], v1 = acc[ai][bj][m][1];
#pragma unroll
                for (int e = 0; e < 4; ++e) { v0[e] = fast_sigmoid(v0[e]); v1[e] = fast_sigmoid(v1[e]); }
                u32x4 w; w.x = cvt_pk_bf16(v0[0], v0[1]); w.y = cvt_pk_bf16(v0[2], v0[3]); w.z = cvt_pk_bf16(v1[0], v1[1]); w.w = cvt_pk_bf16(v1[2], v1[3]);
                *(u32x4*)(rowp + 128 * bj) = w; }
        }
    }
};
template <bool FIRST> struct EpiBranch {
    static constexpr bool PERM = true, AFTER_DRAIN = false;
    const bf16_t* gate; bf16_t* ym; float sc;
    __device__ __forceinline__ void operator()(const f32x4 (&acc)[2][2][4][2], const Unit& u, int wr, int wc, int fr, int fq) const {
        asm volatile("" : "+v"(fr), "+v"(fq));
        EPI_ROWS(ai, m) {
            const int R = 128 * ai + 64 * wr + 16 * m + fr; const size_t grow = (size_t)u.pm * 256 + R;
            const int col = 256 * u.pn + 32 * wc + 8 * fq;
#pragma unroll
            for (int bj = 0; bj < 2; ++bj) {
                const u32x4 g = *(const u32x4*)(gate + grow * NGATE + col + 128 * bj);
                f32x4 v0 = acc[ai][bj][m][0], v1 = acc[ai][bj][m][1];
                v0 = v0 * (f32x4){bflo(g.x), bfhi(g.x), bflo(g.y), bfhi(g.y)} * sc; v1 = v1 * (f32x4){bflo(g.z), bfhi(g.z), bflo(g.w), bfhi(g.w)} * sc;
                bf16_t* op = ym + grow * 1024 + col + 128 * bj;
                if (!FIRST) { const u32x4 o = *(const u32x4*)op; v0 = v0 + (f32x4){bflo(o.x), bfhi(o.x), bflo(o.y), bfhi(o.y)}; v1 = v1 + (f32x4){bflo(o.z), bfhi(o.z), bflo(o.w), bfhi(o.w)}; }
                u32x4 w; w.x = cvt_pk_bf16(v0[0], v0[1]); w.y = cvt_pk_bf16(v0[2], v0[3]); w.z = cvt_pk_bf16(v1[0], v1[1]); w.w = cvt_pk_bf16(v1[2], v1[3]);
                *(u32x4*)op = w; }
        }
    }
};
struct EpiF32 {
    static constexpr bool PERM = false, AFTER_DRAIN = false;
    float* out; int ldc;
    __device__ __forceinline__ void operator()(const f32x4 (&acc)[2][2][4][2], const Unit& u, int wr, int wc, int fr, int fq) const {
        asm volatile("" : "+v"(fr), "+v"(fq));
        EPI_ROWS(ai, m) {
            const int R = 128 * ai + 64 * wr + 16 * m + fr; const size_t grow = (size_t)u.pm * 256 + R;
            float* rowp = out + grow * ldc + 256 * u.pn + 32 * wc + 4 * fq;
#pragma unroll
            for (int bj = 0; bj < 2; ++bj)
#pragma unroll
                for (int n = 0; n < 2; ++n) *(f32x4*)(rowp + 128 * bj + 16 * n) = acc[ai][bj][m][n];
        }
    }
};
struct EpiBf16 {
    static constexpr bool PERM = true, AFTER_DRAIN = false;
    bf16_t* out; int ldc;
    __device__ __forceinline__ void operator()(const f32x4 (&acc)[2][2][4][2], const Unit& u, int wr, int wc, int fr, int fq) const {
        asm volatile("" : "+v"(fr), "+v"(fq));
        EPI_ROWS(ai, m) {
            const int R = 128 * ai + 64 * wr + 16 * m + fr; const size_t grow = (size_t)u.pm * 256 + R;
            bf16_t* rowp = out + grow * ldc + 256 * u.pn + 32 * wc + 8 * fq;
#pragma unroll
            for (int bj = 0; bj < 2; ++bj) { const f32x4 v0 = acc[ai][bj][m][0], v1 = acc[ai][bj][m][1];
                u32x4 w; w.x = cvt_pk_bf16(v0[0], v0[1]); w.y = cvt_pk_bf16(v0[2], v0[3]); w.z = cvt_pk_bf16(v1[0], v1[1]); w.w = cvt_pk_bf16(v1[2], v1[3]);
                *(u32x4*)(rowp + 128 * bj) = w; }
        }
    }
};
struct EpiF0 {
    static constexpr bool PERM = false, AFTER_DRAIN = false;
    bf16_t* yt;
    __device__ __forceinline__ void operator()(const f32x4 (&acc)[2][2][4][2], const Unit& u, int wr, int wc, int fr, int fq) const {
        asm volatile("" : "+v"(fr), "+v"(fq));
        EPI_ROWS(ai, m) {
            const int R = 128 * ai + 64 * wr + 16 * m + fr; const int ri = R >> 7, mch = R & 127;
            bf16_t* rowp = yt + (size_t)((ri * 4 + u.pm) * 128 + mch) * ML + 256 * u.pn + 32 * wc + 4 * fq;
#pragma unroll
            for (int bj = 0; bj < 2; ++bj)
#pragma unroll
                for (int n = 0; n < 2; ++n) *(u32x2*)(rowp + 128 * bj + 16 * n) = pk4(acc[ai][bj][m][n]);
        }
    }
};
struct EpiF0c {
    static constexpr bool PERM = false, AFTER_DRAIN = false;
    bf16_t* ytc;
    __device__ __forceinline__ void operator()(const f32x4 (&acc)[2][2][4][2], const Unit& u, int wr, int wc, int fr, int fq) const {
        asm volatile("" : "+v"(fr), "+v"(fq));
        EPI_ROWS(ai, m) {
            const int R = 128 * ai + 64 * wr + 16 * m + fr; const int ri = R >> 7, mch = R & 127;
            bf16_t* rowp = ytc + (size_t)((((u.pn * 4 + u.pm) * 128 + mch) * 2 + ri)) * 256 + 32 * wc + 4 * fq;
#pragma unroll
            for (int bj = 0; bj < 2; ++bj)
#pragma unroll
                for (int n = 0; n < 2; ++n) *(u32x2*)(rowp + 128 * bj + 16 * n) = pk4(acc[ai][bj][m][n]);
        }
    }
};
struct EpiF1 {
    static constexpr bool PERM = false, AFTER_DRAIN = false;
    bf16_t* x1; const float* tw;
    __device__ __forceinline__ void operator()(const f32x4 (&acc)[2][2][4][2], const Unit& u, int wr, int wc, int fr, int fq) const {
        asm volatile("" : "+v"(fr), "+v"(fq));
        const int gp = u.pn >> 7, mch = u.pn & 127, g = 2 * wr + gp;
#pragma unroll
        for (int m = 0; m < 4; ++m) {
            const int kl = 16 * m + fr;
#pragma unroll
            for (int bj = 0; bj < 2; ++bj)
#pragma unroll
                for (int n = 0; n < 2; ++n) {
                    const int colL = 128 * bj + 32 * wc + 16 * n + 4 * fq, tl = colL & 63, bb = colL >> 6;
                    const f32x4 a = *(const f32x4*)(tw + (kl * 64 + tl) * 2), b = *(const f32x4*)(tw + (kl * 64 + tl) * 2 + 4);
                    const f32x4 cc = (f32x4){a[0], a[2], b[0], b[2]}, ss = (f32x4){a[1], a[3], b[1], b[3]};
                    const f32x4 re = acc[0][bj][m][n], im = acc[1][bj][m][n];
                    const f32x4 re2 = re * cc + im * ss, im2 = im * cc - re * ss;
                    const size_t o = ((size_t)bb * 32768 + kl * 512 + g * 128 + mch) * 64 + tl;
                    *(u32x2*)(x1 + o) = pk4(re2); *(u32x2*)(x1 + (size_t)4 * 32768 * 64 + o) = pk4(im2);
                }
        }
    }
};
struct EpiF2 {
    static constexpr bool PERM = false, AFTER_DRAIN = false;
    bf16_t* of;
    __device__ __forceinline__ void operator()(const f32x4 (&acc)[2][2][4][2], const Unit& u, int wr, int wc, int fr, int fq) const {
        asm volatile("" : "+v"(fr), "+v"(fq));
        const int kl = u.pn >> 1, gm0 = (u.pn & 1) * 256;
        EPI_ROWS(ai, m) {
            const int R = 128 * ai + 64 * wr + 16 * m + fr; const int b = R >> 6, kh = R & 63;
            bf16_t* rowp = of + (size_t)(b * 4096 + 64 * kh + kl) * 512 + gm0 + 32 * wc + 4 * fq;
#pragma unroll
            for (int bj = 0; bj < 2; ++bj)
#pragma unroll
                for (int n = 0; n < 2; ++n) *(u32x2*)(rowp + 128 * bj + 16 * n) = pk4(acc[ai][bj][m][n]);
        }
    }
};
struct EpiFc {
    static constexpr bool PERM = false, AFTER_DRAIN = false;
    bf16_t* of;
    __device__ __forceinline__ void operator()(const f32x4 (&acc)[2][2][4][2], const Unit& u, int wr, int wc, int fr, int fq) const {
        asm volatile("" : "+v"(fr), "+v"(fq));
        const int b = u.pn >> 1, gm0 = (u.pn & 1) * 256;
        EPI_ROWS(ai, m) {
            const int R = 128 * ai + 64 * wr + 16 * m + fr;
            bf16_t* rowp = of + (size_t)(ML + b * 256 + R) * 512 + gm0 + 32 * wc + 4 * fq;
#pragma unroll
            for (int bj = 0; bj < 2; ++bj)
#pragma unroll
                for (int n = 0; n < 2; ++n) *(u32x2*)(rowp + 128 * bj + 16 * n) = pk4(acc[ai][bj][m][n]);
        }
    }
};
struct EpiRwkvPost {
    static constexpr bool PERM = false, AFTER_DRAIN = true;
    const bf16_t* y0; const bf16_t* y1; const bf16_t* cs; const float* bon; const float* mu; const float* lnw; const float* lnb; bf16_t* oc;
    __device__ __forceinline__ void fused(f32x4 (&acc)[2][2][4][2], const Unit& u, int wr, int wc, int fr, int fq, PG8_LAS unsigned char* lds, int wid, int lane) const {
        asm volatile("" : "+v"(fr), "+v"(fq));
        PG8_LAS f32x2* P = (PG8_LAS f32x2*)lds;
        EPI_ROWS(ai, m) {
            const int R = 128 * ai + 64 * wr + 16 * m + fr; const size_t grow = (size_t)u.pm * 256 + R;
#pragma unroll
            for (int bj = 0; bj < 2; ++bj) {
                const size_t o = grow * 512 + 256 * u.pn + 128 * bj + 32 * wc + 4 * fq;
                const f32x4 a = up4(*(const u32x2*)(y0 + o)) + up4(*(const u32x2*)(y1 + o)), b = up4(*(const u32x2*)(y0 + o + 16)) + up4(*(const u32x2*)(y1 + o + 16));
                float s = (a[0] + a[1]) + (a[2] + a[3]) + (b[0] + b[1]) + (b[2] + b[3]);
                s += __shfl_xor(s, 16); s += __shfl_xor(s, 32);
                const float mw = s * (1.f / 32.f); const f32x4 da = a - mw, db = b - mw;
                float q = (da[0] * da[0] + da[1] * da[1]) + (da[2] * da[2] + da[3] * da[3]) + (db[0] * db[0] + db[1] * db[1]) + (db[2] * db[2] + db[3] * db[3]);
                q += __shfl_xor(q, 16); q += __shfl_xor(q, 32);
                if (fq == 0) P[(R * 4 + 2 * bj + (wc >> 1)) * 2 + (wc & 1)] = (f32x2){mw, q};
            }
        }
        asm volatile("s_waitcnt lgkmcnt(0)" ::: "memory"); __builtin_amdgcn_s_barrier(); asm volatile("" ::: "memory");
        EPI_ROWS(ai, m) {
            const int R = 128 * ai + 64 * wr + 16 * m + fr; const size_t grow = (size_t)u.pm * 256 + R;
            int pos, len; if (grow < (size_t)ML) { pos = (int)(grow & 4095); len = SEQ; } else { pos = (int)((grow - ML) & 255); len = CTXL; }
            const bool hp = pos > 0, hn = pos < len - 1;
            const size_t rp = hp ? grow - 1 : grow, rn = hn ? grow + 1 : grow;
#pragma unroll
            for (int bj = 0; bj < 2; ++bj) {
                const int hl = 2 * bj + (wc >> 1), head = 4 * u.pn + hl;
                const f32x2 pa = P[(R * 4 + hl) * 2 + 0], pb = P[(R * 4 + hl) * 2 + 1];
                const float mean = 0.5f * (pa.x + pb.x), dm = pa.x - pb.x, var = (pa.y + pb.y + 16.f * dm * dm) * (1.f / 64.f);
                const float rstd = 1.0f / sqrtf(var + 64.f * 1e-5f);
                const float bsum = bon[grow * 8 + head] + bon[(size_t)MT * 8 + grow * 8 + head];
#pragma unroll
                for (int n = 0; n < 2; ++n) {
                    const int c = 256 * u.pn + 128 * bj + 32 * wc + 16 * n + 4 * fq;
                    const size_t o = grow * 512 + c;
                    const f32x4 yv = up4(*(const u32x2*)(y0 + o)) + up4(*(const u32x2*)(y1 + o));
                    const f32x4 w4 = *(const f32x4*)(lnw + c), b4 = *(const f32x4*)(lnb + c);
                    const f32x4 m0 = *(const f32x4*)(mu + 512 + c), m1 = *(const f32x4*)(mu + 1920 + 512 + c);
                    const f32x4 vc = up4(*(const u32x2*)(cs + grow * DCS + 512 + c));
                    f32x4 vp = up4(*(const u32x2*)(cs + rp * DCS + 512 + c)), vn = up4(*(const u32x2*)(cs + rn * DCS + 512 + c));
                    if (!hp) vp = (f32x4){0.f, 0.f, 0.f, 0.f}; if (!hn) vn = (f32x4){0.f, 0.f, 0.f, 0.f};
                    const f32x4 vs = vc + m0 * (vp - vc) + m1 * (vn - vc);
                    const f32x4 yn = (yv - mean) * rstd * w4 + b4;
                    const f32x4 r = (yn + bsum * vs) * acc[ai][bj][m][n];
                    *(u32x2*)(oc + o) = pk4(r);
                }
            }
        }
    }
};
}
namespace attn {
#define SBAR() __builtin_amdgcn_sched_barrier(0)
constexpr int QBLK = 32, KVBLK = 64;
constexpr float SCALE = 0.125f;
#ifndef ATTN_THR
#define ATTN_THR 6.f
#endif
constexpr int SHM_V = KVBLK * 128 * 2, SHM_K = KVBLK * 64 * 2;
constexpr int LDS_V = 0, LDS_K = 2 * SHM_V, LDS_WS = LDS_K + 2 * SHM_K, LDS_STASH = LDS_WS + NWAVES * 64 * 4, LDS_END = LDS_STASH + NWAVES * 8192;
static_assert(LDS_END <= RING_BYTES, "attention LDS");
__device__ __forceinline__ int crow(int r, int hi) { return (r & 3) + 8 * (r >> 2) + 4 * hi; }
__device__ __forceinline__ int kswz(int row, int chunk) { return row * 128 + ((chunk ^ ((row >> 1) & 7)) << 4); }

__device__ __forceinline__ void partialSM(f32x16& p0, f32x16& p1, float& m_reg, float& mn, float& alpha) {
    constexpr float C = SCALE * 1.4426950408889634f;
    float pmax = p0[0];
#pragma unroll
    for (int r = 1; r < 16; ++r) pmax = fmaxf(pmax, p0[r]);
#pragma unroll
    for (int r = 0; r < 16; ++r) pmax = fmaxf(pmax, p1[r]);
    { auto rr = __builtin_amdgcn_permlane32_swap(__float_as_uint(pmax), __float_as_uint(pmax), false, false);
      pmax = fmaxf(__uint_as_float(rr[0]), __uint_as_float(rr[1])); }
    if (__builtin_expect(__all(pmax - m_reg <= ATTN_THR / SCALE), 1)) { mn = m_reg; alpha = 1.f; }
    else { mn = fmaxf(m_reg, pmax); alpha = __builtin_amdgcn_exp2f((m_reg - mn) * C); m_reg = mn; }
    const float mnC = -mn * C; const f32x2 C2 = {C, C}, mnC2 = {mnC, mnC};
#pragma unroll
    for (int r = 0; r < 16; r += 2) { const f32x2 t = (f32x2){p0[r], p0[r + 1]} * C2 + mnC2; p0[r] = t.x; p0[r + 1] = t.y; }
#pragma unroll
    for (int r = 0; r < 16; r += 2) { const f32x2 t = (f32x2){p1[r], p1[r + 1]} * C2 + mnC2; p1[r] = t.x; p1[r + 1] = t.y; }
#pragma unroll
    for (int r = 0; r < 16; ++r) p0[r] = __builtin_amdgcn_exp2f(p0[r]);
}
__device__ __forceinline__ void finishSM(f32x16& p0, f32x16& p1, float alpha, float& l_reg, bf16x8& pa0, bf16x8& pa1, bf16x8& pa2, bf16x8& pa3) {
#pragma unroll
    for (int r = 0; r < 16; ++r) p1[r] = __builtin_amdgcn_exp2f(p1[r]);
    f32x2 ps2 = (f32x2){p0[0], p0[1]} + (f32x2){p1[0], p1[1]};
#pragma unroll
    for (int r = 2; r < 16; r += 2) { ps2 += (f32x2){p0[r], p0[r + 1]}; ps2 += (f32x2){p1[r], p1[r + 1]}; }
    float ps = ps2.x + ps2.y;
    { auto rr = __builtin_amdgcn_permlane32_swap(__float_as_uint(ps), __float_as_uint(ps), false, false);
      ps = __uint_as_float(rr[0]) + __uint_as_float(rr[1]); }
    l_reg = l_reg * alpha + ps;
#define PK4(P, BASE, OUT) do { unsigned a0 = cvt_pk_bf16(P[BASE + 0], P[BASE + 1]), a1 = cvt_pk_bf16(P[BASE + 2], P[BASE + 3]);   \
    unsigned b0 = cvt_pk_bf16(P[BASE + 4], P[BASE + 5]), b1 = cvt_pk_bf16(P[BASE + 6], P[BASE + 7]);                              \
    auto r0 = __builtin_amdgcn_permlane32_swap(a0, b0, false, false); auto r1 = __builtin_amdgcn_permlane32_swap(a1, b1, false, false); \
    u32x4 w = {r0[0], r1[0], r0[1], r1[1]}; OUT = *reinterpret_cast<bf16x8*>(&w); } while (0)
    PK4(p0, 0, pa0); PK4(p0, 8, pa1); PK4(p1, 0, pa2); PK4(p1, 8, pa3);
#undef PK4
}
__device__ __forceinline__ void qkt(f32x16& p0, f32x16& p1, const LAS char* Ks, const bf16x8 q0, const bf16x8 q1, const bf16x8 q2, const bf16x8 q3, int r32, int hi) {
    p0 = f32x16{}; p1 = f32x16{};
#define QK1(d0, Q) do { const bf16x8 b0 = *(const LAS bf16x8*)(Ks + kswz(r32, 2 * (d0) + hi)); const bf16x8 b1 = *(const LAS bf16x8*)(Ks + kswz(32 + r32, 2 * (d0) + hi)); \
    p0 = __builtin_amdgcn_mfma_f32_32x32x16_bf16(b0, Q, p0, 0, 0, 0); p1 = __builtin_amdgcn_mfma_f32_32x32x16_bf16(b1, Q, p1, 0, 0, 0); } while (0)
    QK1(0, q0); QK1(1, q1); QK1(2, q2); QK1(3, q3);
#undef QK1
}
__device__ __forceinline__ int v_st(int k, int c) { const int kk = (k & ~0xC) | ((k & 4) << 1) | ((k & 8) >> 1); return ((kk >> 3) * 4 + (c >> 5)) * 512 + ((kk & 7) * 32 + (c & 31)) * 2; }
__device__ __forceinline__ int v_rd_base(int lane) { return ((lane & 3) << 3) | (((lane >> 2) & 3) << 6) | (((lane >> 4) & 1) << 5) | (((lane >> 5) & 1) << 8); }
constexpr int v_rd_off(int d0, int ks, int half) { return d0 * 512 + ks * 4096 + half * 2048; }
template <int OFF> __device__ __forceinline__ s16x4 tr_read(int vb) {
    s16x4 r; asm volatile("ds_read_b64_tr_b16 %0, %1 offset:%2" : "=&v"(r) : "v"(vb), "i"(OFF) : "memory"); return r;
}
template <int D0> __device__ __forceinline__ void pv_one(f32x16& od, int vb, bf16x8 pa0, bf16x8 pa1, bf16x8 pa2, bf16x8 pa3) {
    const s16x4 l0 = tr_read<v_rd_off(D0, 0, 0)>(vb), h0 = tr_read<v_rd_off(D0, 0, 1)>(vb), l1 = tr_read<v_rd_off(D0, 1, 0)>(vb), h1 = tr_read<v_rd_off(D0, 1, 1)>(vb);
    const s16x4 l2 = tr_read<v_rd_off(D0, 2, 0)>(vb), h2 = tr_read<v_rd_off(D0, 2, 1)>(vb), l3 = tr_read<v_rd_off(D0, 3, 0)>(vb), h3 = tr_read<v_rd_off(D0, 3, 1)>(vb);
    asm volatile("s_waitcnt lgkmcnt(0)" ::: "memory"); SBAR();
#define PK(L, H) (bf16x8){L[0], L[1], L[2], L[3], H[0], H[1], H[2], H[3]}
    od = __builtin_amdgcn_mfma_f32_32x32x16_bf16(pa0, PK(l0, h0), od, 0, 0, 0);
    od = __builtin_amdgcn_mfma_f32_32x32x16_bf16(pa1, PK(l1, h1), od, 0, 0, 0);
    od = __builtin_amdgcn_mfma_f32_32x32x16_bf16(pa2, PK(l2, h2), od, 0, 0, 0);
    od = __builtin_amdgcn_mfma_f32_32x32x16_bf16(pa3, PK(l3, h3), od, 0, 0, 0);
#undef PK
}
__device__ __forceinline__ void pv_d0(f32x16* o, int vb, bf16x8 pa0, bf16x8 pa1, bf16x8 pa2, bf16x8 pa3) {
    pv_one<0>(o[0], vb, pa0, pa1, pa2, pa3); pv_one<1>(o[1], vb, pa0, pa1, pa2, pa3); pv_one<2>(o[2], vb, pa0, pa1, pa2, pa3); pv_one<3>(o[3], vb, pa0, pa1, pa2, pa3);
}

template <bool LATENT>
__device__ __forceinline__ void attn_unit(const bf16_t* Qb, const bf16_t* Kb, const bf16_t* Vb, bf16_t* Ob, int qrow0, int b, int hh,
                                          float lam, float oscale, const float* __restrict__ subln, const float* __restrict__ rope, LAS char* lds, int wave_) {
    int wid = wave_; asm volatile("" : "+s"(wid));
    const int lane = fresh_lane(), tid = (wid << 6) | lane, r32 = lane & 31, hi = lane >> 5;
    LAS char* V_lds = lds + LDS_V; LAS char* K_lds = lds + LDS_K;
    LAS float* wsf = (LAS float*)(lds + LDS_WS) + wid * 64; LAS float* li_l = wsf; LAS float* al_l = wsf + 32;
    LAS unsigned* stash = (LAS unsigned*)(lds + LDS_STASH + wid * 8192);
    constexpr int NT = 64;
    const int ctx0 = ML + b * CTXL, lat0 = b * SEQ;
    const int myrow = qrow0 + wid * QBLK + r32;
    const int ksr = tid >> 3, ksc = tid & 7, kst = kswz(ksr, ksc);
    const int sr = tid >> 4, sc = (tid & 15) * 8, vst0 = v_st(sr, sc), vst1 = v_st(32 + sr, sc);
    const int vb0 = (int)(uintptr_t)V_lds + v_rd_base(lane);
    f32x16 o[4];
#pragma unroll 1
    for (int c = 0; c < 2; ++c) {
        bf16x8 q0, q1, q2, q3;
        { const bf16_t* Qw = Qb + (size_t)myrow * 1024 + hh * 128 + c * 64 + hi * 8;
          q0 = *(const bf16x8*)(Qw); q1 = *(const bf16x8*)(Qw + 16); q2 = *(const bf16x8*)(Qw + 32); q3 = *(const bf16x8*)(Qw + 48); }
        const unsigned voV0 = (unsigned)(sr * 1024 + hh * 128 + sc) * 2u, voK = (unsigned)(ksr * 1024 + hh * 128 + c * 64 + ksc * 8) * 2u;
        float m_reg = -1e30f, l_reg = 0.f;
#pragma unroll
        for (int d = 0; d < 4; ++d) o[d] = f32x16{};
        bf16x8 sv0[1], sv1[1], sk0[1];
#define SLOAD(i, kr) do { unsigned a_ = voV0, b_ = voV0 + 32u * 2048u, c_ = voK; asm volatile("" : "+v"(a_), "+v"(b_), "+v"(c_)); \
        const char* vb_ = (const char*)Vb + (size_t)(kr) * 2048; const char* kb_ = (const char*)Kb + (size_t)(kr) * 2048; \
        sv0[i] = *(const bf16x8*)(vb_ + a_); sv1[i] = *(const bf16x8*)(vb_ + b_); sk0[i] = *(const bf16x8*)(kb_ + c_); } while (0)
#define SWRITE(bb, i) do { *(LAS bf16x8*)(V_lds + (bb) * SHM_V + vst0) = sv0[i]; *(LAS bf16x8*)(V_lds + (bb) * SHM_V + vst1) = sv1[i]; *(LAS bf16x8*)(K_lds + (bb) * SHM_K + kst) = sk0[i]; } while (0)
#define SWAIT() asm volatile("s_waitcnt vmcnt(3)" ::: "memory")
#define RESC(a) do { if (__any((a) < 1.f)) { if (hi == 0) al_l[r32] = (a); asm volatile("s_waitcnt lgkmcnt(0)" ::: "memory"); \
        _Pragma("unroll") for (int d = 0; d < 4; ++d) _Pragma("unroll") for (int r = 0; r < 16; ++r) o[d][r] *= al_l[crow(r, hi)]; } } while (0)
        f32x16 pA0, pA1; float mnA, alA; bf16x8 pa0, pa1, pa2, pa3;
        SLOAD(0, ctx0);
#pragma unroll 1
        for (int j = 0; j < 4; ++j) {
            __syncthreads();
            asm volatile("s_waitcnt vmcnt(0)" ::: "memory"); SWRITE(0, 0);
            { const int nr = j < 3 ? ctx0 + 64 * (j + 1) : (LATENT ? lat0 : ctx0); SLOAD(0, nr); }
            __syncthreads();
            qkt(pA0, pA1, K_lds, q0, q1, q2, q3, r32, hi); partialSM(pA0, pA1, m_reg, mnA, alA);
            RESC(alA);
            finishSM(pA0, pA1, alA, l_reg, pa0, pa1, pa2, pa3); SBAR();
            pv_d0(o, vb0, pa0, pa1, pa2, pa3);
        }
        if (LATENT) {
            {
                const int t = myrow & 4095, pos0 = t >> 6, pos1 = t & 63;
                const float* r0p = rope + (pos0 * 16 + 8 * hi) * 2; const float* r1p = rope + (pos1 * 16 + 8 * hi) * 2;
#pragma unroll
                for (int j = 0; j < 8; ++j) {
                    const float c0 = r0p[2 * j], s0 = r0p[2 * j + 1], c1 = r1p[2 * j], s1 = r1p[2 * j + 1];
                    const float x1 = bf2f((unsigned short)q0[j]), x2 = bf2f((unsigned short)q1[j]), z1 = bf2f((unsigned short)q2[j]), z2 = bf2f((unsigned short)q3[j]);
                    const unsigned w0 = cvt_pk_bf16(x1 * c0 - x2 * s0, x2 * c0 + x1 * s0), w1 = cvt_pk_bf16(z1 * c1 - z2 * s1, z2 * c1 + z1 * s1);
                    q0[j] = (short)(w0 & 0xffffu); q1[j] = (short)(w0 >> 16); q2[j] = (short)(w1 & 0xffffu); q3[j] = (short)(w1 >> 16);
                }
            }
            f32x16 pB0, pB1; float mnB, alB;
            __syncthreads();
            asm volatile("s_waitcnt vmcnt(0)" ::: "memory"); SWRITE(0, 0);
            SLOAD(0, lat0 + 64); __syncthreads();
            qkt(pA0, pA1, K_lds, q0, q1, q2, q3, r32, hi); partialSM(pA0, pA1, m_reg, mnA, alA);
            RESC(alA);
            asm volatile("s_waitcnt vmcnt(0)" ::: "memory"); SWRITE(1, 0); SLOAD(0, lat0 + 128); __syncthreads();
#pragma unroll 1
            for (int j = 1; j + 1 < NT; j += 2) {
                SBAR(); qkt(pB0, pB1, K_lds + SHM_K, q0, q1, q2, q3, r32, hi);
                finishSM(pA0, pA1, alA, l_reg, pa0, pa1, pa2, pa3); SBAR();
                pv_d0(o, vb0, pa0, pa1, pa2, pa3); partialSM(pB0, pB1, m_reg, mnB, alB);
                __syncthreads(); asm volatile("s_waitcnt vmcnt(0)" ::: "memory"); SWRITE(0, 0);
                SLOAD(0, lat0 + 64 * (j + 2 < NT ? j + 2 : NT - 1));
                RESC(alB); __syncthreads();
                SBAR(); qkt(pA0, pA1, K_lds, q0, q1, q2, q3, r32, hi);
                finishSM(pB0, pB1, alB, l_reg, pa0, pa1, pa2, pa3); SBAR();
                pv_d0(o, vb0 + SHM_V, pa0, pa1, pa2, pa3); partialSM(pA0, pA1, m_reg, mnA, alA);
                __syncthreads(); asm volatile("s_waitcnt vmcnt(0)" ::: "memory"); SWRITE(1, 0);
                SLOAD(0, lat0 + 64 * (j + 3 < NT ? j + 3 : NT - 1));
                RESC(alA); __syncthreads();
            }
            SBAR(); qkt(pB0, pB1, K_lds + SHM_K, q0, q1, q2, q3, r32, hi);
            finishSM(pA0, pA1, alA, l_reg, pa0, pa1, pa2, pa3); SBAR();
            pv_d0(o, vb0, pa0, pa1, pa2, pa3); partialSM(pB0, pB1, m_reg, mnB, alB);
            __syncthreads(); RESC(alB);
            finishSM(pB0, pB1, alB, l_reg, pa0, pa1, pa2, pa3); SBAR();
            pv_d0(o, vb0 + SHM_V, pa0, pa1, pa2, pa3);
        }
        if (hi == 0) li_l[r32] = l_reg; asm volatile("s_waitcnt lgkmcnt(0)" ::: "memory");
        if (c == 0) {
#pragma unroll
            for (int r = 0; r < 16; ++r) { const float rl = 1.0f / li_l[crow(r, hi)];
#pragma unroll
                for (int d = 0; d < 4; d += 2) stash[(r * 2 + (d >> 1)) * 64 + lane] = cvt_pk_bf16(o[d][r] * rl, o[d + 1][r] * rl); }
        } else {
            bf16_t* Ow = Ob + (size_t)(qrow0 + wid * QBLK) * 1024 + hh * 128;
            float gsub[4];
#pragma unroll
            for (int d = 0; d < 4; ++d) gsub[d] = subln[d * 32 + r32] * oscale;
#pragma unroll
            for (int r = 0; r < 16; ++r) {
                const float rl = lam / li_l[crow(r, hi)]; float acc2 = 0.f;
#pragma unroll
                for (int d = 0; d < 4; d += 2) { const unsigned w = stash[(r * 2 + (d >> 1)) * 64 + lane];
                    const float a0 = bflo(w) - o[d][r] * rl, a1 = bfhi(w) - o[d + 1][r] * rl;
                    o[d][r] = a0; o[d + 1][r] = a1; acc2 += a0 * a0 + a1 * a1; }
#pragma unroll
                for (int off = 1; off < 32; off <<= 1) acc2 += __shfl_xor(acc2, off);
                const float rs = 1.0f / sqrtf(acc2 * (1.f / 128.f) + 1e-5f);
                const int orow = crow(r, hi);
#pragma unroll
                for (int d = 0; d < 4; ++d) Ow[(size_t)orow * 1024 + d * 32 + r32] = (bf16_t)(cvt_pk_bf16(o[d][r] * rs * gsub[d], 0.f) & 0xffffu);
            }
        }
    }
#undef SLOAD
#undef SWRITE
#undef SWAIT
#undef RESC
}
#undef SBAR
}
#ifndef SCAN_TSEL
#define SCAN_TSEL 0
#endif
namespace rwkv {
constexpr int A_W = 0, A_KK = 16384, A_B = 32768, A_KD = 49152, A_R = 65536, A_V = 81920, A_Y = 98304, A_TW = A_Y, A_TA = A_Y + 8192, A_PRM = 133120, A_GC = A_PRM + 15 * 256, A_GT = A_GC + 256, A_END = A_GT + 2048;
constexpr int C_AT = 0, C_RT = 8192, C_BT = 16384, C_KT = 24576, C_KHT = 32768, C_BHT = 40960, C_VT = 49152, C_LAK = 57344, C_LAB = 65536  , C_RHS = 82944  , C_MRK = 100352, C_MRB = 108544, C_ZN = 116736, C_S0B = 139264;
constexpr int RHSP = 68;
constexpr int LABP = 68;
static_assert(A_END <= C_S0B && C_S0B + 8192 <= LDS_BYTES && C_ZN + 8192 <= RING_BYTES && C_RHS >= C_LAB + 64 * LABP * 4 && C_MRK >= C_RHS + 64 * RHSP * 4 && A_END <= LDS_BYTES && A_PRM >= MISC_OFF + 512, "scan LDS");
struct Params { const bf16_t* cs; bf16_t* co; bf16_t* y; float* bon; const float* mu; const float* w0; const float* w2; const float* a0; const float* a2; const float* kk; const float* ka; const float* rk; };
__device__ __forceinline__ float dpp_ror_add(float x, int) { return x; }
#define ROR_ADD(x, n) do { const int t_ = __builtin_amdgcn_update_dpp(0, __builtin_bit_cast(int, x), 0x120 + (n), 0xf, 0xf, false); x += __builtin_bit_cast(float, t_); } while (0)
__device__ __forceinline__ float row16_sum(float x) { ROR_ADD(x, 8); ROR_ADD(x, 4); ROR_ADD(x, 2); ROR_ADD(x, 1); return x; }
__device__ __forceinline__ void ld8(const bf16_t* p, float (&o)[8]) { const u32x4 w = *(const u32x4*)p; o[0] = bflo(w.x); o[1] = bfhi(w.x); o[2] = bflo(w.y); o[3] = bfhi(w.y); o[4] = bflo(w.z); o[5] = bfhi(w.z); o[6] = bflo(w.w); o[7] = bfhi(w.w); }
template <class MP> __device__ __forceinline__ void shift8(const bf16_t* base, size_t pitch, size_t row, int col, bool hp, bool hn, MP m0, MP m1, float (&o)[8]) {
    float c[8], p[8], n[8]; ld8(base + row * pitch + col, c); ld8(base + (hp ? row - 1 : row) * pitch + col, p); ld8(base + (hn ? row + 1 : row) * pitch + col, n);
#pragma unroll
    for (int i = 0; i < 8; ++i) { const float pv = hp ? p[i] : 0.f, nv = hn ? n[i] : 0.f; o[i] = c[i] + m0[i] * (pv - c[i]) + m1[i] * (nv - c[i]); }
}
__device__ __forceinline__ void lds_ld8(const LAS float* p, float (&o)[8]) { const f32x4 a = *(const LAS f32x4*)p, b = *(const LAS f32x4*)(p + 4); o[0] = a[0]; o[1] = a[1]; o[2] = a[2]; o[3] = a[3]; o[4] = b[0]; o[5] = b[1]; o[6] = b[2]; o[7] = b[3]; }
__device__ __forceinline__ void lds_st8(LAS float* p, const float (&o)[8]) { *(LAS f32x4*)p = (f32x4){o[0], o[1], o[2], o[3]}; *(LAS f32x4*)(p + 4) = (f32x4){o[4], o[5], o[6], o[7]}; }
__device__ __forceinline__ void scan_wg(const Params& P, int d, int b, int hh, LAS char* lds, int wave_) {
    unsigned long long tprev_ = 0;
#define SC_T(k) do { if (SCAN_TSEL != 0) { if (blockIdx.x == 0 && tid == 0) { const unsigned long long tn_ = __builtin_amdgcn_s_memrealtime(); if ((SCAN_TSEL >> (k)) & 1) { volatile LAS unsigned* M_ = (volatile LAS unsigned*)(lds + MISC_OFF); const unsigned long long ac_ = (((unsigned long long)M_[19] << 32) | M_[18]) + (tn_ - tprev_); M_[18] = (unsigned)ac_; M_[19] = (unsigned)(ac_ >> 32); } tprev_ = tn_; } } } while (0)
    int wid = wave_; asm volatile("" : "+s"(wid));
    const int lane0 = fresh_lane(), tid = (wid << 6) | lane0, r32o = lane0 & 31, hio = lane0 >> 5;
    LAS float* W = (LAS float*)(lds + A_W); LAS float* KK = (LAS float*)(lds + A_KK); LAS float* Bv = (LAS float*)(lds + A_B); LAS float* KD = (LAS float*)(lds + A_KD);
    LAS float* Rv = (LAS float*)(lds + A_R); LAS float* Vv = (LAS float*)(lds + A_V); LAS float* Y = (LAS float*)(lds + A_Y);
    LAS bf16_t* TW = (LAS bf16_t*)(lds + A_TW); LAS bf16_t* TA = (LAS bf16_t*)(lds + A_TA); LAS float* PRM = (LAS float*)(lds + A_PRM);
    __syncthreads();
    for (int i = tid; i < 15 * 64; i += NTHREADS) { const int p = i >> 6, c = i & 63; float v;
        switch (p) {
            case 0: v = P.mu[hh * 64 + c]; break;             case 1: v = P.mu[1920 + hh * 64 + c]; break;
            case 2: v = P.mu[512 + hh * 64 + c]; break;       case 3: v = P.mu[1920 + 512 + hh * 64 + c]; break;
            case 4: v = P.mu[1024 + d * 64 + c]; break;       case 5: v = P.mu[1920 + 1024 + d * 64 + c]; break;
            case 6: v = P.mu[1152 + d * 64 + c]; break;       case 7: v = P.mu[1920 + 1152 + d * 64 + c]; break;
            case 8: v = P.mu[1280 + hh * 64 + c]; break;      case 9: v = P.mu[1920 + 1280 + hh * 64 + c]; break;
            case 10: v = P.w0[d * 512 + hh * 64 + c]; break;  case 11: v = P.a0[d * 512 + hh * 64 + c]; break;
            case 12: v = P.kk[hh * 64 + c]; break;            case 13: v = P.ka[hh * 64 + c]; break;
            default: v = P.rk[hh * 64 + c]; break; }
        PRM[i] = v; }
    const int mtx = wid >> 2, ti = (wid >> 1) & 1, tj = wid & 1;
    bf16x8 bw[4];
    { const int r32 = r32o, hi = hio; const float* src = (mtx == 0 ? P.w2 : P.a2) + (size_t)d * 64 * 512 + hh * 64 + 32 * tj + r32;
#pragma unroll
      for (int s = 0; s < 4; ++s) {
          u32x4 w;
          w.x = cvt_pk_bf16(src[(size_t)(16 * s + 8 * hi + 0) * 512], src[(size_t)(16 * s + 8 * hi + 1) * 512]);
          w.y = cvt_pk_bf16(src[(size_t)(16 * s + 8 * hi + 2) * 512], src[(size_t)(16 * s + 8 * hi + 3) * 512]);
          w.z = cvt_pk_bf16(src[(size_t)(16 * s + 8 * hi + 4) * 512], src[(size_t)(16 * s + 8 * hi + 5) * 512]);
          w.w = cvt_pk_bf16(src[(size_t)(16 * s + 8 * hi + 6) * 512], src[(size_t)(16 * s + 8 * hi + 7) * 512]);
          bw[s] = __builtin_bit_cast(bf16x8, w); } }
    LAS float* GC = (LAS float*)(lds + A_GC); LAS float* GT = (LAS float*)(lds + A_GT);
    f32x16 Sreg = f32x16{};
    for (int i = tid; i < 2048; i += NTHREADS) ((LAS unsigned*)(lds + C_S0B))[i] = 0u;
    __syncthreads();
    u32x4 rc[5], rpv[5], rnv[5];
#define LOADRAW(BLK) do { const bool ic_ = (BLK) < 4; const int bb_ = ic_ ? (BLK) : (BLK) - 4; const int sb_ = ic_ ? ML + b * CTXL : b * SEQ, sl_ = ic_ ? CTXL : SEQ; \
        const int r0_ = d == 0 ? sb_ + 64 * bb_ : sb_ + sl_ - 64 * (bb_ + 1); int tq_ = tid; asm volatile("" : "+v"(tq_)); const int pj_ = tq_ >> 3, cg_ = tq_ & 7; \
        const int row_ = d == 0 ? r0_ + pj_ : r0_ + 63 - pj_; const int pos_ = row_ - sb_; const size_t rp_ = pos_ > 0 ? row_ - 1 : row_, rn_ = pos_ < sl_ - 1 ? row_ + 1 : row_; \
        const int cs_[5] = {hh * 64 + 8 * cg_, 512 + hh * 64 + 8 * cg_, 1024 + d * 64 + 8 * cg_, 1152 + d * 64 + 8 * cg_, hh * 64 + 8 * cg_}; \
        _Pragma("unroll") for (int sgi = 0; sgi < 5; ++sgi) { const bf16_t* base_ = sgi < 4 ? P.cs : (const bf16_t*)P.co; const size_t pitch_ = sgi < 4 ? DCS : DCOP; \
            rc[sgi] = *(const u32x4*)(base_ + (size_t)row_ * pitch_ + cs_[sgi]); rpv[sgi] = *(const u32x4*)(base_ + rp_ * pitch_ + cs_[sgi]); rnv[sgi] = *(const u32x4*)(base_ + rn_ * pitch_ + cs_[sgi]); \
            } } while (0)
    LOADRAW(0);
#pragma unroll 1
    for (int blk = 0; blk < 68; ++blk) {
        const bool isctx = blk < 4; const int bb = isctx ? blk : blk - 4;
        const int segbase = isctx ? ML + b * CTXL : b * SEQ, seglen = isctx ? CTXL : SEQ;
        const int r0 = d == 0 ? segbase + 64 * bb : segbase + seglen - 64 * (bb + 1);
        int tl_ = tid; asm volatile("" : "+v"(tl_));
        const int lane = tl_ & 63, r32 = lane & 31, hi = lane >> 5, pj = tl_ >> 3, cg = tl_ & 7;
        SC_T(0);
        {
            const int row = d == 0 ? r0 + pj : r0 + 63 - pj; const int pos = row - segbase; const unsigned pmk = pos > 0 ? 0xffffffffu : 0u, nmk = pos < seglen - 1 ? 0xffffffffu : 0u;
#define SHIFT8(sgi, M0, M1, OUT) do { const unsigned cw_[4] = {rc[sgi].x, rc[sgi].y, rc[sgi].z, rc[sgi].w}, pw_[4] = {rpv[sgi].x & pmk, rpv[sgi].y & pmk, rpv[sgi].z & pmk, rpv[sgi].w & pmk}, nw_[4] = {rnv[sgi].x & nmk, rnv[sgi].y & nmk, rnv[sgi].z & nmk, rnv[sgi].w & nmk}; \
                _Pragma("unroll") for (int i = 0; i < 4; ++i) { const f32x2 c_ = {bflo(cw_[i]), bfhi(cw_[i])}, p_ = {bflo(pw_[i]), bfhi(pw_[i])}, n_ = {bflo(nw_[i]), bfhi(nw_[i])}; \
                    const f32x2 a0_ = {(M0)[2 * i], (M0)[2 * i + 1]}, a1_ = {(M1)[2 * i], (M1)[2 * i + 1]}; const f32x2 o_ = c_ + a0_ * (p_ - c_) + a1_ * (n_ - c_); OUT[2 * i] = o_.x; OUT[2 * i + 1] = o_.y; } } while (0)
            float ks[8], xs[8], ssq = 0.f;
            float m0[8], m1[8];
            lds_ld8(PRM + 0 * 64 + 8 * cg, m0); lds_ld8(PRM + 1 * 64 + 8 * cg, m1); SHIFT8(0, m0, m1, ks);
            lds_st8(KD + pj * 64 + 8 * cg, ks);
            lds_ld8(PRM + 12 * 64 + 8 * cg, m0);
#pragma unroll
            for (int i = 0; i < 8; ++i) { const float t = ks[i] * m0[i]; ks[i] = t; ssq += t * t; }
            ssq += __shfl_xor(ssq, 1); ssq += __shfl_xor(ssq, 2); ssq += __shfl_xor(ssq, 4);
            const float inv = __builtin_amdgcn_rcpf(fmaxf(sqrtf(ssq), 1e-12f));
#pragma unroll
            for (int i = 0; i < 8; ++i) ks[i] *= inv;
            lds_st8(KK + pj * 64 + 8 * cg, ks);
            lds_ld8(PRM + 2 * 64 + 8 * cg, m0); lds_ld8(PRM + 3 * 64 + 8 * cg, m1); SHIFT8(1, m0, m1, xs);
            lds_st8(Vv + pj * 64 + 8 * cg, xs);
            lds_ld8(PRM + 8 * 64 + 8 * cg, m0); lds_ld8(PRM + 9 * 64 + 8 * cg, m1); SHIFT8(4, m0, m1, xs);
            lds_st8(Rv + pj * 64 + 8 * cg, xs);
            lds_ld8(PRM + 4 * 64 + 8 * cg, m0); lds_ld8(PRM + 5 * 64 + 8 * cg, m1); SHIFT8(2, m0, m1, xs);
            { u32x4 w;
#pragma unroll
              for (int i = 0; i < 8; ++i) { const float e2 = __expf(2.f * xs[i]); xs[i] = 1.f - 2.f / (e2 + 1.f); }
              w.x = cvt_pk_bf16(xs[0], xs[1]); w.y = cvt_pk_bf16(xs[2], xs[3]); w.z = cvt_pk_bf16(xs[4], xs[5]); w.w = cvt_pk_bf16(xs[6], xs[7]);
              *(LAS u32x4*)(TW + pj * 64 + 8 * cg) = w; }
            lds_ld8(PRM + 6 * 64 + 8 * cg, m0); lds_ld8(PRM + 7 * 64 + 8 * cg, m1); SHIFT8(3, m0, m1, xs);
            { u32x4 w; w.x = cvt_pk_bf16(xs[0], xs[1]); w.y = cvt_pk_bf16(xs[2], xs[3]); w.z = cvt_pk_bf16(xs[4], xs[5]); w.w = cvt_pk_bf16(xs[6], xs[7]);
              *(LAS u32x4*)(TA + pj * 64 + 8 * cg) = w; }
#undef SHIFT8
        }
        if (blk + 1 < 68) LOADRAW(blk + 1);
        __syncthreads(); SC_T(1);
        {
            const LAS bf16_t* T = mtx == 0 ? TW : TA; LAS float* dst = mtx == 0 ? W : Bv;
            f32x16 cacc = f32x16{};
#pragma unroll
            for (int s = 0; s < 4; ++s) { const bf16x8 af = *(const LAS bf16x8*)(T + (32 * ti + r32) * 64 + 16 * s + 8 * hi);
                cacc = __builtin_amdgcn_mfma_f32_32x32x16_bf16(af, bw[s], cacc, 0, 0, 0); }
#pragma unroll
            for (int r = 0; r < 16; ++r) dst[(32 * ti + (r & 3) + 8 * (r >> 2) + 4 * hi) * 64 + 32 * tj + r32] = cacc[r];
        }
        __syncthreads(); SC_T(2);
        {
            const int row = d == 0 ? r0 + pj : r0 + 63 - pj; float bsum = 0.f; const int o8 = pj * 64 + 8 * cg;
            float lw[8], la[8], kdv[8], kkv[8], rv[8], p10[8], p11[8], p13[8], p14[8];
            lds_ld8(W + o8, lw); lds_ld8(Bv + o8, la); lds_ld8(KD + o8, kdv); lds_ld8(KK + o8, kkv); lds_ld8(Rv + o8, rv);
            lds_ld8(PRM + 10 * 64 + 8 * cg, p10); lds_ld8(PRM + 11 * 64 + 8 * cg, p11); lds_ld8(PRM + 13 * 64 + 8 * cg, p13); lds_ld8(PRM + 14 * 64 + 8 * cg, p14);
#pragma unroll
            for (int i = 0; i < 8; ++i) {
                const float x = p10[i] + lw[i]; const float dec = __expf(-0.60653065971263342f * sigmoidf_(x));
                const float a = sigmoidf_(p11[i] + la[i]);
                const float kd = kdv[i] * (1.f + (a - 1.f) * p13[i]);
                lw[i] = dec; kdv[i] = kd; la[i] = kkv[i] * a; bsum += rv[i] * kd * p14[i]; }
            lds_st8(W + o8, lw); lds_st8(KD + o8, kdv); lds_st8(Bv + o8, la);
            bsum += __shfl_xor(bsum, 1); bsum += __shfl_xor(bsum, 2); bsum += __shfl_xor(bsum, 4);
            if (cg == 0) P.bon[(size_t)d * MT * 8 + (size_t)row * 8 + hh] = bsum;
        }
        __syncthreads(); SC_T(3);
        {
            const int kcol = tl_ & 63, seg = wid; float p[8], run = 1.f;
#pragma unroll
            for (int i = 0; i < 8; ++i) { run *= W[(8 * seg + i) * 64 + kcol]; p[i] = run; }
            GT[seg * 64 + kcol] = run;
            __syncthreads();
            float pre = 1.f;
#pragma unroll
            for (int sg2 = 0; sg2 < 7; ++sg2) { const float tv = GT[sg2 * 64 + kcol]; if (sg2 < seg) pre *= tv; }
#pragma unroll
            for (int i = 0; i < 8; ++i) W[(8 * seg + i) * 64 + kcol] = pre * p[i];
        }
        __syncthreads();
        {
            const int o8 = pj * 64 + 8 * cg;
            float g[8], gx[8], kk[8], rr[8], bb[8], kd[8];
            lds_ld8(W + o8, g); if (pj > 0) lds_ld8(W + o8 - 64, gx); else {
#pragma unroll
                for (int i = 0; i < 8; ++i) gx[i] = 1.f; }
            lds_ld8(KK + o8, kk); lds_ld8(Rv + o8, rr); lds_ld8(Bv + o8, bb); lds_ld8(KD + o8, kd);
            const int kc2 = tl_ & 63, tc2 = wid;
            float g2[8], kd2[8], bb2[8], vv2[8]; const float gc2 = W[63 * 64 + kc2];
#pragma unroll
            for (int i = 0; i < 8; ++i) { const int o = (8 * tc2 + i) * 64 + kc2; g2[i] = W[o]; kd2[i] = KD[o]; bb2[i] = Bv[o]; vv2[i] = Vv[o]; }
            __syncthreads();
            u32x4 w;
#define PK8(EXPR) do { float e_[8]; _Pragma("unroll") for (int i = 0; i < 8; ++i) e_[i] = (EXPR); w.x = cvt_pk_bf16(e_[0], e_[1]); w.y = cvt_pk_bf16(e_[2], e_[3]); w.z = cvt_pk_bf16(e_[4], e_[5]); w.w = cvt_pk_bf16(e_[6], e_[7]); } while (0)
            const int ao = attn::kswz(pj, cg);
            PK8(kk[i] * gx[i]); *(LAS u32x4*)(lds + C_AT + ao) = w;
            PK8(rr[i] * g[i]);  *(LAS u32x4*)(lds + C_RT + ao) = w;
            float ig[8];
#pragma unroll
            for (int i = 0; i < 8; ++i) ig[i] = __builtin_amdgcn_rcpf(g[i]);
            PK8(bb[i] * ig[i]); *(LAS u32x4*)(lds + C_BT + ao) = w;
            PK8(kd[i] * ig[i]); *(LAS u32x4*)(lds + C_KT + ao) = w;
            const int ao2 = attn::kswz(kc2, tc2);
#pragma unroll
            for (int i = 0; i < 8; ++i) ig[i] = gc2 * __builtin_amdgcn_rcpf(g2[i]);
            PK8(kd2[i] * ig[i]); *(LAS u32x4*)(lds + C_KHT + ao2) = w;
            PK8(bb2[i] * ig[i]); *(LAS u32x4*)(lds + C_BHT + ao2) = w;
            PK8(vv2[i]);               *(LAS u32x4*)(lds + C_VT + ao2) = w;
            if (tc2 == 7) GC[kc2] = gc2;
#undef PK8
        }
        __syncthreads(); SC_T(4);
#define FRAG(ARR, ROW, CH) (*(const LAS bf16x8*)(lds + (ARR) + attn::kswz((ROW), (CH))))
        {
            const int tr = wid >> 1, ti = tr & 1; const int Aarr = tr < 2 ? C_AT : C_RT;
#pragma unroll
            for (int h2 = 0; h2 < 2; ++h2) { const int tc = 2 * (wid & 1) + h2, tj = tc & 1; const int Barr = tc < 2 ? C_BT : C_KT;
                f32x16 acc = f32x16{};
#pragma unroll
                for (int q = 0; q < 4; ++q) acc = __builtin_amdgcn_mfma_f32_32x32x16_bf16(FRAG(Barr, 32 * tj + r32, 2 * q + hi), FRAG(Aarr, 32 * ti + r32, 2 * q + hi), acc, 0, 0, 0);
                const int t = 32 * ti + r32;
                const int d0 = 32 * tj + 4 * hi - t - (tr < 2 ? 0 : 1);
                if (tr < 2 && tc < 2) {
                    LAS float* lp = (LAS float*)(lds + C_LAB) + (32 * tj + 4 * hi) * LABP + (t & 3) * 16 + (t >> 2);
#pragma unroll
                    for (int r = 0; r < 16; ++r) { const int e = (r & 3) + 8 * (r >> 2); const unsigned mk = (unsigned)((d0 + e) >> 31);
                        lp[e * LABP] = __uint_as_float(__float_as_uint(acc[r]) & mk); }
                } else {
                    const int dst = tr < 2 ? C_LAK : (tc < 2 ? C_MRB : C_MRK);
#pragma unroll
                    for (int gq = 0; gq < 4; ++gq) { const int tp0 = 32 * tj + 8 * gq + 4 * hi; float vv4[4];
#pragma unroll
                        for (int e = 0; e < 4; ++e) { const unsigned mk = (unsigned)((d0 + 8 * gq + e) >> 31); vv4[e] = __uint_as_float(__float_as_uint(acc[4 * gq + e]) & mk); }
                        u32x2 w2; w2.x = cvt_pk_bf16(vv4[0], vv4[1]); w2.y = cvt_pk_bf16(vv4[2], vv4[3]);
                        *(LAS u32x2*)(lds + dst + attn::kswz(t, tp0 >> 3) + (tp0 & 7) * 2) = w2; }
                }
            }
        }
        __syncthreads(); SC_T(5);
        if (wid < 4) {
            const int ti = wid >> 1, tj = wid & 1; f32x16 acc = f32x16{};
#pragma unroll
            for (int q = 0; q < 4; ++q) acc = __builtin_amdgcn_mfma_f32_32x32x16_bf16(FRAG(C_S0B, 32 * tj + r32, 2 * q + hi), FRAG(C_AT, 32 * ti + r32, 2 * q + hi), acc, 0, 0, 0);
#pragma unroll
            for (int q = 0; q < 4; ++q) acc = __builtin_amdgcn_mfma_f32_32x32x16_bf16(FRAG(C_VT, 32 * tj + r32, 2 * q + hi), FRAG(C_LAK, 32 * ti + r32, 2 * q + hi), acc, 0, 0, 0);
            const int t = 32 * ti + r32;
#pragma unroll
            for (int r = 0; r < 16; ++r) { const int v = 32 * tj + (r & 3) + 8 * (r >> 2) + 4 * hi; *(LAS float*)(lds + C_RHS + (v * RHSP + (t & 3) * 16 + (t >> 2)) * 4) = acc[r]; }
        }
        else {
                const int ti = (wid >> 1) & 1, tj = wid & 1; const float gcv = GC[32 * tj + r32];
#pragma unroll
                for (int r = 0; r < 16; ++r) Sreg[r] *= gcv;
#pragma unroll
                for (int q = 0; q < 4; ++q) Sreg = __builtin_amdgcn_mfma_f32_32x32x16_bf16(FRAG(C_VT, 32 * ti + r32, 2 * q + hi), FRAG(C_KHT, 32 * tj + r32, 2 * q + hi), Sreg, 0, 0, 0);
        }
        __syncthreads(); SC_T(6);
        f32x16 Yacc = f32x16{}; bf16x8 mrb[4] = {};
        if (wid >= 4) {
            const int q = lane & 3, v = 16 * (wid - 4) + (lane >> 2);
            const LAS float* LT = (const LAS float*)(lds + C_LAB) + q * 16;
            f32x2 sa[8]; float zo[16];
            { const LAS f32x4* rp = (const LAS f32x4*)(lds + C_RHS + (v * RHSP + q * 16) * 4);
#pragma unroll
              for (int g4 = 0; g4 < 4; ++g4) { const f32x4 x = rp[g4]; sa[2 * g4] = (f32x2){x[0], x[1]}; sa[2 * g4 + 1] = (f32x2){x[2], x[3]}; } }
#pragma unroll
            for (int i = 0; i < 16; ++i) zo[i] = 0.f;
            f32x4 la[4], lb[4];
#define LLOAD(t, A) do { const LAS f32x4* lp_ = (const LAS f32x4*)(LT + (t) * LABP); _Pragma("unroll") for (int g_ = (t) >> 4; g_ < 4; ++g_) A[g_] = lp_[g_]; } while (0)
#define SOLVE_STEP(t, A, N) do { if ((t) < 63) LLOAD((t) + 1, N); const float zown_ = (((t) >> 2) & 1) ? sa[(t) >> 3].y : sa[(t) >> 3].x; \
                const float zt_ = __builtin_bit_cast(float, __builtin_amdgcn_update_dpp(0, __builtin_bit_cast(int, zown_), ((t) & 3) * 0x55, 0xf, 0xf, true)); \
                if (q == ((t) & 3)) zo[(t) >> 2] = zt_; const f32x2 nz_ = {-zt_, -zt_}; \
                _Pragma("unroll") for (int p_ = (t) >> 3; p_ < 8; ++p_) { const f32x2 l2_ = (p_ & 1) ? (f32x2){A[p_ >> 1][2], A[p_ >> 1][3]} : (f32x2){A[p_ >> 1][0], A[p_ >> 1][1]}; sa[p_] = l2_ * nz_ + sa[p_]; } } while (0)
#define SOLVE2(t) SOLVE_STEP(t, la, lb); SOLVE_STEP((t) + 1, lb, la)
#define SOLVE8(t) SOLVE2(t); SOLVE2((t) + 2); SOLVE2((t) + 4); SOLVE2((t) + 6)
            LLOAD(0, la);
            SOLVE8(0); SOLVE8(8); SOLVE8(16); SOLVE8(24); SOLVE8(32); SOLVE8(40); SOLVE8(48); SOLVE8(56);
#undef SOLVE8
#undef SOLVE2
#undef SOLVE_STEP
#undef LLOAD
#pragma unroll
            for (int i = 0; i < 16; ++i) { const int t = 4 * i + q; *(LAS bf16_t*)(lds + C_ZN + attn::kswz(v, t >> 3) + (t & 7) * 2) = (bf16_t)(cvt_pk_bf16(-zo[i], 0.f) & 0xffffu); }
        } else {
            const int ti = wid >> 1, tj = wid & 1;
#pragma unroll
            for (int q = 0; q < 4; ++q) mrb[q] = FRAG(C_MRB, 32 * ti + r32, 2 * q + hi);
#pragma unroll
            for (int q = 0; q < 4; ++q) Yacc = __builtin_amdgcn_mfma_f32_32x32x16_bf16(FRAG(C_RT, 32 * ti + r32, 2 * q + hi), FRAG(C_S0B, 32 * tj + r32, 2 * q + hi), Yacc, 0, 0, 0);
#pragma unroll
            for (int q = 0; q < 4; ++q) Yacc = __builtin_amdgcn_mfma_f32_32x32x16_bf16(FRAG(C_MRK, 32 * ti + r32, 2 * q + hi), FRAG(C_VT, 32 * tj + r32, 2 * q + hi), Yacc, 0, 0, 0);
        }
        __syncthreads(); SC_T(7);
        if (wid < 4) {
            const int ti = wid >> 1, tj = wid & 1;
#pragma unroll
            for (int q = 0; q < 4; ++q) Yacc = __builtin_amdgcn_mfma_f32_32x32x16_bf16(mrb[q], FRAG(C_ZN, 32 * tj + r32, 2 * q + hi), Yacc, 0, 0, 0);
            bf16_t* yb = P.y + (size_t)d * MT * 512 + hh * 64 + 32 * tj + r32;
#pragma unroll
            for (int r = 0; r < 16; ++r) { const int t = 32 * ti + (r & 3) + 8 * (r >> 2) + 4 * hi; const int row = d == 0 ? r0 + t : r0 + 63 - t;
                yb[(size_t)row * 512] = (bf16_t)(cvt_pk_bf16(Yacc[r], 0.f) & 0xffffu); }
            SC_T(8);
        } else {
            const int ti = (wid >> 1) & 1, tj = wid & 1; const int k = 32 * tj + r32;
#pragma unroll
            for (int q = 0; q < 4; ++q) Sreg = __builtin_amdgcn_mfma_f32_32x32x16_bf16(FRAG(C_ZN, 32 * ti + r32, 2 * q + hi), FRAG(C_BHT, 32 * tj + r32, 2 * q + hi), Sreg, 0, 0, 0);
#pragma unroll
            for (int r = 0; r < 16; ++r) { const int v = 32 * ti + (r & 3) + 8 * (r >> 2) + 4 * hi;
                *(LAS bf16_t*)(lds + C_S0B + attn::kswz(v, k >> 3) + (k & 7) * 2) = (bf16_t)(cvt_pk_bf16(Sreg[r], 0.f) & 0xffffu); }
        }
#undef FRAG
    }
    __syncthreads();
}
#undef ROR_ADD
}
struct Frame {
    LAS unsigned char* lds; char* ldsg; volatile LAS unsigned* MISC; gu32* ctl;
    int tid, lane, wave, G, gw, NGW;
    const float* x_in; const float* ctx_in; float* out; unsigned char* ws;
};
enum { I_X = 0, I_C, I_CTX, I_CCTX, I_ADAW, I_ADAB, I_WIN, I_LAMQK, I_SUBLN, I_MU, I_W0, I_W2, I_A0, I_A2, I_G2, I_KK, I_KA, I_RK, I_LNW, I_LNB,
       I_WPA, I_WPF, I_WPC, I_WO, I_LN1G, I_LN1B, I_FUP, I_FCONV, I_FCONVB, I_FDN, I_LN2G, I_LN2B };

struct Row16 { f32x4 v[4]; };
__device__ __forceinline__ void row_load_f32(Row16& r, const float* p, int lane) {
#pragma unroll
    for (int j = 0; j < 4; ++j) r.v[j] = *(const f32x4*)(p + 256 * j + 4 * lane);
}
__device__ __forceinline__ void row_load_bf16(Row16& r, const bf16_t* p, int lane) {
#pragma unroll
    for (int j = 0; j < 4; ++j) { const u32x2 w = *(const u32x2*)(p + 256 * j + 4 * lane); r.v[j] = (f32x4){bflo(w.x), bfhi(w.x), bflo(w.y), bfhi(w.y)}; }
}
__device__ __forceinline__ void row_store_f32(const Row16& r, float* p, int lane) {
#pragma unroll
    for (int j = 0; j < 4; ++j) *(f32x4*)(p + 256 * j + 4 * lane) = r.v[j];
}
__device__ __forceinline__ void row_store_bf16(const Row16& r, bf16_t* p, int lane) {
#pragma unroll
    for (int j = 0; j < 4; ++j) { u32x2 w; w.x = cvt_pk_bf16(r.v[j][0], r.v[j][1]); w.y = cvt_pk_bf16(r.v[j][2], r.v[j][3]); *(u32x2*)(p + 256 * j + 4 * lane) = w; }
}
__device__ __forceinline__ void row_ln_plain(Row16& r) {
    float s = 0.f;
#pragma unroll
    for (int j = 0; j < 4; ++j) s += (r.v[j][0] + r.v[j][1]) + (r.v[j][2] + r.v[j][3]);
    const float mean = wave_sum(s) * (1.f / DM); float q = 0.f;
#pragma unroll
    for (int j = 0; j < 4; ++j) { r.v[j] = r.v[j] - mean; q += (r.v[j][0] * r.v[j][0] + r.v[j][1] * r.v[j][1]) + (r.v[j][2] * r.v[j][2] + r.v[j][3] * r.v[j][3]); }
    const float rstd = 1.0f / sqrtf(wave_sum(q) * (1.f / DM) + LN_EPS);
#pragma unroll
    for (int j = 0; j < 4; ++j) r.v[j] = r.v[j] * rstd;
}
__device__ __forceinline__ void row_affine(Row16& r, const float* g, const float* b, int lane, float gadd) {
#pragma unroll
    for (int j = 0; j < 4; ++j) { const f32x4 gg = *(const f32x4*)(g + 256 * j + 4 * lane), bb = *(const f32x4*)(b + 256 * j + 4 * lane); r.v[j] = r.v[j] * (gg + gadd) + bb; }
}
__device__ __forceinline__ const float* modrow(const Frame& F, int layer, int row) { return (const float*)(F.ws + TAB_MOD) + ((size_t)layer * 5 + (row < ML ? (row >> 12) : 4)) * 6144; }
__device__ __forceinline__ const float* xrow_in(const Frame& F, int layer, int row) {
    if (layer == 0) return row < ML ? F.x_in + (size_t)row * DM : F.ctx_in + (size_t)(row - ML) * DM;
    return row < ML ? F.out + (size_t)row * DM : (const float*)(F.ws + WS_XC) + (size_t)(row - ML) * DM;
}
__device__ __forceinline__ float* xrow_out(const Frame& F, int row) { return row < ML ? F.out + (size_t)row * DM : (float*)(F.ws + WS_XC) + (size_t)(row - ML) * DM; }

__device__ __forceinline__ void pass_modulate(const Frame& F0, int layer, bf16_t* dst, int nrows) {
    Frame F = F0; F.lane = fresh_lane(); F.tid = (F.wave << 6) | F.lane;
    for (int row = F.gw; row < nrows; row += F.NGW) {
        Row16 r; row_load_f32(r, xrow_in(F, layer, row), F.lane); row_ln_plain(r);
        const float* mv = modrow(F, layer, row); row_affine(r, mv + 1024, mv, F.lane, 1.f);
        row_store_bf16(r, dst + (size_t)row * DM, F.lane);
    }
}
__device__ __forceinline__ void pass_ln1(Frame F, int layer, const bf16_t* mix, bf16_t* h2, int nrows, const float* g, const float* bt) {
    F.lane = fresh_lane(); F.tid = (F.wave << 6) | F.lane;
    for (int row0 = F.gw; row0 < nrows; row0 += 2 * F.NGW) {
        const int row1 = row0 + F.NGW; const bool two = row1 < nrows; const int rowb = two ? row1 : row0;
        Row16 ra, ma, rb, mb; row_load_f32(ra, xrow_in(F, layer, row0), F.lane); row_load_bf16(ma, mix + (size_t)row0 * DM, F.lane);
        row_load_f32(rb, xrow_in(F, layer, rowb), F.lane); row_load_bf16(mb, mix + (size_t)rowb * DM, F.lane);
        const float* mva = modrow(F, layer, row0); const float* mvb = modrow(F, layer, rowb);
#pragma unroll
        for (int j = 0; j < 4; ++j) { f32x4 gt = *(const f32x4*)(mva + 2048 + 256 * j + 4 * F.lane); if (DBG_ZERO_MIX) gt = gt * 0.f; ra.v[j] = ra.v[j] * ALPHA + gt * ma.v[j];
            f32x4 gu = *(const f32x4*)(mvb + 2048 + 256 * j + 4 * F.lane); if (DBG_ZERO_MIX) gu = gu * 0.f; rb.v[j] = rb.v[j] * ALPHA + gu * mb.v[j]; }
        row_ln_plain(ra); row_ln_plain(rb); row_affine(ra, g, bt, F.lane, 0.f); row_affine(rb, g, bt, F.lane, 0.f);
        row_store_f32(ra, xrow_out(F, row0), F.lane); if (two) row_store_f32(rb, xrow_out(F, row1), F.lane);
        row_ln_plain(ra); row_ln_plain(rb); row_affine(ra, mva + 4096, mva + 3072, F.lane, 1.f); row_affine(rb, mvb + 4096, mvb + 3072, F.lane, 1.f);
        row_store_bf16(ra, h2 + (size_t)row0 * DM, F.lane); if (two) row_store_bf16(rb, h2 + (size_t)row1 * DM, F.lane);
    }
}
__device__ __forceinline__ void pass_ln2(Frame F, int layer, bf16_t* ffn_h, int nrows, bool next_h, const float* g, const float* bt) {
    F.lane = fresh_lane(); F.tid = (F.wave << 6) | F.lane;
    for (int row0 = F.gw; row0 < nrows; row0 += 2 * F.NGW) {
        const int row1 = row0 + F.NGW; const bool two = row1 < nrows; const int rowb = two ? row1 : row0;
        Row16 ra, ma, rb, mb; float* xa = xrow_out(F, row0); float* xb = xrow_out(F, rowb);
        row_load_f32(ra, xa, F.lane); row_load_bf16(ma, ffn_h + (size_t)row0 * DM, F.lane); row_load_f32(rb, xb, F.lane); row_load_bf16(mb, ffn_h + (size_t)rowb * DM, F.lane);
        const float* mva = modrow(F, layer, row0); const float* mvb = modrow(F, layer, rowb);
#pragma unroll
        for (int j = 0; j < 4; ++j) { f32x4 gt = *(const f32x4*)(mva + 5120 + 256 * j + 4 * F.lane); if (DBG_ZERO_FFN) gt = gt * 0.f; ra.v[j] = ra.v[j] * ALPHA + gt * ma.v[j];
            f32x4 gu = *(const f32x4*)(mvb + 5120 + 256 * j + 4 * F.lane); if (DBG_ZERO_FFN) gu = gu * 0.f; rb.v[j] = rb.v[j] * ALPHA + gu * mb.v[j]; }
        row_ln_plain(ra); row_ln_plain(rb); row_affine(ra, g, bt, F.lane, 0.f); row_affine(rb, g, bt, F.lane, 0.f);
        row_store_f32(ra, xa, F.lane); if (two) row_store_f32(rb, xb, F.lane);
        if (next_h) { const float* mna = modrow(F, layer + 1, row0); const float* mnb = modrow(F, layer + 1, rowb);
            row_ln_plain(ra); row_ln_plain(rb); row_affine(ra, mna + 1024, mna, F.lane, 1.f); row_affine(rb, mnb + 1024, mnb, F.lane, 1.f);
            row_store_bf16(ra, ffn_h + (size_t)row0 * DM, F.lane); if (two) row_store_bf16(rb, ffn_h + (size_t)row1 * DM, F.lane); }
    }
}
__device__ __forceinline__ float gelu_fast(float v) {
    const float av = fabsf(v), t = __builtin_amdgcn_rcpf(av * 0.2316418882f + 1.0f);
    float q = t * 0.5307027145f + (-0.7265760135f); q = q * t + 0.7107068705f; q = q * t + (-0.142248368f); q = q * t + 0.127414796f; q = q * t;
    const float e = __builtin_amdgcn_exp2f((v * v) * (-0.72134752044f)); const float m = v * (q * e);
    return v < 0.f ? m : v - m;
}
__device__ __forceinline__ void pass_conv(Frame F, bf16_t* ug, int nrows, const float* cw, const float* cb) {
    F.lane = fresh_lane(); F.tid = (F.wave << 6) | F.lane;
    const long total = (long)nrows * (DFF / 8), stride = (long)F.G * NTHREADS;
    for (long it = (long)blockIdx.x * NTHREADS + F.tid; it < total; it += stride) {
        const int row = (int)(it / (DFF / 8)), c = (int)(it % (DFF / 8)) * 8;
        int pos, len; if (row < ML) { pos = row & 4095; len = SEQ; } else { pos = (row - ML) & 255; len = CTXL; }
        const bool hp = pos > 0, hn = pos < len - 1;
        bf16_t* up = ug + (size_t)row * NP + c;
        float u[8], gc[8], gp[8], gn[8];
        rwkv::ld8(up, u); rwkv::ld8(up + DFF, gc); rwkv::ld8(up + DFF - (hp ? NP : 0), gp); rwkv::ld8(up + DFF + (hn ? NP : 0), gn);
        float o[8];
        float w0[8], w1[8], w2[8], bb[8];
        { const f32x4 a = *(const f32x4*)(cw + c), b = *(const f32x4*)(cw + c + 4); w0[0]=a[0];w0[1]=a[1];w0[2]=a[2];w0[3]=a[3];w0[4]=b[0];w0[5]=b[1];w0[6]=b[2];w0[7]=b[3]; }
        { const f32x4 a = *(const f32x4*)(cw + DFF + c), b = *(const f32x4*)(cw + DFF + c + 4); w1[0]=a[0];w1[1]=a[1];w1[2]=a[2];w1[3]=a[3];w1[4]=b[0];w1[5]=b[1];w1[6]=b[2];w1[7]=b[3]; }
        { const f32x4 a = *(const f32x4*)(cw + 2 * DFF + c), b = *(const f32x4*)(cw + 2 * DFF + c + 4); w2[0]=a[0];w2[1]=a[1];w2[2]=a[2];w2[3]=a[3];w2[4]=b[0];w2[5]=b[1];w2[6]=b[2];w2[7]=b[3]; }
        { const f32x4 a = *(const f32x4*)(cb + c), b = *(const f32x4*)(cb + c + 4); bb[0]=a[0];bb[1]=a[1];bb[2]=a[2];bb[3]=a[3];bb[4]=b[0];bb[5]=b[1];bb[6]=b[2];bb[7]=b[3]; }
#pragma unroll
        for (int i = 0; i < 8; ++i) {
            const float x = w0[i] * (hp ? gp[i] : 0.f) + w1[i] * gc[i] + w2[i] * (hn ? gn[i] : 0.f) + bb[i];
            o[i] = gelu_fast(x) * u[i];
        }
        u32x4 w; w.x = cvt_pk_bf16(o[0], o[1]); w.y = cvt_pk_bf16(o[2], o[3]); w.z = cvt_pk_bf16(o[4], o[5]); w.w = cvt_pk_bf16(o[6], o[7]);
        *(u32x4*)up = w;
    }
}

__device__ __forceinline__ void ldf8(const float* p, float (&o)[8]) { const f32x4 a = *(const f32x4*)p, b = *(const f32x4*)(p + 4); o[0]=a[0];o[1]=a[1];o[2]=a[2];o[3]=a[3];o[4]=b[0];o[5]=b[1];o[6]=b[2];o[7]=b[3]; }
__device__ __forceinline__ void pass_sg(Frame F, bf16_t* co, int nrows, const float* mu) {
    F.lane = fresh_lane(); F.tid = (F.wave << 6) | F.lane;
    const int sub = F.lane >> 4, cl = (F.lane & 15) * 8;
    float m0[8], m1[8]; ldf8(mu + 1280 + 512 + cl, m0); ldf8(mu + 1920 + 1280 + 512 + cl, m1);
    for (int row = 4 * F.gw + sub; row < nrows; row += 4 * F.NGW) {
        int pos, len; if (row < ML) { pos = row & 4095; len = SEQ; } else { pos = (row - ML) & 255; len = CTXL; }
        const bool hp = pos > 0, hn = pos < len - 1;
        bf16_t* p = co + (size_t)row * DCOP + 512 + cl;
        float c[8], pv[8], nv[8], o[8]; rwkv::ld8(p, c); rwkv::ld8(p - (hp ? DCOP : 0), pv); rwkv::ld8(p + (hn ? DCOP : 0), nv);
#pragma unroll
        for (int i = 0; i < 8; ++i) { const float a = hp ? pv[i] : 0.f, b = hn ? nv[i] : 0.f; o[i] = sigmoidf_(c[i] + m0[i] * (a - c[i]) + m1[i] * (b - c[i])); }
        u32x4 w; w.x = cvt_pk_bf16(o[0], o[1]); w.y = cvt_pk_bf16(o[2], o[3]); w.z = cvt_pk_bf16(o[4], o[5]); w.w = cvt_pk_bf16(o[6], o[7]);
        *(u32x4*)(p + (DCO - 512)) = w;
    }
}
struct PostRow { u32x4 a0, a1, gg, vc, vp, vn; float bsum; };
__device__ __forceinline__ void post_load(PostRow& R, int row, int c, int head, const bf16_t* y0, const bf16_t* y1, const bf16_t* g, const bf16_t* cs, const float* bon) {
    int pos, len; if (row < ML) { pos = row & 4095; len = SEQ; } else { pos = (row - ML) & 255; len = CTXL; }
    const bool hp = pos > 0, hn = pos < len - 1; const size_t o = (size_t)row * 512 + c;
    R.a0 = *(const u32x4*)(y0 + o); R.a1 = *(const u32x4*)(y1 + o); R.gg = *(const u32x4*)(g + o);
    const bf16_t* vq = cs + (size_t)row * DCS + 512 + c;
    R.vc = *(const u32x4*)vq; R.vp = *(const u32x4*)(vq - (hp ? DCS : 0)); R.vn = *(const u32x4*)(vq + (hn ? DCS : 0));
    if (!hp) R.vp = (u32x4){0u, 0u, 0u, 0u}; if (!hn) R.vn = (u32x4){0u, 0u, 0u, 0u};
    R.bsum = bon[(size_t)row * 8 + head] + bon[(size_t)MT * 8 + (size_t)row * 8 + head];
}
__device__ __forceinline__ void up8(const u32x4 w, float (&o)[8]) { o[0] = bflo(w.x); o[1] = bfhi(w.x); o[2] = bflo(w.y); o[3] = bfhi(w.y); o[4] = bflo(w.z); o[5] = bfhi(w.z); o[6] = bflo(w.w); o[7] = bfhi(w.w); }
__device__ __forceinline__ u32x4 post_finish(const PostRow& R, const float (&lw)[8], const float (&lb)[8], const float (&m0)[8], const float (&m1)[8]) {
    float y[8], t[8], gv[8], vc[8], vp[8], vn[8]; up8(R.a0, y); up8(R.a1, t); up8(R.gg, gv); up8(R.vc, vc); up8(R.vp, vp); up8(R.vn, vn);
    float s = 0.f;
#pragma unroll
    for (int i = 0; i < 8; ++i) { y[i] += t[i]; s += y[i]; }
    s += __shfl_xor(s, 1); s += __shfl_xor(s, 2); s += __shfl_xor(s, 4);
    const float mean = s * (1.f / 64.f); float q = 0.f;
#pragma unroll
    for (int i = 0; i < 8; ++i) { y[i] -= mean; q += y[i] * y[i]; }
    q += __shfl_xor(q, 1); q += __shfl_xor(q, 2); q += __shfl_xor(q, 4);
    const float rstd = 1.0f / sqrtf(q * (1.f / 64.f) + 64.f * 1e-5f);
#pragma unroll
    for (int i = 0; i < 8; ++i) { const float vs = vc[i] + m0[i] * (vp[i] - vc[i]) + m1[i] * (vn[i] - vc[i]); y[i] = (y[i] * rstd * lw[i] + lb[i] + R.bsum * vs) * gv[i]; }
    u32x4 w; w.x = cvt_pk_bf16(y[0], y[1]); w.y = cvt_pk_bf16(y[2], y[3]); w.z = cvt_pk_bf16(y[4], y[5]); w.w = cvt_pk_bf16(y[6], y[7]);
    return w;
}
__device__ __forceinline__ void pass_post(Frame F, int nrows, bf16_t* y0, const bf16_t* y1, const bf16_t* g, const bf16_t* cs, const float* bon, const float* mu, const float* lnw, const float* lnb) {
    F.lane = fresh_lane(); F.tid = (F.wave << 6) | F.lane;
    const int c = 8 * F.lane, head = F.lane >> 3;
    float lw[8], lb[8], m0[8], m1[8]; ldf8(lnw + c, lw); ldf8(lnb + c, lb); ldf8(mu + 512 + c, m0); ldf8(mu + 1920 + 512 + c, m1);
    for (int row0 = F.gw; row0 < nrows; row0 += 2 * F.NGW) {
        const int row1 = row0 + F.NGW; const bool two = row1 < nrows; const int rowb = two ? row1 : row0;
        PostRow A, B; post_load(A, row0, c, head, y0, y1, g, cs, bon); post_load(B, rowb, c, head, y0, y1, g, cs, bon);
        const u32x4 wa = post_finish(A, lw, lb, m0, m1), wb = post_finish(B, lw, lb, m0, m1);
        *(u32x4*)(y0 + (size_t)row0 * 512 + c) = wa; if (two) *(u32x4*)(y0 + (size_t)row1 * 512 + c) = wb;
    }
}

__device__ __forceinline__ unsigned f2bf(float f) { unsigned u = __builtin_bit_cast(unsigned, f); return (u + 0x7fffu + ((u >> 16) & 1u)) >> 16; }
__device__ __forceinline__ unsigned pk2(float lo, float hi) { return f2bf(lo) | (f2bf(hi) << 16); }
__device__ __forceinline__ void transpose_item(const float* W, int K, int N, bf16_t* WT, int item, LAS float* scr, int lane, int rowadd_from, int rowadd) {
    const int nblk = N / 32, kb = item / nblk, nb = item % nblk, k0 = 64 * kb, n0 = 32 * nb;
    const int row_off = n0 >= rowadd_from ? rowadd : 0;
    float wv[32];
#pragma unroll
    for (int i = 0; i < 32; ++i) { const int kk = 2 * i + (lane >> 5); wv[i] = W[(size_t)(k0 + kk) * N + n0 + (lane & 31)]; }
#pragma unroll
    for (int i = 0; i < 32; ++i) { const int kk = 2 * i + (lane >> 5); scr[kk * 33 + (lane & 31)] = wv[i]; }
    LDS_WAIT(); asm volatile("" ::: "memory");
    const int c = lane & 7;
#pragma unroll
    for (int j = 0; j < 4; ++j) { const int n = (lane >> 3) + 8 * j; const LAS float* s = scr + (8 * c) * 33 + n;
        u32x4 o; o.x = pk2(s[0 * 33], s[1 * 33]); o.y = pk2(s[2 * 33], s[3 * 33]); o.z = pk2(s[4 * 33], s[5 * 33]); o.w = pk2(s[6 * 33], s[7 * 33]);
        *(GAS u32x4*)(WT + (size_t)(row_off + n0 + n) * K + k0 + 8 * c) = o; }
    LDS_WAIT(); asm volatile("" ::: "memory");
}
#define CONVERT_WEIGHTS(F, layer, INP) do { \
    convert_weights_((F), (layer), INP(I_WIN), INP(I_WPA), INP(I_WPF), INP(I_WPC), INP(I_WO), INP(I_FUP), INP(I_FDN), INP(I_G2)); } while (0)
__device__ __forceinline__ void convert_weights_(const Frame& F_, int layer, const float* p_win, const float* p_wpa, const float* p_wpf, const float* p_wpc, const float* p_wo, const float* p_fup, const float* p_fdn, const float* p_g2) {
    Frame F = F_; F.lane = fresh_lane(); F.tid = (F.wave << 6) | F.lane;
    LAS float* scr = (LAS float*)(F.lds + F.wave * 16384);
    constexpr int N_IN = 16 * (D_IN_SRC / 32), N_PA = 16 * 32, N_PF = 8 * 32, N_PC = 8 * 32, N_O = 16 * 32, N_UP = 16 * (2 * DFF / 32), N_DN = (DFF / 64) * 32, N_G2 = 2 * 16;
    constexpr int NITEMS = N_IN + N_PA + N_PF + N_PC + N_O + N_UP + N_DN + N_G2;
    unsigned char* ws = F.ws;
    for (int it = F.gw; it < NITEMS; it += F.NGW) {
        int r = it;
        if (r < N_IN) { transpose_item(p_win + (size_t)layer * DM * D_IN_SRC, DM, D_IN_SRC, (bf16_t*)(ws + W_IN), r, scr, F.lane, 5504, 128); continue; } r -= N_IN;
        if (r < N_PA) { transpose_item(p_wpa + (size_t)layer * 1024 * DM, 1024, DM, (bf16_t*)(ws + W_PA), r, scr, F.lane, 1 << 30, 0); continue; } r -= N_PA;
        if (r < N_PF) { transpose_item(p_wpf + (size_t)layer * 512 * DM, 512, DM, (bf16_t*)(ws + W_PF), r, scr, F.lane, 1 << 30, 0); continue; } r -= N_PF;
        if (r < N_PC) { transpose_item(p_wpc + (size_t)layer * 512 * DM, 512, DM, (bf16_t*)(ws + W_PC), r, scr, F.lane, 1 << 30, 0); continue; } r -= N_PC;
        if (r < N_O) { transpose_item(p_wo + (size_t)layer * DM * DM, DM, DM, (bf16_t*)(ws + W_O), r, scr, F.lane, 1 << 30, 0); continue; } r -= N_O;
        if (r < N_UP) { transpose_item(p_fup + (size_t)layer * DM * 2 * DFF, DM, 2 * DFF, (bf16_t*)(ws + W_UP), r, scr, F.lane, 1 << 30, 0); continue; } r -= N_UP;
        if (r < N_DN) { transpose_item(p_fdn + (size_t)layer * DFF * DM, DFF, DM, (bf16_t*)(ws + W_DN), r, scr, F.lane, 1 << 30, 0); continue; } r -= N_DN;
        transpose_item(p_g2 + (size_t)layer * 128 * 512, 128, 512, (bf16_t*)(ws + W_G2T), r, scr, F.lane, 1 << 30, 0);
    }
    { u32x4* z = (u32x4*)(ws + W_IN + (size_t)5504 * DM * 2); const int n16 = 128 * DM * 2 / 16;
      unsigned zz = 0u; asm volatile("" : "+v"(zz));
      for (int i = blockIdx.x * NTHREADS + F.tid; i < n16; i += F.G * NTHREADS) z[i] = (u32x4){zz, zz, zz, zz}; }
}
__device__ __forceinline__ void build_tables(Frame F, const float* lamqk) {
    F.lane = fresh_lane(); F.tid = (F.wave << 6) | F.lane;
    const int gt = blockIdx.x * NTHREADS + F.tid, NT_ = F.G * NTHREADS;
    float* rope = (float*)(F.ws + TAB_ROPE); float* tw = (float*)(F.ws + TAB_TW);
    bf16_t* w0 = (bf16_t*)(F.ws + TAB_W0); bf16_t* f1 = (bf16_t*)(F.ws + TAB_F1); bf16_t* f2 = (bf16_t*)(F.ws + TAB_F2); bf16_t* dc = (bf16_t*)(F.ws + TAB_DC);
    for (int i = gt; i < 1024; i += NT_) { const int pos = i >> 4, f = i & 15; const float inv = powf(10000.f, -(float)f / 16.f); const float ang = (float)pos * inv;
        rope[2 * i] = (float)cos((double)ang); rope[2 * i + 1] = (float)sin((double)ang); }
    for (int i = gt; i < 4096; i += NT_) { const int kl = i >> 6, tl = i & 63; float s, c; sincospif(2.f * (float)(kl * tl) / 4096.f, &s, &c); tw[2 * i] = c; tw[2 * i + 1] = s; }
    for (int i = gt; i < 256 * 128; i += NT_) { const int r = i >> 7, c = i & 127, ri = r >> 7, m = r & 127; float s, co; sincospif(2.f * (float)((m * c) & 127) / 128.f, &s, &co);
        w0[i] = (bf16_t)f2bf((ri == 0 ? co : -s) * 0.088388347648318f); }
    for (int i = gt; i < 256 * 256; i += NT_) { const int r = i >> 8, k = i & 255; const int rip = r >> 7, p = (r >> 6) & 1, kl = r & 63, ri = k >> 7, p2 = (k >> 6) & 1, th = k & 63;
        float s, co; sincospif(2.f * (float)((kl * th) & 63) / 64.f, &s, &co);
        float v = 0.f; if (p == p2) v = (rip == ri) ? co : (rip == 0 ? s : -s);
        f1[i] = (bf16_t)f2bf(v * 0.125f); }
    for (int i = gt; i < 256 * 512; i += NT_) { const int r = i >> 9, k = i & 511; const int pp = r >> 6, kh = r & 63, rip = k >> 8, p2 = (k >> 6) & 3, tl = k & 63;
        float s, co; sincospif(2.f * (float)((kh * tl) & 63) / 64.f, &s, &co);
        const float v = (pp == p2) ? (rip == 0 ? co : s) : 0.f;
        f2[i] = (bf16_t)f2bf(v * 0.125f); }
    for (int i = gt; i < 256 * 512; i += NT_) { const int k = i >> 9, kk = i & 511, ri = kk >> 8, t = kk & 255;
        float s, co; sincospif(2.f * (float)((k * t) & 255) / 256.f, &s, &co);
        dc[i] = (bf16_t)f2bf((ri == 0 ? co : s) * 0.0625f); }
    if (gt < NLAYER) {
        const float* lq = lamqk + gt * 256; float s1 = 0.f, s2 = 0.f;
        for (int i = 0; i < 64; ++i) { s1 += lq[i] * lq[64 + i]; s2 += lq[128 + i] * lq[192 + i]; }
        const float lam_init = 0.8f - 0.6f * expf(-0.3f * (float)gt);
        float* lamv = (float*)(F.ws + TAB_LAM); lamv[2 * gt] = expf(s1) - expf(s2) + lam_init; lamv[2 * gt + 1] = 1.f - lam_init;
    }
}
__device__ __forceinline__ void build_mod(Frame F, const float* cvec, const float* cctx, const float* adaw, const float* adab) {
    F.lane = fresh_lane(); F.tid = (F.wave << 6) | F.lane;
    LAS float* sil = (LAS float*)F.lds;
    LAS float* part = sil + 5 * 1024;
    for (int i = F.tid; i < 5 * 1024; i += NTHREADS) { const int s = i >> 10, k = i & 1023; const float c = s < 4 ? cvec[s * 1024 + k] : cctx[k]; sil[i] = c / (1.f + expf(-c)); }
    __syncthreads();
    for (int cgid = blockIdx.x; cgid < 256; cgid += F.G) {
        const int l = cgid >> 7, j0 = (cgid & 127) * 48;
        if (F.tid < 384) { const int col = F.tid % 48, kg = F.tid / 48; const float* w = adaw + ((size_t)l * 1024 + 128 * kg) * 6144 + j0 + col;
            float a0 = 0.f, a1 = 0.f, a2 = 0.f, a3 = 0.f, a4 = 0.f;
            for (int k = 0; k < 128; ++k) { const float wv = w[(size_t)k * 6144]; const int kk = 128 * kg + k;
                a0 += sil[kk] * wv; a1 += sil[1024 + kk] * wv; a2 += sil[2048 + kk] * wv; a3 += sil[3072 + kk] * wv; a4 += sil[4096 + kk] * wv; }
            part[(kg * 5 + 0) * 48 + col] = a0; part[(kg * 5 + 1) * 48 + col] = a1; part[(kg * 5 + 2) * 48 + col] = a2; part[(kg * 5 + 3) * 48 + col] = a3; part[(kg * 5 + 4) * 48 + col] = a4; }
        __syncthreads();
        if (F.tid < 240) { const int s = F.tid / 48, col = F.tid % 48; float a = adab[l * 6144 + j0 + col];
            for (int kg = 0; kg < 8; ++kg) a += part[(kg * 5 + s) * 48 + col];
            ((float*)(F.ws + TAB_MOD))[((size_t)l * 5 + s) * 6144 + j0 + col] = a; }
        __syncthreads();
    }
}
#ifndef MK_PER_PHASE
#define MK_PER_PHASE 0
#endif
#ifndef TIME_SEL
#define TIME_SEL 0
#endif
constexpr int N_PHASES = 2 + 13 * NLAYER;
#ifndef SCAN_SEL
#define SCAN_SEL(bx) ((((bx) >> 3) & 3) == 0 && ((bx) >> 5) < 8)
#define SCAN_SID(bx) (((bx) >> 5) * 8 + ((bx) & 7))
#define SCAN_RANK(bx) ((bx) - 8 * (((bx) >> 5) + 1))
#endif
struct Args { const float* in[32]; float* out; unsigned char* ws; int ph_lo, ph_hi; };

__device__ __forceinline__ pg8::Operand opnd(const void* base, long tM, long tN, long rstride, long kstep) {
    pg8::Operand o; o.base = (const char*)base; o.tM = tM; o.tN = tN; o.tN2 = 0; o.nshift = 30; o.rstride = rstride; o.hstep = 128 * rstride; o.kstep = kstep; return o; }
constexpr int CW_SUB = 2048;
__device__ __forceinline__ void sub_arrive_wait(gu32* cnt, unsigned add, unsigned target, bool t0) {
    asm volatile("s_waitcnt vmcnt(0)" ::: "memory"); __syncthreads();
    if (t0) {
        __builtin_amdgcn_fence(__ATOMIC_RELEASE, "agent"); asm volatile("s_waitcnt vmcnt(0)" ::: "memory");
        if (add) (void)__hip_atomic_fetch_add(cnt, add, RLX_AGENT);
        unsigned sp = 0; while (__hip_atomic_load(cnt, RLX_AGENT) < target) { __builtin_amdgcn_s_sleep(2); if (++sp > (1u << 24)) break; }
        __builtin_amdgcn_fence(__ATOMIC_ACQUIRE, "agent"); asm volatile("s_waitcnt vmcnt(0)" ::: "memory");
    }
    __syncthreads();
}
struct RowF0 { __device__ __forceinline__ unsigned operator()(int R) const { return (unsigned)(((R & 63) * 64 + (R >> 6)) * 1024); } };

__global__ void __launch_bounds__(NTHREADS, 2) mk_fwd(Args args) {
    extern __shared__ __attribute__((aligned(16))) unsigned char lds[];
    Frame F;
    F.lds = (LAS unsigned char*)lds; F.ldsg = (char*)lds;
    F.MISC = (volatile LAS unsigned*)(F.lds + MISC_OFF);
    F.tid = threadIdx.x; F.lane = F.tid & 63; F.wave = __builtin_amdgcn_readfirstlane(F.tid >> 6);
    F.G = gridDim.x; F.gw = blockIdx.x * NWAVES + F.wave; F.NGW = F.G * NWAVES;
    F.x_in = args.in[I_X]; F.ctx_in = args.in[I_CTX];
    F.out = args.out; F.ws = args.ws; F.ctl = (gu32*)(args.ws + WS_CTL);
    unsigned char* ws0 = args.ws;
#define T0 (fresh_tid(F.wave) == 0)
#ifndef CH_WG
#define CH_WG 8
#endif
#define CH_T(k) do { if ((TIME_SEL >> 20) != 0) { if (blockIdx.x == CH_WG && T0) { const unsigned long long tn_ = __builtin_amdgcn_s_memrealtime(); const unsigned long long tp_ = ((unsigned long long)F.MISC[21] << 32) | F.MISC[20]; if ((TIME_SEL >> (20 + (k))) & 1) { const unsigned long long ac_ = (((unsigned long long)F.MISC[19] << 32) | F.MISC[18]) + (tn_ - tp_); F.MISC[18] = (unsigned)ac_; F.MISC[19] = (unsigned)(ac_ >> 32); } F.MISC[20] = (unsigned)tn_; F.MISC[21] = (unsigned)(tn_ >> 32); } } } while (0)
#define LWS size_t wo_ = 0; int bx = bx0, G = G0; asm volatile("" : "+s"(wo_), "+s"(bx), "+s"(G)); unsigned char* ws = ws0 + wo_
    for (int u = F.tid; u < (LDS_BYTES - LDSCTL_OFF) / 4; u += NTHREADS) ((LAS unsigned*)(F.lds + LDSCTL_OFF))[u] = 0u;
    __syncthreads();
    XcdBarrier bar; bar.bar = (unsigned*)(F.ctl + CW_BAR); bar.x = 0; bar.st = nullptr;
    if (!MK_PER_PHASE) bar = xcd_barrier_post((unsigned*)(F.ctl + CW_BAR), F.MISC + 8);
    const int lo = args.ph_lo, hi = args.ph_hi;
    if (TIME_SEL) { if (blockIdx.x == 0 && T0) { const unsigned long long tn_ = __builtin_amdgcn_s_memrealtime(); F.MISC[16] = (unsigned)tn_; F.MISC[17] = (unsigned)(tn_ >> 32); } }
#ifndef PHMASK
#define PHMASK 0x7fff
#endif
#define IN(k) (lo <= (k) && (k) < hi)
#define KIND(b) ((PHMASK >> (b)) & 1)
#define INP(i) (args.in[i])
#define SEAM(k) do { if (!MK_PER_PHASE && IN((k) + 1)) xcd_barrier(bar.bar, bar.x, bar.st, T0 ? 1u : 0u); \
    if (TIME_SEL) { if (blockIdx.x == 0 && T0) { const unsigned long long tn_ = __builtin_amdgcn_s_memrealtime(); const unsigned long long tp_ = ((unsigned long long)F.MISC[17] << 32) | F.MISC[16]; \
        const int kind_ = (k) < 2 ? (k) : 2 + ((k) - 2) % 13; if ((TIME_SEL >> kind_) & 1) { const unsigned long long ac_ = (((unsigned long long)F.MISC[19] << 32) | F.MISC[18]) + (tn_ - tp_); F.MISC[18] = (unsigned)ac_; F.MISC[19] = (unsigned)(ac_ >> 32); } \
        F.MISC[16] = (unsigned)tn_; F.MISC[17] = (unsigned)(tn_ >> 32); } } } while (0)
    const int bx0 = blockIdx.x, G0 = F.G;
    pg8::StaticOrder S; S.wave = F.wave;
    const pg8::RowLin rl2048{2048}, rl1024{1024}, rl128{128}, rl256{256}, rl11264{11264}, rl5632{5632};

    if (KIND(0) && IN(0)) { LWS; build_mod(F, INP(I_C), INP(I_CCTX), INP(I_ADAW), INP(I_ADAB)); __syncthreads(); build_tables(F, INP(I_LAMQK)); CONVERT_WEIGHTS(F, 0, INP); SEAM(0); }
    if (KIND(1) && IN(1)) { LWS; pass_modulate(F, 0, (bf16_t*)(ws + WS_HY), MT); SEAM(1); }

#pragma unroll 1
    for (int layer = 0; layer < NLAYER; ++layer) {
        const int pb = 2 + 13 * layer;
        const bool last = layer == NLAYER - 1;
        const int MR = last ? ML : MT;

        if (KIND(2) && IN(pb + 0)) { LWS;
            S.init(MT, NP, G, bx);
            pg8::EpiInProj E{ws, (const float*)(ws + TAB_ROPE)};
            pg8::gemm_phase<pg8::EpiInProj, pg8::RowLin, true>(F.lds, opnd(ws + WS_HY, 256 * 2048, 0, 2048, 128), opnd(ws + W_IN, 0, 256 * 2048, 2048, 128), rl2048, 16, S, E);
            SEAM(pb + 0);
        }
        if (KIND(3) && IN(pb + 1)) { LWS;
#ifndef DBG_NO_SCAN
            if (SCAN_SEL(bx)) {
                const int sid = SCAN_SID(bx);
                rwkv::Params P; P.cs = (const bf16_t*)(ws + P_CS); P.co = (bf16_t*)(ws + P_CO); P.y = (bf16_t*)(ws + WS_HY); P.bon = (float*)(ws + WS_BON);
                P.mu = INP(I_MU) + layer * 2 * 1920; P.w0 = INP(I_W0) + layer * 1024; P.w2 = INP(I_W2) + (size_t)layer * 2 * 64 * 512; P.a0 = INP(I_A0) + layer * 1024;
                P.a2 = INP(I_A2) + (size_t)layer * 2 * 64 * 512; P.kk = INP(I_KK) + layer * 512; P.ka = INP(I_KA) + layer * 512; P.rk = INP(I_RK) + layer * 512;
                unsigned long long ts0_ = 0; if ((TIME_SEL >> 16) & 1) ts0_ = __builtin_amdgcn_s_memrealtime();
                rwkv::scan_wg(P, sid >> 5, (sid >> 3) & 3, sid & 7, (LAS char*)F.lds, F.wave);
                if ((TIME_SEL >> 16) & 1) { if (blockIdx.x == 0 && T0) { const unsigned long long ac_ = (((unsigned long long)F.MISC[19] << 32) | F.MISC[18]) + (__builtin_amdgcn_s_memrealtime() - ts0_); F.MISC[18] = (unsigned)ac_; F.MISC[19] = (unsigned)(ac_ >> 32); } }
            }
#endif
            unsigned long long ta0_ = 0; if ((TIME_SEL >> 17) & 1) ta0_ = __builtin_amdgcn_s_memrealtime();
            if ((TIME_SEL >> 20) != 0) { if (blockIdx.x == CH_WG && T0) { const unsigned long long tn_ = __builtin_amdgcn_s_memrealtime(); F.MISC[20] = (unsigned)tn_; F.MISC[21] = (unsigned)(tn_ >> 32); } }
#if 0
#endif
            const float* tabf = (const float*)(ws + TAB_LAM); const float lam = tabf[2 * layer], osc = tabf[2 * layer + 1];
            const int x = bx & 7, nun = last ? 64 : 68;
            gu32* qw = F.ctl + CW_QUEUE + 64 * (layer * 8 + x);
#ifndef DBG_NO_ATTN
            unsigned ndone = 0;
            for (;;) {
                __syncthreads();
                if (T0) F.MISC[0] = __hip_atomic_fetch_add(qw, 1u, RLX_AGENT);
                __syncthreads();
                const int i = (int)F.MISC[0];
                if (i >= nun) break;
                ++ndone;
                const bf16_t* Q = (const bf16_t*)(ws + P_Q); const bf16_t* K = (const bf16_t*)(ws + P_K); const bf16_t* V = (const bf16_t*)(ws + P_V);
                const float* sub = INP(I_SUBLN) + layer * 128; const float* rope = (const float*)(ws + TAB_ROPE);
                if (i < 64) { const int pair = x + 8 * (i >> 4), qb = i & 15, b = pair >> 3, hh = pair & 7;
                    attn::attn_unit<true>(Q, K, V, (bf16_t*)(ws + P_Q), b * SEQ + 256 * qb, b, hh, lam, osc, sub, rope, (LAS char*)F.lds, F.wave); }
                else { const int pair = x + 8 * (i - 64), b = pair >> 3, hh = pair & 7;
#ifndef DBG_NO_ATTNC
                    attn::attn_unit<false>(Q, K, V, (bf16_t*)(ws + P_Q), ML + b * CTXL, b, hh, lam, osc, sub, rope, (LAS char*)F.lds, F.wave);
#endif
                }
            }
#endif
            CH_T(0);
            {
                const bool is_scan = SCAN_SEL(bx);
                gu32* dcnt = F.ctl + CW_SUB + 64 * (layer * 4 + 0);
                const unsigned total = 8u * (unsigned)nun;
                if (is_scan || G != 256) { sub_arrive_wait(dcnt, ndone, 0u, T0); }
                else {
                    const int rank = SCAN_RANK(bx), GF = 192;
                    { Frame F2 = F; F2.gw = rank * NWAVES + F.wave; F2.NGW = GF * NWAVES;
                      pass_sg(F2, (bf16_t*)(ws + P_CO), MR, INP(I_MU) + layer * 2 * 1920); }
                    sub_arrive_wait(dcnt, ndone, total, T0); CH_T(1);
                    { S.init(1024, ML, GF, rank); pg8::EpiF0 E{(bf16_t*)(ws + P_K)};
                      pg8::Operand B = opnd(ws + P_F, 256, 4 * 1024, 1024, 128); B.nshift = 4; B.tN2 = 4096L * 1024; B.hstep = 2 * 1024;
                      pg8::gemm_phase<pg8::EpiF0, RowF0, true>(F.lds, opnd(ws + TAB_W0, 0, 0, 256, 128), B, RowF0{}, 2, S, E); }
                    if (!last) { S.init(1024, MC, GF, (rank + GF - 64) % GF); pg8::EpiF0c E{(bf16_t*)(ws + P_K + 32 * MiB)};
                      pg8::gemm_phase<pg8::EpiF0c, pg8::RowLin, true>(F.lds, opnd(ws + TAB_W0, 0, 0, 256, 128), opnd(ws + P_F + (size_t)ML * 1024, 256, 256 * 1024, 1024, 128), rl1024, 2, S, E); }
                    sub_arrive_wait(F.ctl + CW_SUB + 64 * (layer * 4 + 1), 1u, (unsigned)GF, T0); CH_T(4);
                    { S.init(256, 65536, GF, rank); pg8::EpiF1 E{(bf16_t*)(ws + P_V), (const float*)(ws + TAB_TW)};
                      pg8::gemm_phase<pg8::EpiF1, pg8::RowLin, true>(F.lds, opnd(ws + TAB_F1, 0, 0, 512, 128), opnd(ws + P_K, 0, 256 * 128, 128, 8 * MiB), rl128, 4, S, E); }
                    if (!last) { S.init(256, 2048, GF, (rank + GF - 72) % GF); pg8::EpiFc E{(bf16_t*)(ws + P_F)};
                      pg8::gemm_phase<pg8::EpiFc, pg8::RowLin, true>(F.lds, opnd(ws + TAB_DC, 0, 0, 1024, 128), opnd(ws + P_K + 32 * MiB, 0, 256 * 1024, 1024, 128), rl1024, 8, S, E); }
                    sub_arrive_wait(F.ctl + CW_SUB + 64 * (layer * 4 + 2), 1u, (unsigned)GF, T0); CH_T(5);
                    { S.init(256, 32768, GF, rank); pg8::EpiF2 E{(bf16_t*)(ws + P_F)};
                      pg8::gemm_phase<pg8::EpiF2, pg8::RowLin, true>(F.lds, opnd(ws + TAB_F2, 0, 0, 1024, 128), opnd(ws + P_V, 0, 256 * 128, 128, 4 * MiB), rl128, 8, S, E); }
                    sub_arrive_wait(F.ctl + CW_SUB + 64 * (layer * 4 + 3), 1u, (unsigned)GF, T0); CH_T(2);
                    { S.init(MR, 512, GF, rank); pg8::EpiBf16 E{(bf16_t*)(ws + P_V), 512};
                      pg8::gemm_phase<pg8::EpiBf16, pg8::RowLin, true>(F.lds, opnd(ws + P_CO + DCO * 2, 256 * 1536, 0, 1536, 128), opnd(ws + W_G2T, 0, 256 * 256, 256, 128), rl256, 2, S, E); }
                    {
                        Frame F2 = F; F2.gw = rank * NWAVES + F.wave; F2.NGW = GF * NWAVES;
                        pass_modulate(F2, layer, (bf16_t*)(ws + P_K), MR); }
                    CH_T(3);
                }
            }
            if ((TIME_SEL >> 17) & 1) { if (blockIdx.x == 8 && T0) { const unsigned long long ac_ = (((unsigned long long)F.MISC[19] << 32) | F.MISC[18]) + (__builtin_amdgcn_s_memrealtime() - ta0_); F.MISC[18] = (unsigned)ac_; F.MISC[19] = (unsigned)(ac_ >> 32); } }
            SEAM(pb + 1); CH_T(6);
        }
        if (KIND(4) && IN(pb + 2)) { LWS;
          if (G != 256) {
            { S.init(1024, ML, G, bx); pg8::EpiF0 E{(bf16_t*)(ws + P_K)};
              pg8::Operand B = opnd(ws + P_F, 256, 4 * 1024, 1024, 128); B.nshift = 4; B.tN2 = 4096L * 1024; B.hstep = 2 * 1024;
              pg8::gemm_phase<pg8::EpiF0, RowF0, true>(F.lds, opnd(ws + TAB_W0, 0, 0, 256, 128), B, RowF0{}, 2, S, E); }
            if (!last) { S.init(1024, MC, G, (bx + G - 16) % G); pg8::EpiF0c E{(bf16_t*)(ws + P_K + 32 * MiB)};
              pg8::gemm_phase<pg8::EpiF0c, pg8::RowLin, true>(F.lds, opnd(ws + TAB_W0, 0, 0, 256, 128), opnd(ws + P_F + (size_t)ML * 1024, 256, 256 * 1024, 1024, 128), rl1024, 2, S, E); }
          }
            if (G != 256) { pass_sg(F, (bf16_t*)(ws + P_CO), MR, INP(I_MU) + layer * 2 * 1920); SEAM(pb + 2); }
        }
        if (KIND(5) && IN(pb + 3)) { LWS;
          if (G != 256) {
            { S.init(256, 65536, G, bx); pg8::EpiF1 E{(bf16_t*)(ws + P_V), (const float*)(ws + TAB_TW)};
              pg8::gemm_phase<pg8::EpiF1, pg8::RowLin, true>(F.lds, opnd(ws + TAB_F1, 0, 0, 512, 128), opnd(ws + P_K, 0, 256 * 128, 128, 8 * MiB), rl128, 4, S, E); }
            if (!last) { S.init(256, 2048, G, (bx + G - 8) % G); pg8::EpiFc E{(bf16_t*)(ws + P_F)};
              pg8::gemm_phase<pg8::EpiFc, pg8::RowLin, true>(F.lds, opnd(ws + TAB_DC, 0, 0, 1024, 128), opnd(ws + P_K + 32 * MiB, 0, 256 * 1024, 1024, 128), rl1024, 8, S, E); }
          }
            if (G != 256) SEAM(pb + 3);
        }
        if (KIND(6) && IN(pb + 4)) { LWS;
            if (G != 256) { S.init(256, 32768, G, bx); pg8::EpiF2 E{(bf16_t*)(ws + P_F)};
              pg8::gemm_phase<pg8::EpiF2, pg8::RowLin, true>(F.lds, opnd(ws + TAB_F2, 0, 0, 1024, 128), opnd(ws + P_V, 0, 256 * 128, 128, 4 * MiB), rl128, 8, S, E); }
            if (G != 256) { S.init(MR, 512, G, bx);
              pg8::EpiRwkvPost E{(const bf16_t*)(ws + WS_HY), (const bf16_t*)(ws + WS_HY) + (size_t)MT * 512, (const bf16_t*)(ws + P_CS), (const float*)(ws + WS_BON),
                                 INP(I_MU) + layer * 2 * 1920, INP(I_LNW) + layer * 512, INP(I_LNB) + layer * 512, (bf16_t*)(ws + WS_HY)};
              pg8::gemm_phase<pg8::EpiRwkvPost, pg8::RowLin, false>(F.lds, opnd(ws + P_CO + DCO * 2, 256 * 1536, 0, 1536, 128), opnd(ws + W_G2T, 0, 256 * 256, 256, 128), rl256, 2, S, E); }
            else pass_post(F, MR, (bf16_t*)(ws + WS_HY), (const bf16_t*)(ws + WS_HY) + (size_t)MT * 512, (const bf16_t*)(ws + P_V), (const bf16_t*)(ws + P_CS), (const float*)(ws + WS_BON),
                           INP(I_MU) + layer * 2 * 1920, INP(I_LNW) + layer * 512, INP(I_LNB) + layer * 512);
            if (G != 256) pass_modulate(F, layer, (bf16_t*)(ws + P_K), MR);
            SEAM(pb + 4);
        }
        if (KIND(7) && IN(pb + 5)) { LWS;
            S.init(MR, NGATE, G, bx); pg8::EpiGate E{(bf16_t*)(ws + P_V)};
            pg8::gemm_phase<pg8::EpiGate, pg8::RowLin, true>(F.lds, opnd(ws + P_K, 256 * 2048, 0, 2048, 128), opnd(ws + W_IN + (size_t)NP * 2048, 0, 256 * 2048, 2048, 128), rl2048, 16, S, E);
            SEAM(pb + 5);
        }
        if (KIND(8) && IN(pb + 6)) { LWS;
            S.init(MR, 1024, G, bx);
            { pg8::EpiBranch<true> E{(const bf16_t*)(ws + P_V), (bf16_t*)(ws + P_K), (DBG_BR & 1) ? 1.f : 0.f};
              pg8::gemm_phase<pg8::EpiBranch<true>, pg8::RowLin, true>(F.lds, opnd(ws + P_Q, 256 * 2048, 0, 2048, 128), opnd(ws + W_PA, 0, 256 * 2048, 2048, 128), rl2048, 16, S, E); }
            VM_WAIT();
            { pg8::EpiBranch<false> E{(const bf16_t*)(ws + P_V) + 1024, (bf16_t*)(ws + P_K), (DBG_BR & 2) ? 1.f : 0.f};
              pg8::gemm_phase<pg8::EpiBranch<false>, pg8::RowLin, true>(F.lds, opnd(ws + P_F, 256 * 1024, 0, 1024, 128), opnd(ws + W_PF, 0, 256 * 1024, 1024, 128), rl1024, 8, S, E); }
            VM_WAIT();
            { pg8::EpiBranch<false> E{(const bf16_t*)(ws + P_V) + 2048, (bf16_t*)(ws + P_K), (DBG_BR & 4) ? 1.f : 0.f};
              pg8::gemm_phase<pg8::EpiBranch<false>, pg8::RowLin, true>(F.lds, opnd(ws + WS_HY, 256 * 1024, 0, 1024, 128), opnd(ws + W_PC, 0, 256 * 1024, 1024, 128), rl1024, 8, S, E); }
            SEAM(pb + 6);
        }
        if (KIND(9) && IN(pb + 7)) { LWS;
            S.init(MR, 1024, G, bx); pg8::EpiBf16 E{(bf16_t*)(ws + P_V), 1024};
            pg8::gemm_phase<pg8::EpiBf16, pg8::RowLin, true>(F.lds, opnd(ws + P_K, 256 * 2048, 0, 2048, 128), opnd(ws + W_O, 0, 256 * 2048, 2048, 128), rl2048, 16, S, E);
            SEAM(pb + 7);
        }
        if (KIND(10) && IN(pb + 8)) { LWS; pass_ln1(F, layer, (const bf16_t*)(ws + P_V), (bf16_t*)(ws + WS_HY), MR, INP(I_LN1G) + layer * DM, INP(I_LN1B) + layer * DM); SEAM(pb + 8); }
        if (KIND(11) && IN(pb + 9)) { LWS;
            S.init(MR, NP, G, bx); pg8::EpiBf16 E{(bf16_t*)(ws + WS_P), NP};
            pg8::gemm_phase<pg8::EpiBf16, pg8::RowLin, true>(F.lds, opnd(ws + WS_HY, 256 * 2048, 0, 2048, 128), opnd(ws + W_UP, 0, 256 * 2048, 2048, 128), rl2048, 16, S, E);
            SEAM(pb + 9);
        }
        if (KIND(12) && IN(pb + 10)) { LWS; pass_conv(F, (bf16_t*)(ws + WS_P), MR, INP(I_FCONV) + (size_t)layer * 3 * DFF, INP(I_FCONVB) + (size_t)layer * DFF); SEAM(pb + 10); }
        if (KIND(13) && IN(pb + 11)) { LWS;
            S.init(MR, 1024, G, bx); pg8::EpiBf16 E{(bf16_t*)(ws + WS_HY), 1024};
            pg8::gemm_phase<pg8::EpiBf16, pg8::RowLin, true>(F.lds, opnd(ws + WS_P, 256 * 11264, 0, 11264, 128), opnd(ws + W_DN, 0, 256 * 5632, 5632, 128), rl5632, 44, S, E);
            SEAM(pb + 11);
        }
        if (KIND(14) && IN(pb + 12)) { LWS;
            pass_ln2(F, layer, (bf16_t*)(ws + WS_HY), MR, !last, INP(I_LN2G) + layer * DM, INP(I_LN2B) + layer * DM);
            if (!last) { __syncthreads(); CONVERT_WEIGHTS(F, layer + 1, INP); }
            SEAM(pb + 12);
        }
    }
    if (TIME_SEL || SCAN_TSEL != 0) { if ((blockIdx.x == 0 || blockIdx.x == 8 || blockIdx.x == CH_WG) && T0) { const unsigned long long ac_ = ((unsigned long long)F.MISC[19] << 32) | F.MISC[18]; const unsigned long long t0_ = __builtin_amdgcn_s_memrealtime(); while (__builtin_amdgcn_s_memrealtime() - t0_ < ac_) __builtin_amdgcn_s_sleep(8); } }
#undef IN
#undef SEAM
}

extern "C" void kernel_launch(void* const* d_in, const int* in_sizes, int n_in, void* d_out, int out_size, void* d_ws, size_t ws_size, hipStream_t stream) {
    static int grid = 0;
    if (grid == 0) {
        if (n_in != 32 || in_sizes[0] != ML * DM || out_size != ML * DM || ws_size < WS_END) { fprintf(stderr, "kernel_launch: unexpected shapes (n_in %d, ws %zu)\n", n_in, ws_size); grid = -1; return; }
        int dev = 0, cus = 0, per_cu = 0;
        if (hipGetDevice(&dev) != hipSuccess || hipDeviceGetAttribute(&cus, hipDeviceAttributeMultiprocessorCount, dev) != hipSuccess) { grid = -1; return; }
        if (hipFuncSetAttribute((const void*)mk_fwd, hipFuncAttributeMaxDynamicSharedMemorySize, LDS_BYTES) != hipSuccess) { fprintf(stderr, "kernel_launch: hipFuncSetAttribute failed\n"); grid = -1; return; }
        if (hipOccupancyMaxActiveBlocksPerMultiprocessor(&per_cu, (const void*)mk_fwd, NTHREADS, LDS_BYTES) != hipSuccess || per_cu < 1) { fprintf(stderr, "kernel_launch: occupancy query says %d\n", per_cu); per_cu = 1; }
        (void)hipGetLastError();
        grid = cus;
        if (grid < 256 || (grid % 8) != 0) fprintf(stderr, "kernel_launch: grid %d\n", grid);
    }
    if (grid < 0) return;
    (void)hipMemsetAsync((char*)d_ws + WS_CTL, 0, CTL_ZERO_BYTES, stream);
    Args a{};
    for (int i = 0; i < 32; ++i) a.in[i] = (const float*)d_in[i];
    a.out = (float*)d_out; a.ws = (unsigned char*)d_ws;
#if MK_PER_PHASE
    unsigned char* ws8 = (unsigned char*)d_ws; (void)ws8;
    for (int p = 0; p < N_PHASES; ++p) {
#if defined(DBG_CHECK)
        if (DBG_CHECK == 14 && p == 7 + 13 * DBG_LAYER) hipLaunchKernelGGL(dbg_fill, dim3(2048), dim3(256), 0, stream, (unsigned char*)d_ws);
        if (DBG_CHECK == 1 && p == 3 + 13 * DBG_LAYER) hipLaunchKernelGGL(dbg_pre, dim3(2048), dim3(256), 0, stream, (unsigned char*)d_ws, (float*)d_out);
#endif
        a.ph_lo = p; a.ph_hi = p + 1; hipLaunchKernelGGL(mk_fwd, dim3(grid), dim3(NTHREADS), LDS_BYTES, stream, a);
#if defined(DBG_CHECK)
#ifndef DBG_LAYER
#define DBG_LAYER 0
#endif
        if (DBG_CHECK == 2 && p == 2 + 13 * DBG_LAYER) hipLaunchKernelGGL(dbg_inproj, dim3(9), dim3(64), 0, stream, (unsigned char*)d_ws, (const float*)d_in[I_WIN] + (size_t)DBG_LAYER * 1024 * D_IN_SRC);
        if (DBG_CHECK == 3 && p == 4 + 13 * DBG_LAYER) hipLaunchKernelGGL(dbg_fourier_ref, dim3(128), dim3(512), 0, stream, (unsigned char*)d_ws);
        if (DBG_CHECK == 3 && p == 6 + 13 * DBG_LAYER) hipLaunchKernelGGL(dbg_fourier_cmp, dim3(1), dim3(128), 0, stream, (unsigned char*)d_ws);
        if (DBG_CHECK == 4 && p == 3 + 13 * DBG_LAYER) hipLaunchKernelGGL(dbg_scan, dim3(64), dim3(64), 0, stream, (unsigned char*)d_ws, (float*)d_out, (const float*)d_in[I_MU] + DBG_LAYER * 3840, (const float*)d_in[I_W0] + DBG_LAYER * 1024, (const float*)d_in[I_W2] + DBG_LAYER * 65536, (const float*)d_in[I_A0] + DBG_LAYER * 1024, (const float*)d_in[I_A2] + DBG_LAYER * 65536, (const float*)d_in[I_KK] + DBG_LAYER * 512, (const float*)d_in[I_KA] + DBG_LAYER * 512, (const float*)d_in[I_RK] + DBG_LAYER * 512); if (DBG_CHECK == 4 && DBG_SUB == 10 && p == 3 + 13 * DBG_LAYER) hipLaunchKernelGGL(dbg_scan_fin, dim3(1), dim3(1), 0, stream, (unsigned char*)d_ws);
        if (DBG_CHECK == 5 && p == 7 + 13 * DBG_LAYER) hipLaunchKernelGGL(dbg_merge_ref, dim3(48), dim3(512), 0, stream, (unsigned char*)d_ws, (float*)(ws8 + WS_DBG + 262144), (const float*)d_in[I_WIN] + (size_t)DBG_LAYER * 1024 * D_IN_SRC, (const float*)d_in[I_WPA] + DBG_LAYER * 1048576, (const float*)d_in[I_WPF] + DBG_LAYER * 524288, (const float*)d_in[I_WPC] + DBG_LAYER * 524288, (const float*)d_in[I_WO] + DBG_LAYER * 1048576);
        if (DBG_CHECK == 5 && p == 9 + 13 * DBG_LAYER) hipLaunchKernelGGL(dbg_merge_cmp, dim3(48), dim3(64), 0, stream, (unsigned char*)d_ws, (const float*)(ws8 + WS_DBG + 262144));
        if (DBG_CHECK == 6 && p == 5 + 13 * DBG_LAYER) hipLaunchKernelGGL(dbg_post_ref, dim3(96), dim3(512), 0, stream, (unsigned char*)d_ws, (float*)(ws8 + WS_DBG + 262144), (const float*)d_in[I_MU] + DBG_LAYER * 3840, (const float*)d_in[I_G2] + DBG_LAYER * 65536, (const float*)d_in[I_LNW] + DBG_LAYER * 512, (const float*)d_in[I_LNB] + DBG_LAYER * 512);
        if (DBG_CHECK == 6 && p == 6 + 13 * DBG_LAYER) hipLaunchKernelGGL(dbg_post_cmp, dim3(96), dim3(512), 0, stream, (unsigned char*)d_ws, (const float*)(ws8 + WS_DBG + 262144));
        if (DBG_CHECK == 7 && p == 1) hipLaunchKernelGGL(dbg_mod, dim3(10), dim3(64), 0, stream, (unsigned char*)d_ws, (const float*)d_in[I_C], (const float*)d_in[I_CCTX], (const float*)d_in[I_ADAW], (const float*)d_in[I_ADAB], (const float*)d_in[I_X], (const float*)d_in[I_CTX]);
        if (DBG_CHECK == 8 && p == 10 + 13 * DBG_LAYER) hipLaunchKernelGGL(dbg_ffn_ref, dim3(48), dim3(512), 0, stream, (unsigned char*)d_ws, (const float*)d_in[I_FUP] + (size_t)DBG_LAYER * 1024 * 5632, (const float*)d_in[I_FCONV] + DBG_LAYER * 3 * 2816, (const float*)d_in[I_FCONVB] + DBG_LAYER * 2816, (const float*)d_in[I_FDN] + (size_t)DBG_LAYER * 2816 * 1024);
        if (DBG_CHECK == 8 && p == 13 + 13 * DBG_LAYER) hipLaunchKernelGGL(dbg_ffn_cmp, dim3(48), dim3(64), 0, stream, (unsigned char*)d_ws);
        if (DBG_CHECK == 9 && p == 10) hipLaunchKernelGGL(dbg_ln1, dim3(6), dim3(64), 0, stream, (unsigned char*)d_ws, (const float*)d_in[I_X], (const float*)d_in[I_CTX], (const float*)d_out, (const float*)d_in[I_LN1G], (const float*)d_in[I_LN1B]);
        if (DBG_CHECK == 10 && p == 13 + 13 * DBG_LAYER) hipLaunchKernelGGL(dbg_ln2_ref, dim3(64), dim3(64), 0, stream, (unsigned char*)d_ws, (const float*)d_out, (const float*)d_in[I_LN2G] + DBG_LAYER * 1024, (const float*)d_in[I_LN2B] + DBG_LAYER * 1024, DBG_LAYER);
        if (DBG_CHECK == 10 && p == 14 + 13 * DBG_LAYER) hipLaunchKernelGGL(dbg_ln2_cmp, dim3(64), dim3(64), 0, stream, (unsigned char*)d_ws, (const float*)d_out, DBG_LAYER);
        if (DBG_CHECK == 11 && p == 7 + 13 * DBG_LAYER) { hipLaunchKernelGGL(dbg_gate, dim3(256), dim3(64), 0, stream, (unsigned char*)d_ws, (const float*)d_in[I_WIN] + (size_t)DBG_LAYER * 1024 * D_IN_SRC, 0); hipLaunchKernelGGL(dbg_gate, dim3(256), dim3(64), 0, stream, (unsigned char*)d_ws, (const float*)d_in[I_WIN] + (size_t)DBG_LAYER * 1024 * D_IN_SRC, 1); }
        if (DBG_CHECK == 12 && p == 7 + 13 * DBG_LAYER) { hipLaunchKernelGGL(dbg_gate2_init, dim3(1), dim3(1), 0, stream, (unsigned char*)d_ws); hipLaunchKernelGGL(dbg_gate2, dim3(13), dim3(64), 0, stream, (unsigned char*)d_ws, (const float*)d_in[I_WIN] + (size_t)DBG_LAYER * 1024 * D_IN_SRC); hipLaunchKernelGGL(dbg_gate2_fin, dim3(1), dim3(1), 0, stream, (unsigned char*)d_ws); }
        if ((DBG_CHECK == 13 || DBG_CHECK == 14) && p == 7 + 13 * DBG_LAYER) { hipLaunchKernelGGL(dbg_gate3_init, dim3(1), dim3(1), 0, stream, (unsigned char*)d_ws); hipLaunchKernelGGL(dbg_gate3, dim3(2048), dim3(256), 0, stream, (unsigned char*)d_ws); hipLaunchKernelGGL(dbg_gate3_fin, dim3(1), dim3(1), 0, stream, (unsigned char*)d_ws); }
        if (DBG_CHECK == 1 && p == 3 + 13 * DBG_LAYER) hipLaunchKernelGGL(dbg_attn, dim3(2048), dim3(512), 0, stream, (unsigned char*)d_ws, (const float*)d_in[I_SUBLN], DBG_LAYER, (const float*)d_out);
#endif
    }
#if defined(DBG_CHECK)
    hipLaunchKernelGGL(dbg_report, dim3(DBG_TWO ? 4096 : 1), dim3(DBG_TWO ? 256 : 1), 0, stream, (unsigned char*)d_ws, (float*)d_out);
#endif
#else
    a.ph_lo = 0; a.ph_hi = N_PHASES;
    hipLaunchKernelGGL(mk_fwd, dim3(grid), dim3(NTHREADS), LDS_BYTES, stream, a);
#endif
}
```

```cpp
#include <hip/hip_runtime.h>
#include <hip/hip_bf16.h>
#include <cstdio>
#include <cstdint>
#include <cmath>

#ifndef DBG_ZERO_MIX
#define DBG_ZERO_MIX 0
#endif
#ifndef DBG_ZERO_FFN
#define DBG_ZERO_FFN 0
#endif
#ifndef DBG_BR
#define DBG_BR 7
#endif
#define GAS __attribute__((address_space(1)))
#define LAS __attribute__((address_space(3)))
typedef unsigned short bf16_t;
typedef short bf16x8 __attribute__((ext_vector_type(8)));
typedef short s16x4 __attribute__((ext_vector_type(4)));
typedef float f32x4 __attribute__((ext_vector_type(4)));
typedef float f32x2 __attribute__((ext_vector_type(2)));
typedef float f32x16 __attribute__((ext_vector_type(16)));
typedef unsigned u32x4 __attribute__((ext_vector_type(4)));
typedef unsigned u32x2 __attribute__((ext_vector_type(2)));
typedef GAS unsigned gu32;

constexpr int DM = 1024, NBATCH = 4, SEQ = 4096, CTXL = 256, NLAYER = 2;
constexpr int ML = NBATCH * SEQ, MC = NBATCH * CTXL, MT = ML + MC;
constexpr int D_IN_SRC = 8576, NP = 5632, NGATE = 3072, DFF = 2816, DCS = 1280, DCO = 640, DCOP = 768;
constexpr float LN_EPS = 1e-5f, ALPHA = 1.4142135623730951f;
constexpr int NWAVES = 8, NTHREADS = 512;

constexpr size_t MiB = 1u << 20;
constexpr size_t WS_CTL = 0, CTL_ZERO_BYTES = 1 * MiB;
constexpr size_t WS_TAB = 1 * MiB;
constexpr size_t TAB_MOD = WS_TAB + 0;
constexpr size_t TAB_LAM = WS_TAB + 256 * 1024;
constexpr size_t TAB_ROPE = WS_TAB + 260 * 1024;
constexpr size_t TAB_TW = WS_TAB + 272 * 1024;
constexpr size_t TAB_W0 = WS_TAB + 320 * 1024;
constexpr size_t TAB_F1 = WS_TAB + 384 * 1024;
constexpr size_t TAB_F2 = WS_TAB + 512 * 1024;
constexpr size_t TAB_DC = WS_TAB + 768 * 1024;
constexpr size_t WS_XC = 3 * MiB;
constexpr size_t WS_BON = 7 * MiB;
constexpr size_t WS_W = 9 * MiB;
constexpr size_t W_IN = WS_W, W_PA = WS_W + 17 * MiB, W_PF = WS_W + 19 * MiB, W_PC = WS_W + 20 * MiB, W_O = WS_W + 21 * MiB,
                 W_UP = WS_W + 23 * MiB, W_DN = WS_W + 34 * MiB, W_G2T = WS_W + 39 * MiB + 512 * 1024;
constexpr size_t WS_P = 49 * MiB;
constexpr size_t P_Q = WS_P, P_K = P_Q + (size_t)MT * 1024 * 2, P_F = P_K + (size_t)MT * 1024 * 2, P_V = P_F + (size_t)MT * 512 * 2,
                 P_CS = P_V + (size_t)MT * 1024 * 2, P_CO = P_CS + (size_t)MT * DCS * 2, P_END = P_CO + (size_t)MT * DCOP * 2;
constexpr size_t WS_HY = 236 * MiB, WS_END = 270 * MiB;
static_assert(P_END == WS_HY, "P region is exactly 187 MiB");
static_assert(P_END - P_V == (size_t)MT * NGATE * 2, "gate buffer == v|cs|co");
static_assert(WS_HY + (size_t)MT * 1024 * 2 == WS_END, "HY region 34 MiB");
constexpr int CW_TMO = 0, CW_QUEUE = 64  , CW_BAR = 4096;

constexpr int RING_BYTES = 131072, LDSCTL_OFF = RING_BYTES, MISC_OFF = LDSCTL_OFF + 320, LDS_BYTES = 147456;

#define LDS_WAIT() asm volatile("s_waitcnt lgkmcnt(0)" ::: "memory")
#define VM_WAIT() asm volatile("s_waitcnt vmcnt(0)" ::: "memory")
#define RLX_AGENT __ATOMIC_RELAXED, __HIP_MEMORY_SCOPE_AGENT

typedef __bf16 bf16x2_t __attribute__((ext_vector_type(2)));
__device__ __forceinline__ unsigned cvt_pk_bf16(float lo, float hi) { f32x2 v = {lo, hi}; bf16x2_t b = __builtin_convertvector(v, bf16x2_t); return __builtin_bit_cast(unsigned, b); }
__device__ __forceinline__ float bf2f(unsigned short h) { return __uint_as_float((unsigned)h << 16); }
__device__ __forceinline__ float bflo(unsigned w) { return __uint_as_float(w << 16); }
__device__ __forceinline__ float bfhi(unsigned w) { return __uint_as_float(w & 0xffff0000u); }
__device__ __forceinline__ float sigmoidf_(float x) { return __builtin_amdgcn_rcpf(1.f + __expf(-x)); }
__device__ __forceinline__ int fresh_lane() { unsigned z = 0u; asm volatile("" : "+v"(z)); return (int)__builtin_amdgcn_mbcnt_hi(~0u, __builtin_amdgcn_mbcnt_lo(~0u, z)); }
__device__ __forceinline__ int fresh_tid(int wave) { return (wave << 6) | fresh_lane(); }
__device__ __forceinline__ float wave_sum(float v) {
#pragma unroll
    for (int o = 1; o < 64; o <<= 1) v += __shfl_xor(v, o);
    return v;
}

#define XB_TMO      128
#define XB_XCNT(j)  (256  + 64 * (j))
#define XB_XSUB(j)  (1280 + 64 * (j))
#define XB_XGEN(j)  (2304 + 64 * (j))
#define XB_TOP      3328
#define XB_TOPGEN   3392
#define XCD_BAR_WORDS 3456
#define XB_SPIN_CAP (1u << 22)
__device__ __forceinline__ unsigned xb_ld(unsigned* p)              { return __hip_atomic_load(p, __ATOMIC_RELAXED, __HIP_MEMORY_SCOPE_AGENT); }
__device__ __forceinline__ unsigned xb_add(unsigned* p, unsigned v) { return __hip_atomic_fetch_add(p, v, __ATOMIC_RELAXED, __HIP_MEMORY_SCOPE_AGENT); }
__device__ __forceinline__ unsigned xb_xcc_id() { return (unsigned)__builtin_amdgcn_s_getreg((3 << 11) | 20) & 0xFu; }
#define XB_SPIN(cond, bar) do { unsigned _sp = 0; while (cond) { __builtin_amdgcn_s_sleep(1); \
    if ((++_sp & 255u) == 0u) { if (xb_ld(&(bar)[XB_TMO])) break; if (_sp > XB_SPIN_CAP) { atomicAdd(&(bar)[XB_TMO], 1u); break; } } } } while (0)
struct XcdBarrier { unsigned* bar; unsigned x; volatile LAS unsigned* st; };
__device__ __forceinline__ XcdBarrier xcd_barrier_post(unsigned* bar, volatile LAS unsigned* st) {
    XcdBarrier b; b.bar = bar; b.x = xb_xcc_id(); b.st = st;
    if (threadIdx.x == 0) (void)xb_add(&bar[XB_XCNT(b.x)], 1u);
    return b;
}
__device__ __forceinline__ void xcd_barrier_complete(unsigned* bar, unsigned x, unsigned& nloc, unsigned& nx) {
    const unsigned G = gridDim.x * gridDim.y * gridDim.z;
    unsigned sum, cnt, mine, sp = 0u;
    for (;;) {
        sum = 0u; cnt = 0u; mine = 0u;
#pragma unroll
        for (unsigned j = 0; j < 16; ++j) { const unsigned c = xb_ld(&bar[XB_XCNT(j)]); sum += c; cnt += (c > 0u) ? 1u : 0u; mine = (j == x) ? c : mine; }
        if (sum == G) break;
        __builtin_amdgcn_s_sleep(1);
        if ((++sp & 255u) == 0u) { if (xb_ld(&bar[XB_TMO])) break; if (sp > XB_SPIN_CAP) { atomicAdd(&bar[XB_TMO], 1u); break; } }
    }
    nloc = mine > 0u ? mine : 1u; nx = cnt > 0u ? cnt : 1u;
}
__device__ __attribute__((noinline)) void xcd_barrier(unsigned* bar_, unsigned bx_, volatile LAS unsigned* st_, unsigned t0_) {
    XcdBarrier b; b.bar = bar_; b.x = bx_; b.st = st_;
    asm volatile("s_waitcnt vmcnt(0)" ::: "memory");
    __syncthreads();
    if (t0_) {
        unsigned* bar = b.bar;
        __builtin_amdgcn_s_waitcnt(0);
        unsigned nloc = b.st[0], nx = b.st[1];
        if (nloc == 0u) { xcd_barrier_complete(bar, b.x, nloc, nx); b.st[0] = nloc; b.st[1] = nx; }
        const unsigned old = xb_add(&bar[XB_XSUB(b.x)], 1u);
        const unsigned gen = old / nloc;
        if (old + 1u == (gen + 1u) * nloc) {
            __builtin_amdgcn_fence(__ATOMIC_RELEASE, "agent");
            asm volatile("s_waitcnt vmcnt(0)" ::: "memory");
            const unsigned og = xb_add(&bar[XB_TOP], 1u);
            const unsigned tg = og / nx;
            if (og + 1u == (tg + 1u) * nx) xb_add(&bar[XB_TOPGEN], 1u);
            else XB_SPIN(xb_ld(&bar[XB_TOPGEN]) == tg, bar);
            __builtin_amdgcn_fence(__ATOMIC_ACQUIRE, "agent");
            xb_add(&bar[XB_XGEN(b.x)], 1u);
            asm volatile("s_waitcnt vmcnt(0)" ::: "memory");
        } else {
            XB_SPIN(xb_ld(&bar[XB_XGEN(b.x)]) == gen, bar);
            __builtin_amdgcn_fence(__ATOMIC_ACQUIRE, "agent");
            asm volatile("s_waitcnt vmcnt(0)" ::: "memory");
        }
    }
    __syncthreads();
}

namespace pg8 {
#define PG8_LAS __attribute__((address_space(3)))
constexpr int BM = 256, BK = 64, HALF = 128, HTB = HALF * BK * 2, STAGE_BYTES = 8 * HTB, NXCD = 8, WGM = 8;
__host__ __device__ __forceinline__ int lds_byte(int r, int c) { const int st = (r >> 4) * 2 + (c >> 5), rr = r & 15, cc = c & 31, ob = rr * 64 + cc * 2; return st * 1024 + (ob ^ (((ob >> 9) & 1) << 5)); }
__host__ __device__ __forceinline__ void stage_rc(int b, int& R, int& C) { const int st = b / 1024, sb = b % 1024, swz = sb ^ (((sb >> 9) & 1) << 5); R = (st >> 1) * 16 + swz / 64; C = (st & 1) * 32 + (swz % 64) / 2; }
__host__ __device__ __forceinline__ int perm32(int rho) { const int n = rho >> 4, i = rho & 15; return 8 * (i >> 2) + 4 * n + (i & 3); }
struct Unit { int pm, pn; };
struct Operand { const char* base; long tM, tN, tN2; int nshift; long rstride; long hstep; long kstep;
    __device__ __forceinline__ long tile(const Unit& u) const { return (long)u.pm * tM + (long)(u.pn & ((1 << nshift) - 1)) * tN + (long)(u.pn >> nshift) * tN2; }
    __device__ __forceinline__ unsigned row(int R) const { return (unsigned)((long)R * rstride); } };
struct StaticOrder {
    int nM, nN, nwg, G, c, wave;
    __host__ __device__ void init(int M, int N, int G_, int c_) { nM = M / BM; nN = N / BM; nwg = nM * nN; G = G_; c = c_; }
    __host__ __device__ bool next(int i, Unit& u) const {
        const long L = (long)i * G + c; if (L >= nwg) return false;
        int wgid = (int)L; { const int q = nwg / NXCD, r = nwg % NXCD, xcd = wgid % NXCD, off = wgid / NXCD; wgid = (xcd < r ? xcd * (q + 1) : r * (q + 1) + (xcd - r) * q) + off; }
        const int nig = WGM * nN, gid = wgid / nig, fm = gid * WGM, gsz = (nM - fm) < WGM ? (nM - fm) : WGM;
        u.pm = fm + ((wgid % nig) % gsz); u.pn = (wgid % nig) / gsz; return true;
    }
};

template <class Epi, class RowMapB, bool ALIGN_EPI>
__device__ __forceinline__ void gemm_phase(PG8_LAS unsigned char* lds, const Operand A, const Operand B, const RowMapB bmap, const int nt, const StaticOrder& S, const Epi& E) {
    int wid = S.wave; asm volatile("" : "+s"(wid));
    const int lane = fresh_lane(), tid = (wid << 6) | lane, wr = wid >> 2, wc = wid & 3, fr = lane & 15, fq = lane >> 4;
    unsigned voffA[2], voffB[2];
#pragma unroll
    for (int i = 0; i < 2; ++i) { int R, C; stage_rc(tid * 16 + i * 8192, R, C); const int Rb = Epi::PERM ? ((R & ~31) + perm32(R & 31)) : R;
        voffA[i] = A.row(R) + (unsigned)C * 2u; voffB[i] = bmap(Rb) + (unsigned)C * 2u; }
    const long kA = A.kstep, kB = B.kstep, hA = A.hstep, hB = B.hstep;
    const unsigned ldsw = (unsigned)wid * 1024u;
    const int aoff = lds_byte(wr * 64 + fr, fq * 8), boff = lds_byte(wc * 32 + fr, fq * 8);
#define PG8_SA(b, h) (((b) * 2 + (h)) * HTB)
#define PG8_SB(b, h) ((4 + (b) * 2 + (h)) * HTB)
#define PG8_STAGE(bufoff, gbase, voff) do { _Pragma("unroll") for (int _i = 0; _i < 2; ++_i) \
        __builtin_amdgcn_global_load_lds((const unsigned*)((const char*)(gbase) + (voff)[_i]), (PG8_LAS unsigned*)(lds + (bufoff) + ldsw + _i * 8192), 16, 0, 0); } while (0)
#define PG8_LDA(dst, b, h) do { _Pragma("unroll") for (int m = 0; m < 4; ++m) _Pragma("unroll") for (int k = 0; k < 2; ++k) dst[m][k] = *(const PG8_LAS bf16x8*)(lds + PG8_SA(b, h) + aoff + m * 2048 + k * 1024); } while (0)
#define PG8_LDB(dst, b, h) do { _Pragma("unroll") for (int n = 0; n < 2; ++n) _Pragma("unroll") for (int k = 0; k < 2; ++k) dst[n][k] = *(const PG8_LAS bf16x8*)(lds + PG8_SB(b, h) + boff + n * 2048 + k * 1024); } while (0)
#define PG8_MMA(ai, bj, At, Bt) do { __builtin_amdgcn_s_setprio(1); _Pragma("unroll") for (int m = 0; m < 4; ++m) _Pragma("unroll") for (int n = 0; n < 2; ++n) _Pragma("unroll") for (int k = 0; k < 2; ++k) \
        acc[ai][bj][m][n] = __builtin_amdgcn_mfma_f32_16x16x32_bf16(Bt[n][k], At[m][k], acc[ai][bj][m][n], 0, 0, 0); __builtin_amdgcn_s_setprio(0); } while (0)
#define PG8_WAIT_V(n) asm volatile("s_waitcnt vmcnt(" #n ")" ::: "memory")
#define PG8_WAIT_L(n) asm volatile("s_waitcnt lgkmcnt(" #n ")" ::: "memory")
#define PG8_BAR __builtin_amdgcn_s_barrier()
#define PG8_SCHED __builtin_amdgcn_sched_barrier(0)
    Unit cur, nxt; int ui = 0;
    if (!S.next(0, cur)) return;
    f32x4 acc[2][2][4][2];
#pragma unroll
    for (int a = 0; a < 2; ++a)
#pragma unroll
        for (int b = 0; b < 2; ++b)
#pragma unroll
            for (int m = 0; m < 4; ++m)
#pragma unroll
                for (int n = 0; n < 2; ++n) acc[a][b][m][n] = (f32x4){0.f, 0.f, 0.f, 0.f};
    bf16x8 At[4][2], B0[2][2], B1[2][2];
    const char* cA = A.base + A.tile(cur); const char* cB = B.base + B.tile(cur);
    PG8_STAGE(PG8_SB(0, 0), cB, voffB); PG8_STAGE(PG8_SB(0, 1), cB + hB, voffB); PG8_STAGE(PG8_SA(0, 0), cA, voffA); PG8_STAGE(PG8_SA(0, 1), cA + hA, voffA);
    if (wr == 1) PG8_BAR;
    PG8_WAIT_V(2); PG8_BAR;
    PG8_STAGE(PG8_SB(1, 0), cB + kB, voffB); PG8_STAGE(PG8_SA(1, 0), cA + kA, voffA); PG8_STAGE(PG8_SB(1, 1), cB + hB + kB, voffB);
    PG8_WAIT_V(6); PG8_BAR;
    for (;;) {
        const bool has_next = S.next(ui + 1, nxt);
        const char* nA = has_next ? A.base + A.tile(nxt) : cA; const char* nB = has_next ? B.base + B.tile(nxt) : cB;
        for (int t = 0; t < nt; t += 2) {
            const bool last = (t == nt - 2);
            asm volatile("" : "+v"(voffA[0]), "+v"(voffA[1]), "+v"(voffB[0]), "+v"(voffB[1]));
            const char* a1 = cA + (long)(t + 1) * kA;
            const char* a2 = last ? nA : cA + (long)(t + 2) * kA; const char* b2 = last ? nB : cB + (long)(t + 2) * kB;
            const char* a3 = a2 + kA; const char* b3 = b2 + kB;
            PG8_LDB(B0, 0, 0); PG8_LDB(B1, 0, 1); PG8_SCHED; PG8_LDA(At, 0, 0); PG8_STAGE(PG8_SA(1, 1), a1 + hA, voffA);
            PG8_WAIT_V(8); PG8_WAIT_L(0); PG8_BAR; PG8_MMA(0, 0, At, B0); PG8_MMA(0, 1, At, B1); PG8_BAR; PG8_SCHED;
            PG8_LDA(At, 0, 1); PG8_STAGE(PG8_SB(0, 0), b2, voffB); PG8_STAGE(PG8_SB(0, 1), b2 + hB, voffB); PG8_STAGE(PG8_SA(0, 0), a2, voffA);
            PG8_WAIT_V(8); PG8_WAIT_L(0); PG8_BAR; PG8_MMA(1, 0, At, B0); PG8_MMA(1, 1, At, B1); PG8_BAR; PG8_SCHED;
            PG8_LDB(B0, 1, 0); PG8_LDB(B1, 1, 1); PG8_SCHED; PG8_LDA(At, 1, 0); PG8_STAGE(PG8_SA(0, 1), a2 + hA, voffA);
            PG8_WAIT_V(8); PG8_WAIT_L(0); PG8_BAR; PG8_MMA(0, 0, At, B0); PG8_MMA(0, 1, At, B1); PG8_BAR; PG8_SCHED;
            PG8_LDA(At, 1, 1); PG8_STAGE(PG8_SB(1, 0), b3, voffB); PG8_STAGE(PG8_SB(1, 1), b3 + hB, voffB); PG8_STAGE(PG8_SA(1, 0), a3, voffA);
            PG8_WAIT_V(8); PG8_WAIT_L(0); PG8_BAR; PG8_MMA(1, 0, At, B0); PG8_MMA(1, 1, At, B1); PG8_BAR; PG8_SCHED;
        }
        if constexpr (ALIGN_EPI) { if (wr == 0) PG8_BAR; }
        if constexpr (!Epi::AFTER_DRAIN) { const int le = fresh_lane(); E(acc, cur, wr, wc, le & 15, le >> 4); }
        if (!has_next) break;
#pragma unroll
        for (int a = 0; a < 2; ++a)
#pragma unroll
            for (int b = 0; b < 2; ++b)
#pragma unroll
                for (int m = 0; m < 4; ++m)
#pragma unroll
                    for (int n = 0; n < 2; ++n) acc[a][b][m][n] = (f32x4){0.f, 0.f, 0.f, 0.f};
        cur = nxt; cA = nA; cB = nB; ++ui;
        if constexpr (ALIGN_EPI) { if (wr == 1) PG8_BAR; }
    }
    PG8_WAIT_V(0);
    if constexpr (!ALIGN_EPI) { if (wr == 0) PG8_BAR; }
    PG8_BAR;
    if constexpr (Epi::AFTER_DRAIN) { const int le = fresh_lane(); E.fused(acc, cur, wr, wc, le & 15, le >> 4, lds, wid, le); }
#undef PG8_SA
#undef PG8_SB
#undef PG8_STAGE
#undef PG8_LDA
#undef PG8_LDB
#undef PG8_MMA
#undef PG8_WAIT_V
#undef PG8_WAIT_L
#undef PG8_BAR
#undef PG8_SCHED
}
struct RowLin { long rstride; __device__ __forceinline__ unsigned operator()(int R) const { return (unsigned)((long)R * rstride); } };
}
namespace pg8 {
__device__ __forceinline__ u32x2 pk4(f32x4 v) { u32x2 w; w.x = cvt_pk_bf16(v[0], v[1]); w.y = cvt_pk_bf16(v[2], v[3]); return w; }
__device__ __forceinline__ f32x4 up4(u32x2 w) { return (f32x4){bflo(w.x), bfhi(w.x), bflo(w.y), bfhi(w.y)}; }
__device__ __forceinline__ float fast_sigmoid(float x) { return __builtin_amdgcn_rcpf(1.f + __expf(-x)); }
#define EPI_ROWS(ai, m) _Pragma("unroll") for (int ai = 0; ai < 2; ++ai) _Pragma("unroll") for (int m = 0; m < 4; ++m)

struct EpiInProj {
    static constexpr bool PERM = false, AFTER_DRAIN = false;
    unsigned char* ws; const float* rope;
    __device__ __forceinline__ void operator()(const f32x4 (&acc)[2][2][4][2], const Unit& u, int wr, int wc, int fr, int fq) const {
        asm volatile("" : "+v"(fr), "+v"(fq));
        const int pn = u.pn; size_t boff; int pitch, c0;
        if (pn < 4) { boff = P_Q; pitch = 1024; c0 = 256 * pn; }
        else if (pn < 8) { boff = P_K; pitch = 1024; c0 = 256 * (pn - 4); }
        else if (pn < 12) { boff = P_V; pitch = 1024; c0 = 256 * (pn - 8); }
        else if (pn < 14) { boff = P_F; pitch = 512; c0 = 256 * (pn - 12); }
        else if (pn < 19) { boff = P_CS; pitch = DCS; c0 = 256 * (pn - 14); }
        else { boff = P_CO; pitch = DCOP; c0 = 256 * (pn - 19); }
        bf16_t* base = (bf16_t*)(ws + boff);
        const bool dorope = (pn >= 4 && pn < 8 && u.pm < ML / 256);
        EPI_ROWS(ai, m) {
            const int R = 128 * ai + 64 * wr + 16 * m + fr; const size_t grow = (size_t)u.pm * 256 + R;
            f32x4 cc = (f32x4){1.f, 1.f, 1.f, 1.f}, ss = (f32x4){0.f, 0.f, 0.f, 0.f};
            if (dorope) { const int t = (int)(grow & 4095); const int pos = (wc & 1) ? (t & 63) : (t >> 6);
                const f32x4 a = *(const f32x4*)(rope + (pos * 16 + 4 * fq) * 2), b = *(const f32x4*)(rope + (pos * 16 + 4 * fq) * 2 + 4);
                cc = (f32x4){a[0], a[2], b[0], b[2]}; ss = (f32x4){a[1], a[3], b[1], b[3]}; }
            bf16_t* rowp = base + grow * pitch + c0 + 32 * wc + 4 * fq;
#pragma unroll
            for (int bj = 0; bj < 2; ++bj) { const f32x4 x1 = acc[ai][bj][m][0], x2 = acc[ai][bj][m][1];
                const f32x4 y1 = x1 * cc - x2 * ss, y2 = x2 * cc + x1 * ss;
                *(u32x2*)(rowp + 128 * bj) = pk4(y1); *(u32x2*)(rowp + 128 * bj + 16) = pk4(y2); }
        }
    }
};
struct EpiGate {
    static constexpr bool PERM = true, AFTER_DRAIN = false;
    bf16_t* gate;
    __device__ __forceinline__ void operator()(const f32x4 (&acc)[2][2][4][2], const Unit& u, int wr, int wc, int fr, int fq) const {
        asm volatile("" : "+v"(fr), "+v"(fq));
        EPI_ROWS(ai, m) {
            const int R = 128 * ai + 64 * wr + 16 * m + fr; const size_t grow = (size_t)u.pm * 256 + R;
            bf16_t* rowp = gate + grow * NGATE + 256 * u.pn + 32 * wc + 8 * fq;
#pragma unroll
            for (int bj = 0; bj < 2; ++bj) { f32x4 v0 = acc[ai][bj][m][0], v1 = acc[ai][bj][m][1];
#pragma unroll
                for (int e = 0; e < 4; ++e) { v0[e] = fast_sigmoid(v0[e]); v1[e] = fast_sigmoid(v1[e]); }
                u32x4 w; w.x = cvt_pk_bf16(v0[0], v0[1]); w.y = cvt_pk_bf16(v0[2], v0[3]); w.z = cvt_pk_bf16(v1[0], v1[1]); w.w = cvt_pk_bf16(v1[2], v1[3]);
                *(u32x4*)(rowp + 128 * bj) = w; }
        }
    }
};
template <bool FIRST> struct EpiBranch {
    static constexpr bool PERM = true, AFTER_DRAIN = false;
    const bf16_t* gate; bf16_t* ym; float sc;
    __device__ __forceinline__ void operator()(const f32x4 (&acc)[2][2][4][2], const Unit& u, int wr, int wc, int fr, int fq) const {
        asm volatile("" : "+v"(fr), "+v"(fq));
        EPI_ROWS(ai, m) {
            const int R = 128 * ai + 64 * wr + 16 * m + fr; const size_t grow = (size_t)u.pm * 256 + R;
            const int col = 256 * u.pn + 32 * wc + 8 * fq;
#pragma unroll
            for (int bj = 0; bj < 2; ++bj) {
                const u32x4 g = *(const u32x4*)(gate + grow * NGATE + col + 128 * bj);
                f32x4 v0 = acc[ai][bj][m][0], v1 = acc[ai][bj][m][1];
                v0 = v0 * (f32x4){bflo(g.x), bfhi(g.x), bflo(g.y), bfhi(g.y)} * sc; v1 = v1 * (f32x4){bflo(g.z), bfhi(g.z), bflo(g.w), bfhi(g.w)} * sc;
                bf16_t* op = ym + grow * 1024 + col + 128 * bj;
                if (!FIRST) { const u32x4 o = *(const u32x4*)op; v0 = v0 + (f32x4){bflo(o.x), bfhi(o.x), bflo(o.y), bfhi(o.y)}; v1 = v1 + (f32x4){bflo(o.z), bfhi(o.z), bflo(o.w), bfhi(o.w)}; }
                u32x4 w; w.x = cvt_pk_bf16(v0[0], v0[1]); w.y = cvt_pk_bf16(v0[2], v0[3]); w.z = cvt_pk_bf16(v1[0], v1[1]); w.w = cvt_pk_bf16(v1[2], v1[3]);
                *(u32x4*)op = w; }
        }
    }
};
struct EpiF32 {
    static constexpr bool PERM = false, AFTER_DRAIN = false;
    float* out; int ldc;
    __device__ __forceinline__ void operator()(const f32x4 (&acc)[2][2][4][2], const Unit& u, int wr, int wc, int fr, int fq) const {
        asm volatile("" : "+v"(fr), "+v"(fq));
        EPI_ROWS(ai, m) {
            const int R = 128 * ai + 64 * wr + 16 * m + fr; const size_t grow = (size_t)u.pm * 256 + R;
            float* rowp = out + grow * ldc + 256 * u.pn + 32 * wc + 4 * fq;
#pragma unroll
            for (int bj = 0; bj < 2; ++bj)
#pragma unroll
                for (int n = 0; n < 2; ++n) *(f32x4*)(rowp + 128 * bj + 16 * n) = acc[ai][bj][m][n];
        }
    }
};
struct EpiBf16 {
    static constexpr bool PERM = true, AFTER_DRAIN = false;
    bf16_t* out; int ldc;
    __device__ __forceinline__ void operator()(const f32x4 (&acc)[2][2][4][2], const Unit& u, int wr, int wc, int fr, int fq) const {
        asm volatile("" : "+v"(fr), "+v"(fq));
        EPI_ROWS(ai, m) {
            const int R = 128 * ai + 64 * wr + 16 * m + fr; const size_t grow = (size_t)u.pm * 256 + R;
            bf16_t* rowp = out + grow * ldc + 256 * u.pn + 32 * wc + 8 * fq;
#pragma unroll
            for (int bj = 0; bj < 2; ++bj) { const f32x4 v0 = acc[ai][bj][m][0], v1 = acc[ai][bj][m][1];
                u32x4 w; w.x = cvt_pk_bf16(v0[0], v0[1]); w.y = cvt_pk_bf16(v0[2], v0[3]); w.z = cvt_pk_bf16(v1[0], v1[1]); w.w = cvt_pk_bf16(v1[2], v1[3]);
                *(u32x4*)(rowp + 128 * bj) = w; }
        }
    }
};
struct EpiF0 {
    static constexpr bool PERM = false, AFTER_DRAIN = false;
    bf16_t* yt;
    __device__ __forceinline__ void operator()(const f32x4 (&acc)[2][2][4][2], const Unit& u, int wr, int wc, int fr, int fq) const {
        asm volatile("" : "+v"(fr), "+v"(fq));
        EPI_ROWS(ai, m) {
            const int R = 128 * ai + 64 * wr + 16 * m + fr; const int ri = R >> 7, mch = R & 127;
            bf16_t* rowp = yt + (size_t)((ri * 4 + u.pm) * 128 + mch) * ML + 256 * u.pn + 32 * wc + 4 * fq;
#pragma unroll
            for (int bj = 0; bj < 2; ++bj)
#pragma unroll
                for (int n = 0; n < 2; ++n) *(u32x2*)(rowp + 128 * bj + 16 * n) = pk4(acc[ai][bj][m][n]);
        }
    }
};
struct EpiF0c {
    static constexpr bool PERM = false, AFTER_DRAIN = false;
    bf16_t* ytc;
    __device__ __forceinline__ void operator()(const f32x4 (&acc)[2][2][4][2], const Unit& u, int wr, int wc, int fr, int fq) const {
        asm volatile("" : "+v"(fr), "+v"(fq));
        EPI_ROWS(ai, m) {
            const int R = 128 * ai + 64 * wr + 16 * m + fr; const int ri = R >> 7, mch = R & 127;
            bf16_t* rowp = ytc + (size_t)((((u.pn * 4 + u.pm) * 128 + mch) * 2 + ri)) * 256 + 32 * wc + 4 * fq;
#pragma unroll
            for (int bj = 0; bj < 2; ++bj)
#pragma unroll
                for (int n = 0; n < 2; ++n) *(u32x2*)(rowp + 128 * bj + 16 * n) = pk4(acc[ai][bj][m][n]);
        }
    }
};
struct EpiF1 {
    static constexpr bool PERM = false, AFTER_DRAIN = false;
    bf16_t* x1; const float* tw;
    __device__ __forceinline__ void operator()(const f32x4 (&acc)[2][2][4][2], const Unit& u, int wr, int wc, int fr, int fq) const {
        asm volatile("" : "+v"(fr), "+v"(fq));
        const int gp = u.pn >> 7, mch = u.pn & 127, g = 2 * wr + gp;
#pragma unroll
        for (int m = 0; m < 4; ++m) {
            const int kl = 16 * m + fr;
#pragma unroll
            for (int bj = 0; bj < 2; ++bj)
#pragma unroll
                for (int n = 0; n < 2; ++n) {
                    const int colL = 128 * bj + 32 * wc + 16 * n + 4 * fq, tl = colL & 63, bb = colL >> 6;
                    const f32x4 a = *(const f32x4*)(tw + (kl * 64 + tl) * 2), b = *(const f32x4*)(tw + (kl * 64 + tl) * 2 + 4);
                    const f32x4 cc = (f32x4){a[0], a[2], b[0], b[2]}, ss = (f32x4){a[1], a[3], b[1], b[3]};
                    const f32x4 re = acc[0][bj][m][n], im = acc[1][bj][m][n];
                    const f32x4 re2 = re * cc + im * ss, im2 = im * cc - re * ss;
                    const size_t o = ((size_t)bb * 32768 + kl * 512 + g * 128 + mch) * 64 + tl;
                    *(u32x2*)(x1 + o) = pk4(re2); *(u32x2*)(x1 + (size_t)4 * 32768 * 64 + o) = pk4(im2);
                }
        }
    }
};
struct EpiF2 {
    static constexpr bool PERM = false, AFTER_DRAIN = false;
    bf16_t* of;
    __device__ __forceinline__ void operator()(const f32x4 (&acc)[2][2][4][2], const Unit& u, int wr, int wc, int fr, int fq) const {
        asm volatile("" : "+v"(fr), "+v"(fq));
        const int kl = u.pn >> 1, gm0 = (u.pn & 1) * 256;
        EPI_ROWS(ai, m) {
            const int R = 128 * ai + 64 * wr + 16 * m + fr; const int b = R >> 6, kh = R & 63;
            bf16_t* rowp = of + (size_t)(b * 4096 + 64 * kh + kl) * 512 + gm0 + 32 * wc + 4 * fq;
#pragma unroll
            for (int bj = 0; bj < 2; ++bj)
#pragma unroll
                for (int n = 0; n < 2; ++n) *(u32x2*)(rowp + 128 * bj + 16 * n) = pk4(acc[ai][bj][m][n]);
        }
    }
};
struct EpiFc {
    static constexpr bool PERM = false, AFTER_DRAIN = false;
    bf16_t* of;
    __device__ __forceinline__ void operator()(const f32x4 (&acc)[2][2][4][2], const Unit& u, int wr, int wc, int fr, int fq) const {
        asm volatile("" : "+v"(fr), "+v"(fq));
        const int b = u.pn >> 1, gm0 = (u.pn & 1) * 256;
        EPI_ROWS(ai, m) {
            const int R = 128 * ai + 64 * wr + 16 * m + fr;
            bf16_t* rowp = of + (size_t)(ML + b * 256 + R) * 512 + gm0 + 32 * wc + 4 * fq;
#pragma unroll
            for (int bj = 0; bj < 2; ++bj)
#pragma unroll
                for (int n = 0; n < 2; ++n) *(u32x2*)(rowp + 128 * bj + 16 * n) = pk4(acc[ai][bj][m][n]);
        }
    }
};
struct EpiRwkvPost {
    static constexpr bool PERM = false, AFTER_DRAIN = true;
    const bf16_t* y0; const bf16_t* y1; const bf16_t* cs; const float* bon; const float* mu; const float* lnw; const float* lnb; bf16_t* oc;
    __device__ __forceinline__ void fused(f32x4 (&acc)[2][2][4][2], const Unit& u, int wr, int wc, int fr, int fq, PG8_LAS unsigned char* lds, int wid, int lane) const {
        asm volatile("" : "+v"(fr), "+v"(fq));
        PG8_LAS f32x2* P = (PG8_LAS f32x2*)lds;
        EPI_ROWS(ai, m) {
            const int R = 128 * ai + 64 * wr + 16 * m + fr; const size_t grow = (size_t)u.pm * 256 + R;
#pragma unroll
            for (int bj = 0; bj < 2; ++bj) {
                const size_t o = grow * 512 + 256 * u.pn + 128 * bj + 32 * wc + 4 * fq;
                const f32x4 a = up4(*(const u32x2*)(y0 + o)) + up4(*(const u32x2*)(y1 + o)), b = up4(*(const u32x2*)(y0 + o + 16)) + up4(*(const u32x2*)(y1 + o + 16));
                float s = (a[0] + a[1]) + (a[2] + a[3]) + (b[0] + b[1]) + (b[2] + b[3]);
                s += __shfl_xor(s, 16); s += __shfl_xor(s, 32);
                const float mw = s * (1.f / 32.f); const f32x4 da = a - mw, db = b - mw;
                float q = (da[0] * da[0] + da[1] * da[1]) + (da[2] * da[2] + da[3] * da[3]) + (db[0] * db[0] + db[1] * db[1]) + (db[2] * db[2] + db[3] * db[3]);
                q += __shfl_xor(q, 16); q += __shfl_xor(q, 32);
                if (fq == 0) P[(R * 4 + 2 * bj + (wc >> 1)) * 2 + (wc & 1)] = (f32x2){mw, q};
            }
        }
        asm volatile("s_waitcnt lgkmcnt(0)" ::: "memory"); __builtin_amdgcn_s_barrier(); asm volatile("" ::: "memory");
        EPI_ROWS(ai, m) {
            const int R = 128 * ai + 64 * wr + 16 * m + fr; const size_t grow = (size_t)u.pm * 256 + R;
            int pos, len; if (grow < (size_t)ML) { pos = (int)(grow & 4095); len = SEQ; } else { pos = (int)((grow - ML) & 255); len = CTXL; }
            const bool hp = pos > 0, hn = pos < len - 1;
            const size_t rp = hp ? grow - 1 : grow, rn = hn ? grow + 1 : grow;
#pragma unroll
            for (int bj = 0; bj < 2; ++bj) {
                const int hl = 2 * bj + (wc >> 1), head = 4 * u.pn + hl;
                const f32x2 pa = P[(R * 4 + hl) * 2 + 0], pb = P[(R * 4 + hl) * 2 + 1];
                const float mean = 0.5f * (pa.x + pb.x), dm = pa.x - pb.x, var = (pa.y + pb.y + 16.f * dm * dm) * (1.f / 64.f);
                const float rstd = 1.0f / sqrtf(var + 64.f * 1e-5f);
                const float bsum = bon[grow * 8 + head] + bon[(size_t)MT * 8 + grow * 8 + head];
#pragma unroll
                for (int n = 0; n < 2; ++n) {
                    const int c = 256 * u.pn + 128 * bj + 32 * wc + 16 * n + 4 * fq;
                    const size_t o = grow * 512 + c;
                    const f32x4 yv = up4(*(const u32x2*)(y0 + o)) + up4(*(const u32x2*)(y1 + o));
                    const f32x4 w4 = *(const f32x4*)(lnw + c), b4 = *(const f32x4*)(lnb + c);
                    const f32x4 m0 = *(const f32x4*)(mu + 512 + c), m1 = *(const f32x4*)(mu + 1920 + 512 + c);
                    const f32x4 vc = up4(*(const u32x2*)(cs + grow * DCS + 512 + c));
                    f32x4 vp = up4(*(const u32x2*)(cs + rp * DCS + 512 + c)), vn = up4(*(const u32x2*)(cs + rn * DCS + 512 + c));
                    if (!hp) vp = (f32x4){0.f, 0.f, 0.f, 0.f}; if (!hn) vn = (f32x4){0.f, 0.f, 0.f, 0.f};
                    const f32x4 vs = vc + m0 * (vp - vc) + m1 * (vn - vc);
                    const f32x4 yn = (yv - mean) * rstd * w4 + b4;
                    const f32x4 r = (yn + bsum * vs) * acc[ai][bj][m][n];
                    *(u32x2*)(oc + o) = pk4(r);
                }
            }
        }
    }
};
}
namespace attn {
#define SBAR() __builtin_amdgcn_sched_barrier(0)
constexpr int QBLK = 32, KVBLK = 64;
constexpr float SCALE = 0.125f;
#ifndef ATTN_THR
#define ATTN_THR 6.f
#endif
constexpr int SHM_V = KVBLK * 128 * 2, SHM_K = KVBLK * 64 * 2;
constexpr int LDS_V = 0, LDS_K = 3 * SHM_V, LDS_STASH = LDS_K + 2 * SHM_K, LDS_END = LDS_STASH + NWAVES * 8192, LDS_WS = 135168;
static_assert(LDS_END <= RING_BYTES && LDS_WS >= MISC_OFF + 512 && LDS_WS + NWAVES * 64 * 4 <= LDS_BYTES, "attention LDS");
__device__ __forceinline__ int crow(int r, int hi) { return (r & 3) + 8 * (r >> 2) + 4 * hi; }
__device__ __forceinline__ int kswz(int row, int chunk) { return row * 128 + ((chunk ^ ((row >> 1) & 7)) << 4); }

__device__ __forceinline__ void partialSM(f32x16& p0, f32x16& p1, float& m_reg, float& mn, float& alpha) {
    constexpr float C = SCALE * 1.4426950408889634f;
    float pmax = p0[0];
#pragma unroll
    for (int r = 1; r < 16; ++r) pmax = fmaxf(pmax, p0[r]);
#pragma unroll
    for (int r = 0; r < 16; ++r) pmax = fmaxf(pmax, p1[r]);
    { auto rr = __builtin_amdgcn_permlane32_swap(__float_as_uint(pmax), __float_as_uint(pmax), false, false);
      pmax = fmaxf(__uint_as_float(rr[0]), __uint_as_float(rr[1])); }
    if (__builtin_expect(__all(pmax - m_reg <= ATTN_THR / SCALE), 1)) { mn = m_reg; alpha = 1.f; }
    else { mn = fmaxf(m_reg, pmax); alpha = __builtin_amdgcn_exp2f((m_reg - mn) * C); m_reg = mn; }
    const float mnC = -mn * C; const f32x2 C2 = {C, C}, mnC2 = {mnC, mnC};
#pragma unroll
    for (int r = 0; r < 16; r += 2) { const f32x2 t = (f32x2){p0[r], p0[r + 1]} * C2 + mnC2; p0[r] = t.x; p0[r + 1] = t.y; }
#pragma unroll
    for (int r = 0; r < 16; r += 2) { const f32x2 t = (f32x2){p1[r], p1[r + 1]} * C2 + mnC2; p1[r] = t.x; p1[r + 1] = t.y; }
#pragma unroll
    for (int r = 0; r < 16; ++r) p0[r] = __builtin_amdgcn_exp2f(p0[r]);
}
__device__ __forceinline__ void finishSM(f32x16& p0, f32x16& p1, float alpha, float& l_reg, bf16x8& pa0, bf16x8& pa1, bf16x8& pa2, bf16x8& pa3) {
#pragma unroll
    for (int r = 0; r < 16; ++r) p1[r] = __builtin_amdgcn_exp2f(p1[r]);
    f32x2 ps2 = (f32x2){p0[0], p0[1]} + (f32x2){p1[0], p1[1]};
#pragma unroll
    for (int r = 2; r < 16; r += 2) { ps2 += (f32x2){p0[r], p0[r + 1]}; ps2 += (f32x2){p1[r], p1[r + 1]}; }
    float ps = ps2.x + ps2.y;
    { auto rr = __builtin_amdgcn_permlane32_swap(__float_as_uint(ps), __float_as_uint(ps), false, false);
      ps = __uint_as_float(rr[0]) + __uint_as_float(rr[1]); }
    l_reg = l_reg * alpha + ps;
#define PK4(P, BASE, OUT) do { unsigned a0 = cvt_pk_bf16(P[BASE + 0], P[BASE + 1]), a1 = cvt_pk_bf16(P[BASE + 2], P[BASE + 3]);   \
    unsigned b0 = cvt_pk_bf16(P[BASE + 4], P[BASE + 5]), b1 = cvt_pk_bf16(P[BASE + 6], P[BASE + 7]);                              \
    auto r0 = __builtin_amdgcn_permlane32_swap(a0, b0, false, false); auto r1 = __builtin_amdgcn_permlane32_swap(a1, b1, false, false); \
    u32x4 w = {r0[0], r1[0], r0[1], r1[1]}; OUT = *reinterpret_cast<bf16x8*>(&w); } while (0)
    PK4(p0, 0, pa0); PK4(p0, 8, pa1); PK4(p1, 0, pa2); PK4(p1, 8, pa3);
#undef PK4
}
__device__ __forceinline__ void qkt(f32x16& p0, f32x16& p1, const LAS char* Ks, const bf16x8 q0, const bf16x8 q1, const bf16x8 q2, const bf16x8 q3, int r32, int hi) {
    p0 = f32x16{}; p1 = f32x16{};
#define QK1(d0, Q) do { const bf16x8 b0 = *(const LAS bf16x8*)(Ks + kswz(r32, 2 * (d0) + hi)); const bf16x8 b1 = *(const LAS bf16x8*)(Ks + kswz(32 + r32, 2 * (d0) + hi)); \
    p0 = __builtin_amdgcn_mfma_f32_32x32x16_bf16(b0, Q, p0, 0, 0, 0); p1 = __builtin_amdgcn_mfma_f32_32x32x16_bf16(b1, Q, p1, 0, 0, 0); } while (0)
    QK1(0, q0); QK1(1, q1); QK1(2, q2); QK1(3, q3);
#undef QK1
}
__device__ __forceinline__ int v_st(int k, int c) { const int kk = (k & ~0xC) | ((k & 4) << 1) | ((k & 8) >> 1); return ((kk >> 3) * 4 + (c >> 5)) * 512 + ((kk & 7) * 32 + (c & 31)) * 2; }
__device__ __forceinline__ int v_rd_base(int lane) { return ((lane & 3) << 3) | (((lane >> 2) & 3) << 6) | (((lane >> 4) & 1) << 5) | (((lane >> 5) & 1) << 8); }
constexpr int v_rd_off(int d0, int ks, int half) { return d0 * 512 + ks * 4096 + half * 2048; }
template <int OFF> __device__ __forceinline__ s16x4 tr_read(int vb) {
    s16x4 r; asm volatile("ds_read_b64_tr_b16 %0, %1 offset:%2" : "=&v"(r) : "v"(vb), "i"(OFF) : "memory"); return r;
}
template <int D0> __device__ __forceinline__ void pv_one(f32x16& od, int vb, bf16x8 pa0, bf16x8 pa1, bf16x8 pa2, bf16x8 pa3) {
    const s16x4 l0 = tr_read<v_rd_off(D0, 0, 0)>(vb), h0 = tr_read<v_rd_off(D0, 0, 1)>(vb), l1 = tr_read<v_rd_off(D0, 1, 0)>(vb), h1 = tr_read<v_rd_off(D0, 1, 1)>(vb);
    const s16x4 l2 = tr_read<v_rd_off(D0, 2, 0)>(vb), h2 = tr_read<v_rd_off(D0, 2, 1)>(vb), l3 = tr_read<v_rd_off(D0, 3, 0)>(vb), h3 = tr_read<v_rd_off(D0, 3, 1)>(vb);
    asm volatile("s_waitcnt lgkmcnt(0)" ::: "memory"); SBAR();
#define PK(L, H) (bf16x8){L[0], L[1], L[2], L[3], H[0], H[1], H[2], H[3]}
    od = __builtin_amdgcn_mfma_f32_32x32x16_bf16(pa0, PK(l0, h0), od, 0, 0, 0);
    od = __builtin_amdgcn_mfma_f32_32x32x16_bf16(pa1, PK(l1, h1), od, 0, 0, 0);
    od = __builtin_amdgcn_mfma_f32_32x32x16_bf16(pa2, PK(l2, h2), od, 0, 0, 0);
    od = __builtin_amdgcn_mfma_f32_32x32x16_bf16(pa3, PK(l3, h3), od, 0, 0, 0);
#undef PK
}
__device__ __forceinline__ void pv_d0(f32x16* o, int vb, bf16x8 pa0, bf16x8 pa1, bf16x8 pa2, bf16x8 pa3) {
    pv_one<0>(o[0], vb, pa0, pa1, pa2, pa3); pv_one<1>(o[1], vb, pa0, pa1, pa2, pa3); pv_one<2>(o[2], vb, pa0, pa1, pa2, pa3); pv_one<3>(o[3], vb, pa0, pa1, pa2, pa3);
}

template <bool LATENT>
__device__ __forceinline__ void attn_unit(const bf16_t* Qb, const bf16_t* Kb, const bf16_t* Vb, bf16_t* Ob, int qrow0, int b, int hh,
                                          float lam, float oscale, const float* __restrict__ subln, const float* __restrict__ rope, LAS char* lds, int wave_) {
    int wid = wave_; asm volatile("" : "+s"(wid));
    const int lane = fresh_lane(), tid = (wid << 6) | lane, r32 = lane & 31, hi = lane >> 5;
    LAS char* V_lds = lds + LDS_V; LAS char* K_lds = lds + LDS_K;
    LAS float* wsf = (LAS float*)(lds + LDS_WS) + wid * 64; LAS float* li_l = wsf; LAS float* al_l = wsf + 32;
    LAS unsigned* stash = (LAS unsigned*)(lds + LDS_STASH + wid * 8192);
    constexpr int NT = 64;
    const int ctx0 = ML + b * CTXL, lat0 = b * SEQ;
    const int myrow = qrow0 + wid * QBLK + r32;
    const int ksr = tid >> 3, ksc = tid & 7, kst = kswz(ksr, ksc);
    const int sr = tid >> 4, sc = (tid & 15) * 8, vst0 = v_st(sr, sc), vst1 = v_st(32 + sr, sc);
    const int vb0 = (int)(uintptr_t)V_lds + v_rd_base(lane);
    f32x16 o[4];
#pragma unroll 1
    for (int c = 0; c < 2; ++c) {
        bf16x8 q0, q1, q2, q3;
        { const bf16_t* Qw = Qb + (size_t)myrow * 1024 + hh * 128 + c * 64 + hi * 8;
          q0 = *(const bf16x8*)(Qw); q1 = *(const bf16x8*)(Qw + 16); q2 = *(const bf16x8*)(Qw + 32); q3 = *(const bf16x8*)(Qw + 48); }
        const unsigned voV0 = (unsigned)(sr * 1024 + hh * 128 + sc) * 2u, voK = (unsigned)(ksr * 1024 + hh * 128 + c * 64 + ksc * 8) * 2u;
        float m_reg = -1e30f, l_reg = 0.f;
#pragma unroll
        for (int d = 0; d < 4; ++d) o[d] = f32x16{};
        bf16x8 sv0[1], sv1[1], sk0[1];
#define SLOAD(i, kr) do { unsigned a_ = voV0, b_ = voV0 + 32u * 2048u, c_ = voK; asm volatile("" : "+v"(a_), "+v"(b_), "+v"(c_)); \
        const char* vb_ = (const char*)Vb + (size_t)(kr) * 2048; const char* kb_ = (const char*)Kb + (size_t)(kr) * 2048; \
        sv0[i] = *(const bf16x8*)(vb_ + a_); sv1[i] = *(const bf16x8*)(vb_ + b_); sk0[i] = *(const bf16x8*)(kb_ + c_); } while (0)
#define SWRITE2(vs, kb, i) do { *(LAS bf16x8*)(V_lds + (vs) * SHM_V + vst0) = sv0[i]; *(LAS bf16x8*)(V_lds + (vs) * SHM_V + vst1) = sv1[i]; *(LAS bf16x8*)(K_lds + (kb) * SHM_K + kst) = sk0[i]; } while (0)
#define SWRITE(bb, i) SWRITE2(bb, bb, i)
#define SWAIT() asm volatile("s_waitcnt vmcnt(3)" ::: "memory")
#define RESC(a) do { if (__any((a) < 1.f)) { if (hi == 0) al_l[r32] = (a); asm volatile("s_waitcnt lgkmcnt(0)" ::: "memory"); \
        _Pragma("unroll") for (int d = 0; d < 4; ++d) _Pragma("unroll") for (int r = 0; r < 16; ++r) o[d][r] *= al_l[crow(r, hi)]; } } while (0)
        f32x16 pA0, pA1; float mnA, alA; bf16x8 pa0, pa1, pa2, pa3;
        SLOAD(0, ctx0);
#pragma unroll 1
        for (int j = 0; j < 4; ++j) {
            __syncthreads();
            asm volatile("s_waitcnt vmcnt(0)" ::: "memory"); SWRITE(0, 0);
            { const int nr = j < 3 ? ctx0 + 64 * (j + 1) : (LATENT ? lat0 : ctx0); SLOAD(0, nr); }
            __syncthreads();
            qkt(pA0, pA1, K_lds, q0, q1, q2, q3, r32, hi); partialSM(pA0, pA1, m_reg, mnA, alA);
            RESC(alA);
            finishSM(pA0, pA1, alA, l_reg, pa0, pa1, pa2, pa3); SBAR();
            pv_d0(o, vb0, pa0, pa1, pa2, pa3);
        }
        if (LATENT) {
            {
                const int t = myrow & 4095, pos0 = t >> 6, pos1 = t & 63;
                const float* r0p = rope + (pos0 * 16 + 8 * hi) * 2; const float* r1p = rope + (pos1 * 16 + 8 * hi) * 2;
#pragma unroll
                for (int j = 0; j < 8; ++j) {
                    const float c0 = r0p[2 * j], s0 = r0p[2 * j + 1], c1 = r1p[2 * j], s1 = r1p[2 * j + 1];
                    const float x1 = bf2f((unsigned short)q0[j]), x2 = bf2f((unsigned short)q1[j]), z1 = bf2f((unsigned short)q2[j]), z2 = bf2f((unsigned short)q3[j]);
                    const unsigned w0 = cvt_pk_bf16(x1 * c0 - x2 * s0, x2 * c0 + x1 * s0), w1 = cvt_pk_bf16(z1 * c1 - z2 * s1, z2 * c1 + z1 * s1);
                    q0[j] = (short)(w0 & 0xffffu); q1[j] = (short)(w0 >> 16); q2[j] = (short)(w1 & 0xffffu); q3[j] = (short)(w1 >> 16);
                }
            }
            f32x16 pB0, pB1; float mnB, alB;
            __syncthreads();
            asm volatile("s_waitcnt vmcnt(0)" ::: "memory"); SWRITE(0, 0);
            SLOAD(0, lat0 + 64); __syncthreads();
            qkt(pA0, pA1, K_lds, q0, q1, q2, q3, r32, hi); partialSM(pA0, pA1, m_reg, mnA, alA);
            RESC(alA);
            asm volatile("s_waitcnt vmcnt(0)" ::: "memory"); SWRITE(1, 0); SLOAD(0, lat0 + 128); __syncthreads();
            const bool gB = wid >= 4;
            int ph = 0;
#pragma unroll 1
            for (int j = 1; j + 1 < NT; j += 2) {
                const int s0 = ph, s1 = ph == 2 ? 0 : ph + 1, s2 = s1 == 2 ? 0 : s1 + 1;
                SBAR(); qkt(pB0, pB1, K_lds + SHM_K, q0, q1, q2, q3, r32, hi);
                finishSM(pA0, pA1, alA, l_reg, pa0, pa1, pa2, pa3); SBAR();
                if (!gB) { pv_d0(o, vb0 + s0 * SHM_V, pa0, pa1, pa2, pa3); partialSM(pB0, pB1, m_reg, mnB, alB); }
                __syncthreads(); asm volatile("s_waitcnt vmcnt(0)" ::: "memory"); SWRITE2(s2, 0, 0);
                SLOAD(0, lat0 + 64 * (j + 2 < NT ? j + 2 : NT - 1));
                if (!gB) RESC(alB);
                __syncthreads();
                if (gB) { pv_d0(o, vb0 + s0 * SHM_V, pa0, pa1, pa2, pa3); partialSM(pB0, pB1, m_reg, mnB, alB); RESC(alB); }
                SBAR(); qkt(pA0, pA1, K_lds, q0, q1, q2, q3, r32, hi);
                finishSM(pB0, pB1, alB, l_reg, pa0, pa1, pa2, pa3); SBAR();
                if (!gB) { pv_d0(o, vb0 + s1 * SHM_V, pa0, pa1, pa2, pa3); partialSM(pA0, pA1, m_reg, mnA, alA); }
                __syncthreads(); asm volatile("s_waitcnt vmcnt(0)" ::: "memory"); SWRITE2(s0, 1, 0);
                SLOAD(0, lat0 + 64 * (j + 3 < NT ? j + 3 : NT - 1));
                if (!gB) RESC(alA);
                __syncthreads();
                if (gB) { pv_d0(o, vb0 + s1 * SHM_V, pa0, pa1, pa2, pa3); partialSM(pA0, pA1, m_reg, mnA, alA); RESC(alA); }
                ph = s2;
            }
            { const int s0 = ph, s1 = ph == 2 ? 0 : ph + 1;
            SBAR(); qkt(pB0, pB1, K_lds + SHM_K, q0, q1, q2, q3, r32, hi);
            finishSM(pA0, pA1, alA, l_reg, pa0, pa1, pa2, pa3); SBAR();
            pv_d0(o, vb0 + s0 * SHM_V, pa0, pa1, pa2, pa3); partialSM(pB0, pB1, m_reg, mnB, alB);
            __syncthreads(); RESC(alB);
            finishSM(pB0, pB1, alB, l_reg, pa0, pa1, pa2, pa3); SBAR();
            pv_d0(o, vb0 + s1 * SHM_V, pa0, pa1, pa2, pa3); }
        }
        if (hi == 0) li_l[r32] = l_reg; asm volatile("s_waitcnt lgkmcnt(0)" ::: "memory");
        if (c == 0) {
#pragma unroll
            for (int r = 0; r < 16; ++r) { const float rl = 1.0f / li_l[crow(r, hi)];
#pragma unroll
                for (int d = 0; d < 4; d += 2) stash[(r * 2 + (d >> 1)) * 64 + lane] = cvt_pk_bf16(o[d][r] * rl, o[d + 1][r] * rl); }
        } else {
            bf16_t* Ow = Ob + (size_t)(qrow0 + wid * QBLK) * 1024 + hh * 128;
            float gsub[4];
#pragma unroll
            for (int d = 0; d < 4; ++d) gsub[d] = subln[d * 32 + r32] * oscale;
#pragma unroll
            for (int r = 0; r < 16; ++r) {
                const float rl = lam / li_l[crow(r, hi)]; float acc2 = 0.f;
#pragma unroll
                for (int d = 0; d < 4; d += 2) { const unsigned w = stash[(r * 2 + (d >> 1)) * 64 + lane];
                    const float a0 = bflo(w) - o[d][r] * rl, a1 = bfhi(w) - o[d + 1][r] * rl;
                    o[d][r] = a0; o[d + 1][r] = a1; acc2 += a0 * a0 + a1 * a1; }
#pragma unroll
                for (int off = 1; off < 32; off <<= 1) acc2 += __shfl_xor(acc2, off);
                const float rs = 1.0f / sqrtf(acc2 * (1.f / 128.f) + 1e-5f);
                const int orow = crow(r, hi);
#pragma unroll
                for (int d = 0; d < 4; ++d) Ow[(size_t)orow * 1024 + d * 32 + r32] = (bf16_t)(cvt_pk_bf16(o[d][r] * rs * gsub[d], 0.f) & 0xffffu);
            }
        }
    }
#undef SLOAD
#undef SWRITE
#undef SWAIT
#undef RESC
}
#undef SBAR
}
#ifndef SCAN_TSEL
#define SCAN_TSEL 0
#endif
namespace rwkv {
constexpr int A_W = 0, A_KK = 16384, A_B = 32768, A_KD = 49152, A_R = 65536, A_V = 81920, A_Y = 98304, A_TW = A_Y, A_TA = A_Y + 8192, A_PRM = 133120, A_GC = A_PRM + 15 * 256, A_GT = A_GC + 256, A_END = A_GT + 2048;
constexpr int C_AT = 0, C_RT = 8192, C_BT = 16384, C_KT = 24576, C_KHT = 32768, C_BHT = 40960, C_VT = 49152, C_LAK = 57344, C_LAB = 65536  , C_RHS = 82944  , C_MRK = 100352, C_MRB = 108544, C_ZN = 116736, C_S0B = 139264;
constexpr int RHSP = 68;
constexpr int LABP = 68;
static_assert(A_END <= C_S0B && C_S0B + 8192 <= LDS_BYTES && C_ZN + 8192 <= RING_BYTES && C_RHS >= C_LAB + 64 * LABP * 4 && C_MRK >= C_RHS + 64 * RHSP * 4 && A_END <= LDS_BYTES && A_PRM >= MISC_OFF + 512, "scan LDS");
struct Params { const bf16_t* cs; bf16_t* co; bf16_t* y; float* bon; const float* mu; const float* w0; const float* w2; const float* a0; const float* a2; const float* kk; const float* ka; const float* rk; };
__device__ __forceinline__ float dpp_ror_add(float x, int) { return x; }
#define ROR_ADD(x, n) do { const int t_ = __builtin_amdgcn_update_dpp(0, __builtin_bit_cast(int, x), 0x120 + (n), 0xf, 0xf, false); x += __builtin_bit_cast(float, t_); } while (0)
__device__ __forceinline__ float row16_sum(float x) { ROR_ADD(x, 8); ROR_ADD(x, 4); ROR_ADD(x, 2); ROR_ADD(x, 1); return x; }
__device__ __forceinline__ void ld8(const bf16_t* p, float (&o)[8]) { const u32x4 w = *(const u32x4*)p; o[0] = bflo(w.x); o[1] = bfhi(w.x); o[2] = bflo(w.y); o[3] = bfhi(w.y); o[4] = bflo(w.z); o[5] = bfhi(w.z); o[6] = bflo(w.w); o[7] = bfhi(w.w); }
template <class MP> __device__ __forceinline__ void shift8(const bf16_t* base, size_t pitch, size_t row, int col, bool hp, bool hn, MP m0, MP m1, float (&o)[8]) {
    float c[8], p[8], n[8]; ld8(base + row * pitch + col, c); ld8(base + (hp ? row - 1 : row) * pitch + col, p); ld8(base + (hn ? row + 1 : row) * pitch + col, n);
#pragma unroll
    for (int i = 0; i < 8; ++i) { const float pv = hp ? p[i] : 0.f, nv = hn ? n[i] : 0.f; o[i] = c[i] + m0[i] * (pv - c[i]) + m1[i] * (nv - c[i]); }
}
__device__ __forceinline__ void lds_ld8(const LAS float* p, float (&o)[8]) { const f32x4 a = *(const LAS f32x4*)p, b = *(const LAS f32x4*)(p + 4); o[0] = a[0]; o[1] = a[1]; o[2] = a[2]; o[3] = a[3]; o[4] = b[0]; o[5] = b[1]; o[6] = b[2]; o[7] = b[3]; }
__device__ __forceinline__ void lds_st8(LAS float* p, const float (&o)[8]) { *(LAS f32x4*)p = (f32x4){o[0], o[1], o[2], o[3]}; *(LAS f32x4*)(p + 4) = (f32x4){o[4], o[5], o[6], o[7]}; }
__device__ __forceinline__ void scan_wg(const Params& P, int d, int b, int hh, LAS char* lds, int wave_) {
    unsigned long long tprev_ = 0;
#define SC_T(k) do { if (SCAN_TSEL != 0) { if (blockIdx.x == 0 && tid == 0) { const unsigned long long tn_ = __builtin_amdgcn_s_memrealtime(); if ((SCAN_TSEL >> (k)) & 1) { volatile LAS unsigned* M_ = (volatile LAS unsigned*)(lds + MISC_OFF); const unsigned long long ac_ = (((unsigned long long)M_[19] << 32) | M_[18]) + (tn_ - tprev_); M_[18] = (unsigned)ac_; M_[19] = (unsigned)(ac_ >> 32); } tprev_ = tn_; } } } while (0)
    int wid = wave_; asm volatile("" : "+s"(wid));
    const int lane0 = fresh_lane(), tid = (wid << 6) | lane0, r32o = lane0 & 31, hio = lane0 >> 5;
    LAS float* W = (LAS float*)(lds + A_W); LAS float* KK = (LAS float*)(lds + A_KK); LAS float* Bv = (LAS float*)(lds + A_B); LAS float* KD = (LAS float*)(lds + A_KD);
    LAS float* Rv = (LAS float*)(lds + A_R); LAS float* Vv = (LAS float*)(lds + A_V); LAS float* Y = (LAS float*)(lds + A_Y);
    LAS bf16_t* TW = (LAS bf16_t*)(lds + A_TW); LAS bf16_t* TA = (LAS bf16_t*)(lds + A_TA); LAS float* PRM = (LAS float*)(lds + A_PRM);
    __syncthreads();
    for (int i = tid; i < 15 * 64; i += NTHREADS) { const int p = i >> 6, c = i & 63; float v;
        switch (p) {
            case 0: v = P.mu[hh * 64 + c]; break;             case 1: v = P.mu[1920 + hh * 64 + c]; break;
            case 2: v = P.mu[512 + hh * 64 + c]; break;       case 3: v = P.mu[1920 + 512 + hh * 64 + c]; break;
            case 4: v = P.mu[1024 + d * 64 + c]; break;       case 5: v = P.mu[1920 + 1024 + d * 64 + c]; break;
            case 6: v = P.mu[1152 + d * 64 + c]; break;       case 7: v = P.mu[1920 + 1152 + d * 64 + c]; break;
            case 8: v = P.mu[1280 + hh * 64 + c]; break;      case 9: v = P.mu[1920 + 1280 + hh * 64 + c]; break;
            case 10: v = P.w0[d * 512 + hh * 64 + c]; break;  case 11: v = P.a0[d * 512 + hh * 64 + c]; break;
            case 12: v = P.kk[hh * 64 + c]; break;            case 13: v = P.ka[hh * 64 + c]; break;
            default: v = P.rk[hh * 64 + c]; break; }
        PRM[i] = v; }
    const int mtx = wid >> 2, ti = (wid >> 1) & 1, tj = wid & 1;
    bf16x8 bw[4];
    { const int r32 = r32o, hi = hio; const float* src = (mtx == 0 ? P.w2 : P.a2) + (size_t)d * 64 * 512 + hh * 64 + 32 * tj + r32;
#pragma unroll
      for (int s = 0; s < 4; ++s) {
          u32x4 w;
          w.x = cvt_pk_bf16(src[(size_t)(16 * s + 8 * hi + 0) * 512], src[(size_t)(16 * s + 8 * hi + 1) * 512]);
          w.y = cvt_pk_bf16(src[(size_t)(16 * s + 8 * hi + 2) * 512], src[(size_t)(16 * s + 8 * hi + 3) * 512]);
          w.z = cvt_pk_bf16(src[(size_t)(16 * s + 8 * hi + 4) * 512], src[(size_t)(16 * s + 8 * hi + 5) * 512]);
          w.w = cvt_pk_bf16(src[(size_t)(16 * s + 8 * hi + 6) * 512], src[(size_t)(16 * s + 8 * hi + 7) * 512]);
          bw[s] = __builtin_bit_cast(bf16x8, w); } }
    LAS float* GC = (LAS float*)(lds + A_GC); LAS float* GT = (LAS float*)(lds + A_GT);
    f32x16 Sreg = f32x16{};
    for (int i = tid; i < 2048; i += NTHREADS) ((LAS unsigned*)(lds + C_S0B))[i] = 0u;
    __syncthreads();
    u32x4 rc[5], rpv[5], rnv[5];
#define LOADRAW(BLK) do { const bool ic_ = (BLK) < 4; const int bb_ = ic_ ? (BLK) : (BLK) - 4; const int sb_ = ic_ ? ML + b * CTXL : b * SEQ, sl_ = ic_ ? CTXL : SEQ; \
        const int r0_ = d == 0 ? sb_ + 64 * bb_ : sb_ + sl_ - 64 * (bb_ + 1); int tq_ = tid; asm volatile("" : "+v"(tq_)); const int pj_ = tq_ >> 3, cg_ = tq_ & 7; \
        const int row_ = d == 0 ? r0_ + pj_ : r0_ + 63 - pj_; const int pos_ = row_ - sb_; const size_t rp_ = pos_ > 0 ? row_ - 1 : row_, rn_ = pos_ < sl_ - 1 ? row_ + 1 : row_; \
        const int cs_[5] = {hh * 64 + 8 * cg_, 512 + hh * 64 + 8 * cg_, 1024 + d * 64 + 8 * cg_, 1152 + d * 64 + 8 * cg_, hh * 64 + 8 * cg_}; \
        _Pragma("unroll") for (int sgi = 0; sgi < 5; ++sgi) { const bf16_t* base_ = sgi < 4 ? P.cs : (const bf16_t*)P.co; const size_t pitch_ = sgi < 4 ? DCS : DCOP; \
            rc[sgi] = *(const u32x4*)(base_ + (size_t)row_ * pitch_ + cs_[sgi]); rpv[sgi] = *(const u32x4*)(base_ + rp_ * pitch_ + cs_[sgi]); rnv[sgi] = *(const u32x4*)(base_ + rn_ * pitch_ + cs_[sgi]); \
            } } while (0)
    LOADRAW(0);
#pragma unroll 1
    for (int blk = 0; blk < 68; ++blk) {
        const bool isctx = blk < 4; const int bb = isctx ? blk : blk - 4;
        const int segbase = isctx ? ML + b * CTXL : b * SEQ, seglen = isctx ? CTXL : SEQ;
        const int r0 = d == 0 ? segbase + 64 * bb : segbase + seglen - 64 * (bb + 1);
        int tl_ = tid; asm volatile("" : "+v"(tl_));
        const int lane = tl_ & 63, r32 = lane & 31, hi = lane >> 5, pj = tl_ >> 3, cg = tl_ & 7;
        SC_T(0);
        {
            const int row = d == 0 ? r0 + pj : r0 + 63 - pj; const int pos = row - segbase; const unsigned pmk = pos > 0 ? 0xffffffffu : 0u, nmk = pos < seglen - 1 ? 0xffffffffu : 0u;
#define SHIFT8(sgi, M0, M1, OUT) do { const unsigned cw_[4] = {rc[sgi].x, rc[sgi].y, rc[sgi].z, rc[sgi].w}, pw_[4] = {rpv[sgi].x & pmk, rpv[sgi].y & pmk, rpv[sgi].z & pmk, rpv[sgi].w & pmk}, nw_[4] = {rnv[sgi].x & nmk, rnv[sgi].y & nmk, rnv[sgi].z & nmk, rnv[sgi].w & nmk}; \
                _Pragma("unroll") for (int i = 0; i < 4; ++i) { const f32x2 c_ = {bflo(cw_[i]), bfhi(cw_[i])}, p_ = {bflo(pw_[i]), bfhi(pw_[i])}, n_ = {bflo(nw_[i]), bfhi(nw_[i])}; \
                    const f32x2 a0_ = {(M0)[2 * i], (M0)[2 * i + 1]}, a1_ = {(M1)[2 * i], (M1)[2 * i + 1]}; const f32x2 o_ = c_ + a0_ * (p_ - c_) + a1_ * (n_ - c_); OUT[2 * i] = o_.x; OUT[2 * i + 1] = o_.y; } } while (0)
            float ks[8], xs[8], ssq = 0.f;
            float m0[8], m1[8];
            lds_ld8(PRM + 0 * 64 + 8 * cg, m0); lds_ld8(PRM + 1 * 64 + 8 * cg, m1); SHIFT8(0, m0, m1, ks);
            lds_st8(KD + pj * 64 + 8 * cg, ks);
            lds_ld8(PRM + 12 * 64 + 8 * cg, m0);
#pragma unroll
            for (int i = 0; i < 8; ++i) { const float t = ks[i] * m0[i]; ks[i] = t; ssq += t * t; }
            ssq += __shfl_xor(ssq, 1); ssq += __shfl_xor(ssq, 2); ssq += __shfl_xor(ssq, 4);
            const float inv = __builtin_amdgcn_rcpf(fmaxf(sqrtf(ssq), 1e-12f));
#pragma unroll
            for (int i = 0; i < 8; ++i) ks[i] *= inv;
            lds_st8(KK + pj * 64 + 8 * cg, ks);
            lds_ld8(PRM + 2 * 64 + 8 * cg, m0); lds_ld8(PRM + 3 * 64 + 8 * cg, m1); SHIFT8(1, m0, m1, xs);
            lds_st8(Vv + pj * 64 + 8 * cg, xs);
            lds_ld8(PRM + 8 * 64 + 8 * cg, m0); lds_ld8(PRM + 9 * 64 + 8 * cg, m1); SHIFT8(4, m0, m1, xs);
            lds_st8(Rv + pj * 64 + 8 * cg, xs);
            lds_ld8(PRM + 4 * 64 + 8 * cg, m0); lds_ld8(PRM + 5 * 64 + 8 * cg, m1); SHIFT8(2, m0, m1, xs);
            { u32x4 w;
#pragma unroll
              for (int i = 0; i < 8; ++i) { const float e2 = __expf(2.f * xs[i]); xs[i] = 1.f - 2.f / (e2 + 1.f); }
              w.x = cvt_pk_bf16(xs[0], xs[1]); w.y = cvt_pk_bf16(xs[2], xs[3]); w.z = cvt_pk_bf16(xs[4], xs[5]); w.w = cvt_pk_bf16(xs[6], xs[7]);
              *(LAS u32x4*)(TW + pj * 64 + 8 * cg) = w; }
            lds_ld8(PRM + 6 * 64 + 8 * cg, m0); lds_ld8(PRM + 7 * 64 + 8 * cg, m1); SHIFT8(3, m0, m1, xs);
            { u32x4 w; w.x = cvt_pk_bf16(xs[0], xs[1]); w.y = cvt_pk_bf16(xs[2], xs[3]); w.z = cvt_pk_bf16(xs[4], xs[5]); w.w = cvt_pk_bf16(xs[6], xs[7]);
              *(LAS u32x4*)(TA + pj * 64 + 8 * cg) = w; }
#undef SHIFT8
        }
        if (blk + 1 < 68) LOADRAW(blk + 1);
        __syncthreads(); SC_T(1);
        {
            const LAS bf16_t* T = mtx == 0 ? TW : TA; LAS float* dst = mtx == 0 ? W : Bv;
            f32x16 cacc = f32x16{};
#pragma unroll
            for (int s = 0; s < 4; ++s) { const bf16x8 af = *(const LAS bf16x8*)(T + (32 * ti + r32) * 64 + 16 * s + 8 * hi);
                cacc = __builtin_amdgcn_mfma_f32_32x32x16_bf16(af, bw[s], cacc, 0, 0, 0); }
#pragma unroll
            for (int r = 0; r < 16; ++r) dst[(32 * ti + (r & 3) + 8 * (r >> 2) + 4 * hi) * 64 + 32 * tj + r32] = cacc[r];
        }
        __syncthreads(); SC_T(2);
        {
            const int row = d == 0 ? r0 + pj : r0 + 63 - pj; float bsum = 0.f; const int o8 = pj * 64 + 8 * cg;
            float lw[8], la[8], kdv[8], kkv[8], rv[8], p10[8], p11[8], p13[8], p14[8];
            lds_ld8(W + o8, lw); lds_ld8(Bv + o8, la); lds_ld8(KD + o8, kdv); lds_ld8(KK + o8, kkv); lds_ld8(Rv + o8, rv);
            lds_ld8(PRM + 10 * 64 + 8 * cg, p10); lds_ld8(PRM + 11 * 64 + 8 * cg, p11); lds_ld8(PRM + 13 * 64 + 8 * cg, p13); lds_ld8(PRM + 14 * 64 + 8 * cg, p14);
#pragma unroll
            for (int i = 0; i < 8; ++i) {
                const float x = p10[i] + lw[i]; const float dec = __expf(-0.60653065971263342f * sigmoidf_(x));
                const float a = sigmoidf_(p11[i] + la[i]);
                const float kd = kdv[i] * (1.f + (a - 1.f) * p13[i]);
                lw[i] = dec; kdv[i] = kd; la[i] = kkv[i] * a; bsum += rv[i] * kd * p14[i]; }
            lds_st8(W + o8, lw); lds_st8(KD + o8, kdv); lds_st8(Bv + o8, la);
            bsum += __shfl_xor(bsum, 1); bsum += __shfl_xor(bsum, 2); bsum += __shfl_xor(bsum, 4);
            if (cg == 0) P.bon[(size_t)d * MT * 8 + (size_t)row * 8 + hh] = bsum;
        }
        __syncthreads(); SC_T(3);
        {
            const int kcol = tl_ & 63, seg = wid; float p[8], run = 1.f;
#pragma unroll
            for (int i = 0; i < 8; ++i) { run *= W[(8 * seg + i) * 64 + kcol]; p[i] = run; }
            GT[seg * 64 + kcol] = run;
            __syncthreads();
            float pre = 1.f;
#pragma unroll
            for (int sg2 = 0; sg2 < 7; ++sg2) { const float tv = GT[sg2 * 64 + kcol]; if (sg2 < seg) pre *= tv; }
#pragma unroll
            for (int i = 0; i < 8; ++i) W[(8 * seg + i) * 64 + kcol] = pre * p[i];
        }
        __syncthreads();
        {
            const int o8 = pj * 64 + 8 * cg;
            float g[8], gx[8], kk[8], rr[8], bb[8], kd[8];
            lds_ld8(W + o8, g); if (pj > 0) lds_ld8(W + o8 - 64, gx); else {
#pragma unroll
                for (int i = 0; i < 8; ++i) gx[i] = 1.f; }
            lds_ld8(KK + o8, kk); lds_ld8(Rv + o8, rr); lds_ld8(Bv + o8, bb); lds_ld8(KD + o8, kd);
            const int kc2 = tl_ & 63, tc2 = wid;
            float g2[8], kd2[8], bb2[8], vv2[8]; const float gc2 = W[63 * 64 + kc2];
#pragma unroll
            for (int i = 0; i < 8; ++i) { const int o = (8 * tc2 + i) * 64 + kc2; g2[i] = W[o]; kd2[i] = KD[o]; bb2[i] = Bv[o]; vv2[i] = Vv[o]; }
            __syncthreads();
            u32x4 w;
#define PK8(EXPR) do { float e_[8]; _Pragma("unroll") for (int i = 0; i < 8; ++i) e_[i] = (EXPR); w.x = cvt_pk_bf16(e_[0], e_[1]); w.y = cvt_pk_bf16(e_[2], e_[3]); w.z = cvt_pk_bf16(e_[4], e_[5]); w.w = cvt_pk_bf16(e_[6], e_[7]); } while (0)
            const int ao = attn::kswz(pj, cg);
            PK8(kk[i] * gx[i]); *(LAS u32x4*)(lds + C_AT + ao) = w;
            PK8(rr[i] * g[i]);  *(LAS u32x4*)(lds + C_RT + ao) = w;
            float ig[8];
#pragma unroll
            for (int i = 0; i < 8; ++i) ig[i] = __builtin_amdgcn_rcpf(g[i]);
            PK8(bb[i] * ig[i]); *(LAS u32x4*)(lds + C_BT + ao) = w;
            PK8(kd[i] * ig[i]); *(LAS u32x4*)(lds + C_KT + ao) = w;
            const int ao2 = attn::kswz(kc2, tc2);
#pragma unroll
            for (int i = 0; i < 8; ++i) ig[i] = gc2 * __builtin_amdgcn_rcpf(g2[i]);
            PK8(kd2[i] * ig[i]); *(LAS u32x4*)(lds + C_KHT + ao2) = w;
            PK8(bb2[i] * ig[i]); *(LAS u32x4*)(lds + C_BHT + ao2) = w;
            PK8(vv2[i]);               *(LAS u32x4*)(lds + C_VT + ao2) = w;
            if (tc2 == 7) GC[kc2] = gc2;
#undef PK8
        }
        __syncthreads(); SC_T(4);
#define FRAG(ARR, ROW, CH) (*(const LAS bf16x8*)(lds + (ARR) + attn::kswz((ROW), (CH))))
        {
            const int tr = wid >> 1, ti = tr & 1; const int Aarr = tr < 2 ? C_AT : C_RT;
#pragma unroll
            for (int h2 = 0; h2 < 2; ++h2) { const int tc = 2 * (wid & 1) + h2, tj = tc & 1; const int Barr = tc < 2 ? C_BT : C_KT;
                f32x16 acc = f32x16{};
#pragma unroll
                for (int q = 0; q < 4; ++q) acc = __builtin_amdgcn_mfma_f32_32x32x16_bf16(FRAG(Barr, 32 * tj + r32, 2 * q + hi), FRAG(Aarr, 32 * ti + r32, 2 * q + hi), acc, 0, 0, 0);
                const int t = 32 * ti + r32;
                const int d0 = 32 * tj + 4 * hi - t - (tr < 2 ? 0 : 1);
                if (tr < 2 && tc < 2) {
                    LAS float* lp = (LAS float*)(lds + C_LAB) + (32 * tj + 4 * hi) * LABP + (t & 3) * 16 + (t >> 2);
#pragma unroll
                    for (int r = 0; r < 16; ++r) { const int e = (r & 3) + 8 * (r >> 2); const unsigned mk = (unsigned)((d0 + e) >> 31);
                        lp[e * LABP] = __uint_as_float(__float_as_uint(acc[r]) & mk); }
                } else {
                    const int dst = tr < 2 ? C_LAK : (tc < 2 ? C_MRB : C_MRK);
#pragma unroll
                    for (int gq = 0; gq < 4; ++gq) { const int tp0 = 32 * tj + 8 * gq + 4 * hi; float vv4[4];
#pragma unroll
                        for (int e = 0; e < 4; ++e) { const unsigned mk = (unsigned)((d0 + 8 * gq + e) >> 31); vv4[e] = __uint_as_float(__float_as_uint(acc[4 * gq + e]) & mk); }
                        u32x2 w2; w2.x = cvt_pk_bf16(vv4[0], vv4[1]); w2.y = cvt_pk_bf16(vv4[2], vv4[3]);
                        *(LAS u32x2*)(lds + dst + attn::kswz(t, tp0 >> 3) + (tp0 & 7) * 2) = w2; }
                }
            }
        }
        __syncthreads(); SC_T(5);
        if (wid < 4) {
            const int ti = wid >> 1, tj = wid & 1; f32x16 acc = f32x16{};
#pragma unroll
            for (int q = 0; q < 4; ++q) acc = __builtin_amdgcn_mfma_f32_32x32x16_bf16(FRAG(C_S0B, 32 * tj + r32, 2 * q + hi), FRAG(C_AT, 32 * ti + r32, 2 * q + hi), acc, 0, 0, 0);
#pragma unroll
            for (int q = 0; q < 4; ++q) acc = __builtin_amdgcn_mfma_f32_32x32x16_bf16(FRAG(C_VT, 32 * tj + r32, 2 * q + hi), FRAG(C_LAK, 32 * ti + r32, 2 * q + hi), acc, 0, 0, 0);
            const int t = 32 * ti + r32;
#pragma unroll
            for (int r = 0; r < 16; ++r) { const int v = 32 * tj + (r & 3) + 8 * (r >> 2) + 4 * hi; *(LAS float*)(lds + C_RHS + (v * RHSP + (t & 3) * 16 + (t >> 2)) * 4) = acc[r]; }
        }
        else {
                const int ti = (wid >> 1) & 1, tj = wid & 1; const float gcv = GC[32 * tj + r32];
#pragma unroll
                for (int r = 0; r < 16; ++r) Sreg[r] *= gcv;
#pragma unroll
                for (int q = 0; q < 4; ++q) Sreg = __builtin_amdgcn_mfma_f32_32x32x16_bf16(FRAG(C_VT, 32 * ti + r32, 2 * q + hi), FRAG(C_KHT, 32 * tj + r32, 2 * q + hi), Sreg, 0, 0, 0);
        }
        __syncthreads(); SC_T(6);
        f32x16 Yacc = f32x16{}; bf16x8 mrb[4] = {};
        if (wid >= 4) {
            const int q = lane & 3, v = 16 * (wid - 4) + (lane >> 2);
            const LAS float* LT = (const LAS float*)(lds + C_LAB) + q * 16;
            f32x2 sa[8]; float zo[16];
            { const LAS f32x4* rp = (const LAS f32x4*)(lds + C_RHS + (v * RHSP + q * 16) * 4);
#pragma unroll
              for (int g4 = 0; g4 < 4; ++g4) { const f32x4 x = rp[g4]; sa[2 * g4] = (f32x2){x[0], x[1]}; sa[2 * g4 + 1] = (f32x2){x[2], x[3]}; } }
#pragma unroll
            for (int i = 0; i < 16; ++i) zo[i] = 0.f;
            f32x4 la[4], lb[4];
#define LLOAD(t, A) do { const LAS f32x4* lp_ = (const LAS f32x4*)(LT + (t) * LABP); _Pragma("unroll") for (int g_ = (t) >> 4; g_ < 4; ++g_) A[g_] = lp_[g_]; } while (0)
#define SOLVE_STEP(t, A, N) do { if ((t) < 63) LLOAD((t) + 1, N); const float zown_ = (((t) >> 2) & 1) ? sa[(t) >> 3].y : sa[(t) >> 3].x; \
                const float zt_ = __builtin_bit_cast(float, __builtin_amdgcn_update_dpp(0, __builtin_bit_cast(int, zown_), ((t) & 3) * 0x55, 0xf, 0xf, true)); \
                if (q == ((t) & 3)) zo[(t) >> 2] = zt_; const f32x2 nz_ = {-zt_, -zt_}; \
                _Pragma("unroll") for (int p_ = (t) >> 3; p_ < 8; ++p_) { const f32x2 l2_ = (p_ & 1) ? (f32x2){A[p_ >> 1][2], A[p_ >> 1][3]} : (f32x2){A[p_ >> 1][0], A[p_ >> 1][1]}; sa[p_] = l2_ * nz_ + sa[p_]; } } while (0)
#define SOLVE2(t) SOLVE_STEP(t, la, lb); SOLVE_STEP((t) + 1, lb, la)
#define SOLVE8(t) SOLVE2(t); SOLVE2((t) + 2); SOLVE2((t) + 4); SOLVE2((t) + 6)
            LLOAD(0, la);
            SOLVE8(0); SOLVE8(8); SOLVE8(16); SOLVE8(24); SOLVE8(32); SOLVE8(40); SOLVE8(48); SOLVE8(56);
#undef SOLVE8
#undef SOLVE2
#undef SOLVE_STEP
#undef LLOAD
#pragma unroll
            for (int i = 0; i < 16; ++i) { const int t = 4 * i + q; *(LAS bf16_t*)(lds + C_ZN + attn::kswz(v, t >> 3) + (t & 7) * 2) = (bf16_t)(cvt_pk_bf16(-zo[i], 0.f) & 0xffffu); }
        } else {
            const int ti = wid >> 1, tj = wid & 1;
#pragma unroll
            for (int q = 0; q < 4; ++q) mrb[q] = FRAG(C_MRB, 32 * ti + r32, 2 * q + hi);
#pragma unroll
            for (int q = 0; q < 4; ++q) Yacc = __builtin_amdgcn_mfma_f32_32x32x16_bf16(FRAG(C_RT, 32 * ti + r32, 2 * q + hi), FRAG(C_S0B, 32 * tj + r32, 2 * q + hi), Yacc, 0, 0, 0);
#pragma unroll
            for (int q = 0; q < 4; ++q) Yacc = __builtin_amdgcn_mfma_f32_32x32x16_bf16(FRAG(C_MRK, 32 * ti + r32, 2 * q + hi), FRAG(C_VT, 32 * tj + r32, 2 * q + hi), Yacc, 0, 0, 0);
        }
        __syncthreads(); SC_T(7);
        if (wid < 4) {
            const int ti = wid >> 1, tj = wid & 1;
#pragma unroll
            for (int q = 0; q < 4; ++q) Yacc = __builtin_amdgcn_mfma_f32_32x32x16_bf16(mrb[q], FRAG(C_ZN, 32 * tj + r32, 2 * q + hi), Yacc, 0, 0, 0);
            bf16_t* yb = P.y + (size_t)d * MT * 512 + hh * 64 + 32 * tj + r32;
#pragma unroll
            for (int r = 0; r < 16; ++r) { const int t = 32 * ti + (r & 3) + 8 * (r >> 2) + 4 * hi; const int row = d == 0 ? r0 + t : r0 + 63 - t;
                yb[(size_t)row * 512] = (bf16_t)(cvt_pk_bf16(Yacc[r], 0.f) & 0xffffu); }
            SC_T(8);
        } else {
            const int ti = (wid >> 1) & 1, tj = wid & 1; const int k = 32 * tj + r32;
#pragma unroll
            for (int q = 0; q < 4; ++q) Sreg = __builtin_amdgcn_mfma_f32_32x32x16_bf16(FRAG(C_ZN, 32 * ti + r32, 2 * q + hi), FRAG(C_BHT, 32 * tj + r32, 2 * q + hi), Sreg, 0, 0, 0);
#pragma unroll
            for (int r = 0; r < 16; ++r) { const int v = 32 * ti + (r & 3) + 8 * (r >> 2) + 4 * hi;
                *(LAS bf16_t*)(lds + C_S0B + attn::kswz(v, k >> 3) + (k & 7) * 2) = (bf16_t)(cvt_pk_bf16(Sreg[r], 0.f) & 0xffffu); }
        }
#undef FRAG
    }
    __syncthreads();
}
#undef ROR_ADD
}
struct Frame {
    LAS unsigned char* lds; char* ldsg; volatile LAS unsigned* MISC; gu32* ctl;
    int tid, lane, wave, G, gw, NGW;
    const float* x_in; const float* ctx_in; float* out; unsigned char* ws;
};
enum { I_X = 0, I_C, I_CTX, I_CCTX, I_ADAW, I_ADAB, I_WIN, I_LAMQK, I_SUBLN, I_MU, I_W0, I_W2, I_A0, I_A2, I_G2, I_KK, I_KA, I_RK, I_LNW, I_LNB,
       I_WPA, I_WPF, I_WPC, I_WO, I_LN1G, I_LN1B, I_FUP, I_FCONV, I_FCONVB, I_FDN, I_LN2G, I_LN2B };

struct Row16 { f32x4 v[4]; };
__device__ __forceinline__ void row_load_f32(Row16& r, const float* p, int lane) {
#pragma unroll
    for (int j = 0; j < 4; ++j) r.v[j] = *(const f32x4*)(p + 256 * j + 4 * lane);
}
__device__ __forceinline__ void row_load_bf16(Row16& r, const bf16_t* p, int lane) {
#pragma unroll
    for (int j = 0; j < 4; ++j) { const u32x2 w = *(const u32x2*)(p + 256 * j + 4 * lane); r.v[j] = (f32x4){bflo(w.x), bfhi(w.x), bflo(w.y), bfhi(w.y)}; }
}
__device__ __forceinline__ void row_store_f32(const Row16& r, float* p, int lane) {
#pragma unroll
    for (int j = 0; j < 4; ++j) *(f32x4*)(p + 256 * j + 4 * lane) = r.v[j];
}
__device__ __forceinline__ void row_store_bf16(const Row16& r, bf16_t* p, int lane) {
#pragma unroll
    for (int j = 0; j < 4; ++j) { u32x2 w; w.x = cvt_pk_bf16(r.v[j][0], r.v[j][1]); w.y = cvt_pk_bf16(r.v[j][2], r.v[j][3]); *(u32x2*)(p + 256 * j + 4 * lane) = w; }
}
__device__ __forceinline__ void row_ln_plain(Row16& r) {
    float s = 0.f;
#pragma unroll
    for (int j = 0; j < 4; ++j) s += (r.v[j][0] + r.v[j][1]) + (r.v[j][2] + r.v[j][3]);
    const float mean = wave_sum(s) * (1.f / DM); float q = 0.f;
#pragma unroll
    for (int j = 0; j < 4; ++j) { r.v[j] = r.v[j] - mean; q += (r.v[j][0] * r.v[j][0] + r.v[j][1] * r.v[j][1]) + (r.v[j][2] * r.v[j][2] + r.v[j][3] * r.v[j][3]); }
    const float rstd = 1.0f / sqrtf(wave_sum(q) * (1.f / DM) + LN_EPS);
#pragma unroll
    for (int j = 0; j < 4; ++j) r.v[j] = r.v[j] * rstd;
}
__device__ __forceinline__ void row_affine(Row16& r, const float* g, const float* b, int lane, float gadd) {
#pragma unroll
    for (int j = 0; j < 4; ++j) { const f32x4 gg = *(const f32x4*)(g + 256 * j + 4 * lane), bb = *(const f32x4*)(b + 256 * j + 4 * lane); r.v[j] = r.v[j] * (gg + gadd) + bb; }
}
__device__ __forceinline__ const float* modrow(const Frame& F, int layer, int row) { return (const float*)(F.ws + TAB_MOD) + ((size_t)layer * 5 + (row < ML ? (row >> 12) : 4)) * 6144; }
__device__ __forceinline__ const float* xrow_in(const Frame& F, int layer, int row) {
    if (layer == 0) return row < ML ? F.x_in + (size_t)row * DM : F.ctx_in + (size_t)(row - ML) * DM;
    return row < ML ? F.out + (size_t)row * DM : (const float*)(F.ws + WS_XC) + (size_t)(row - ML) * DM;
}
__device__ __forceinline__ float* xrow_out(const Frame& F, int row) { return row < ML ? F.out + (size_t)row * DM : (float*)(F.ws + WS_XC) + (size_t)(row - ML) * DM; }

__device__ __forceinline__ void pass_modulate(const Frame& F0, int layer, bf16_t* dst, int nrows) {
    Frame F = F0; F.lane = fresh_lane(); F.tid = (F.wave << 6) | F.lane;
    for (int row = F.gw; row < nrows; row += F.NGW) {
        Row16 r; row_load_f32(r, xrow_in(F, layer, row), F.lane); row_ln_plain(r);
        const float* mv = modrow(F, layer, row); row_affine(r, mv + 1024, mv, F.lane, 1.f);
        row_store_bf16(r, dst + (size_t)row * DM, F.lane);
    }
}
__device__ __forceinline__ void pass_ln1(Frame F, int layer, const bf16_t* mix, bf16_t* h2, int nrows, const float* g, const float* bt) {
    F.lane = fresh_lane(); F.tid = (F.wave << 6) | F.lane;
    for (int row0 = F.gw; row0 < nrows; row0 += 2 * F.NGW) {
        const int row1 = row0 + F.NGW; const bool two = row1 < nrows; const int rowb = two ? row1 : row0;
        Row16 ra, ma, rb, mb; row_load_f32(ra, xrow_in(F, layer, row0), F.lane); row_load_bf16(ma, mix + (size_t)row0 * DM, F.lane);
        row_load_f32(rb, xrow_in(F, layer, rowb), F.lane); row_load_bf16(mb, mix + (size_t)rowb * DM, F.lane);
        const float* mva = modrow(F, layer, row0); const float* mvb = modrow(F, layer, rowb);
#pragma unroll
        for (int j = 0; j < 4; ++j) { f32x4 gt = *(const f32x4*)(mva + 2048 + 256 * j + 4 * F.lane); if (DBG_ZERO_MIX) gt = gt * 0.f; ra.v[j] = ra.v[j] * ALPHA + gt * ma.v[j];
            f32x4 gu = *(const f32x4*)(mvb + 2048 + 256 * j + 4 * F.lane); if (DBG_ZERO_MIX) gu = gu * 0.f; rb.v[j] = rb.v[j] * ALPHA + gu * mb.v[j]; }
        row_ln_plain(ra); row_ln_plain(rb); row_affine(ra, g, bt, F.lane, 0.f); row_affine(rb, g, bt, F.lane, 0.f);
        row_store_f32(ra, xrow_out(F, row0), F.lane); if (two) row_store_f32(rb, xrow_out(F, row1), F.lane);
        row_ln_plain(ra); row_ln_plain(rb); row_affine(ra, mva + 4096, mva + 3072, F.lane, 1.f); row_affine(rb, mvb + 4096, mvb + 3072, F.lane, 1.f);
        row_store_bf16(ra, h2 + (size_t)row0 * DM, F.lane); if (two) row_store_bf16(rb, h2 + (size_t)row1 * DM, F.lane);
    }
}
__device__ __forceinline__ void pass_ln2(Frame F, int layer, bf16_t* ffn_h, int nrows, bool next_h, const float* g, const float* bt) {
    F.lane = fresh_lane(); F.tid = (F.wave << 6) | F.lane;
    for (int row0 = F.gw; row0 < nrows; row0 += 2 * F.NGW) {
        const int row1 = row0 + F.NGW; const bool two = row1 < nrows; const int rowb = two ? row1 : row0;
        Row16 ra, ma, rb, mb; float* xa = xrow_out(F, row0); float* xb = xrow_out(F, rowb);
        row_load_f32(ra, xa, F.lane); row_load_bf16(ma, ffn_h + (size_t)row0 * DM, F.lane); row_load_f32(rb, xb, F.lane); row_load_bf16(mb, ffn_h + (size_t)rowb * DM, F.lane);
        const float* mva = modrow(F, layer, row0); const float* mvb = modrow(F, layer, rowb);
#pragma unroll
        for (int j = 0; j < 4; ++j) { f32x4 gt = *(const f32x4*)(mva + 5120 + 256 * j + 4 * F.lane); if (DBG_ZERO_FFN) gt = gt * 0.f; ra.v[j] = ra.v[j] * ALPHA + gt * ma.v[j];
            f32x4 gu = *(const f32x4*)(mvb + 5120 + 256 * j + 4 * F.lane); if (DBG_ZERO_FFN) gu = gu * 0.f; rb.v[j] = rb.v[j] * ALPHA + gu * mb.v[j]; }
        row_ln_plain(ra); row_ln_plain(rb); row_affine(ra, g, bt, F.lane, 0.f); row_affine(rb, g, bt, F.lane, 0.f);
        row_store_f32(ra, xa, F.lane); if (two) row_store_f32(rb, xb, F.lane);
        if (next_h) { const float* mna = modrow(F, layer + 1, row0); const float* mnb = modrow(F, layer + 1, rowb);
            row_ln_plain(ra); row_ln_plain(rb); row_affine(ra, mna + 1024, mna, F.lane, 1.f); row_affine(rb, mnb + 1024, mnb, F.lane, 1.f);
            row_store_bf16(ra, ffn_h + (size_t)row0 * DM, F.lane); if (two) row_store_bf16(rb, ffn_h + (size_t)row1 * DM, F.lane); }
    }
}
__device__ __forceinline__ float gelu_fast(float v) {
    const float av = fabsf(v), t = __builtin_amdgcn_rcpf(av * 0.2316418882f + 1.0f);
    float q = t * 0.5307027145f + (-0.7265760135f); q = q * t + 0.7107068705f; q = q * t + (-0.142248368f); q = q * t + 0.127414796f; q = q * t;
    const float e = __builtin_amdgcn_exp2f((v * v) * (-0.72134752044f)); const float m = v * (q * e);
    return v < 0.f ? m : v - m;
}
__device__ __forceinline__ void pass_conv(Frame F, bf16_t* ug, int nrows, const float* cw, const float* cb) {
    F.lane = fresh_lane(); F.tid = (F.wave << 6) | F.lane;
    const long total = (long)nrows * (DFF / 8), stride = (long)F.G * NTHREADS;
    for (long it = (long)blockIdx.x * NTHREADS + F.tid; it < total; it += stride) {
        const int row = (int)(it / (DFF / 8)), c = (int)(it % (DFF / 8)) * 8;
        int pos, len; if (row < ML) { pos = row & 4095; len = SEQ; } else { pos = (row - ML) & 255; len = CTXL; }
        const bool hp = pos > 0, hn = pos < len - 1;
        bf16_t* up = ug + (size_t)row * NP + c;
        float u[8], gc[8], gp[8], gn[8];
        rwkv::ld8(up, u); rwkv::ld8(up + DFF, gc); rwkv::ld8(up + DFF - (hp ? NP : 0), gp); rwkv::ld8(up + DFF + (hn ? NP : 0), gn);
        float o[8];
        float w0[8], w1[8], w2[8], bb[8];
        { const f32x4 a = *(const f32x4*)(cw + c), b = *(const f32x4*)(cw + c + 4); w0[0]=a[0];w0[1]=a[1];w0[2]=a[2];w0[3]=a[3];w0[4]=b[0];w0[5]=b[1];w0[6]=b[2];w0[7]=b[3]; }
        { const f32x4 a = *(const f32x4*)(cw + DFF + c), b = *(const f32x4*)(cw + DFF + c + 4); w1[0]=a[0];w1[1]=a[1];w1[2]=a[2];w1[3]=a[3];w1[4]=b[0];w1[5]=b[1];w1[6]=b[2];w1[7]=b[3]; }
        { const f32x4 a = *(const f32x4*)(cw + 2 * DFF + c), b = *(const f32x4*)(cw + 2 * DFF + c + 4); w2[0]=a[0];w2[1]=a[1];w2[2]=a[2];w2[3]=a[3];w2[4]=b[0];w2[5]=b[1];w2[6]=b[2];w2[7]=b[3]; }
        { const f32x4 a = *(const f32x4*)(cb + c), b = *(const f32x4*)(cb + c + 4); bb[0]=a[0];bb[1]=a[1];bb[2]=a[2];bb[3]=a[3];bb[4]=b[0];bb[5]=b[1];bb[6]=b[2];bb[7]=b[3]; }
#pragma unroll
        for (int i = 0; i < 8; ++i) {
            const float x = w0[i] * (hp ? gp[i] : 0.f) + w1[i] * gc[i] + w2[i] * (hn ? gn[i] : 0.f) + bb[i];
            o[i] = gelu_fast(x) * u[i];
        }
        u32x4 w; w.x = cvt_pk_bf16(o[0], o[1]); w.y = cvt_pk_bf16(o[2], o[3]); w.z = cvt_pk_bf16(o[4], o[5]); w.w = cvt_pk_bf16(o[6], o[7]);
        *(u32x4*)up = w;
    }
}

__device__ __forceinline__ void ldf8(const float* p, float (&o)[8]) { const f32x4 a = *(const f32x4*)p, b = *(const f32x4*)(p + 4); o[0]=a[0];o[1]=a[1];o[2]=a[2];o[3]=a[3];o[4]=b[0];o[5]=b[1];o[6]=b[2];o[7]=b[3]; }
__device__ __forceinline__ void pass_sg(Frame F, bf16_t* co, int nrows, const float* mu) {
    F.lane = fresh_lane(); F.tid = (F.wave << 6) | F.lane;
    const int sub = F.lane >> 4, cl = (F.lane & 15) * 8;
    float m0[8], m1[8]; ldf8(mu + 1280 + 512 + cl, m0); ldf8(mu + 1920 + 1280 + 512 + cl, m1);
    for (int row = 4 * F.gw + sub; row < nrows; row += 4 * F.NGW) {
        int pos, len; if (row < ML) { pos = row & 4095; len = SEQ; } else { pos = (row - ML) & 255; len = CTXL; }
        const bool hp = pos > 0, hn = pos < len - 1;
        bf16_t* p = co + (size_t)row * DCOP + 512 + cl;
        float c[8], pv[8], nv[8], o[8]; rwkv::ld8(p, c); rwkv::ld8(p - (hp ? DCOP : 0), pv); rwkv::ld8(p + (hn ? DCOP : 0), nv);
#pragma unroll
        for (int i = 0; i < 8; ++i) { const float a = hp ? pv[i] : 0.f, b = hn ? nv[i] : 0.f; o[i] = sigmoidf_(c[i] + m0[i] * (a - c[i]) + m1[i] * (b - c[i])); }
        u32x4 w; w.x = cvt_pk_bf16(o[0], o[1]); w.y = cvt_pk_bf16(o[2], o[3]); w.z = cvt_pk_bf16(o[4], o[5]); w.w = cvt_pk_bf16(o[6], o[7]);
        *(u32x4*)(p + (DCO - 512)) = w;
    }
}
struct PostRow { u32x4 a0, a1, gg, vc, vp, vn; float bsum; };
__device__ __forceinline__ void post_load(PostRow& R, int row, int c, int head, const bf16_t* y0, const bf16_t* y1, const bf16_t* g, const bf16_t* cs, const float* bon) {
    int pos, len; if (row < ML) { pos = row & 4095; len = SEQ; } else { pos = (row - ML) & 255; len = CTXL; }
    const bool hp = pos > 0, hn = pos < len - 1; const size_t o = (size_t)row * 512 + c;
    R.a0 = *(const u32x4*)(y0 + o); R.a1 = *(const u32x4*)(y1 + o); R.gg = *(const u32x4*)(g + o);
    const bf16_t* vq = cs + (size_t)row * DCS + 512 + c;
    R.vc = *(const u32x4*)vq; R.vp = *(const u32x4*)(vq - (hp ? DCS : 0)); R.vn = *(const u32x4*)(vq + (hn ? DCS : 0));
    if (!hp) R.vp = (u32x4){0u, 0u, 0u, 0u}; if (!hn) R.vn = (u32x4){0u, 0u, 0u, 0u};
    R.bsum = bon[(size_t)row * 8 + head] + bon[(size_t)MT * 8 + (size_t)row * 8 + head];
}
__device__ __forceinline__ void up8(const u32x4 w, float (&o)[8]) { o[0] = bflo(w.x); o[1] = bfhi(w.x); o[2] = bflo(w.y); o[3] = bfhi(w.y); o[4] = bflo(w.z); o[5] = bfhi(w.z); o[6] = bflo(w.w); o[7] = bfhi(w.w); }
__device__ __forceinline__ u32x4 post_finish(const PostRow& R, const float (&lw)[8], const float (&lb)[8], const float (&m0)[8], const float (&m1)[8]) {
    float y[8], t[8], gv[8], vc[8], vp[8], vn[8]; up8(R.a0, y); up8(R.a1, t); up8(R.gg, gv); up8(R.vc, vc); up8(R.vp, vp); up8(R.vn, vn);
    float s = 0.f;
#pragma unroll
    for (int i = 0; i < 8; ++i) { y[i] += t[i]; s += y[i]; }
    s += __shfl_xor(s, 1); s += __shfl_xor(s, 2); s += __shfl_xor(s, 4);
    const float mean = s * (1.f / 64.f); float q = 0.f;
#pragma unroll
    for (int i = 0; i < 8; ++i) { y[i] -= mean; q += y[i] * y[i]; }
    q += __shfl_xor(q, 1); q += __shfl_xor(q, 2); q += __shfl_xor(q, 4);
    const float rstd = 1.0f / sqrtf(q * (1.f / 64.f) + 64.f * 1e-5f);
#pragma unroll
    for (int i = 0; i < 8; ++i) { const float vs = vc[i] + m0[i] * (vp[i] - vc[i]) + m1[i] * (vn[i] - vc[i]); y[i] = (y[i] * rstd * lw[i] + lb[i] + R.bsum * vs) * gv[i]; }
    u32x4 w; w.x = cvt_pk_bf16(y[0], y[1]); w.y = cvt_pk_bf16(y[2], y[3]); w.z = cvt_pk_bf16(y[4], y[5]); w.w = cvt_pk_bf16(y[6], y[7]);
    return w;
}
__device__ __forceinline__ void pass_post(Frame F, int nrows, bf16_t* y0, const bf16_t* y1, const bf16_t* g, const bf16_t* cs, const float* bon, const float* mu, const float* lnw, const float* lnb) {
    F.lane = fresh_lane(); F.tid = (F.wave << 6) | F.lane;
    const int c = 8 * F.lane, head = F.lane >> 3;
    float lw[8], lb[8], m0[8], m1[8]; ldf8(lnw + c, lw); ldf8(lnb + c, lb); ldf8(mu + 512 + c, m0); ldf8(mu + 1920 + 512 + c, m1);
    for (int row0 = F.gw; row0 < nrows; row0 += 2 * F.NGW) {
        const int row1 = row0 + F.NGW; const bool two = row1 < nrows; const int rowb = two ? row1 : row0;
        PostRow A, B; post_load(A, row0, c, head, y0, y1, g, cs, bon); post_load(B, rowb, c, head, y0, y1, g, cs, bon);
        const u32x4 wa = post_finish(A, lw, lb, m0, m1), wb = post_finish(B, lw, lb, m0, m1);
        *(u32x4*)(y0 + (size_t)row0 * 512 + c) = wa; if (two) *(u32x4*)(y0 + (size_t)row1 * 512 + c) = wb;
    }
}

__device__ __forceinline__ unsigned f2bf(float f) { unsigned u = __builtin_bit_cast(unsigned, f); return (u + 0x7fffu + ((u >> 16) & 1u)) >> 16; }
__device__ __forceinline__ unsigned pk2(float lo, float hi) { return f2bf(lo) | (f2bf(hi) << 16); }
__device__ __forceinline__ void transpose_item(const float* W, int K, int N, bf16_t* WT, int item, LAS float* scr, int lane, int rowadd_from, int rowadd) {
    const int nblk = N / 32, kb = item / nblk, nb = item % nblk, k0 = 64 * kb, n0 = 32 * nb;
    const int row_off = n0 >= rowadd_from ? rowadd : 0;
    float wv[32];
#pragma unroll
    for (int i = 0; i < 32; ++i) { const int kk = 2 * i + (lane >> 5); wv[i] = W[(size_t)(k0 + kk) * N + n0 + (lane & 31)]; }
#pragma unroll
    for (int i = 0; i < 32; ++i) { const int kk = 2 * i + (lane >> 5); scr[kk * 33 + (lane & 31)] = wv[i]; }
    LDS_WAIT(); asm volatile("" ::: "memory");
    const int c = lane & 7;
#pragma unroll
    for (int j = 0; j < 4; ++j) { const int n = (lane >> 3) + 8 * j; const LAS float* s = scr + (8 * c) * 33 + n;
        u32x4 o; o.x = pk2(s[0 * 33], s[1 * 33]); o.y = pk2(s[2 * 33], s[3 * 33]); o.z = pk2(s[4 * 33], s[5 * 33]); o.w = pk2(s[6 * 33], s[7 * 33]);
        *(GAS u32x4*)(WT + (size_t)(row_off + n0 + n) * K + k0 + 8 * c) = o; }
    LDS_WAIT(); asm volatile("" ::: "memory");
}
#define CONVERT_WEIGHTS(F, layer, INP) do { \
    convert_weights_((F), (layer), INP(I_WIN), INP(I_WPA), INP(I_WPF), INP(I_WPC), INP(I_WO), INP(I_FUP), INP(I_FDN), INP(I_G2)); } while (0)
__device__ __forceinline__ void convert_weights_(const Frame& F_, int layer, const float* p_win, const float* p_wpa, const float* p_wpf, const float* p_wpc, const float* p_wo, const float* p_fup, const float* p_fdn, const float* p_g2) {
    Frame F = F_; F.lane = fresh_lane(); F.tid = (F.wave << 6) | F.lane;
    LAS float* scr = (LAS float*)(F.lds + F.wave * 16384);
    constexpr int N_IN = 16 * (D_IN_SRC / 32), N_PA = 16 * 32, N_PF = 8 * 32, N_PC = 8 * 32, N_O = 16 * 32, N_UP = 16 * (2 * DFF / 32), N_DN = (DFF / 64) * 32, N_G2 = 2 * 16;
    constexpr int NITEMS = N_IN + N_PA + N_PF + N_PC + N_O + N_UP + N_DN + N_G2;
    unsigned char* ws = F.ws;
    for (int it = F.gw; it < NITEMS; it += F.NGW) {
        int r = it;
        if (r < N_IN) { transpose_item(p_win + (size_t)layer * DM * D_IN_SRC, DM, D_IN_SRC, (bf16_t*)(ws + W_IN), r, scr, F.lane, 5504, 128); continue; } r -= N_IN;
        if (r < N_PA) { transpose_item(p_wpa + (size_t)layer * 1024 * DM, 1024, DM, (bf16_t*)(ws + W_PA), r, scr, F.lane, 1 << 30, 0); continue; } r -= N_PA;
        if (r < N_PF) { transpose_item(p_wpf + (size_t)layer * 512 * DM, 512, DM, (bf16_t*)(ws + W_PF), r, scr, F.lane, 1 << 30, 0); continue; } r -= N_PF;
        if (r < N_PC) { transpose_item(p_wpc + (size_t)layer * 512 * DM, 512, DM, (bf16_t*)(ws + W_PC), r, scr, F.lane, 1 << 30, 0); continue; } r -= N_PC;
        if (r < N_O) { transpose_item(p_wo + (size_t)layer * DM * DM, DM, DM, (bf16_t*)(ws + W_O), r, scr, F.lane, 1 << 30, 0); continue; } r -= N_O;
        if (r < N_UP) { transpose_item(p_fup + (size_t)layer * DM * 2 * DFF, DM, 2 * DFF, (bf16_t*)(ws + W_UP), r, scr, F.lane, 1 << 30, 0); continue; } r -= N_UP;
        if (r < N_DN) { transpose_item(p_fdn + (size_t)layer * DFF * DM, DFF, DM, (bf16_t*)(ws + W_DN), r, scr, F.lane, 1 << 30, 0); continue; } r -= N_DN;
        transpose_item(p_g2 + (size_t)layer * 128 * 512, 128, 512, (bf16_t*)(ws + W_G2T), r, scr, F.lane, 1 << 30, 0);
    }
    { u32x4* z = (u32x4*)(ws + W_IN + (size_t)5504 * DM * 2); const int n16 = 128 * DM * 2 / 16;
      unsigned zz = 0u; asm volatile("" : "+v"(zz));
      for (int i = blockIdx.x * NTHREADS + F.tid; i < n16; i += F.G * NTHREADS) z[i] = (u32x4){zz, zz, zz, zz}; }
}
__device__ __forceinline__ void build_tables(Frame F, const float* lamqk) {
    F.lane = fresh_lane(); F.tid = (F.wave << 6) | F.lane;
    const int gt = blockIdx.x * NTHREADS + F.tid, NT_ = F.G * NTHREADS;
    float* rope = (float*)(F.ws + TAB_ROPE); float* tw = (float*)(F.ws + TAB_TW);
    bf16_t* w0 = (bf16_t*)(F.ws + TAB_W0); bf16_t* f1 = (bf16_t*)(F.ws + TAB_F1); bf16_t* f2 = (bf16_t*)(F.ws + TAB_F2); bf16_t* dc = (bf16_t*)(F.ws + TAB_DC);
    for (int i = gt; i < 1024; i += NT_) { const int pos = i >> 4, f = i & 15; const float inv = powf(10000.f, -(float)f / 16.f); const float ang = (float)pos * inv;
        rope[2 * i] = (float)cos((double)ang); rope[2 * i + 1] = (float)sin((double)ang); }
    for (int i = gt; i < 4096; i += NT_) { const int kl = i >> 6, tl = i & 63; float s, c; sincospif(2.f * (float)(kl * tl) / 4096.f, &s, &c); tw[2 * i] = c; tw[2 * i + 1] = s; }
    for (int i = gt; i < 256 * 128; i += NT_) { const int r = i >> 7, c = i & 127, ri = r >> 7, m = r & 127; float s, co; sincospif(2.f * (float)((m * c) & 127) / 128.f, &s, &co);
        w0[i] = (bf16_t)f2bf((ri == 0 ? co : -s) * 0.088388347648318f); }
    for (int i = gt; i < 256 * 256; i += NT_) { const int r = i >> 8, k = i & 255; const int rip = r >> 7, p = (r >> 6) & 1, kl = r & 63, ri = k >> 7, p2 = (k >> 6) & 1, th = k & 63;
        float s, co; sincospif(2.f * (float)((kl * th) & 63) / 64.f, &s, &co);
        float v = 0.f; if (p == p2) v = (rip == ri) ? co : (rip == 0 ? s : -s);
        f1[i] = (bf16_t)f2bf(v * 0.125f); }
    for (int i = gt; i < 256 * 512; i += NT_) { const int r = i >> 9, k = i & 511; const int pp = r >> 6, kh = r & 63, rip = k >> 8, p2 = (k >> 6) & 3, tl = k & 63;
        float s, co; sincospif(2.f * (float)((kh * tl) & 63) / 64.f, &s, &co);
        const float v = (pp == p2) ? (rip == 0 ? co : s) : 0.f;
        f2[i] = (bf16_t)f2bf(v * 0.125f); }
    for (int i = gt; i < 256 * 512; i += NT_) { const int k = i >> 9, kk = i & 511, ri = kk >> 8, t = kk & 255;
        float s, co; sincospif(2.f * (float)((k * t) & 255) / 256.f, &s, &co);
        dc[i] = (bf16_t)f2bf((ri == 0 ? co : s) * 0.0625f); }
    if (gt < NLAYER) {
        const float* lq = lamqk + gt * 256; float s1 = 0.f, s2 = 0.f;
        for (int i = 0; i < 64; ++i) { s1 += lq[i] * lq[64 + i]; s2 += lq[128 + i] * lq[192 + i]; }
        const float lam_init = 0.8f - 0.6f * expf(-0.3f * (float)gt);
        float* lamv = (float*)(F.ws + TAB_LAM); lamv[2 * gt] = expf(s1) - expf(s2) + lam_init; lamv[2 * gt + 1] = 1.f - lam_init;
    }
}
__device__ __forceinline__ void build_mod(Frame F, const float* cvec, const float* cctx, const float* adaw, const float* adab) {
    F.lane = fresh_lane(); F.tid = (F.wave << 6) | F.lane;
    LAS float* sil = (LAS float*)F.lds;
    LAS float* part = sil + 5 * 1024;
    for (int i = F.tid; i < 5 * 1024; i += NTHREADS) { const int s = i >> 10, k = i & 1023; const float c = s < 4 ? cvec[s * 1024 + k] : cctx[k]; sil[i] = c / (1.f + expf(-c)); }
    __syncthreads();
    for (int cgid = blockIdx.x; cgid < 256; cgid += F.G) {
        const int l = cgid >> 7, j0 = (cgid & 127) * 48;
        if (F.tid < 384) { const int col = F.tid % 48, kg = F.tid / 48; const float* w = adaw + ((size_t)l * 1024 + 128 * kg) * 6144 + j0 + col;
            float a0 = 0.f, a1 = 0.f, a2 = 0.f, a3 = 0.f, a4 = 0.f;
            for (int k = 0; k < 128; ++k) { const float wv = w[(size_t)k * 6144]; const int kk = 128 * kg + k;
                a0 += sil[kk] * wv; a1 += sil[1024 + kk] * wv; a2 += sil[2048 + kk] * wv; a3 += sil[3072 + kk] * wv; a4 += sil[4096 + kk] * wv; }
            part[(kg * 5 + 0) * 48 + col] = a0; part[(kg * 5 + 1) * 48 + col] = a1; part[(kg * 5 + 2) * 48 + col] = a2; part[(kg * 5 + 3) * 48 + col] = a3; part[(kg * 5 + 4) * 48 + col] = a4; }
        __syncthreads();
        if (F.tid < 240) { const int s = F.tid / 48, col = F.tid % 48; float a = adab[l * 6144 + j0 + col];
            for (int kg = 0; kg < 8; ++kg) a += part[(kg * 5 + s) * 48 + col];
            ((float*)(F.ws + TAB_MOD))[((size_t)l * 5 + s) * 6144 + j0 + col] = a; }
        __syncthreads();
    }
}
#ifndef MK_PER_PHASE
#define MK_PER_PHASE 0
#endif
#ifndef TIME_SEL
#define TIME_SEL 0
#endif
constexpr int N_PHASES = 2 + 13 * NLAYER;
#ifndef SCAN_SEL
#define SCAN_SEL(bx) ((((bx) >> 3) & 3) == 0 && ((bx) >> 5) < 8)
#define SCAN_SID(bx) (((bx) >> 5) * 8 + ((bx) & 7))
#define SCAN_RANK(bx) ((bx) - 8 * (((bx) >> 5) + 1))
#endif
struct Args { const float* in[32]; float* out; unsigned char* ws; int ph_lo, ph_hi; };

__device__ __forceinline__ pg8::Operand opnd(const void* base, long tM, long tN, long rstride, long kstep) {
    pg8::Operand o; o.base = (const char*)base; o.tM = tM; o.tN = tN; o.tN2 = 0; o.nshift = 30; o.rstride = rstride; o.hstep = 128 * rstride; o.kstep = kstep; return o; }
constexpr int CW_SUB = 2048;
__device__ __forceinline__ void sub_arrive_wait(gu32* cnt, unsigned add, unsigned target, bool t0) {
    asm volatile("s_waitcnt vmcnt(0)" ::: "memory"); __syncthreads();
    if (t0) {
        __builtin_amdgcn_fence(__ATOMIC_RELEASE, "agent"); asm volatile("s_waitcnt vmcnt(0)" ::: "memory");
        if (add) (void)__hip_atomic_fetch_add(cnt, add, RLX_AGENT);
        unsigned sp = 0; while (__hip_atomic_load(cnt, RLX_AGENT) < target) { __builtin_amdgcn_s_sleep(2); if (++sp > (1u << 24)) break; }
        __builtin_amdgcn_fence(__ATOMIC_ACQUIRE, "agent"); asm volatile("s_waitcnt vmcnt(0)" ::: "memory");
    }
    __syncthreads();
}
struct RowF0 { __device__ __forceinline__ unsigned operator()(int R) const { return (unsigned)(((R & 63) * 64 + (R >> 6)) * 1024); } };

__global__ void __launch_bounds__(NTHREADS, 2) mk_fwd(Args args) {
    extern __shared__ __attribute__((aligned(16))) unsigned char lds[];
    Frame F;
    F.lds = (LAS unsigned char*)lds; F.ldsg = (char*)lds;
    F.MISC = (volatile LAS unsigned*)(F.lds + MISC_OFF);
    F.tid = threadIdx.x; F.lane = F.tid & 63; F.wave = __builtin_amdgcn_readfirstlane(F.tid >> 6);
    F.G = gridDim.x; F.gw = blockIdx.x * NWAVES + F.wave; F.NGW = F.G * NWAVES;
    F.x_in = args.in[I_X]; F.ctx_in = args.in[I_CTX];
    F.out = args.out; F.ws = args.ws; F.ctl = (gu32*)(args.ws + WS_CTL);
    unsigned char* ws0 = args.ws;
#define T0 (fresh_tid(F.wave) == 0)
#ifndef CH_WG
#define CH_WG 8
#endif
#define CH_T(k) do { if ((TIME_SEL >> 20) != 0) { if (blockIdx.x == CH_WG && T0) { const unsigned long long tn_ = __builtin_amdgcn_s_memrealtime(); const unsigned long long tp_ = ((unsigned long long)F.MISC[21] << 32) | F.MISC[20]; if ((TIME_SEL >> (20 + (k))) & 1) { const unsigned long long ac_ = (((unsigned long long)F.MISC[19] << 32) | F.MISC[18]) + (tn_ - tp_); F.MISC[18] = (unsigned)ac_; F.MISC[19] = (unsigned)(ac_ >> 32); } F.MISC[20] = (unsigned)tn_; F.MISC[21] = (unsigned)(tn_ >> 32); } } } while (0)
#define LWS size_t wo_ = 0; int bx = bx0, G = G0; asm volatile("" : "+s"(wo_), "+s"(bx), "+s"(G)); unsigned char* ws = ws0 + wo_
    for (int u = F.tid; u < (LDS_BYTES - LDSCTL_OFF) / 4; u += NTHREADS) ((LAS unsigned*)(F.lds + LDSCTL_OFF))[u] = 0u;
    __syncthreads();
    XcdBarrier bar; bar.bar = (unsigned*)(F.ctl + CW_BAR); bar.x = 0; bar.st = nullptr;
    if (!MK_PER_PHASE) bar = xcd_barrier_post((unsigned*)(F.ctl + CW_BAR), F.MISC + 8);
    const int lo = args.ph_lo, hi = args.ph_hi;
    if (TIME_SEL) { if (blockIdx.x == 0 && T0) { const unsigned long long tn_ = __builtin_amdgcn_s_memrealtime(); F.MISC[16] = (unsigned)tn_; F.MISC[17] = (unsigned)(tn_ >> 32); } }
#ifndef PHMASK
#define PHMASK 0x7fff
#endif
#define IN(k) (lo <= (k) && (k) < hi)
#define KIND(b) ((PHMASK >> (b)) & 1)
#define INP(i) (args.in[i])
#define SEAM(k) do { if (!MK_PER_PHASE && IN((k) + 1)) xcd_barrier(bar.bar, bar.x, bar.st, T0 ? 1u : 0u); \
    if (TIME_SEL) { if (blockIdx.x == 0 && T0) { const unsigned long long tn_ = __builtin_amdgcn_s_memrealtime(); const unsigned long long tp_ = ((unsigned long long)F.MISC[17] << 32) | F.MISC[16]; \
        const int kind_ = (k) < 2 ? (k) : 2 + ((k) - 2) % 13; if ((TIME_SEL >> kind_) & 1) { const unsigned long long ac_ = (((unsigned long long)F.MISC[19] << 32) | F.MISC[18]) + (tn_ - tp_); F.MISC[18] = (unsigned)ac_; F.MISC[19] = (unsigned)(ac_ >> 32); } \
        F.MISC[16] = (unsigned)tn_; F.MISC[17] = (unsigned)(tn_ >> 32); } } } while (0)
    const int bx0 = blockIdx.x, G0 = F.G;
    pg8::StaticOrder S; S.wave = F.wave;
    const pg8::RowLin rl2048{2048}, rl1024{1024}, rl128{128}, rl256{256}, rl11264{11264}, rl5632{5632};

    if (KIND(0) && IN(0)) { LWS; build_mod(F, INP(I_C), INP(I_CCTX), INP(I_ADAW), INP(I_ADAB)); __syncthreads(); build_tables(F, INP(I_LAMQK)); CONVERT_WEIGHTS(F, 0, INP); SEAM(0); }
    if (KIND(1) && IN(1)) { LWS; pass_modulate(F, 0, (bf16_t*)(ws + WS_HY), MT); SEAM(1); }

#pragma unroll 1
    for (int layer = 0; layer < NLAYER; ++layer) {
        const int pb = 2 + 13 * layer;
        const bool last = layer == NLAYER - 1;
        const int MR = last ? ML : MT;

        if (KIND(2) && IN(pb + 0)) { LWS;
            S.init(MT, NP, G, bx);
            pg8::EpiInProj E{ws, (const float*)(ws + TAB_ROPE)};
            pg8::gemm_phase<pg8::EpiInProj, pg8::RowLin, true>(F.lds, opnd(ws + WS_HY, 256 * 2048, 0, 2048, 128), opnd(ws + W_IN, 0, 256 * 2048, 2048, 128), rl2048, 16, S, E);
            SEAM(pb + 0);
        }
        if (KIND(3) && IN(pb + 1)) { LWS;
#ifndef DBG_NO_SCAN
            if (SCAN_SEL(bx)) {
                const int sid = SCAN_SID(bx);
                rwkv::Params P; P.cs = (const bf16_t*)(ws + P_CS); P.co = (bf16_t*)(ws + P_CO); P.y = (bf16_t*)(ws + WS_HY); P.bon = (float*)(ws + WS_BON);
                P.mu = INP(I_MU) + layer * 2 * 1920; P.w0 = INP(I_W0) + layer * 1024; P.w2 = INP(I_W2) + (size_t)layer * 2 * 64 * 512; P.a0 = INP(I_A0) + layer * 1024;
                P.a2 = INP(I_A2) + (size_t)layer * 2 * 64 * 512; P.kk = INP(I_KK) + layer * 512; P.ka = INP(I_KA) + layer * 512; P.rk = INP(I_RK) + layer * 512;
                unsigned long long ts0_ = 0; if ((TIME_SEL >> 16) & 1) ts0_ = __builtin_amdgcn_s_memrealtime();
                rwkv::scan_wg(P, sid >> 5, (sid >> 3) & 3, sid & 7, (LAS char*)F.lds, F.wave);
                if ((TIME_SEL >> 16) & 1) { if (blockIdx.x == 0 && T0) { const unsigned long long ac_ = (((unsigned long long)F.MISC[19] << 32) | F.MISC[18]) + (__builtin_amdgcn_s_memrealtime() - ts0_); F.MISC[18] = (unsigned)ac_; F.MISC[19] = (unsigned)(ac_ >> 32); } }
            }
#endif
            unsigned long long ta0_ = 0; if ((TIME_SEL >> 17) & 1) ta0_ = __builtin_amdgcn_s_memrealtime();
            if ((TIME_SEL >> 20) != 0) { if (blockIdx.x == CH_WG && T0) { const unsigned long long tn_ = __builtin_amdgcn_s_memrealtime(); F.MISC[20] = (unsigned)tn_; F.MISC[21] = (unsigned)(tn_ >> 32); } }
#if 0
#endif
            const float* tabf = (const float*)(ws + TAB_LAM); const float lam = tabf[2 * layer], osc = tabf[2 * layer + 1];
            const int x = bx & 7, nun = last ? 64 : 68;
            gu32* qw = F.ctl + CW_QUEUE + 64 * (layer * 8 + x);
#ifndef DBG_NO_ATTN
            unsigned ndone = 0;
            for (;;) {
                __syncthreads();
                if (T0) F.MISC[0] = __hip_atomic_fetch_add(qw, 1u, RLX_AGENT);
                __syncthreads();
                const int i = (int)F.MISC[0];
                if (i >= nun) break;
                ++ndone;
                const bf16_t* Q = (const bf16_t*)(ws + P_Q); const bf16_t* K = (const bf16_t*)(ws + P_K); const bf16_t* V = (const bf16_t*)(ws + P_V);
                const float* sub = INP(I_SUBLN) + layer * 128; const float* rope = (const float*)(ws + TAB_ROPE);
                if (i < 64) { const int pair = x + 8 * (i >> 4), qb = i & 15, b = pair >> 3, hh = pair & 7;
                    attn::attn_unit<true>(Q, K, V, (bf16_t*)(ws + P_Q), b * SEQ + 256 * qb, b, hh, lam, osc, sub, rope, (LAS char*)F.lds, F.wave); }
                else { const int pair = x + 8 * (i - 64), b = pair >> 3, hh = pair & 7;
#ifndef DBG_NO_ATTNC
                    attn::attn_unit<false>(Q, K, V, (bf16_t*)(ws + P_Q), ML + b * CTXL, b, hh, lam, osc, sub, rope, (LAS char*)F.lds, F.wave);
#endif
                }
            }
#endif
            CH_T(0);
            {
                const bool is_scan = SCAN_SEL(bx);
                gu32* dcnt = F.ctl + CW_SUB + 64 * (layer * 4 + 0);
                const unsigned total = 8u * (unsigned)nun;
                if (is_scan || G != 256) { sub_arrive_wait(dcnt, ndone, 0u, T0); }
                else {
                    const int rank = SCAN_RANK(bx), GF = 192;
                    { Frame F2 = F; F2.gw = rank * NWAVES + F.wave; F2.NGW = GF * NWAVES;
                      pass_sg(F2, (bf16_t*)(ws + P_CO), MR, INP(I_MU) + layer * 2 * 1920); }
                    sub_arrive_wait(dcnt, ndone, total, T0); CH_T(1);
                    { S.init(1024, ML, GF, rank); pg8::EpiF0 E{(bf16_t*)(ws + P_K)};
                      pg8::Operand B = opnd(ws + P_F, 256, 4 * 1024, 1024, 128); B.nshift = 4; B.tN2 = 4096L * 1024; B.hstep = 2 * 1024;
                      pg8::gemm_phase<pg8::EpiF0, RowF0, true>(F.lds, opnd(ws + TAB_W0, 0, 0, 256, 128), B, RowF0{}, 2, S, E); }
                    if (!last) { S.init(1024, MC, GF, (rank + GF - 64) % GF); pg8::EpiF0c E{(bf16_t*)(ws + P_K + 32 * MiB)};
                      pg8::gemm_phase<pg8::EpiF0c, pg8::RowLin, true>(F.lds, opnd(ws + TAB_W0, 0, 0, 256, 128), opnd(ws + P_F + (size_t)ML * 1024, 256, 256 * 1024, 1024, 128), rl1024, 2, S, E); }
                    sub_arrive_wait(F.ctl + CW_SUB + 64 * (layer * 4 + 1), 1u, (unsigned)GF, T0); CH_T(4);
                    { S.init(256, 65536, GF, rank); pg8::EpiF1 E{(bf16_t*)(ws + P_V), (const float*)(ws + TAB_TW)};
                      pg8::gemm_phase<pg8::EpiF1, pg8::RowLin, true>(F.lds, opnd(ws + TAB_F1, 0, 0, 512, 128), opnd(ws + P_K, 0, 256 * 128, 128, 8 * MiB), rl128, 4, S, E); }
                    if (!last) { S.init(256, 2048, GF, (rank + GF - 72) % GF); pg8::EpiFc E{(bf16_t*)(ws + P_F)};
                      pg8::gemm_phase<pg8::EpiFc, pg8::RowLin, true>(F.lds, opnd(ws + TAB_DC, 0, 0, 1024, 128), opnd(ws + P_K + 32 * MiB, 0, 256 * 1024, 1024, 128), rl1024, 8, S, E); }
                    sub_arrive_wait(F.ctl + CW_SUB + 64 * (layer * 4 + 2), 1u, (unsigned)GF, T0); CH_T(5);
                    { S.init(256, 32768, GF, rank); pg8::EpiF2 E{(bf16_t*)(ws + P_F)};
                      pg8::gemm_phase<pg8::EpiF2, pg8::RowLin, true>(F.lds, opnd(ws + TAB_F2, 0, 0, 1024, 128), opnd(ws + P_V, 0, 256 * 128, 128, 4 * MiB), rl128, 8, S, E); }
                    sub_arrive_wait(F.ctl + CW_SUB + 64 * (layer * 4 + 3), 1u, (unsigned)GF, T0); CH_T(2);
                    { S.init(MR, 512, GF, rank); pg8::EpiBf16 E{(bf16_t*)(ws + P_V), 512};
                      pg8::gemm_phase<pg8::EpiBf16, pg8::RowLin, true>(F.lds, opnd(ws + P_CO + DCO * 2, 256 * 1536, 0, 1536, 128), opnd(ws + W_G2T, 0, 256 * 256, 256, 128), rl256, 2, S, E); }
                    {
                        Frame F2 = F; F2.gw = rank * NWAVES + F.wave; F2.NGW = GF * NWAVES;
                        pass_modulate(F2, layer, (bf16_t*)(ws + P_K), MR); }
                    CH_T(3);
                }
            }
            if ((TIME_SEL >> 17) & 1) { if (blockIdx.x == 8 && T0) { const unsigned long long ac_ = (((unsigned long long)F.MISC[19] << 32) | F.MISC[18]) + (__builtin_amdgcn_s_memrealtime() - ta0_); F.MISC[18] = (unsigned)ac_; F.MISC[19] = (unsigned)(ac_ >> 32); } }
            SEAM(pb + 1); CH_T(6);
        }
        if (KIND(4) && IN(pb + 2)) { LWS;
          if (G != 256) {
            { S.init(1024, ML, G, bx); pg8::EpiF0 E{(bf16_t*)(ws + P_K)};
              pg8::Operand B = opnd(ws + P_F, 256, 4 * 1024, 1024, 128); B.nshift = 4; B.tN2 = 4096L * 1024; B.hstep = 2 * 1024;
              pg8::gemm_phase<pg8::EpiF0, RowF0, true>(F.lds, opnd(ws + TAB_W0, 0, 0, 256, 128), B, RowF0{}, 2, S, E); }
            if (!last) { S.init(1024, MC, G, (bx + G - 16) % G); pg8::EpiF0c E{(bf16_t*)(ws + P_K + 32 * MiB)};
              pg8::gemm_phase<pg8::EpiF0c, pg8::RowLin, true>(F.lds, opnd(ws + TAB_W0, 0, 0, 256, 128), opnd(ws + P_F + (size_t)ML * 1024, 256, 256 * 1024, 1024, 128), rl1024, 2, S, E); }
          }
            if (G != 256) { pass_sg(F, (bf16_t*)(ws + P_CO), MR, INP(I_MU) + layer * 2 * 1920); SEAM(pb + 2); }
        }
        if (KIND(5) && IN(pb + 3)) { LWS;
          if (G != 256) {
            { S.init(256, 65536, G, bx); pg8::EpiF1 E{(bf16_t*)(ws + P_V), (const float*)(ws + TAB_TW)};
              pg8::gemm_phase<pg8::EpiF1, pg8::RowLin, true>(F.lds, opnd(ws + TAB_F1, 0, 0, 512, 128), opnd(ws + P_K, 0, 256 * 128, 128, 8 * MiB), rl128, 4, S, E); }
            if (!last) { S.init(256, 2048, G, (bx + G - 8) % G); pg8::EpiFc E{(bf16_t*)(ws + P_F)};
              pg8::gemm_phase<pg8::EpiFc, pg8::RowLin, true>(F.lds, opnd(ws + TAB_DC, 0, 0, 1024, 128), opnd(ws + P_K + 32 * MiB, 0, 256 * 1024, 1024, 128), rl1024, 8, S, E); }
          }
            if (G != 256) SEAM(pb + 3);
        }
        if (KIND(6) && IN(pb + 4)) { LWS;
            if (G != 256) { S.init(256, 32768, G, bx); pg8::EpiF2 E{(bf16_t*)(ws + P_F)};
              pg8::gemm_phase<pg8::EpiF2, pg8::RowLin, true>(F.lds, opnd(ws + TAB_F2, 0, 0, 1024, 128), opnd(ws + P_V, 0, 256 * 128, 128, 4 * MiB), rl128, 8, S, E); }
            if (G != 256) { S.init(MR, 512, G, bx);
              pg8::EpiRwkvPost E{(const bf16_t*)(ws + WS_HY), (const bf16_t*)(ws + WS_HY) + (size_t)MT * 512, (const bf16_t*)(ws + P_CS), (const float*)(ws + WS_BON),
                                 INP(I_MU) + layer * 2 * 1920, INP(I_LNW) + layer * 512, INP(I_LNB) + layer * 512, (bf16_t*)(ws + WS_HY)};
              pg8::gemm_phase<pg8::EpiRwkvPost, pg8::RowLin, false>(F.lds, opnd(ws + P_CO + DCO * 2, 256 * 1536, 0, 1536, 128), opnd(ws + W_G2T, 0, 256 * 256, 256, 128), rl256, 2, S, E); }
            else pass_post(F, MR, (bf16_t*)(ws + WS_HY), (const bf16_t*)(ws + WS_HY) + (size_t)MT * 512, (const bf16_t*)(ws + P_V), (const bf16_t*)(ws + P_CS), (const float*)(ws + WS_BON),
                           INP(I_MU) + layer * 2 * 1920, INP(I_LNW) + layer * 512, INP(I_LNB) + layer * 512);
            if (G != 256) pass_modulate(F, layer, (bf16_t*)(ws + P_K), MR);
            SEAM(pb + 4);
        }
        if (KIND(7) && IN(pb + 5)) { LWS;
            S.init(MR, NGATE, G, bx); pg8::EpiGate E{(bf16_t*)(ws + P_V)};
            pg8::gemm_phase<pg8::EpiGate, pg8::RowLin, true>(F.lds, opnd(ws + P_K, 256 * 2048, 0, 2048, 128), opnd(ws + W_IN + (size_t)NP * 2048, 0, 256 * 2048, 2048, 128), rl2048, 16, S, E);
            SEAM(pb + 5);
        }
        if (KIND(8) && IN(pb + 6)) { LWS;
            S.init(MR, 1024, G, bx);
            { pg8::EpiBranch<true> E{(const bf16_t*)(ws + P_V), (bf16_t*)(ws + P_K), (DBG_BR & 1) ? 1.f : 0.f};
              pg8::gemm_phase<pg8::EpiBranch<true>, pg8::RowLin, true>(F.lds, opnd(ws + P_Q, 256 * 2048, 0, 2048, 128), opnd(ws + W_PA, 0, 256 * 2048, 2048, 128), rl2048, 16, S, E); }
            VM_WAIT();
            { pg8::EpiBranch<false> E{(const bf16_t*)(ws + P_V) + 1024, (bf16_t*)(ws + P_K), (DBG_BR & 2) ? 1.f : 0.f};
              pg8::gemm_phase<pg8::EpiBranch<false>, pg8::RowLin, true>(F.lds, opnd(ws + P_F, 256 * 1024, 0, 1024, 128), opnd(ws + W_PF, 0, 256 * 1024, 1024, 128), rl1024, 8, S, E); }
            VM_WAIT();
            { pg8::EpiBranch<false> E{(const bf16_t*)(ws + P_V) + 2048, (bf16_t*)(ws + P_K), (DBG_BR & 4) ? 1.f : 0.f};
              pg8::gemm_phase<pg8::EpiBranch<false>, pg8::RowLin, true>(F.lds, opnd(ws + WS_HY, 256 * 1024, 0, 1024, 128), opnd(ws + W_PC, 0, 256 * 1024, 1024, 128), rl1024, 8, S, E); }
            SEAM(pb + 6);
        }
        if (KIND(9) && IN(pb + 7)) { LWS;
            S.init(MR, 1024, G, bx); pg8::EpiBf16 E{(bf16_t*)(ws + P_V), 1024};
            pg8::gemm_phase<pg8::EpiBf16, pg8::RowLin, true>(F.lds, opnd(ws + P_K, 256 * 2048, 0, 2048, 128), opnd(ws + W_O, 0, 256 * 2048, 2048, 128), rl2048, 16, S, E);
            SEAM(pb + 7);
        }
        if (KIND(10) && IN(pb + 8)) { LWS; pass_ln1(F, layer, (const bf16_t*)(ws + P_V), (bf16_t*)(ws + WS_HY), MR, INP(I_LN1G) + layer * DM, INP(I_LN1B) + layer * DM); SEAM(pb + 8); }
        if (KIND(11) && IN(pb + 9)) { LWS;
            S.init(MR, NP, G, bx); pg8::EpiBf16 E{(bf16_t*)(ws + WS_P), NP};
            pg8::gemm_phase<pg8::EpiBf16, pg8::RowLin, true>(F.lds, opnd(ws + WS_HY, 256 * 2048, 0, 2048, 128), opnd(ws + W_UP, 0, 256 * 2048, 2048, 128), rl2048, 16, S, E);
            SEAM(pb + 9);
        }
        if (KIND(12) && IN(pb + 10)) { LWS; pass_conv(F, (bf16_t*)(ws + WS_P), MR, INP(I_FCONV) + (size_t)layer * 3 * DFF, INP(I_FCONVB) + (size_t)layer * DFF); SEAM(pb + 10); }
        if (KIND(13) && IN(pb + 11)) { LWS;
            S.init(MR, 1024, G, bx); pg8::EpiBf16 E{(bf16_t*)(ws + WS_HY), 1024};
            pg8::gemm_phase<pg8::EpiBf16, pg8::RowLin, true>(F.lds, opnd(ws + WS_P, 256 * 11264, 0, 11264, 128), opnd(ws + W_DN, 0, 256 * 5632, 5632, 128), rl5632, 44, S, E);
            SEAM(pb + 11);
        }
        if (KIND(14) && IN(pb + 12)) { LWS;
            pass_ln2(F, layer, (bf16_t*)(ws + WS_HY), MR, !last, INP(I_LN2G) + layer * DM, INP(I_LN2B) + layer * DM);
            if (!last) { __syncthreads(); CONVERT_WEIGHTS(F, layer + 1, INP); }
            SEAM(pb + 12);
        }
    }
    if (TIME_SEL || SCAN_TSEL != 0) { if ((blockIdx.x == 0 || blockIdx.x == 8 || blockIdx.x == CH_WG) && T0) { const unsigned long long ac_ = ((unsigned long long)F.MISC[19] << 32) | F.MISC[18]; const unsigned long long t0_ = __builtin_amdgcn_s_memrealtime(); while (__builtin_amdgcn_s_memrealtime() - t0_ < ac_) __builtin_amdgcn_s_sleep(8); } }
#undef IN
#undef SEAM
}

extern "C" void kernel_launch(void* const* d_in, const int* in_sizes, int n_in, void* d_out, int out_size, void* d_ws, size_t ws_size, hipStream_t stream) {
    static int grid = 0;
    if (grid == 0) {
        if (n_in != 32 || in_sizes[0] != ML * DM || out_size != ML * DM || ws_size < WS_END) { fprintf(stderr, "kernel_launch: unexpected shapes (n_in %d, ws %zu)\n", n_in, ws_size); grid = -1; return; }
        int dev = 0, cus = 0, per_cu = 0;
        if (hipGetDevice(&dev) != hipSuccess || hipDeviceGetAttribute(&cus, hipDeviceAttributeMultiprocessorCount, dev) != hipSuccess) { grid = -1; return; }
        if (hipFuncSetAttribute((const void*)mk_fwd, hipFuncAttributeMaxDynamicSharedMemorySize, LDS_BYTES) != hipSuccess) { fprintf(stderr, "kernel_launch: hipFuncSetAttribute failed\n"); grid = -1; return; }
        if (hipOccupancyMaxActiveBlocksPerMultiprocessor(&per_cu, (const void*)mk_fwd, NTHREADS, LDS_BYTES) != hipSuccess || per_cu < 1) { fprintf(stderr, "kernel_launch: occupancy query says %d\n", per_cu); per_cu = 1; }
        (void)hipGetLastError();
        grid = cus;
        if (grid < 256 || (grid % 8) != 0) fprintf(stderr, "kernel_launch: grid %d\n", grid);
    }
    if (grid < 0) return;
    (void)hipMemsetAsync((char*)d_ws + WS_CTL, 0, CTL_ZERO_BYTES, stream);
    Args a{};
    for (int i = 0; i < 32; ++i) a.in[i] = (const float*)d_in[i];
    a.out = (float*)d_out; a.ws = (unsigned char*)d_ws;
#if MK_PER_PHASE
    unsigned char* ws8 = (unsigned char*)d_ws; (void)ws8;
    for (int p = 0; p < N_PHASES; ++p) {
#if defined(DBG_CHECK)
        if (DBG_CHECK == 14 && p == 7 + 13 * DBG_LAYER) hipLaunchKernelGGL(dbg_fill, dim3(2048), dim3(256), 0, stream, (unsigned char*)d_ws);
        if (DBG_CHECK == 1 && p == 3 + 13 * DBG_LAYER) hipLaunchKernelGGL(dbg_pre, dim3(2048), dim3(256), 0, stream, (unsigned char*)d_ws, (float*)d_out);
#endif
        a.ph_lo = p; a.ph_hi = p + 1; hipLaunchKernelGGL(mk_fwd, dim3(grid), dim3(NTHREADS), LDS_BYTES, stream, a);
#if defined(DBG_CHECK)
#ifndef DBG_LAYER
#define DBG_LAYER 0
#endif
        if (DBG_CHECK == 2 && p == 2 + 13 * DBG_LAYER) hipLaunchKernelGGL(dbg_inproj, dim3(9), dim3(64), 0, stream, (unsigned char*)d_ws, (const float*)d_in[I_WIN] + (size_t)DBG_LAYER * 1024 * D_IN_SRC);
        if (DBG_CHECK == 3 && p == 4 + 13 * DBG_LAYER) hipLaunchKernelGGL(dbg_fourier_ref, dim3(128), dim3(512), 0, stream, (unsigned char*)d_ws);
        if (DBG_CHECK == 3 && p == 6 + 13 * DBG_LAYER) hipLaunchKernelGGL(dbg_fourier_cmp, dim3(1), dim3(128), 0, stream, (unsigned char*)d_ws);
        if (DBG_CHECK == 4 && p == 3 + 13 * DBG_LAYER) hipLaunchKernelGGL(dbg_scan, dim3(64), dim3(64), 0, stream, (unsigned char*)d_ws, (float*)d_out, (const float*)d_in[I_MU] + DBG_LAYER * 3840, (const float*)d_in[I_W0] + DBG_LAYER * 1024, (const float*)d_in[I_W2] + DBG_LAYER * 65536, (const float*)d_in[I_A0] + DBG_LAYER * 1024, (const float*)d_in[I_A2] + DBG_LAYER * 65536, (const float*)d_in[I_KK] + DBG_LAYER * 512, (const float*)d_in[I_KA] + DBG_LAYER * 512, (const float*)d_in[I_RK] + DBG_LAYER * 512); if (DBG_CHECK == 4 && DBG_SUB == 10 && p == 3 + 13 * DBG_LAYER) hipLaunchKernelGGL(dbg_scan_fin, dim3(1), dim3(1), 0, stream, (unsigned char*)d_ws);
        if (DBG_CHECK == 5 && p == 7 + 13 * DBG_LAYER) hipLaunchKernelGGL(dbg_merge_ref, dim3(48), dim3(512), 0, stream, (unsigned char*)d_ws, (float*)(ws8 + WS_DBG + 262144), (const float*)d_in[I_WIN] + (size_t)DBG_LAYER * 1024 * D_IN_SRC, (const float*)d_in[I_WPA] + DBG_LAYER * 1048576, (const float*)d_in[I_WPF] + DBG_LAYER * 524288, (const float*)d_in[I_WPC] + DBG_LAYER * 524288, (const float*)d_in[I_WO] + DBG_LAYER * 1048576);
        if (DBG_CHECK == 5 && p == 9 + 13 * DBG_LAYER) hipLaunchKernelGGL(dbg_merge_cmp, dim3(48), dim3(64), 0, stream, (unsigned char*)d_ws, (const float*)(ws8 + WS_DBG + 262144));
        if (DBG_CHECK == 6 && p == 5 + 13 * DBG_LAYER) hipLaunchKernelGGL(dbg_post_ref, dim3(96), dim3(512), 0, stream, (unsigned char*)d_ws, (float*)(ws8 + WS_DBG + 262144), (const float*)d_in[I_MU] + DBG_LAYER * 3840, (const float*)d_in[I_G2] + DBG_LAYER * 65536, (const float*)d_in[I_LNW] + DBG_LAYER * 512, (const float*)d_in[I_LNB] + DBG_LAYER * 512);
        if (DBG_CHECK == 6 && p == 6 + 13 * DBG_LAYER) hipLaunchKernelGGL(dbg_post_cmp, dim3(96), dim3(512), 0, stream, (unsigned char*)d_ws, (const float*)(ws8 + WS_DBG + 262144));
        if (DBG_CHECK == 7 && p == 1) hipLaunchKernelGGL(dbg_mod, dim3(10), dim3(64), 0, stream, (unsigned char*)d_ws, (const float*)d_in[I_C], (const float*)d_in[I_CCTX], (const float*)d_in[I_ADAW], (const float*)d_in[I_ADAB], (const float*)d_in[I_X], (const float*)d_in[I_CTX]);
        if (DBG_CHECK == 8 && p == 10 + 13 * DBG_LAYER) hipLaunchKernelGGL(dbg_ffn_ref, dim3(48), dim3(512), 0, stream, (unsigned char*)d_ws, (const float*)d_in[I_FUP] + (size_t)DBG_LAYER * 1024 * 5632, (const float*)d_in[I_FCONV] + DBG_LAYER * 3 * 2816, (const float*)d_in[I_FCONVB] + DBG_LAYER * 2816, (const float*)d_in[I_FDN] + (size_t)DBG_LAYER * 2816 * 1024);
        if (DBG_CHECK == 8 && p == 13 + 13 * DBG_LAYER) hipLaunchKernelGGL(dbg_ffn_cmp, dim3(48), dim3(64), 0, stream, (unsigned char*)d_ws);
        if (DBG_CHECK == 9 && p == 10) hipLaunchKernelGGL(dbg_ln1, dim3(6), dim3(64), 0, stream, (unsigned char*)d_ws, (const float*)d_in[I_X], (const float*)d_in[I_CTX], (const float*)d_out, (const float*)d_in[I_LN1G], (const float*)d_in[I_LN1B]);
        if (DBG_CHECK == 10 && p == 13 + 13 * DBG_LAYER) hipLaunchKernelGGL(dbg_ln2_ref, dim3(64), dim3(64), 0, stream, (unsigned char*)d_ws, (const float*)d_out, (const float*)d_in[I_LN2G] + DBG_LAYER * 1024, (const float*)d_in[I_LN2B] + DBG_LAYER * 1024, DBG_LAYER);
        if (DBG_CHECK == 10 && p == 14 + 13 * DBG_LAYER) hipLaunchKernelGGL(dbg_ln2_cmp, dim3(64), dim3(64), 0, stream, (unsigned char*)d_ws, (const float*)d_out, DBG_LAYER);
        if (DBG_CHECK == 11 && p == 7 + 13 * DBG_LAYER) { hipLaunchKernelGGL(dbg_gate, dim3(256), dim3(64), 0, stream, (unsigned char*)d_ws, (const float*)d_in[I_WIN] + (size_t)DBG_LAYER * 1024 * D_IN_SRC, 0); hipLaunchKernelGGL(dbg_gate, dim3(256), dim3(64), 0, stream, (unsigned char*)d_ws, (const float*)d_in[I_WIN] + (size_t)DBG_LAYER * 1024 * D_IN_SRC, 1); }
        if (DBG_CHECK == 12 && p == 7 + 13 * DBG_LAYER) { hipLaunchKernelGGL(dbg_gate2_init, dim3(1), dim3(1), 0, stream, (unsigned char*)d_ws); hipLaunchKernelGGL(dbg_gate2, dim3(13), dim3(64), 0, stream, (unsigned char*)d_ws, (const float*)d_in[I_WIN] + (size_t)DBG_LAYER * 1024 * D_IN_SRC); hipLaunchKernelGGL(dbg_gate2_fin, dim3(1), dim3(1), 0, stream, (unsigned char*)d_ws); }
        if ((DBG_CHECK == 13 || DBG_CHECK == 14) && p == 7 + 13 * DBG_LAYER) { hipLaunchKernelGGL(dbg_gate3_init, dim3(1), dim3(1), 0, stream, (unsigned char*)d_ws); hipLaunchKernelGGL(dbg_gate3, dim3(2048), dim3(256), 0, stream, (unsigned char*)d_ws); hipLaunchKernelGGL(dbg_gate3_fin, dim3(1), dim3(1), 0, stream, (unsigned char*)d_ws); }
        if (DBG_CHECK == 1 && p == 3 + 13 * DBG_LAYER) hipLaunchKernelGGL(dbg_attn, dim3(2048), dim3(512), 0, stream, (unsigned char*)d_ws, (const float*)d_in[I_SUBLN], DBG_LAYER, (const float*)d_out);
#endif
    }
#if defined(DBG_CHECK)
    hipLaunchKernelGGL(dbg_report, dim3(DBG_TWO ? 4096 : 1), dim3(DBG_TWO ? 256 : 1), 0, stream, (unsigned char*)d_ws, (float*)d_out);
#endif
#else
    a.ph_lo = 0; a.ph_hi = N_PHASES;
    hipLaunchKernelGGL(mk_fwd, dim3(grid), dim3(NTHREADS), LDS_BYTES, stream, a);
#endif
}
```

```cpp
#include <hip/hip_runtime.h>
#include <hip/hip_bf16.h>
#include <cstdio>
#include <cstdint>
#include <cmath>

#ifndef DBG_ZERO_MIX
#define DBG_ZERO_MIX 0
#endif
#ifndef DBG_ZERO_FFN
#define DBG_ZERO_FFN 0
#endif
#ifndef DBG_BR
#define DBG_BR 7
#endif
#define GAS __attribute__((address_space(1)))
#define LAS __attribute__((address_space(3)))
typedef unsigned short bf16_t;
typedef short bf16x8 __attribute__((ext_vector_type(8)));
typedef short s16x4 __attribute__((ext_vector_type(4)));
typedef float f32x4 __attribute__((ext_vector_type(4)));
typedef float f32x2 __attribute__((ext_vector_type(2)));
typedef float f32x16 __attribute__((ext_vector_type(16)));
typedef unsigned u32x4 __attribute__((ext_vector_type(4)));
typedef unsigned u32x2 __attribute__((ext_vector_type(2)));
typedef GAS unsigned gu32;

constexpr int DM = 1024, NBATCH = 4, SEQ = 4096, CTXL = 256, NLAYER = 2;
constexpr int ML = NBATCH * SEQ, MC = NBATCH * CTXL, MT = ML + MC;
constexpr int D_IN_SRC = 8576, NP = 5632, NGATE = 3072, DFF = 2816, DCS = 1280, DCO = 640, DCOP = 768;
constexpr float LN_EPS = 1e-5f, ALPHA = 1.4142135623730951f;
constexpr float QK_PRESCALE = 0.125f * 1.4426950408889634f;
constexpr int NWAVES = 8, NTHREADS = 512;

constexpr size_t MiB = 1u << 20;
constexpr size_t WS_CTL = 0, CTL_ZERO_BYTES = 1 * MiB;
constexpr size_t WS_TAB = 1 * MiB;
constexpr size_t TAB_MOD = WS_TAB + 0;
constexpr size_t TAB_LAM = WS_TAB + 256 * 1024;
constexpr size_t TAB_ROPE = WS_TAB + 260 * 1024;
constexpr size_t TAB_TW = WS_TAB + 272 * 1024;
constexpr size_t TAB_W0 = WS_TAB + 320 * 1024;
constexpr size_t TAB_F1 = WS_TAB + 384 * 1024;
constexpr size_t TAB_F2 = WS_TAB + 512 * 1024;
constexpr size_t TAB_DC = WS_TAB + 768 * 1024;
constexpr size_t WS_XC = 3 * MiB;
constexpr size_t WS_BON = 7 * MiB;
constexpr size_t WS_W = 9 * MiB;
constexpr size_t W_IN = WS_W, W_PA = WS_W + 17 * MiB, W_PF = WS_W + 19 * MiB, W_PC = WS_W + 20 * MiB, W_O = WS_W + 21 * MiB,
                 W_UP = WS_W + 23 * MiB, W_DN = WS_W + 34 * MiB, W_G2T = WS_W + 39 * MiB + 512 * 1024;
constexpr size_t WS_P = 49 * MiB;
constexpr size_t P_Q = WS_P, P_K = P_Q + (size_t)MT * 1024 * 2, P_F = P_K + (size_t)MT * 1024 * 2, P_V = P_F + (size_t)MT * 512 * 2,
                 P_CS = P_V + (size_t)MT * 1024 * 2, P_CO = P_CS + (size_t)MT * DCS * 2, P_END = P_CO + (size_t)MT * DCOP * 2;
constexpr size_t WS_HY = 236 * MiB, WS_END = 270 * MiB;
static_assert(P_END == WS_HY, "P region is exactly 187 MiB");
static_assert(P_END - P_V == (size_t)MT * NGATE * 2, "gate buffer == v|cs|co");
static_assert(WS_HY + (size_t)MT * 1024 * 2 == WS_END, "HY region 34 MiB");
constexpr int CW_TMO = 0, CW_QUEUE = 64  , CW_BAR = 4096;

constexpr int RING_BYTES = 131072, LDSCTL_OFF = RING_BYTES, MISC_OFF = LDSCTL_OFF + 320, LDS_BYTES = 147456;

#define LDS_WAIT() asm volatile("s_waitcnt lgkmcnt(0)" ::: "memory")
#define VM_WAIT() asm volatile("s_waitcnt vmcnt(0)" ::: "memory")
#define RLX_AGENT __ATOMIC_RELAXED, __HIP_MEMORY_SCOPE_AGENT

typedef __bf16 bf16x2_t __attribute__((ext_vector_type(2)));
__device__ __forceinline__ unsigned cvt_pk_bf16(float lo, float hi) { f32x2 v = {lo, hi}; bf16x2_t b = __builtin_convertvector(v, bf16x2_t); return __builtin_bit_cast(unsigned, b); }
__device__ __forceinline__ float bf2f(unsigned short h) { return __uint_as_float((unsigned)h << 16); }
__device__ __forceinline__ float bflo(unsigned w) { return __uint_as_float(w << 16); }
__device__ __forceinline__ float bfhi(unsigned w) { return __uint_as_float(w & 0xffff0000u); }
__device__ __forceinline__ float sigmoidf_(float x) { return __builtin_amdgcn_rcpf(1.f + __expf(-x)); }
__device__ __forceinline__ int fresh_lane() { unsigned z = 0u; asm volatile("" : "+v"(z)); return (int)__builtin_amdgcn_mbcnt_hi(~0u, __builtin_amdgcn_mbcnt_lo(~0u, z)); }
__device__ __forceinline__ int fresh_tid(int wave) { return (wave << 6) | fresh_lane(); }
__device__ __forceinline__ float wave_sum(float v) {
#pragma unroll
    for (int o = 1; o < 64; o <<= 1) v += __shfl_xor(v, o);
    return v;
}

#define XB_TMO      128
#define XB_XCNT(j)  (256  + 64 * (j))
#define XB_XSUB(j)  (1280 + 64 * (j))
#define XB_XGEN(j)  (2304 + 64 * (j))
#define XB_TOP      3328
#define XB_TOPGEN   3392
#define XCD_BAR_WORDS 3456
#define XB_SPIN_CAP (1u << 22)
__device__ __forceinline__ unsigned xb_ld(unsigned* p)              { return __hip_atomic_load(p, __ATOMIC_RELAXED, __HIP_MEMORY_SCOPE_AGENT); }
__device__ __forceinline__ unsigned xb_add(unsigned* p, unsigned v) { return __hip_atomic_fetch_add(p, v, __ATOMIC_RELAXED, __HIP_MEMORY_SCOPE_AGENT); }
__device__ __forceinline__ unsigned xb_xcc_id() { return (unsigned)__builtin_amdgcn_s_getreg((3 << 11) | 20) & 0xFu; }
#define XB_SPIN(cond, bar) do { unsigned _sp = 0; while (cond) { __builtin_amdgcn_s_sleep(1); \
    if ((++_sp & 255u) == 0u) { if (xb_ld(&(bar)[XB_TMO])) break; if (_sp > XB_SPIN_CAP) { atomicAdd(&(bar)[XB_TMO], 1u); break; } } } } while (0)
struct XcdBarrier { unsigned* bar; unsigned x; volatile LAS unsigned* st; };
__device__ __forceinline__ XcdBarrier xcd_barrier_post(unsigned* bar, volatile LAS unsigned* st) {
    XcdBarrier b; b.bar = bar; b.x = xb_xcc_id(); b.st = st;
    if (threadIdx.x == 0) (void)xb_add(&bar[XB_XCNT(b.x)], 1u);
    return b;
}
__device__ __forceinline__ void xcd_barrier_complete(unsigned* bar, unsigned x, unsigned& nloc, unsigned& nx) {
    const unsigned G = gridDim.x * gridDim.y * gridDim.z;
    unsigned sum, cnt, mine, sp = 0u;
    for (;;) {
        sum = 0u; cnt = 0u; mine = 0u;
#pragma unroll
        for (unsigned j = 0; j < 16; ++j) { const unsigned c = xb_ld(&bar[XB_XCNT(j)]); sum += c; cnt += (c > 0u) ? 1u : 0u; mine = (j == x) ? c : mine; }
        if (sum == G) break;
        __builtin_amdgcn_s_sleep(1);
        if ((++sp & 255u) == 0u) { if (xb_ld(&bar[XB_TMO])) break; if (sp > XB_SPIN_CAP) { atomicAdd(&bar[XB_TMO], 1u); break; } }
    }
    nloc = mine > 0u ? mine : 1u; nx = cnt > 0u ? cnt : 1u;
}
__device__ __attribute__((noinline)) void xcd_barrier(unsigned* bar_, unsigned bx_, volatile LAS unsigned* st_, unsigned t0_) {
    XcdBarrier b; b.bar = bar_; b.x = bx_; b.st = st_;
    asm volatile("s_waitcnt vmcnt(0)" ::: "memory");
    __syncthreads();
    if (t0_) {
        unsigned* bar = b.bar;
        __builtin_amdgcn_s_waitcnt(0);
        unsigned nloc = b.st[0], nx = b.st[1];
        if (nloc == 0u) { xcd_barrier_complete(bar, b.x, nloc, nx); b.st[0] = nloc; b.st[1] = nx; }
        const unsigned old = xb_add(&bar[XB_XSUB(b.x)], 1u);
        const unsigned gen = old / nloc;
        if (old + 1u == (gen + 1u) * nloc) {
            __builtin_amdgcn_fence(__ATOMIC_RELEASE, "agent");
            asm volatile("s_waitcnt vmcnt(0)" ::: "memory");
            const unsigned og = xb_add(&bar[XB_TOP], 1u);
            const unsigned tg = og / nx;
            if (og + 1u == (tg + 1u) * nx) xb_add(&bar[XB_TOPGEN], 1u);
            else XB_SPIN(xb_ld(&bar[XB_TOPGEN]) == tg, bar);
            __builtin_amdgcn_fence(__ATOMIC_ACQUIRE, "agent");
            xb_add(&bar[XB_XGEN(b.x)], 1u);
            asm volatile("s_waitcnt vmcnt(0)" ::: "memory");
        } else {
            XB_SPIN(xb_ld(&bar[XB_XGEN(b.x)]) == gen, bar);
            __builtin_amdgcn_fence(__ATOMIC_ACQUIRE, "agent");
            asm volatile("s_waitcnt vmcnt(0)" ::: "memory");
        }
    }
    __syncthreads();
}

namespace pg8 {
#define PG8_LAS __attribute__((address_space(3)))
constexpr int BM = 256, BK = 64, HALF = 128, HTB = HALF * BK * 2, STAGE_BYTES = 8 * HTB, NXCD = 8, WGM = 8;
__host__ __device__ __forceinline__ int lds_byte(int r, int c) { const int st = (r >> 4) * 2 + (c >> 5), rr = r & 15, cc = c & 31, ob = rr * 64 + cc * 2; return st * 1024 + (ob ^ (((ob >> 9) & 1) << 5)); }
__host__ __device__ __forceinline__ void stage_rc(int b, int& R, int& C) { const int st = b / 1024, sb = b % 1024, swz = sb ^ (((sb >> 9) & 1) << 5); R = (st >> 1) * 16 + swz / 64; C = (st & 1) * 32 + (swz % 64) / 2; }
__host__ __device__ __forceinline__ int perm32(int rho) { const int n = rho >> 4, i = rho & 15; return 8 * (i >> 2) + 4 * n + (i & 3); }
struct Unit { int pm, pn; };
struct Operand { const char* base; long tM, tN, tN2; int nshift; long rstride; long hstep; long kstep;
    __device__ __forceinline__ long tile(const Unit& u) const { return (long)u.pm * tM + (long)(u.pn & ((1 << nshift) - 1)) * tN + (long)(u.pn >> nshift) * tN2; }
    __device__ __forceinline__ unsigned row(int R) const { return (unsigned)((long)R * rstride); } };
struct StaticOrder {
    int nM, nN, nwg, G, c, wave;
    __host__ __device__ void init(int M, int N, int G_, int c_) { nM = M / BM; nN = N / BM; nwg = nM * nN; G = G_; c = c_; }
    __host__ __device__ bool next(int i, Unit& u) const {
        const long L = (long)i * G + c; if (L >= nwg) return false;
        int wgid = (int)L; { const int q = nwg / NXCD, r = nwg % NXCD, xcd = wgid % NXCD, off = wgid / NXCD; wgid = (xcd < r ? xcd * (q + 1) : r * (q + 1) + (xcd - r) * q) + off; }
        const int nig = WGM * nN, gid = wgid / nig, fm = gid * WGM, gsz = (nM - fm) < WGM ? (nM - fm) : WGM;
        u.pm = fm + ((wgid % nig) % gsz); u.pn = (wgid % nig) / gsz; return true;
    }
};

template <class Epi, class RowMapB, bool ALIGN_EPI>
__device__ __forceinline__ void gemm_phase(PG8_LAS unsigned char* lds, const Operand A, const Operand B, const RowMapB bmap, const int nt, const StaticOrder& S, const Epi& E) {
    int wid = S.wave; asm volatile("" : "+s"(wid));
    const int lane = fresh_lane(), tid = (wid << 6) | lane, wr = wid >> 2, wc = wid & 3, fr = lane & 15, fq = lane >> 4;
    unsigned voffA[2], voffB[2];
#pragma unroll
    for (int i = 0; i < 2; ++i) { int R, C; stage_rc(tid * 16 + i * 8192, R, C); const int Rb = Epi::PERM ? ((R & ~31) + perm32(R & 31)) : R;
        voffA[i] = A.row(R) + (unsigned)C * 2u; voffB[i] = bmap(Rb) + (unsigned)C * 2u; }
    const long kA = A.kstep, kB = B.kstep, hA = A.hstep, hB = B.hstep;
    const unsigned ldsw = (unsigned)wid * 1024u;
    const int aoff = lds_byte(wr * 64 + fr, fq * 8), boff = lds_byte(wc * 32 + fr, fq * 8);
#define PG8_SA(b, h) (((b) * 2 + (h)) * HTB)
#define PG8_SB(b, h) ((4 + (b) * 2 + (h)) * HTB)
#define PG8_STAGE(bufoff, gbase, voff) do { _Pragma("unroll") for (int _i = 0; _i < 2; ++_i) \
        __builtin_amdgcn_global_load_lds((const unsigned*)((const char*)(gbase) + (voff)[_i]), (PG8_LAS unsigned*)(lds + (bufoff) + ldsw + _i * 8192), 16, 0, 0); } while (0)
#define PG8_LDA(dst, b, h) do { _Pragma("unroll") for (int m = 0; m < 4; ++m) _Pragma("unroll") for (int k = 0; k < 2; ++k) dst[m][k] = *(const PG8_LAS bf16x8*)(lds + PG8_SA(b, h) + aoff + m * 2048 + k * 1024); } while (0)
#define PG8_LDB(dst, b, h) do { _Pragma("unroll") for (int n = 0; n < 2; ++n) _Pragma("unroll") for (int k = 0; k < 2; ++k) dst[n][k] = *(const PG8_LAS bf16x8*)(lds + PG8_SB(b, h) + boff + n * 2048 + k * 1024); } while (0)
#define PG8_MMA(ai, bj, At, Bt) do { __builtin_amdgcn_s_setprio(1); _Pragma("unroll") for (int m = 0; m < 4; ++m) _Pragma("unroll") for (int n = 0; n < 2; ++n) _Pragma("unroll") for (int k = 0; k < 2; ++k) \
        acc[ai][bj][m][n] = __builtin_amdgcn_mfma_f32_16x16x32_bf16(Bt[n][k], At[m][k], acc[ai][bj][m][n], 0, 0, 0); __builtin_amdgcn_s_setprio(0); } while (0)
#define PG8_WAIT_V(n) asm volatile("s_waitcnt vmcnt(" #n ")" ::: "memory")
#define PG8_WAIT_L(n) asm volatile("s_waitcnt lgkmcnt(" #n ")" ::: "memory")
#define PG8_BAR __builtin_amdgcn_s_barrier()
#define PG8_SCHED __builtin_amdgcn_sched_barrier(0)
    Unit cur, nxt; int ui = 0;
    if (!S.next(0, cur)) return;
    f32x4 acc[2][2][4][2];
#pragma unroll
    for (int a = 0; a < 2; ++a)
#pragma unroll
        for (int b = 0; b < 2; ++b)
#pragma unroll
            for (int m = 0; m < 4; ++m)
#pragma unroll
                for (int n = 0; n < 2; ++n) acc[a][b][m][n] = (f32x4){0.f, 0.f, 0.f, 0.f};
    bf16x8 At[4][2], B0[2][2], B1[2][2];
    const char* cA = A.base + A.tile(cur); const char* cB = B.base + B.tile(cur);
    PG8_STAGE(PG8_SB(0, 0), cB, voffB); PG8_STAGE(PG8_SB(0, 1), cB + hB, voffB); PG8_STAGE(PG8_SA(0, 0), cA, voffA); PG8_STAGE(PG8_SA(0, 1), cA + hA, voffA);
    if (wr == 1) PG8_BAR;
    PG8_WAIT_V(2); PG8_BAR;
    PG8_STAGE(PG8_SB(1, 0), cB + kB, voffB); PG8_STAGE(PG8_SA(1, 0), cA + kA, voffA); PG8_STAGE(PG8_SB(1, 1), cB + hB + kB, voffB);
    PG8_WAIT_V(6); PG8_BAR;
    for (;;) {
        const bool has_next = S.next(ui + 1, nxt);
        const char* nA = has_next ? A.base + A.tile(nxt) : cA; const char* nB = has_next ? B.base + B.tile(nxt) : cB;
        for (int t = 0; t < nt; t += 2) {
            const bool last = (t == nt - 2);
            asm volatile("" : "+v"(voffA[0]), "+v"(voffA[1]), "+v"(voffB[0]), "+v"(voffB[1]));
            const char* a1 = cA + (long)(t + 1) * kA;
            const char* a2 = last ? nA : cA + (long)(t + 2) * kA; const char* b2 = last ? nB : cB + (long)(t + 2) * kB;
            const char* a3 = a2 + kA; const char* b3 = b2 + kB;
            PG8_LDB(B0, 0, 0); PG8_LDB(B1, 0, 1); PG8_SCHED; PG8_LDA(At, 0, 0); PG8_STAGE(PG8_SA(1, 1), a1 + hA, voffA);
            PG8_WAIT_V(8); PG8_WAIT_L(0); PG8_BAR; PG8_MMA(0, 0, At, B0); PG8_MMA(0, 1, At, B1); PG8_BAR; PG8_SCHED;
            PG8_LDA(At, 0, 1); PG8_STAGE(PG8_SB(0, 0), b2, voffB); PG8_STAGE(PG8_SB(0, 1), b2 + hB, voffB); PG8_STAGE(PG8_SA(0, 0), a2, voffA);
            PG8_WAIT_V(8); PG8_WAIT_L(0); PG8_BAR; PG8_MMA(1, 0, At, B0); PG8_MMA(1, 1, At, B1); PG8_BAR; PG8_SCHED;
            PG8_LDB(B0, 1, 0); PG8_LDB(B1, 1, 1); PG8_SCHED; PG8_LDA(At, 1, 0); PG8_STAGE(PG8_SA(0, 1), a2 + hA, voffA);
            PG8_WAIT_V(8); PG8_WAIT_L(0); PG8_BAR; PG8_MMA(0, 0, At, B0); PG8_MMA(0, 1, At, B1); PG8_BAR; PG8_SCHED;
            PG8_LDA(At, 1, 1); PG8_STAGE(PG8_SB(1, 0), b3, voffB); PG8_STAGE(PG8_SB(1, 1), b3 + hB, voffB); PG8_STAGE(PG8_SA(1, 0), a3, voffA);
            PG8_WAIT_V(8); PG8_WAIT_L(0); PG8_BAR; PG8_MMA(1, 0, At, B0); PG8_MMA(1, 1, At, B1); PG8_BAR; PG8_SCHED;
        }
        if constexpr (ALIGN_EPI) { if (wr == 0) PG8_BAR; }
        if constexpr (!Epi::AFTER_DRAIN) { const int le = fresh_lane(); E(acc, cur, wr, wc, le & 15, le >> 4); }
        if (!has_next) break;
#pragma unroll
        for (int a = 0; a < 2; ++a)
#pragma unroll
            for (int b = 0; b < 2; ++b)
#pragma unroll
                for (int m = 0; m < 4; ++m)
#pragma unroll
                    for (int n = 0; n < 2; ++n) acc[a][b][m][n] = (f32x4){0.f, 0.f, 0.f, 0.f};
        cur = nxt; cA = nA; cB = nB; ++ui;
        if constexpr (ALIGN_EPI) { if (wr == 1) PG8_BAR; }
    }
    PG8_WAIT_V(0);
    if constexpr (!ALIGN_EPI) { if (wr == 0) PG8_BAR; }
    PG8_BAR;
    if constexpr (Epi::AFTER_DRAIN) { const int le = fresh_lane(); E.fused(acc, cur, wr, wc, le & 15, le >> 4, lds, wid, le); }
#undef PG8_SA
#undef PG8_SB
#undef PG8_STAGE
#undef PG8_LDA
#undef PG8_LDB
#undef PG8_MMA
#undef PG8_WAIT_V
#undef PG8_WAIT_L
#undef PG8_BAR
#undef PG8_SCHED
}
struct RowLin { long rstride; __device__ __forceinline__ unsigned operator()(int R) const { return (unsigned)((long)R * rstride); } };
}
namespace pg8 {
__device__ __forceinline__ u32x2 pk4(f32x4 v) { u32x2 w; w.x = cvt_pk_bf16(v[0], v[1]); w.y = cvt_pk_bf16(v[2], v[3]); return w; }
__device__ __forceinline__ f32x4 up4(u32x2 w) { return (f32x4){bflo(w.x), bfhi(w.x), bflo(w.y), bfhi(w.y)}; }
__device__ __forceinline__ float fast_sigmoid(float x) { return __builtin_amdgcn_rcpf(1.f + __expf(-x)); }
#define EPI_ROWS(ai, m) _Pragma("unroll") for (int ai = 0; ai < 2; ++ai) _Pragma("unroll") for (int m = 0; m < 4; ++m)

struct EpiInProj {
    static constexpr bool PERM = false, AFTER_DRAIN = false;
    unsigned char* ws; const float* rope;
    __device__ __forceinline__ void operator()(const f32x4 (&acc)[2][2][4][2], const Unit& u, int wr, int wc, int fr, int fq) const {
        asm volatile("" : "+v"(fr), "+v"(fq));
        const int pn = u.pn; size_t boff; int pitch, c0;
        if (pn < 4) { boff = P_Q; pitch = 1024; c0 = 256 * pn; }
        else if (pn < 8) { boff = P_K; pitch = 1024; c0 = 256 * (pn - 4); }
        else if (pn < 12) { boff = P_V; pitch = 1024; c0 = 256 * (pn - 8); }
        else if (pn < 14) { boff = P_F; pitch = 512; c0 = 256 * (pn - 12); }
        else if (pn < 19) { boff = P_CS; pitch = DCS; c0 = 256 * (pn - 14); }
        else { boff = P_CO; pitch = DCOP; c0 = 256 * (pn - 19); }
        bf16_t* base = (bf16_t*)(ws + boff);
        const bool dorope = (pn >= 4 && pn < 8 && u.pm < ML / 256);
        EPI_ROWS(ai, m) {
            const int R = 128 * ai + 64 * wr + 16 * m + fr; const size_t grow = (size_t)u.pm * 256 + R;
            const float qs = pn < 4 ? QK_PRESCALE : 1.f;
            f32x4 cc = (f32x4){qs, qs, qs, qs}, ss = (f32x4){0.f, 0.f, 0.f, 0.f};
            if (dorope) { const int t = (int)(grow & 4095); const int pos = (wc & 1) ? (t & 63) : (t >> 6);
                const f32x4 a = *(const f32x4*)(rope + (pos * 16 + 4 * fq) * 2), b = *(const f32x4*)(rope + (pos * 16 + 4 * fq) * 2 + 4);
                cc = (f32x4){a[0], a[2], b[0], b[2]}; ss = (f32x4){a[1], a[3], b[1], b[3]}; }
            bf16_t* rowp = base + grow * pitch + c0 + 32 * wc + 4 * fq;
#pragma unroll
            for (int bj = 0; bj < 2; ++bj) { const f32x4 x1 = acc[ai][bj][m][0], x2 = acc[ai][bj][m][1];
                const f32x4 y1 = x1 * cc - x2 * ss, y2 = x2 * cc + x1 * ss;
                *(u32x2*)(rowp + 128 * bj) = pk4(y1); *(u32x2*)(rowp + 128 * bj + 16) = pk4(y2); }
        }
    }
};
struct EpiGate {
    static constexpr bool PERM = true, AFTER_DRAIN = false;
    bf16_t* gate;
    __device__ __forceinline__ void operator()(const f32x4 (&acc)[2][2][4][2], const Unit& u, int wr, int wc, int fr, int fq) const {
        asm volatile("" : "+v"(fr), "+v"(fq));
        EPI_ROWS(ai, m) {
            const int R = 128 * ai + 64 * wr + 16 * m + fr; const size_t grow = (size_t)u.pm * 256 + R;
            bf16_t* rowp = gate + grow * NGATE + 256 * u.pn + 32 * wc + 8 * fq;
#pragma unroll
            for (int bj = 0; bj < 2; ++bj) { f32x4 v0 = acc[ai][bj][m][0], v1 = acc[ai][bj][m][1];
#pragma unroll
                for (int e = 0; e < 4; ++e) { v0[e] = fast_sigmoid(v0[e]); v1[e] = fast_sigmoid(v1[e]); }
                u32x4 w; w.x = cvt_pk_bf16(v0[0], v0[1]); w.y = cvt_pk_bf16(v0[2], v0[3]); w.z = cvt_pk_bf16(v1[0], v1[1]); w.w = cvt_pk_bf16(v1[2], v1[3]);
                *(u32x4*)(rowp + 128 * bj) = w; }
        }
    }
};
template <bool FIRST> struct EpiBranch {
    static constexpr bool PERM = true, AFTER_DRAIN = false;
    const bf16_t* gate; bf16_t* ym; float sc;
    __device__ __forceinline__ void operator()(const f32x4 (&acc)[2][2][4][2], const Unit& u, int wr, int wc, int fr, int fq) const {
        asm volatile("" : "+v"(fr), "+v"(fq));
        EPI_ROWS(ai, m) {
            const int R = 128 * ai + 64 * wr + 16 * m + fr; const size_t grow = (size_t)u.pm * 256 + R;
            const int col = 256 * u.pn + 32 * wc + 8 * fq;
#pragma unroll
            for (int bj = 0; bj < 2; ++bj) {
                const u32x4 g = *(const u32x4*)(gate + grow * NGATE + col + 128 * bj);
                f32x4 v0 = acc[ai][bj][m][0], v1 = acc[ai][bj][m][1];
                v0 = v0 * (f32x4){bflo(g.x), bfhi(g.x), bflo(g.y), bfhi(g.y)} * sc; v1 = v1 * (f32x4){bflo(g.z), bfhi(g.z), bflo(g.w), bfhi(g.w)} * sc;
                bf16_t* op = ym + grow * 1024 + col + 128 * bj;
                if (!FIRST) { const u32x4 o = *(const u32x4*)op; v0 = v0 + (f32x4){bflo(o.x), bfhi(o.x), bflo(o.y), bfhi(o.y)}; v1 = v1 + (f32x4){bflo(o.z), bfhi(o.z), bflo(o.w), bfhi(o.w)}; }
                u32x4 w; w.x = cvt_pk_bf16(v0[0], v0[1]); w.y = cvt_pk_bf16(v0[2], v0[3]); w.z = cvt_pk_bf16(v1[0], v1[1]); w.w = cvt_pk_bf16(v1[2], v1[3]);
                *(u32x4*)op = w; }
        }
    }
};
struct EpiF32 {
    static constexpr bool PERM = false, AFTER_DRAIN = false;
    float* out; int ldc;
    __device__ __forceinline__ void operator()(const f32x4 (&acc)[2][2][4][2], const Unit& u, int wr, int wc, int fr, int fq) const {
        asm volatile("" : "+v"(fr), "+v"(fq));
        EPI_ROWS(ai, m) {
            const int R = 128 * ai + 64 * wr + 16 * m + fr; const size_t grow = (size_t)u.pm * 256 + R;
            float* rowp = out + grow * ldc + 256 * u.pn + 32 * wc + 4 * fq;
#pragma unroll
            for (int bj = 0; bj < 2; ++bj)
#pragma unroll
                for (int n = 0; n < 2; ++n) *(f32x4*)(rowp + 128 * bj + 16 * n) = acc[ai][bj][m][n];
        }
    }
};
struct EpiBf16 {
    static constexpr bool PERM = true, AFTER_DRAIN = false;
    bf16_t* out; int ldc;
    __device__ __forceinline__ void operator()(const f32x4 (&acc)[2][2][4][2], const Unit& u, int wr, int wc, int fr, int fq) const {
        asm volatile("" : "+v"(fr), "+v"(fq));
        EPI_ROWS(ai, m) {
            const int R = 128 * ai + 64 * wr + 16 * m + fr; const size_t grow = (size_t)u.pm * 256 + R;
            bf16_t* rowp = out + grow * ldc + 256 * u.pn + 32 * wc + 8 * fq;
#pragma unroll
            for (int bj = 0; bj < 2; ++bj) { const f32x4 v0 = acc[ai][bj][m][0], v1 = acc[ai][bj][m][1];
                u32x4 w; w.x = cvt_pk_bf16(v0[0], v0[1]); w.y = cvt_pk_bf16(v0[2], v0[3]); w.z = cvt_pk_bf16(v1[0], v1[1]); w.w = cvt_pk_bf16(v1[2], v1[3]);
                *(u32x4*)(rowp + 128 * bj) = w; }
        }
    }
};
struct EpiF0 {
    static constexpr bool PERM = false, AFTER_DRAIN = false;
    bf16_t* yt;
    __device__ __forceinline__ void operator()(const f32x4 (&acc)[2][2][4][2], const Unit& u, int wr, int wc, int fr, int fq) const {
        asm volatile("" : "+v"(fr), "+v"(fq));
        EPI_ROWS(ai, m) {
            const int R = 128 * ai + 64 * wr + 16 * m + fr; const int ri = R >> 7, mch = R & 127;
            bf16_t* rowp = yt + (size_t)((ri * 4 + u.pm) * 128 + mch) * ML + 256 * u.pn + 32 * wc + 4 * fq;
#pragma unroll
            for (int bj = 0; bj < 2; ++bj)
#pragma unroll
                for (int n = 0; n < 2; ++n) *(u32x2*)(rowp + 128 * bj + 16 * n) = pk4(acc[ai][bj][m][n]);
        }
    }
};
struct EpiF0c {
    static constexpr bool PERM = false, AFTER_DRAIN = false;
    bf16_t* ytc;
    __device__ __forceinline__ void operator()(const f32x4 (&acc)[2][2][4][2], const Unit& u, int wr, int wc, int fr, int fq) const {
        asm volatile("" : "+v"(fr), "+v"(fq));
        EPI_ROWS(ai, m) {
            const int R = 128 * ai + 64 * wr + 16 * m + fr; const int ri = R >> 7, mch = R & 127;
            bf16_t* rowp = ytc + (size_t)((((u.pn * 4 + u.pm) * 128 + mch) * 2 + ri)) * 256 + 32 * wc + 4 * fq;
#pragma unroll
            for (int bj = 0; bj < 2; ++bj)
#pragma unroll
                for (int n = 0; n < 2; ++n) *(u32x2*)(rowp + 128 * bj + 16 * n) = pk4(acc[ai][bj][m][n]);
        }
    }
};
struct EpiF1 {
    static constexpr bool PERM = false, AFTER_DRAIN = false;
    bf16_t* x1; const float* tw;
    __device__ __forceinline__ void operator()(const f32x4 (&acc)[2][2][4][2], const Unit& u, int wr, int wc, int fr, int fq) const {
        asm volatile("" : "+v"(fr), "+v"(fq));
        const int gp = u.pn >> 7, mch = u.pn & 127, g = 2 * wr + gp;
#pragma unroll
        for (int m = 0; m < 4; ++m) {
            const int kl = 16 * m + fr;
#pragma unroll
            for (int bj = 0; bj < 2; ++bj)
#pragma unroll
                for (int n = 0; n < 2; ++n) {
                    const int colL = 128 * bj + 32 * wc + 16 * n + 4 * fq, tl = colL & 63, bb = colL >> 6;
                    const f32x4 a = *(const f32x4*)(tw + (kl * 64 + tl) * 2), b = *(const f32x4*)(tw + (kl * 64 + tl) * 2 + 4);
                    const f32x4 cc = (f32x4){a[0], a[2], b[0], b[2]}, ss = (f32x4){a[1], a[3], b[1], b[3]};
                    const f32x4 re = acc[0][bj][m][n], im = acc[1][bj][m][n];
                    const f32x4 re2 = re * cc + im * ss, im2 = im * cc - re * ss;
                    const size_t o = ((size_t)bb * 32768 + kl * 512 + g * 128 + mch) * 64 + tl;
                    *(u32x2*)(x1 + o) = pk4(re2); *(u32x2*)(x1 + (size_t)4 * 32768 * 64 + o) = pk4(im2);
                }
        }
    }
};
struct EpiF2 {
    static constexpr bool PERM = false, AFTER_DRAIN = false;
    bf16_t* of;
    __device__ __forceinline__ void operator()(const f32x4 (&acc)[2][2][4][2], const Unit& u, int wr, int wc, int fr, int fq) const {
        asm volatile("" : "+v"(fr), "+v"(fq));
        const int kl = u.pn >> 1, gm0 = (u.pn & 1) * 256;
        EPI_ROWS(ai, m) {
            const int R = 128 * ai + 64 * wr + 16 * m + fr; const int b = R >> 6, kh = R & 63;
            bf16_t* rowp = of + (size_t)(b * 4096 + 64 * kh + kl) * 512 + gm0 + 32 * wc + 4 * fq;
#pragma unroll
            for (int bj = 0; bj < 2; ++bj)
#pragma unroll
                for (int n = 0; n < 2; ++n) *(u32x2*)(rowp + 128 * bj + 16 * n) = pk4(acc[ai][bj][m][n]);
        }
    }
};
struct EpiFc {
    static constexpr bool PERM = false, AFTER_DRAIN = false;
    bf16_t* of;
    __device__ __forceinline__ void operator()(const f32x4 (&acc)[2][2][4][2], const Unit& u, int wr, int wc, int fr, int fq) const {
        asm volatile("" : "+v"(fr), "+v"(fq));
        const int b = u.pn >> 1, gm0 = (u.pn & 1) * 256;
        EPI_ROWS(ai, m) {
            const int R = 128 * ai + 64 * wr + 16 * m + fr;
            bf16_t* rowp = of + (size_t)(ML + b * 256 + R) * 512 + gm0 + 32 * wc + 4 * fq;
#pragma unroll
            for (int bj = 0; bj < 2; ++bj)
#pragma unroll
                for (int n = 0; n < 2; ++n) *(u32x2*)(rowp + 128 * bj + 16 * n) = pk4(acc[ai][bj][m][n]);
        }
    }
};
struct EpiRwkvPost {
    static constexpr bool PERM = false, AFTER_DRAIN = true;
    const bf16_t* y0; const bf16_t* y1; const bf16_t* cs; const float* bon; const float* mu; const float* lnw; const float* lnb; bf16_t* oc;
    __device__ __forceinline__ void fused(f32x4 (&acc)[2][2][4][2], const Unit& u, int wr, int wc, int fr, int fq, PG8_LAS unsigned char* lds, int wid, int lane) const {
        asm volatile("" : "+v"(fr), "+v"(fq));
        PG8_LAS f32x2* P = (PG8_LAS f32x2*)lds;
        EPI_ROWS(ai, m) {
            const int R = 128 * ai + 64 * wr + 16 * m + fr; const size_t grow = (size_t)u.pm * 256 + R;
#pragma unroll
            for (int bj = 0; bj < 2; ++bj) {
                const size_t o = grow * 512 + 256 * u.pn + 128 * bj + 32 * wc + 4 * fq;
                const f32x4 a = up4(*(const u32x2*)(y0 + o)) + up4(*(const u32x2*)(y1 + o)), b = up4(*(const u32x2*)(y0 + o + 16)) + up4(*(const u32x2*)(y1 + o + 16));
                float s = (a[0] + a[1]) + (a[2] + a[3]) + (b[0] + b[1]) + (b[2] + b[3]);
                s += __shfl_xor(s, 16); s += __shfl_xor(s, 32);
                const float mw = s * (1.f / 32.f); const f32x4 da = a - mw, db = b - mw;
                float q = (da[0] * da[0] + da[1] * da[1]) + (da[2] * da[2] + da[3] * da[3]) + (db[0] * db[0] + db[1] * db[1]) + (db[2] * db[2] + db[3] * db[3]);
                q += __shfl_xor(q, 16); q += __shfl_xor(q, 32);
                if (fq == 0) P[(R * 4 + 2 * bj + (wc >> 1)) * 2 + (wc & 1)] = (f32x2){mw, q};
            }
        }
        asm volatile("s_waitcnt lgkmcnt(0)" ::: "memory"); __builtin_amdgcn_s_barrier(); asm volatile("" ::: "memory");
        EPI_ROWS(ai, m) {
            const int R = 128 * ai + 64 * wr + 16 * m + fr; const size_t grow = (size_t)u.pm * 256 + R;
            int pos, len; if (grow < (size_t)ML) { pos = (int)(grow & 4095); len = SEQ; } else { pos = (int)((grow - ML) & 255); len = CTXL; }
            const bool hp = pos > 0, hn = pos < len - 1;
            const size_t rp = hp ? grow - 1 : grow, rn = hn ? grow + 1 : grow;
#pragma unroll
            for (int bj = 0; bj < 2; ++bj) {
                const int hl = 2 * bj + (wc >> 1), head = 4 * u.pn + hl;
                const f32x2 pa = P[(R * 4 + hl) * 2 + 0], pb = P[(R * 4 + hl) * 2 + 1];
                const float mean = 0.5f * (pa.x + pb.x), dm = pa.x - pb.x, var = (pa.y + pb.y + 16.f * dm * dm) * (1.f / 64.f);
                const float rstd = 1.0f / sqrtf(var + 64.f * 1e-5f);
                const float bsum = bon[grow * 8 + head] + bon[(size_t)MT * 8 + grow * 8 + head];
#pragma unroll
                for (int n = 0; n < 2; ++n) {
                    const int c = 256 * u.pn + 128 * bj + 32 * wc + 16 * n + 4 * fq;
                    const size_t o = grow * 512 + c;
                    const f32x4 yv = up4(*(const u32x2*)(y0 + o)) + up4(*(const u32x2*)(y1 + o));
                    const f32x4 w4 = *(const f32x4*)(lnw + c), b4 = *(const f32x4*)(lnb + c);
                    const f32x4 m0 = *(const f32x4*)(mu + 512 + c), m1 = *(const f32x4*)(mu + 1920 + 512 + c);
                    const f32x4 vc = up4(*(const u32x2*)(cs + grow * DCS + 512 + c));
                    f32x4 vp = up4(*(const u32x2*)(cs + rp * DCS + 512 + c)), vn = up4(*(const u32x2*)(cs + rn * DCS + 512 + c));
                    if (!hp) vp = (f32x4){0.f, 0.f, 0.f, 0.f}; if (!hn) vn = (f32x4){0.f, 0.f, 0.f, 0.f};
                    const f32x4 vs = vc + m0 * (vp - vc) + m1 * (vn - vc);
                    const f32x4 yn = (yv - mean) * rstd * w4 + b4;
                    const f32x4 r = (yn + bsum * vs) * acc[ai][bj][m][n];
                    *(u32x2*)(oc + o) = pk4(r);
                }
            }
        }
    }
};
}
namespace attn {
#define SBAR() __builtin_amdgcn_sched_barrier(0)
constexpr int QBLK = 32, KVBLK = 64;
#ifndef ATTN_THR
#define ATTN_THR 6.f
#endif
constexpr int SHM_V = KVBLK * 128 * 2, SHM_K = KVBLK * 64 * 2;
constexpr int LDS_V = 0, LDS_K = 2 * SHM_V, LDS_WS = LDS_K + 2 * SHM_K, LDS_STASH = LDS_WS + NWAVES * 64 * 4, LDS_END = LDS_STASH + NWAVES * 8192;
static_assert(LDS_END <= RING_BYTES, "attention LDS");
__device__ __forceinline__ int crow(int r, int hi) { return (r & 3) + 8 * (r >> 2) + 4 * hi; }
__device__ __forceinline__ int kswz(int row, int chunk) { return row * 128 + ((chunk ^ ((row >> 1) & 7)) << 4); }

__device__ __forceinline__ void partialSM(f32x16& p0, f32x16& p1, float& m_reg, f32x16& negm, bool first, float& alpha) {
    float pmax = p0[0];
#pragma unroll
    for (int r = 1; r < 16; ++r) pmax = fmaxf(pmax, p0[r]);
#pragma unroll
    for (int r = 0; r < 16; ++r) pmax = fmaxf(pmax, p1[r]);
    { auto rr = __builtin_amdgcn_permlane32_swap(__float_as_uint(pmax), __float_as_uint(pmax), false, false);
      pmax = fmaxf(__uint_as_float(rr[0]), __uint_as_float(rr[1])); }
    if (__builtin_expect(!first && __all(pmax <= ATTN_THR * 1.4426950408889634f), 1)) { alpha = 1.f; }
    else { const float d = first ? pmax : fmaxf(pmax, 0.f); alpha = __builtin_amdgcn_exp2f(-d); m_reg += d;
#pragma unroll
        for (int r = 0; r < 16; ++r) { p0[r] -= d; p1[r] -= d; negm[r] = -m_reg; } }
#pragma unroll
    for (int r = 0; r < 16; ++r) p0[r] = __builtin_amdgcn_exp2f(p0[r]);
}
__device__ __forceinline__ void finishSM(f32x16& p0, f32x16& p1, float alpha, float& l_reg, bf16x8& pa0, bf16x8& pa1, bf16x8& pa2, bf16x8& pa3) {
#pragma unroll
    for (int r = 0; r < 16; ++r) p1[r] = __builtin_amdgcn_exp2f(p1[r]);
    f32x2 ps2 = (f32x2){p0[0], p0[1]} + (f32x2){p1[0], p1[1]};
#pragma unroll
    for (int r = 2; r < 16; r += 2) { ps2 += (f32x2){p0[r], p0[r + 1]}; ps2 += (f32x2){p1[r], p1[r + 1]}; }
    float ps = ps2.x + ps2.y;
    { auto rr = __builtin_amdgcn_permlane32_swap(__float_as_uint(ps), __float_as_uint(ps), false, false);
      ps = __uint_as_float(rr[0]) + __uint_as_float(rr[1]); }
    l_reg = l_reg * alpha + ps;
#define PK4(P, BASE, OUT) do { unsigned a0 = cvt_pk_bf16(P[BASE + 0], P[BASE + 1]), a1 = cvt_pk_bf16(P[BASE + 2], P[BASE + 3]);   \
    unsigned b0 = cvt_pk_bf16(P[BASE + 4], P[BASE + 5]), b1 = cvt_pk_bf16(P[BASE + 6], P[BASE + 7]);                              \
    auto r0 = __builtin_amdgcn_permlane32_swap(a0, b0, false, false); auto r1 = __builtin_amdgcn_permlane32_swap(a1, b1, false, false); \
    u32x4 w = {r0[0], r1[0], r0[1], r1[1]}; OUT = *reinterpret_cast<bf16x8*>(&w); } while (0)
    PK4(p0, 0, pa0); PK4(p0, 8, pa1); PK4(p1, 0, pa2); PK4(p1, 8, pa3);
#undef PK4
}
__device__ __forceinline__ void qkt(f32x16& p0, f32x16& p1, const LAS char* Ks, const bf16x8 q0, const bf16x8 q1, const bf16x8 q2, const bf16x8 q3, int r32, int hi, const f32x16& negm) {
    p0 = negm; p1 = negm;
#define QK1(d0, Q) do { const bf16x8 b0 = *(const LAS bf16x8*)(Ks + kswz(r32, 2 * (d0) + hi)); const bf16x8 b1 = *(const LAS bf16x8*)(Ks + kswz(32 + r32, 2 * (d0) + hi)); \
    p0 = __builtin_amdgcn_mfma_f32_32x32x16_bf16(b0, Q, p0, 0, 0, 0); p1 = __builtin_amdgcn_mfma_f32_32x32x16_bf16(b1, Q, p1, 0, 0, 0); } while (0)
    QK1(0, q0); QK1(1, q1); QK1(2, q2); QK1(3, q3);
#undef QK1
}
__device__ __forceinline__ int v_st(int k, int c) { const int kk = (k & ~0xC) | ((k & 4) << 1) | ((k & 8) >> 1); return ((kk >> 3) * 4 + (c >> 5)) * 512 + ((kk & 7) * 32 + (c & 31)) * 2; }
__device__ __forceinline__ int v_rd_base(int lane) { return ((lane & 3) << 3) | (((lane >> 2) & 3) << 6) | (((lane >> 4) & 1) << 5) | (((lane >> 5) & 1) << 8); }
constexpr int v_rd_off(int d0, int ks, int half) { return d0 * 512 + ks * 4096 + half * 2048; }
template <int OFF> __device__ __forceinline__ s16x4 tr_read(int vb) {
    s16x4 r; asm volatile("ds_read_b64_tr_b16 %0, %1 offset:%2" : "=&v"(r) : "v"(vb), "i"(OFF) : "memory"); return r;
}
template <int D0> __device__ __forceinline__ void pv_one(f32x16& od, int vb, bf16x8 pa0, bf16x8 pa1, bf16x8 pa2, bf16x8 pa3) {
    const s16x4 l0 = tr_read<v_rd_off(D0, 0, 0)>(vb), h0 = tr_read<v_rd_off(D0, 0, 1)>(vb), l1 = tr_read<v_rd_off(D0, 1, 0)>(vb), h1 = tr_read<v_rd_off(D0, 1, 1)>(vb);
    const s16x4 l2 = tr_read<v_rd_off(D0, 2, 0)>(vb), h2 = tr_read<v_rd_off(D0, 2, 1)>(vb), l3 = tr_read<v_rd_off(D0, 3, 0)>(vb), h3 = tr_read<v_rd_off(D0, 3, 1)>(vb);
    asm volatile("s_waitcnt lgkmcnt(0)" ::: "memory"); SBAR();
#define PK(L, H) (bf16x8){L[0], L[1], L[2], L[3], H[0], H[1], H[2], H[3]}
    od = __builtin_amdgcn_mfma_f32_32x32x16_bf16(pa0, PK(l0, h0), od, 0, 0, 0);
    od = __builtin_amdgcn_mfma_f32_32x32x16_bf16(pa1, PK(l1, h1), od, 0, 0, 0);
    od = __builtin_amdgcn_mfma_f32_32x32x16_bf16(pa2, PK(l2, h2), od, 0, 0, 0);
    od = __builtin_amdgcn_mfma_f32_32x32x16_bf16(pa3, PK(l3, h3), od, 0, 0, 0);
#undef PK
}
__device__ __forceinline__ void pv_d0(f32x16* o, int vb, bf16x8 pa0, bf16x8 pa1, bf16x8 pa2, bf16x8 pa3) {
    pv_one<0>(o[0], vb, pa0, pa1, pa2, pa3); pv_one<1>(o[1], vb, pa0, pa1, pa2, pa3); pv_one<2>(o[2], vb, pa0, pa1, pa2, pa3); pv_one<3>(o[3], vb, pa0, pa1, pa2, pa3);
}

template <bool LATENT>
__device__ __forceinline__ void attn_unit(const bf16_t* Qb, const bf16_t* Kb, const bf16_t* Vb, bf16_t* Ob, int qrow0, int b, int hh,
                                          float lam, float oscale, const float* __restrict__ subln, const float* __restrict__ rope, LAS char* lds, int wave_) {
    int wid = wave_; asm volatile("" : "+s"(wid));
    const int lane = fresh_lane(), tid = (wid << 6) | lane, r32 = lane & 31, hi = lane >> 5;
    LAS char* V_lds = lds + LDS_V; LAS char* K_lds = lds + LDS_K;
    LAS float* wsf = (LAS float*)(lds + LDS_WS) + wid * 64; LAS float* li_l = wsf; LAS float* al_l = wsf + 32;
    LAS unsigned* stash = (LAS unsigned*)(lds + LDS_STASH + wid * 8192);
    constexpr int NT = 64;
    const int ctx0 = ML + b * CTXL, lat0 = b * SEQ;
    const int myrow = qrow0 + wid * QBLK + r32;
    const int ksr = tid >> 3, ksc = tid & 7, kst = kswz(ksr, ksc);
    const int sr = tid >> 4, sc = (tid & 15) * 8, vst0 = v_st(sr, sc), vst1 = v_st(32 + sr, sc);
    const int vb0 = (int)(uintptr_t)V_lds + v_rd_base(lane);
    f32x16 o[4];
#pragma unroll 1
    for (int c = 0; c < 2; ++c) {
        bf16x8 q0, q1, q2, q3;
        { const int lq = fresh_lane();
          const bf16_t* Qw = Qb + (size_t)(qrow0 + wid * QBLK + (lq & 31)) * 1024 + hh * 128 + c * 64 + (lq >> 5) * 8;
          q0 = *(const bf16x8*)(Qw); q1 = *(const bf16x8*)(Qw + 16); q2 = *(const bf16x8*)(Qw + 32); q3 = *(const bf16x8*)(Qw + 48); }
        const unsigned voV0 = (unsigned)(sr * 1024 + hh * 128 + sc) * 2u, voK = (unsigned)(ksr * 1024 + hh * 128 + c * 64 + ksc * 8) * 2u;
        float m_reg = 0.f, l_reg = 0.f; f32x16 negm = f32x16{};
#pragma unroll
        for (int d = 0; d < 4; ++d) o[d] = f32x16{};
        bf16x8 sv0[1], sv1[1], sk0[1];
#define SLOAD(i, kr) do { unsigned a_ = voV0, b_ = voV0 + 32u * 2048u, c_ = voK; asm volatile("" : "+v"(a_), "+v"(b_), "+v"(c_)); \
        const char* vb_ = (const char*)Vb + (size_t)(kr) * 2048; const char* kb_ = (const char*)Kb + (size_t)(kr) * 2048; \
        sv0[i] = *(const bf16x8*)(vb_ + a_); sv1[i] = *(const bf16x8*)(vb_ + b_); sk0[i] = *(const bf16x8*)(kb_ + c_); } while (0)
#define SWRITE(bb, i) do { *(LAS bf16x8*)(V_lds + (bb) * SHM_V + vst0) = sv0[i]; *(LAS bf16x8*)(V_lds + (bb) * SHM_V + vst1) = sv1[i]; *(LAS bf16x8*)(K_lds + (bb) * SHM_K + kst) = sk0[i]; } while (0)
#define SWAIT() asm volatile("s_waitcnt vmcnt(3)" ::: "memory")
#define RESC(a) do { if (__any((a) < 1.f)) { if (hi == 0) al_l[r32] = (a); asm volatile("s_waitcnt lgkmcnt(0)" ::: "memory"); \
        _Pragma("unroll") for (int d = 0; d < 4; ++d) _Pragma("unroll") for (int r = 0; r < 16; ++r) o[d][r] *= al_l[crow(r, hi)]; } } while (0)
        f32x16 pA0, pA1; float alA; bf16x8 pa0, pa1, pa2, pa3;
        SLOAD(0, ctx0);
#pragma unroll 1
        for (int j = 0; j < 4; ++j) {
            __syncthreads();
            asm volatile("s_waitcnt vmcnt(0)" ::: "memory"); SWRITE(0, 0);
            { const int nr = j < 3 ? ctx0 + 64 * (j + 1) : (LATENT ? lat0 : ctx0); SLOAD(0, nr); }
            __syncthreads();
            qkt(pA0, pA1, K_lds, q0, q1, q2, q3, r32, hi, negm); partialSM(pA0, pA1, m_reg, negm, j == 0, alA);
            RESC(alA);
            finishSM(pA0, pA1, alA, l_reg, pa0, pa1, pa2, pa3); SBAR();
            pv_d0(o, vb0, pa0, pa1, pa2, pa3);
        }
        if (LATENT) {
            {
                const int t = myrow & 4095, pos0 = t >> 6, pos1 = t & 63;
                const float* r0p = rope + (pos0 * 16 + 8 * hi) * 2; const float* r1p = rope + (pos1 * 16 + 8 * hi) * 2;
#pragma unroll
                for (int j = 0; j < 8; ++j) {
                    const float c0 = r0p[2 * j], s0 = r0p[2 * j + 1], c1 = r1p[2 * j], s1 = r1p[2 * j + 1];
                    const float x1 = bf2f((unsigned short)q0[j]), x2 = bf2f((unsigned short)q1[j]), z1 = bf2f((unsigned short)q2[j]), z2 = bf2f((unsigned short)q3[j]);
                    const unsigned w0 = cvt_pk_bf16(x1 * c0 - x2 * s0, x2 * c0 + x1 * s0), w1 = cvt_pk_bf16(z1 * c1 - z2 * s1, z2 * c1 + z1 * s1);
                    q0[j] = (short)(w0 & 0xffffu); q1[j] = (short)(w0 >> 16); q2[j] = (short)(w1 & 0xffffu); q3[j] = (short)(w1 >> 16);
                }
            }
            f32x16 pB0, pB1; float alB;
            __syncthreads();
            asm volatile("s_waitcnt vmcnt(0)" ::: "memory"); SWRITE(0, 0);
            SLOAD(0, lat0 + 64); __syncthreads();
            qkt(pA0, pA1, K_lds, q0, q1, q2, q3, r32, hi, negm); partialSM(pA0, pA1, m_reg, negm, false, alA);
            RESC(alA);
            asm volatile("s_waitcnt vmcnt(0)" ::: "memory"); SWRITE(1, 0); SLOAD(0, lat0 + 128); __syncthreads();
#pragma unroll 1
            for (int j = 1; j + 1 < NT; j += 2) {
                SBAR(); qkt(pB0, pB1, K_lds + SHM_K, q0, q1, q2, q3, r32, hi, negm);
                finishSM(pA0, pA1, alA, l_reg, pa0, pa1, pa2, pa3); SBAR();
                pv_d0(o, vb0, pa0, pa1, pa2, pa3); partialSM(pB0, pB1, m_reg, negm, false, alB);
                __syncthreads(); asm volatile("s_waitcnt vmcnt(0)" ::: "memory"); SWRITE(0, 0);
                SLOAD(0, lat0 + 64 * (j + 2 < NT ? j + 2 : NT - 1));
                RESC(alB); __syncthreads();
                SBAR(); qkt(pA0, pA1, K_lds, q0, q1, q2, q3, r32, hi, negm);
                finishSM(pB0, pB1, alB, l_reg, pa0, pa1, pa2, pa3); SBAR();
                pv_d0(o, vb0 + SHM_V, pa0, pa1, pa2, pa3); partialSM(pA0, pA1, m_reg, negm, false, alA);
                __syncthreads(); asm volatile("s_waitcnt vmcnt(0)" ::: "memory"); SWRITE(1, 0);
                SLOAD(0, lat0 + 64 * (j + 3 < NT ? j + 3 : NT - 1));
                RESC(alA); __syncthreads();
            }
            SBAR(); qkt(pB0, pB1, K_lds + SHM_K, q0, q1, q2, q3, r32, hi, negm);
            finishSM(pA0, pA1, alA, l_reg, pa0, pa1, pa2, pa3); SBAR();
            pv_d0(o, vb0, pa0, pa1, pa2, pa3); partialSM(pB0, pB1, m_reg, negm, false, alB);
            __syncthreads(); RESC(alB);
            finishSM(pB0, pB1, alB, l_reg, pa0, pa1, pa2, pa3); SBAR();
            pv_d0(o, vb0 + SHM_V, pa0, pa1, pa2, pa3);
        }
        const int le = fresh_lane(), r32e = le & 31, hie = le >> 5;
        if (hie == 0) li_l[r32e] = l_reg; asm volatile("s_waitcnt lgkmcnt(0)" ::: "memory");
        if (c == 0) {
#pragma unroll
            for (int r = 0; r < 16; ++r) { const float rl = 1.0f / li_l[crow(r, hie)];
#pragma unroll
                for (int d = 0; d < 4; d += 2) stash[(r * 2 + (d >> 1)) * 64 + le] = cvt_pk_bf16(o[d][r] * rl, o[d + 1][r] * rl); }
        } else {
            bf16_t* Ow = Ob + (size_t)(qrow0 + wid * QBLK) * 1024 + hh * 128;
            float gsub[4];
#pragma unroll
            for (int d = 0; d < 4; ++d) gsub[d] = subln[d * 32 + r32e] * oscale;
#pragma unroll
            for (int r = 0; r < 16; ++r) {
                const float rl = lam / li_l[crow(r, hie)]; float acc2 = 0.f;
#pragma unroll
                for (int d = 0; d < 4; d += 2) { const unsigned w = stash[(r * 2 + (d >> 1)) * 64 + le];
                    const float a0 = bflo(w) - o[d][r] * rl, a1 = bfhi(w) - o[d + 1][r] * rl;
                    o[d][r] = a0; o[d + 1][r] = a1; acc2 += a0 * a0 + a1 * a1; }
#pragma unroll
                for (int off = 1; off < 32; off <<= 1) acc2 += __shfl_xor(acc2, off);
                const float rs = 1.0f / sqrtf(acc2 * (1.f / 128.f) + 1e-5f);
                const int orow = crow(r, hie);
#pragma unroll
                for (int d = 0; d < 4; ++d) Ow[(size_t)orow * 1024 + d * 32 + r32e] = (bf16_t)(cvt_pk_bf16(o[d][r] * rs * gsub[d], 0.f) & 0xffffu);
            }
        }
    }
#undef SLOAD
#undef SWRITE
#undef SWAIT
#undef RESC
}
#undef SBAR
}
#ifndef SCAN_TSEL
#define SCAN_TSEL 0
#endif
namespace rwkv {
constexpr int A_W = 0, A_KK = 16384, A_B = 32768, A_KD = 49152, A_R = 65536, A_V = 81920, A_Y = 98304, A_TW = A_Y, A_TA = A_Y + 8192, A_PRM = 133120, A_GC = A_PRM + 15 * 256, A_GT = A_GC + 256, A_END = A_GT + 2048;
constexpr int C_AT = 0, C_RT = 8192, C_BT = 16384, C_KT = 24576, C_KHT = 32768, C_BHT = 40960, C_VT = 49152, C_LAK = 57344, C_LAB = 65536  , C_RHS = 82944  , C_MRK = 100352, C_MRB = 108544, C_ZN = 116736, C_S0B = 139264;
constexpr int RHSP = 68;
constexpr int LABP = 68;
static_assert(A_END <= C_S0B && C_S0B + 8192 <= LDS_BYTES && C_ZN + 8192 <= RING_BYTES && C_RHS >= C_LAB + 64 * LABP * 4 && C_MRK >= C_RHS + 64 * RHSP * 4 && A_END <= LDS_BYTES && A_PRM >= MISC_OFF + 512, "scan LDS");
struct Params { const bf16_t* cs; bf16_t* co; bf16_t* y; float* bon; const float* mu; const float* w0; const float* w2; const float* a0; const float* a2; const float* kk; const float* ka; const float* rk; };
__device__ __forceinline__ float dpp_ror_add(float x, int) { return x; }
#define ROR_ADD(x, n) do { const int t_ = __builtin_amdgcn_update_dpp(0, __builtin_bit_cast(int, x), 0x120 + (n), 0xf, 0xf, false); x += __builtin_bit_cast(float, t_); } while (0)
__device__ __forceinline__ float row16_sum(float x) { ROR_ADD(x, 8); ROR_ADD(x, 4); ROR_ADD(x, 2); ROR_ADD(x, 1); return x; }
__device__ __forceinline__ void ld8(const bf16_t* p, float (&o)[8]) { const u32x4 w = *(const u32x4*)p; o[0] = bflo(w.x); o[1] = bfhi(w.x); o[2] = bflo(w.y); o[3] = bfhi(w.y); o[4] = bflo(w.z); o[5] = bfhi(w.z); o[6] = bflo(w.w); o[7] = bfhi(w.w); }
template <class MP> __device__ __forceinline__ void shift8(const bf16_t* base, size_t pitch, size_t row, int col, bool hp, bool hn, MP m0, MP m1, float (&o)[8]) {
    float c[8], p[8], n[8]; ld8(base + row * pitch + col, c); ld8(base + (hp ? row - 1 : row) * pitch + col, p); ld8(base + (hn ? row + 1 : row) * pitch + col, n);
#pragma unroll
    for (int i = 0; i < 8; ++i) { const float pv = hp ? p[i] : 0.f, nv = hn ? n[i] : 0.f; o[i] = c[i] + m0[i] * (pv - c[i]) + m1[i] * (nv - c[i]); }
}
__device__ __forceinline__ void lds_ld8(const LAS float* p, float (&o)[8]) { const f32x4 a = *(const LAS f32x4*)p, b = *(const LAS f32x4*)(p + 4); o[0] = a[0]; o[1] = a[1]; o[2] = a[2]; o[3] = a[3]; o[4] = b[0]; o[5] = b[1]; o[6] = b[2]; o[7] = b[3]; }
__device__ __forceinline__ void lds_st8(LAS float* p, const float (&o)[8]) { *(LAS f32x4*)p = (f32x4){o[0], o[1], o[2], o[3]}; *(LAS f32x4*)(p + 4) = (f32x4){o[4], o[5], o[6], o[7]}; }
__device__ __forceinline__ void scan_wg(const Params& P, int d, int b, int hh, LAS char* lds, int wave_) {
    unsigned long long tprev_ = 0;
#define SC_T(k) do { if (SCAN_TSEL != 0) { if (blockIdx.x == 0 && tid == 0) { const unsigned long long tn_ = __builtin_amdgcn_s_memrealtime(); if ((SCAN_TSEL >> (k)) & 1) { volatile LAS unsigned* M_ = (volatile LAS unsigned*)(lds + MISC_OFF); const unsigned long long ac_ = (((unsigned long long)M_[19] << 32) | M_[18]) + (tn_ - tprev_); M_[18] = (unsigned)ac_; M_[19] = (unsigned)(ac_ >> 32); } tprev_ = tn_; } } } while (0)
    int wid = wave_; asm volatile("" : "+s"(wid));
    const int lane0 = fresh_lane(), tid = (wid << 6) | lane0, r32o = lane0 & 31, hio = lane0 >> 5;
    LAS float* W = (LAS float*)(lds + A_W); LAS float* KK = (LAS float*)(lds + A_KK); LAS float* Bv = (LAS float*)(lds + A_B); LAS float* KD = (LAS float*)(lds + A_KD);
    LAS float* Rv = (LAS float*)(lds + A_R); LAS float* Vv = (LAS float*)(lds + A_V); LAS float* Y = (LAS float*)(lds + A_Y);
    LAS bf16_t* TW = (LAS bf16_t*)(lds + A_TW); LAS bf16_t* TA = (LAS bf16_t*)(lds + A_TA); LAS float* PRM = (LAS float*)(lds + A_PRM);
    __syncthreads();
    for (int i = tid; i < 15 * 64; i += NTHREADS) { const int p = i >> 6, c = i & 63; float v;
        switch (p) {
            case 0: v = P.mu[hh * 64 + c]; break;             case 1: v = P.mu[1920 + hh * 64 + c]; break;
            case 2: v = P.mu[512 + hh * 64 + c]; break;       case 3: v = P.mu[1920 + 512 + hh * 64 + c]; break;
            case 4: v = P.mu[1024 + d * 64 + c]; break;       case 5: v = P.mu[1920 + 1024 + d * 64 + c]; break;
            case 6: v = P.mu[1152 + d * 64 + c]; break;       case 7: v = P.mu[1920 + 1152 + d * 64 + c]; break;
            case 8: v = P.mu[1280 + hh * 64 + c]; break;      case 9: v = P.mu[1920 + 1280 + hh * 64 + c]; break;
            case 10: v = P.w0[d * 512 + hh * 64 + c]; break;  case 11: v = P.a0[d * 512 + hh * 64 + c]; break;
            case 12: v = P.kk[hh * 64 + c]; break;            case 13: v = P.ka[hh * 64 + c]; break;
            default: v = P.rk[hh * 64 + c]; break; }
        PRM[i] = v; }
    const int mtx = wid >> 2, ti = (wid >> 1) & 1, tj = wid & 1;
    bf16x8 bw[4];
    { const int r32 = r32o, hi = hio; const float* src = (mtx == 0 ? P.w2 : P.a2) + (size_t)d * 64 * 512 + hh * 64 + 32 * tj + r32;
#pragma unroll
      for (int s = 0; s < 4; ++s) {
          u32x4 w;
          w.x = cvt_pk_bf16(src[(size_t)(16 * s + 8 * hi + 0) * 512], src[(size_t)(16 * s + 8 * hi + 1) * 512]);
          w.y = cvt_pk_bf16(src[(size_t)(16 * s + 8 * hi + 2) * 512], src[(size_t)(16 * s + 8 * hi + 3) * 512]);
          w.z = cvt_pk_bf16(src[(size_t)(16 * s + 8 * hi + 4) * 512], src[(size_t)(16 * s + 8 * hi + 5) * 512]);
          w.w = cvt_pk_bf16(src[(size_t)(16 * s + 8 * hi + 6) * 512], src[(size_t)(16 * s + 8 * hi + 7) * 512]);
          bw[s] = __builtin_bit_cast(bf16x8, w); } }
    LAS float* GC = (LAS float*)(lds + A_GC); LAS float* GT = (LAS float*)(lds + A_GT);
    f32x16 Sreg = f32x16{};
    for (int i = tid; i < 2048; i += NTHREADS) ((LAS unsigned*)(lds + C_S0B))[i] = 0u;
    __syncthreads();
    u32x4 rc[5], rpv[5], rnv[5];
#define LOADRAW(BLK) do { const bool ic_ = (BLK) < 4; const int bb_ = ic_ ? (BLK) : (BLK) - 4; const int sb_ = ic_ ? ML + b * CTXL : b * SEQ, sl_ = ic_ ? CTXL : SEQ; \
        const int r0_ = d == 0 ? sb_ + 64 * bb_ : sb_ + sl_ - 64 * (bb_ + 1); int tq_ = tid; asm volatile("" : "+v"(tq_)); const int pj_ = tq_ >> 3, cg_ = tq_ & 7; \
        const int row_ = d == 0 ? r0_ + pj_ : r0_ + 63 - pj_; const int pos_ = row_ - sb_; const size_t rp_ = pos_ > 0 ? row_ - 1 : row_, rn_ = pos_ < sl_ - 1 ? row_ + 1 : row_; \
        const int cs_[5] = {hh * 64 + 8 * cg_, 512 + hh * 64 + 8 * cg_, 1024 + d * 64 + 8 * cg_, 1152 + d * 64 + 8 * cg_, hh * 64 + 8 * cg_}; \
        _Pragma("unroll") for (int sgi = 0; sgi < 5; ++sgi) { const bf16_t* base_ = sgi < 4 ? P.cs : (const bf16_t*)P.co; const size_t pitch_ = sgi < 4 ? DCS : DCOP; \
            rc[sgi] = *(const u32x4*)(base_ + (size_t)row_ * pitch_ + cs_[sgi]); rpv[sgi] = *(const u32x4*)(base_ + rp_ * pitch_ + cs_[sgi]); rnv[sgi] = *(const u32x4*)(base_ + rn_ * pitch_ + cs_[sgi]); \
            } } while (0)
    LOADRAW(0);
#pragma unroll 1
    for (int blk = 0; blk < 68; ++blk) {
        const bool isctx = blk < 4; const int bb = isctx ? blk : blk - 4;
        const int segbase = isctx ? ML + b * CTXL : b * SEQ, seglen = isctx ? CTXL : SEQ;
        const int r0 = d == 0 ? segbase + 64 * bb : segbase + seglen - 64 * (bb + 1);
        int tl_ = tid; asm volatile("" : "+v"(tl_));
        const int lane = tl_ & 63, r32 = lane & 31, hi = lane >> 5, pj = tl_ >> 3, cg = tl_ & 7;
        SC_T(0);
        {
            const int row = d == 0 ? r0 + pj : r0 + 63 - pj; const int pos = row - segbase; const unsigned pmk = pos > 0 ? 0xffffffffu : 0u, nmk = pos < seglen - 1 ? 0xffffffffu : 0u;
#define SHIFT8(sgi, M0, M1, OUT) do { const unsigned cw_[4] = {rc[sgi].x, rc[sgi].y, rc[sgi].z, rc[sgi].w}, pw_[4] = {rpv[sgi].x & pmk, rpv[sgi].y & pmk, rpv[sgi].z & pmk, rpv[sgi].w & pmk}, nw_[4] = {rnv[sgi].x & nmk, rnv[sgi].y & nmk, rnv[sgi].z & nmk, rnv[sgi].w & nmk}; \
                _Pragma("unroll") for (int i = 0; i < 4; ++i) { const f32x2 c_ = {bflo(cw_[i]), bfhi(cw_[i])}, p_ = {bflo(pw_[i]), bfhi(pw_[i])}, n_ = {bflo(nw_[i]), bfhi(nw_[i])}; \
                    const f32x2 a0_ = {(M0)[2 * i], (M0)[2 * i + 1]}, a1_ = {(M1)[2 * i], (M1)[2 * i + 1]}; const f32x2 o_ = c_ + a0_ * (p_ - c_) + a1_ * (n_ - c_); OUT[2 * i] = o_.x; OUT[2 * i + 1] = o_.y; } } while (0)
            float ks[8], xs[8], ssq = 0.f;
            float m0[8], m1[8];
            lds_ld8(PRM + 0 * 64 + 8 * cg, m0); lds_ld8(PRM + 1 * 64 + 8 * cg, m1); SHIFT8(0, m0, m1, ks);
            lds_st8(KD + pj * 64 + 8 * cg, ks);
            lds_ld8(PRM + 12 * 64 + 8 * cg, m0);
#pragma unroll
            for (int i = 0; i < 8; ++i) { const float t = ks[i] * m0[i]; ks[i] = t; ssq += t * t; }
            ssq += __shfl_xor(ssq, 1); ssq += __shfl_xor(ssq, 2); ssq += __shfl_xor(ssq, 4);
            const float inv = __builtin_amdgcn_rcpf(fmaxf(sqrtf(ssq), 1e-12f));
#pragma unroll
            for (int i = 0; i < 8; ++i) ks[i] *= inv;
            lds_st8(KK + pj * 64 + 8 * cg, ks);
            lds_ld8(PRM + 2 * 64 + 8 * cg, m0); lds_ld8(PRM + 3 * 64 + 8 * cg, m1); SHIFT8(1, m0, m1, xs);
            lds_st8(Vv + pj * 64 + 8 * cg, xs);
            lds_ld8(PRM + 8 * 64 + 8 * cg, m0); lds_ld8(PRM + 9 * 64 + 8 * cg, m1); SHIFT8(4, m0, m1, xs);
            lds_st8(Rv + pj * 64 + 8 * cg, xs);
            lds_ld8(PRM + 4 * 64 + 8 * cg, m0); lds_ld8(PRM + 5 * 64 + 8 * cg, m1); SHIFT8(2, m0, m1, xs);
            { u32x4 w;
#pragma unroll
              for (int i = 0; i < 8; ++i) { const float e2 = __expf(2.f * xs[i]); xs[i] = 1.f - 2.f / (e2 + 1.f); }
              w.x = cvt_pk_bf16(xs[0], xs[1]); w.y = cvt_pk_bf16(xs[2], xs[3]); w.z = cvt_pk_bf16(xs[4], xs[5]); w.w = cvt_pk_bf16(xs[6], xs[7]);
              *(LAS u32x4*)(TW + pj * 64 + 8 * cg) = w; }
            lds_ld8(PRM + 6 * 64 + 8 * cg, m0); lds_ld8(PRM + 7 * 64 + 8 * cg, m1); SHIFT8(3, m0, m1, xs);
            { u32x4 w; w.x = cvt_pk_bf16(xs[0], xs[1]); w.y = cvt_pk_bf16(xs[2], xs[3]); w.z = cvt_pk_bf16(xs[4], xs[5]); w.w = cvt_pk_bf16(xs[6], xs[7]);
              *(LAS u32x4*)(TA + pj * 64 + 8 * cg) = w; }
#undef SHIFT8
        }
        if (blk + 1 < 68) LOADRAW(blk + 1);
        __syncthreads(); SC_T(1);
        {
            const LAS bf16_t* T = mtx == 0 ? TW : TA; LAS float* dst = mtx == 0 ? W : Bv;
            f32x16 cacc = f32x16{};
#pragma unroll
            for (int s = 0; s < 4; ++s) { const bf16x8 af = *(const LAS bf16x8*)(T + (32 * ti + r32) * 64 + 16 * s + 8 * hi);
                cacc = __builtin_amdgcn_mfma_f32_32x32x16_bf16(af, bw[s], cacc, 0, 0, 0); }
#pragma unroll
            for (int r = 0; r < 16; ++r) dst[(32 * ti + (r & 3) + 8 * (r >> 2) + 4 * hi) * 64 + 32 * tj + r32] = cacc[r];
        }
        __syncthreads(); SC_T(2);
        {
            const int row = d == 0 ? r0 + pj : r0 + 63 - pj; float bsum = 0.f; const int o8 = pj * 64 + 8 * cg;
            float lw[8], la[8], kdv[8], kkv[8], rv[8], p10[8], p11[8], p13[8], p14[8];
            lds_ld8(W + o8, lw); lds_ld8(Bv + o8, la); lds_ld8(KD + o8, kdv); lds_ld8(KK + o8, kkv); lds_ld8(Rv + o8, rv);
            lds_ld8(PRM + 10 * 64 + 8 * cg, p10); lds_ld8(PRM + 11 * 64 + 8 * cg, p11); lds_ld8(PRM + 13 * 64 + 8 * cg, p13); lds_ld8(PRM + 14 * 64 + 8 * cg, p14);
#pragma unroll
            for (int i = 0; i < 8; ++i) {
                const float x = p10[i] + lw[i]; const float dec = __expf(-0.60653065971263342f * sigmoidf_(x));
                const float a = sigmoidf_(p11[i] + la[i]);
                const float kd = kdv[i] * (1.f + (a - 1.f) * p13[i]);
                lw[i] = dec; kdv[i] = kd; la[i] = kkv[i] * a; bsum += rv[i] * kd * p14[i]; }
            lds_st8(W + o8, lw); lds_st8(KD + o8, kdv); lds_st8(Bv + o8, la);
            bsum += __shfl_xor(bsum, 1); bsum += __shfl_xor(bsum, 2); bsum += __shfl_xor(bsum, 4);
            if (cg == 0) P.bon[(size_t)d * MT * 8 + (size_t)row * 8 + hh] = bsum;
        }
        __syncthreads(); SC_T(3);
        {
            const int kcol = tl_ & 63, seg = wid; float p[8], run = 1.f;
#pragma unroll
            for (int i = 0; i < 8; ++i) { run *= W[(8 * seg + i) * 64 + kcol]; p[i] = run; }
            GT[seg * 64 + kcol] = run;
            __syncthreads();
            float pre = 1.f;
#pragma unroll
            for (int sg2 = 0; sg2 < 7; ++sg2) { const float tv = GT[sg2 * 64 + kcol]; if (sg2 < seg) pre *= tv; }
#pragma unroll
            for (int i = 0; i < 8; ++i) W[(8 * seg + i) * 64 + kcol] = pre * p[i];
        }
        __syncthreads();
        {
            const int o8 = pj * 64 + 8 * cg;
            float g[8], gx[8], kk[8], rr[8], bb[8], kd[8];
            lds_ld8(W + o8, g); if (pj > 0) lds_ld8(W + o8 - 64, gx); else {
#pragma unroll
                for (int i = 0; i < 8; ++i) gx[i] = 1.f; }
            lds_ld8(KK + o8, kk); lds_ld8(Rv + o8, rr); lds_ld8(Bv + o8, bb); lds_ld8(KD + o8, kd);
            const int kc2 = tl_ & 63, tc2 = wid;
            float g2[8], kd2[8], bb2[8], vv2[8]; const float gc2 = W[63 * 64 + kc2];
#pragma unroll
            for (int i = 0; i < 8; ++i) { const int o = (8 * tc2 + i) * 64 + kc2; g2[i] = W[o]; kd2[i] = KD[o]; bb2[i] = Bv[o]; vv2[i] = Vv[o]; }
            __syncthreads();
            u32x4 w;
#define PK8(EXPR) do { float e_[8]; _Pragma("unroll") for (int i = 0; i < 8; ++i) e_[i] = (EXPR); w.x = cvt_pk_bf16(e_[0], e_[1]); w.y = cvt_pk_bf16(e_[2], e_[3]); w.z = cvt_pk_bf16(e_[4], e_[5]); w.w = cvt_pk_bf16(e_[6], e_[7]); } while (0)
            const int ao = attn::kswz(pj, cg);
            PK8(kk[i] * gx[i]); *(LAS u32x4*)(lds + C_AT + ao) = w;
            PK8(rr[i] * g[i]);  *(LAS u32x4*)(lds + C_RT + ao) = w;
            float ig[8];
#pragma unroll
            for (int i = 0; i < 8; ++i) ig[i] = __builtin_amdgcn_rcpf(g[i]);
            PK8(bb[i] * ig[i]); *(LAS u32x4*)(lds + C_BT + ao) = w;
            PK8(kd[i] * ig[i]); *(LAS u32x4*)(lds + C_KT + ao) = w;
            const int ao2 = attn::kswz(kc2, tc2);
#pragma unroll
            for (int i = 0; i < 8; ++i) ig[i] = gc2 * __builtin_amdgcn_rcpf(g2[i]);
            PK8(kd2[i] * ig[i]); *(LAS u32x4*)(lds + C_KHT + ao2) = w;
            PK8(bb2[i] * ig[i]); *(LAS u32x4*)(lds + C_BHT + ao2) = w;
            PK8(vv2[i]);               *(LAS u32x4*)(lds + C_VT + ao2) = w;
            if (tc2 == 7) GC[kc2] = gc2;
#undef PK8
        }
        __syncthreads(); SC_T(4);
#define FRAG(ARR, ROW, CH) (*(const LAS bf16x8*)(lds + (ARR) + attn::kswz((ROW), (CH))))
        {
            const int tr = wid >> 1, ti = tr & 1; const int Aarr = tr < 2 ? C_AT : C_RT;
#pragma unroll
            for (int h2 = 0; h2 < 2; ++h2) { const int tc = 2 * (wid & 1) + h2, tj = tc & 1; const int Barr = tc < 2 ? C_BT : C_KT;
                f32x16 acc = f32x16{};
#pragma unroll
                for (int q = 0; q < 4; ++q) acc = __builtin_amdgcn_mfma_f32_32x32x16_bf16(FRAG(Barr, 32 * tj + r32, 2 * q + hi), FRAG(Aarr, 32 * ti + r32, 2 * q + hi), acc, 0, 0, 0);
                const int t = 32 * ti + r32;
                const int d0 = 32 * tj + 4 * hi - t - (tr < 2 ? 0 : 1);
                if (tr < 2 && tc < 2) {
                    LAS float* lp = (LAS float*)(lds + C_LAB) + (32 * tj + 4 * hi) * LABP + (t & 3) * 16 + (t >> 2);
#pragma unroll
                    for (int r = 0; r < 16; ++r) { const int e = (r & 3) + 8 * (r >> 2); const unsigned mk = (unsigned)((d0 + e) >> 31);
                        lp[e * LABP] = __uint_as_float(__float_as_uint(acc[r]) & mk); }
                } else {
                    const int dst = tr < 2 ? C_LAK : (tc < 2 ? C_MRB : C_MRK);
#pragma unroll
                    for (int gq = 0; gq < 4; ++gq) { const int tp0 = 32 * tj + 8 * gq + 4 * hi; float vv4[4];
#pragma unroll
                        for (int e = 0; e < 4; ++e) { const unsigned mk = (unsigned)((d0 + 8 * gq + e) >> 31); vv4[e] = __uint_as_float(__float_as_uint(acc[4 * gq + e]) & mk); }
                        u32x2 w2; w2.x = cvt_pk_bf16(vv4[0], vv4[1]); w2.y = cvt_pk_bf16(vv4[2], vv4[3]);
                        *(LAS u32x2*)(lds + dst + attn::kswz(t, tp0 >> 3) + (tp0 & 7) * 2) = w2; }
                }
            }
        }
        __syncthreads(); SC_T(5);
        if (wid < 4) {
            const int ti = wid >> 1, tj = wid & 1; f32x16 acc = f32x16{};
#pragma unroll
            for (int q = 0; q < 4; ++q) acc = __builtin_amdgcn_mfma_f32_32x32x16_bf16(FRAG(C_S0B, 32 * tj + r32, 2 * q + hi), FRAG(C_AT, 32 * ti + r32, 2 * q + hi), acc, 0, 0, 0);
#pragma unroll
            for (int q = 0; q < 4; ++q) acc = __builtin_amdgcn_mfma_f32_32x32x16_bf16(FRAG(C_VT, 32 * tj + r32, 2 * q + hi), FRAG(C_LAK, 32 * ti + r32, 2 * q + hi), acc, 0, 0, 0);
            const int t = 32 * ti + r32;
#pragma unroll
            for (int r = 0; r < 16; ++r) { const int v = 32 * tj + (r & 3) + 8 * (r >> 2) + 4 * hi; *(LAS float*)(lds + C_RHS + (v * RHSP + (t & 3) * 16 + (t >> 2)) * 4) = acc[r]; }
        }
        else {
                const int ti = (wid >> 1) & 1, tj = wid & 1; const float gcv = GC[32 * tj + r32];
#pragma unroll
                for (int r = 0; r < 16; ++r) Sreg[r] *= gcv;
#pragma unroll
                for (int q = 0; q < 4; ++q) Sreg = __builtin_amdgcn_mfma_f32_32x32x16_bf16(FRAG(C_VT, 32 * ti + r32, 2 * q + hi), FRAG(C_KHT, 32 * tj + r32, 2 * q + hi), Sreg, 0, 0, 0);
        }
        __syncthreads(); SC_T(6);
        f32x16 Yacc = f32x16{}; bf16x8 mrb[4] = {};
        if (wid >= 4) {
            const int q = lane & 3, v = 16 * (wid - 4) + (lane >> 2);
            const LAS float* LT = (const LAS float*)(lds + C_LAB) + q * 16;
            f32x2 sa[8]; float zo[16];
            { const LAS f32x4* rp = (const LAS f32x4*)(lds + C_RHS + (v * RHSP + q * 16) * 4);
#pragma unroll
              for (int g4 = 0; g4 < 4; ++g4) { const f32x4 x = rp[g4]; sa[2 * g4] = (f32x2){x[0], x[1]}; sa[2 * g4 + 1] = (f32x2){x[2], x[3]}; } }
#pragma unroll
            for (int i = 0; i < 16; ++i) zo[i] = 0.f;
            f32x4 la[4], lb[4];
#define LLOAD(t, A) do { const LAS f32x4* lp_ = (const LAS f32x4*)(LT + (t) * LABP); _Pragma("unroll") for (int g_ = (t) >> 4; g_ < 4; ++g_) A[g_] = lp_[g_]; } while (0)
#define SOLVE_STEP(t, A, N) do { if ((t) < 63) LLOAD((t) + 1, N); const float zown_ = (((t) >> 2) & 1) ? sa[(t) >> 3].y : sa[(t) >> 3].x; \
                const float zt_ = __builtin_bit_cast(float, __builtin_amdgcn_update_dpp(0, __builtin_bit_cast(int, zown_), ((t) & 3) * 0x55, 0xf, 0xf, true)); \
                if (q == ((t) & 3)) zo[(t) >> 2] = zt_; const f32x2 nz_ = {-zt_, -zt_}; \
                _Pragma("unroll") for (int p_ = (t) >> 3; p_ < 8; ++p_) { const f32x2 l2_ = (p_ & 1) ? (f32x2){A[p_ >> 1][2], A[p_ >> 1][3]} : (f32x2){A[p_ >> 1][0], A[p_ >> 1][1]}; sa[p_] = l2_ * nz_ + sa[p_]; } } while (0)
#define SOLVE2(t) SOLVE_STEP(t, la, lb); SOLVE_STEP((t) + 1, lb, la)
#define SOLVE8(t) SOLVE2(t); SOLVE2((t) + 2); SOLVE2((t) + 4); SOLVE2((t) + 6)
            LLOAD(0, la);
            SOLVE8(0); SOLVE8(8); SOLVE8(16); SOLVE8(24); SOLVE8(32); SOLVE8(40); SOLVE8(48); SOLVE8(56);
#undef SOLVE8
#undef SOLVE2
#undef SOLVE_STEP
#undef LLOAD
#pragma unroll
            for (int i = 0; i < 16; ++i) { const int t = 4 * i + q; *(LAS bf16_t*)(lds + C_ZN + attn::kswz(v, t >> 3) + (t & 7) * 2) = (bf16_t)(cvt_pk_bf16(-zo[i], 0.f) & 0xffffu); }
        } else {
            const int ti = wid >> 1, tj = wid & 1;
#pragma unroll
            for (int q = 0; q < 4; ++q) mrb[q] = FRAG(C_MRB, 32 * ti + r32, 2 * q + hi);
#pragma unroll
            for (int q = 0; q < 4; ++q) Yacc = __builtin_amdgcn_mfma_f32_32x32x16_bf16(FRAG(C_RT, 32 * ti + r32, 2 * q + hi), FRAG(C_S0B, 32 * tj + r32, 2 * q + hi), Yacc, 0, 0, 0);
#pragma unroll
            for (int q = 0; q < 4; ++q) Yacc = __builtin_amdgcn_mfma_f32_32x32x16_bf16(FRAG(C_MRK, 32 * ti + r32, 2 * q + hi), FRAG(C_VT, 32 * tj + r32, 2 * q + hi), Yacc, 0, 0, 0);
        }
        __syncthreads(); SC_T(7);
        if (wid < 4) {
            const int ti = wid >> 1, tj = wid & 1;
#pragma unroll
            for (int q = 0; q < 4; ++q) Yacc = __builtin_amdgcn_mfma_f32_32x32x16_bf16(mrb[q], FRAG(C_ZN, 32 * tj + r32, 2 * q + hi), Yacc, 0, 0, 0);
            bf16_t* yb = P.y + (size_t)d * MT * 512 + hh * 64 + 32 * tj + r32;
#pragma unroll
            for (int r = 0; r < 16; ++r) { const int t = 32 * ti + (r & 3) + 8 * (r >> 2) + 4 * hi; const int row = d == 0 ? r0 + t : r0 + 63 - t;
                yb[(size_t)row * 512] = (bf16_t)(cvt_pk_bf16(Yacc[r], 0.f) & 0xffffu); }
            SC_T(8);
        } else {
            const int ti = (wid >> 1) & 1, tj = wid & 1; const int k = 32 * tj + r32;
#pragma unroll
            for (int q = 0; q < 4; ++q) Sreg = __builtin_amdgcn_mfma_f32_32x32x16_bf16(FRAG(C_ZN, 32 * ti + r32, 2 * q + hi), FRAG(C_BHT, 32 * tj + r32, 2 * q + hi), Sreg, 0, 0, 0);
#pragma unroll
            for (int r = 0; r < 16; ++r) { const int v = 32 * ti + (r & 3) + 8 * (r >> 2) + 4 * hi;
                *(LAS bf16_t*)(lds + C_S0B + attn::kswz(v, k >> 3) + (k & 7) * 2) = (bf16_t)(cvt_pk_bf16(Sreg[r], 0.f) & 0xffffu); }
        }
#undef FRAG
    }
    __syncthreads();
}
#undef ROR_ADD
}
struct Frame {
    LAS unsigned char* lds; char* ldsg; volatile LAS unsigned* MISC; gu32* ctl;
    int tid, lane, wave, G, gw, NGW;
    const float* x_in; const float* ctx_in; float* out; unsigned char* ws;
};
enum { I_X = 0, I_C, I_CTX, I_CCTX, I_ADAW, I_ADAB, I_WIN, I_LAMQK, I_SUBLN, I_MU, I_W0, I_W2, I_A0, I_A2, I_G2, I_KK, I_KA, I_RK, I_LNW, I_LNB,
       I_WPA, I_WPF, I_WPC, I_WO, I_LN1G, I_LN1B, I_FUP, I_FCONV, I_FCONVB, I_FDN, I_LN2G, I_LN2B };

struct Row16 { f32x4 v[4]; };
__device__ __forceinline__ void row_load_f32(Row16& r, const float* p, int lane) {
#pragma unroll
    for (int j = 0; j < 4; ++j) r.v[j] = *(const f32x4*)(p + 256 * j + 4 * lane);
}
__device__ __forceinline__ void row_load_bf16(Row16& r, const bf16_t* p, int lane) {
#pragma unroll
    for (int j = 0; j < 4; ++j) { const u32x2 w = *(const u32x2*)(p + 256 * j + 4 * lane); r.v[j] = (f32x4){bflo(w.x), bfhi(w.x), bflo(w.y), bfhi(w.y)}; }
}
__device__ __forceinline__ void row_store_f32(const Row16& r, float* p, int lane) {
#pragma unroll
    for (int j = 0; j < 4; ++j) *(f32x4*)(p + 256 * j + 4 * lane) = r.v[j];
}
__device__ __forceinline__ void row_store_bf16(const Row16& r, bf16_t* p, int lane) {
#pragma unroll
    for (int j = 0; j < 4; ++j) { u32x2 w; w.x = cvt_pk_bf16(r.v[j][0], r.v[j][1]); w.y = cvt_pk_bf16(r.v[j][2], r.v[j][3]); *(u32x2*)(p + 256 * j + 4 * lane) = w; }
}
__device__ __forceinline__ void row_ln_plain(Row16& r) {
    float s = 0.f;
#pragma unroll
    for (int j = 0; j < 4; ++j) s += (r.v[j][0] + r.v[j][1]) + (r.v[j][2] + r.v[j][3]);
    const float mean = wave_sum(s) * (1.f / DM); float q = 0.f;
#pragma unroll
    for (int j = 0; j < 4; ++j) { r.v[j] = r.v[j] - mean; q += (r.v[j][0] * r.v[j][0] + r.v[j][1] * r.v[j][1]) + (r.v[j][2] * r.v[j][2] + r.v[j][3] * r.v[j][3]); }
    const float rstd = 1.0f / sqrtf(wave_sum(q) * (1.f / DM) + LN_EPS);
#pragma unroll
    for (int j = 0; j < 4; ++j) r.v[j] = r.v[j] * rstd;
}
__device__ __forceinline__ void row_affine(Row16& r, const float* g, const float* b, int lane, float gadd) {
#pragma unroll
    for (int j = 0; j < 4; ++j) { const f32x4 gg = *(const f32x4*)(g + 256 * j + 4 * lane), bb = *(const f32x4*)(b + 256 * j + 4 * lane); r.v[j] = r.v[j] * (gg + gadd) + bb; }
}
__device__ __forceinline__ const float* modrow(const Frame& F, int layer, int row) { return (const float*)(F.ws + TAB_MOD) + ((size_t)layer * 5 + (row < ML ? (row >> 12) : 4)) * 6144; }
__device__ __forceinline__ const float* xrow_in(const Frame& F, int layer, int row) {
    if (layer == 0) return row < ML ? F.x_in + (size_t)row * DM : F.ctx_in + (size_t)(row - ML) * DM;
    return row < ML ? F.out + (size_t)row * DM : (const float*)(F.ws + WS_XC) + (size_t)(row - ML) * DM;
}
__device__ __forceinline__ float* xrow_out(const Frame& F, int row) { return row < ML ? F.out + (size_t)row * DM : (float*)(F.ws + WS_XC) + (size_t)(row - ML) * DM; }

__device__ __forceinline__ void pass_modulate(const Frame& F0, int layer, bf16_t* dst, int nrows) {
    Frame F = F0; F.lane = fresh_lane(); F.tid = (F.wave << 6) | F.lane;
    for (int row = F.gw; row < nrows; row += F.NGW) {
        Row16 r; row_load_f32(r, xrow_in(F, layer, row), F.lane); row_ln_plain(r);
        const float* mv = modrow(F, layer, row); row_affine(r, mv + 1024, mv, F.lane, 1.f);
        row_store_bf16(r, dst + (size_t)row * DM, F.lane);
    }
}
__device__ __forceinline__ void pass_ln1(Frame F, int layer, const bf16_t* mix, bf16_t* h2, int nrows, const float* g, const float* bt) {
    F.lane = fresh_lane(); F.tid = (F.wave << 6) | F.lane;
    for (int row0 = F.gw; row0 < nrows; row0 += 2 * F.NGW) {
        const int row1 = row0 + F.NGW; const bool two = row1 < nrows; const int rowb = two ? row1 : row0;
        Row16 ra, ma, rb, mb; row_load_f32(ra, xrow_in(F, layer, row0), F.lane); row_load_bf16(ma, mix + (size_t)row0 * DM, F.lane);
        row_load_f32(rb, xrow_in(F, layer, rowb), F.lane); row_load_bf16(mb, mix + (size_t)rowb * DM, F.lane);
        const float* mva = modrow(F, layer, row0); const float* mvb = modrow(F, layer, rowb);
#pragma unroll
        for (int j = 0; j < 4; ++j) { f32x4 gt = *(const f32x4*)(mva + 2048 + 256 * j + 4 * F.lane); if (DBG_ZERO_MIX) gt = gt * 0.f; ra.v[j] = ra.v[j] * ALPHA + gt * ma.v[j];
            f32x4 gu = *(const f32x4*)(mvb + 2048 + 256 * j + 4 * F.lane); if (DBG_ZERO_MIX) gu = gu * 0.f; rb.v[j] = rb.v[j] * ALPHA + gu * mb.v[j]; }
        row_ln_plain(ra); row_ln_plain(rb); row_affine(ra, g, bt, F.lane, 0.f); row_affine(rb, g, bt, F.lane, 0.f);
        row_store_f32(ra, xrow_out(F, row0), F.lane); if (two) row_store_f32(rb, xrow_out(F, row1), F.lane);
        row_ln_plain(ra); row_ln_plain(rb); row_affine(ra, mva + 4096, mva + 3072, F.lane, 1.f); row_affine(rb, mvb + 4096, mvb + 3072, F.lane, 1.f);
        row_store_bf16(ra, h2 + (size_t)row0 * DM, F.lane); if (two) row_store_bf16(rb, h2 + (size_t)row1 * DM, F.lane);
    }
}
__device__ __forceinline__ void pass_ln2(Frame F, int layer, bf16_t* ffn_h, int nrows, bool next_h, const float* g, const float* bt) {
    F.lane = fresh_lane(); F.tid = (F.wave << 6) | F.lane;
    for (int row0 = F.gw; row0 < nrows; row0 += 2 * F.NGW) {
        const int row1 = row0 + F.NGW; const bool two = row1 < nrows; const int rowb = two ? row1 : row0;
        Row16 ra, ma, rb, mb; float* xa = xrow_out(F, row0); float* xb = xrow_out(F, rowb);
        row_load_f32(ra, xa, F.lane); row_load_bf16(ma, ffn_h + (size_t)row0 * DM, F.lane); row_load_f32(rb, xb, F.lane); row_load_bf16(mb, ffn_h + (size_t)rowb * DM, F.lane);
        const float* mva = modrow(F, layer, row0); const float* mvb = modrow(F, layer, rowb);
#pragma unroll
        for (int j = 0; j < 4; ++j) { f32x4 gt = *(const f32x4*)(mva + 5120 + 256 * j + 4 * F.lane); if (DBG_ZERO_FFN) gt = gt * 0.f; ra.v[j] = ra.v[j] * ALPHA + gt * ma.v[j];
            f32x4 gu = *(const f32x4*)(mvb + 5120 + 256 * j + 4 * F.lane); if (DBG_ZERO_FFN) gu = gu * 0.f; rb.v[j] = rb.v[j] * ALPHA + gu * mb.v[j]; }
        row_ln_plain(ra); row_ln_plain(rb); row_affine(ra, g, bt, F.lane, 0.f); row_affine(rb, g, bt, F.lane, 0.f);
        row_store_f32(ra, xa, F.lane); if (two) row_store_f32(rb, xb, F.lane);
        if (next_h) { const float* mna = modrow(F, layer + 1, row0); const float* mnb = modrow(F, layer + 1, rowb);
            row_ln_plain(ra); row_ln_plain(rb); row_affine(ra, mna + 1024, mna, F.lane, 1.f); row_affine(rb, mnb + 1024, mnb, F.lane, 1.f);
            row_store_bf16(ra, ffn_h + (size_t)row0 * DM, F.lane); if (two) row_store_bf16(rb, ffn_h + (size_t)row1 * DM, F.lane); }
    }
}
__device__ __forceinline__ float gelu_fast(float v) {
    const float av = fabsf(v), t = __builtin_amdgcn_rcpf(av * 0.2316418882f + 1.0f);
    float q = t * 0.5307027145f + (-0.7265760135f); q = q * t + 0.7107068705f; q = q * t + (-0.142248368f); q = q * t + 0.127414796f; q = q * t;
    const float e = __builtin_amdgcn_exp2f((v * v) * (-0.72134752044f)); const float m = v * (q * e);
    return v < 0.f ? m : v - m;
}
__device__ __forceinline__ void pass_conv(Frame F, bf16_t* ug, int nrows, const float* cw, const float* cb) {
    F.lane = fresh_lane(); F.tid = (F.wave << 6) | F.lane;
    const long total = (long)nrows * (DFF / 8), stride = (long)F.G * NTHREADS;
    for (long it = (long)blockIdx.x * NTHREADS + F.tid; it < total; it += stride) {
        const int row = (int)(it / (DFF / 8)), c = (int)(it % (DFF / 8)) * 8;
        int pos, len; if (row < ML) { pos = row & 4095; len = SEQ; } else { pos = (row - ML) & 255; len = CTXL; }
        const bool hp = pos > 0, hn = pos < len - 1;
        bf16_t* up = ug + (size_t)row * NP + c;
        float u[8], gc[8], gp[8], gn[8];
        rwkv::ld8(up, u); rwkv::ld8(up + DFF, gc); rwkv::ld8(up + DFF - (hp ? NP : 0), gp); rwkv::ld8(up + DFF + (hn ? NP : 0), gn);
        float o[8];
        float w0[8], w1[8], w2[8], bb[8];
        { const f32x4 a = *(const f32x4*)(cw + c), b = *(const f32x4*)(cw + c + 4); w0[0]=a[0];w0[1]=a[1];w0[2]=a[2];w0[3]=a[3];w0[4]=b[0];w0[5]=b[1];w0[6]=b[2];w0[7]=b[3]; }
        { const f32x4 a = *(const f32x4*)(cw + DFF + c), b = *(const f32x4*)(cw + DFF + c + 4); w1[0]=a[0];w1[1]=a[1];w1[2]=a[2];w1[3]=a[3];w1[4]=b[0];w1[5]=b[1];w1[6]=b[2];w1[7]=b[3]; }
        { const f32x4 a = *(const f32x4*)(cw + 2 * DFF + c), b = *(const f32x4*)(cw + 2 * DFF + c + 4); w2[0]=a[0];w2[1]=a[1];w2[2]=a[2];w2[3]=a[3];w2[4]=b[0];w2[5]=b[1];w2[6]=b[2];w2[7]=b[3]; }
        { const f32x4 a = *(const f32x4*)(cb + c), b = *(const f32x4*)(cb + c + 4); bb[0]=a[0];bb[1]=a[1];bb[2]=a[2];bb[3]=a[3];bb[4]=b[0];bb[5]=b[1];bb[6]=b[2];bb[7]=b[3]; }
#pragma unroll
        for (int i = 0; i < 8; ++i) {
            const float x = w0[i] * (hp ? gp[i] : 0.f) + w1[i] * gc[i] + w2[i] * (hn ? gn[i] : 0.f) + bb[i];
            o[i] = gelu_fast(x) * u[i];
        }
        u32x4 w; w.x = cvt_pk_bf16(o[0], o[1]); w.y = cvt_pk_bf16(o[2], o[3]); w.z = cvt_pk_bf16(o[4], o[5]); w.w = cvt_pk_bf16(o[6], o[7]);
        *(u32x4*)up = w;
    }
}

__device__ __forceinline__ void ldf8(const float* p, float (&o)[8]) { const f32x4 a = *(const f32x4*)p, b = *(const f32x4*)(p + 4); o[0]=a[0];o[1]=a[1];o[2]=a[2];o[3]=a[3];o[4]=b[0];o[5]=b[1];o[6]=b[2];o[7]=b[3]; }
__device__ __forceinline__ void pass_sg(Frame F, bf16_t* co, int nrows, const float* mu) {
    F.lane = fresh_lane(); F.tid = (F.wave << 6) | F.lane;
    const int sub = F.lane >> 4, cl = (F.lane & 15) * 8;
    float m0[8], m1[8]; ldf8(mu + 1280 + 512 + cl, m0); ldf8(mu + 1920 + 1280 + 512 + cl, m1);
    for (int row = 4 * F.gw + sub; row < nrows; row += 4 * F.NGW) {
        int pos, len; if (row < ML) { pos = row & 4095; len = SEQ; } else { pos = (row - ML) & 255; len = CTXL; }
        const bool hp = pos > 0, hn = pos < len - 1;
        bf16_t* p = co + (size_t)row * DCOP + 512 + cl;
        float c[8], pv[8], nv[8], o[8]; rwkv::ld8(p, c); rwkv::ld8(p - (hp ? DCOP : 0), pv); rwkv::ld8(p + (hn ? DCOP : 0), nv);
#pragma unroll
        for (int i = 0; i < 8; ++i) { const float a = hp ? pv[i] : 0.f, b = hn ? nv[i] : 0.f; o[i] = sigmoidf_(c[i] + m0[i] * (a - c[i]) + m1[i] * (b - c[i])); }
        u32x4 w; w.x = cvt_pk_bf16(o[0], o[1]); w.y = cvt_pk_bf16(o[2], o[3]); w.z = cvt_pk_bf16(o[4], o[5]); w.w = cvt_pk_bf16(o[6], o[7]);
        *(u32x4*)(p + (DCO - 512)) = w;
    }
}
struct PostRow { u32x4 a0, a1, gg, vc, vp, vn; float bsum; };
__device__ __forceinline__ void post_load(PostRow& R, int row, int c, int head, const bf16_t* y0, const bf16_t* y1, const bf16_t* g, const bf16_t* cs, const float* bon) {
    int pos, len; if (row < ML) { pos = row & 4095; len = SEQ; } else { pos = (row - ML) & 255; len = CTXL; }
    const bool hp = pos > 0, hn = pos < len - 1; const size_t o = (size_t)row * 512 + c;
    R.a0 = *(const u32x4*)(y0 + o); R.a1 = *(const u32x4*)(y1 + o); R.gg = *(const u32x4*)(g + o);
    const bf16_t* vq = cs + (size_t)row * DCS + 512 + c;
    R.vc = *(const u32x4*)vq; R.vp = *(const u32x4*)(vq - (hp ? DCS : 0)); R.vn = *(const u32x4*)(vq + (hn ? DCS : 0));
    if (!hp) R.vp = (u32x4){0u, 0u, 0u, 0u}; if (!hn) R.vn = (u32x4){0u, 0u, 0u, 0u};
    R.bsum = bon[(size_t)row * 8 + head] + bon[(size_t)MT * 8 + (size_t)row * 8 + head];
}
__device__ __forceinline__ void up8(const u32x4 w, float (&o)[8]) { o[0] = bflo(w.x); o[1] = bfhi(w.x); o[2] = bflo(w.y); o[3] = bfhi(w.y); o[4] = bflo(w.z); o[5] = bfhi(w.z); o[6] = bflo(w.w); o[7] = bfhi(w.w); }
__device__ __forceinline__ u32x4 post_finish(const PostRow& R, const float (&lw)[8], const float (&lb)[8], const float (&m0)[8], const float (&m1)[8]) {
    float y[8], t[8], gv[8], vc[8], vp[8], vn[8]; up8(R.a0, y); up8(R.a1, t); up8(R.gg, gv); up8(R.vc, vc); up8(R.vp, vp); up8(R.vn, vn);
    float s = 0.f;
#pragma unroll
    for (int i = 0; i < 8; ++i) { y[i] += t[i]; s += y[i]; }
    s += __shfl_xor(s, 1); s += __shfl_xor(s, 2); s += __shfl_xor(s, 4);
    const float mean = s * (1.f / 64.f); float q = 0.f;
#pragma unroll
    for (int i = 0; i < 8; ++i) { y[i] -= mean; q += y[i] * y[i]; }
    q += __shfl_xor(q, 1); q += __shfl_xor(q, 2); q += __shfl_xor(q, 4);
    const float rstd = 1.0f / sqrtf(q * (1.f / 64.f) + 64.f * 1e-5f);
#pragma unroll
    for (int i = 0; i < 8; ++i) { const float vs = vc[i] + m0[i] * (vp[i] - vc[i]) + m1[i] * (vn[i] - vc[i]); y[i] = (y[i] * rstd * lw[i] + lb[i] + R.bsum * vs) * gv[i]; }
    u32x4 w; w.x = cvt_pk_bf16(y[0], y[1]); w.y = cvt_pk_bf16(y[2], y[3]); w.z = cvt_pk_bf16(y[4], y[5]); w.w = cvt_pk_bf16(y[6], y[7]);
    return w;
}
__device__ __forceinline__ void pass_post(Frame F, int nrows, bf16_t* y0, const bf16_t* y1, const bf16_t* g, const bf16_t* cs, const float* bon, const float* mu, const float* lnw, const float* lnb) {
    F.lane = fresh_lane(); F.tid = (F.wave << 6) | F.lane;
    const int c = 8 * F.lane, head = F.lane >> 3;
    float lw[8], lb[8], m0[8], m1[8]; ldf8(lnw + c, lw); ldf8(lnb + c, lb); ldf8(mu + 512 + c, m0); ldf8(mu + 1920 + 512 + c, m1);
    for (int row0 = F.gw; row0 < nrows; row0 += 2 * F.NGW) {
        const int row1 = row0 + F.NGW; const bool two = row1 < nrows; const int rowb = two ? row1 : row0;
        PostRow A, B; post_load(A, row0, c, head, y0, y1, g, cs, bon); post_load(B, rowb, c, head, y0, y1, g, cs, bon);
        const u32x4 wa = post_finish(A, lw, lb, m0, m1), wb = post_finish(B, lw, lb, m0, m1);
        *(u32x4*)(y0 + (size_t)row0 * 512 + c) = wa; if (two) *(u32x4*)(y0 + (size_t)row1 * 512 + c) = wb;
    }
}

__device__ __forceinline__ unsigned f2bf(float f) { unsigned u = __builtin_bit_cast(unsigned, f); return (u + 0x7fffu + ((u >> 16) & 1u)) >> 16; }
__device__ __forceinline__ unsigned pk2(float lo, float hi) { return f2bf(lo) | (f2bf(hi) << 16); }
__device__ __forceinline__ void transpose_item(const float* W, int K, int N, bf16_t* WT, int item, LAS float* scr, int lane, int rowadd_from, int rowadd) {
    const int nblk = N / 32, kb = item / nblk, nb = item % nblk, k0 = 64 * kb, n0 = 32 * nb;
    const int row_off = n0 >= rowadd_from ? rowadd : 0;
    float wv[32];
#pragma unroll
    for (int i = 0; i < 32; ++i) { const int kk = 2 * i + (lane >> 5); wv[i] = W[(size_t)(k0 + kk) * N + n0 + (lane & 31)]; }
#pragma unroll
    for (int i = 0; i < 32; ++i) { const int kk = 2 * i + (lane >> 5); scr[kk * 33 + (lane & 31)] = wv[i]; }
    LDS_WAIT(); asm volatile("" ::: "memory");
    const int c = lane & 7;
#pragma unroll
    for (int j = 0; j < 4; ++j) { const int n = (lane >> 3) + 8 * j; const LAS float* s = scr + (8 * c) * 33 + n;
        u32x4 o; o.x = pk2(s[0 * 33], s[1 * 33]); o.y = pk2(s[2 * 33], s[3 * 33]); o.z = pk2(s[4 * 33], s[5 * 33]); o.w = pk2(s[6 * 33], s[7 * 33]);
        *(GAS u32x4*)(WT + (size_t)(row_off + n0 + n) * K + k0 + 8 * c) = o; }
    LDS_WAIT(); asm volatile("" ::: "memory");
}
#define CONVERT_WEIGHTS(F, layer, INP) do { \
    convert_weights_((F), (layer), INP(I_WIN), INP(I_WPA), INP(I_WPF), INP(I_WPC), INP(I_WO), INP(I_FUP), INP(I_FDN), INP(I_G2)); } while (0)
__device__ __forceinline__ void convert_weights_(const Frame& F_, int layer, const float* p_win, const float* p_wpa, const float* p_wpf, const float* p_wpc, const float* p_wo, const float* p_fup, const float* p_fdn, const float* p_g2) {
    Frame F = F_; F.lane = fresh_lane(); F.tid = (F.wave << 6) | F.lane;
    LAS float* scr = (LAS float*)(F.lds + F.wave * 16384);
    constexpr int N_IN = 16 * (D_IN_SRC / 32), N_PA = 16 * 32, N_PF = 8 * 32, N_PC = 8 * 32, N_O = 16 * 32, N_UP = 16 * (2 * DFF / 32), N_DN = (DFF / 64) * 32, N_G2 = 2 * 16;
    constexpr int NITEMS = N_IN + N_PA + N_PF + N_PC + N_O + N_UP + N_DN + N_G2;
    unsigned char* ws = F.ws;
    for (int it = F.gw; it < NITEMS; it += F.NGW) {
        int r = it;
        if (r < N_IN) { transpose_item(p_win + (size_t)layer * DM * D_IN_SRC, DM, D_IN_SRC, (bf16_t*)(ws + W_IN), r, scr, F.lane, 5504, 128); continue; } r -= N_IN;
        if (r < N_PA) { transpose_item(p_wpa + (size_t)layer * 1024 * DM, 1024, DM, (bf16_t*)(ws + W_PA), r, scr, F.lane, 1 << 30, 0); continue; } r -= N_PA;
        if (r < N_PF) { transpose_item(p_wpf + (size_t)layer * 512 * DM, 512, DM, (bf16_t*)(ws + W_PF), r, scr, F.lane, 1 << 30, 0); continue; } r -= N_PF;
        if (r < N_PC) { transpose_item(p_wpc + (size_t)layer * 512 * DM, 512, DM, (bf16_t*)(ws + W_PC), r, scr, F.lane, 1 << 30, 0); continue; } r -= N_PC;
        if (r < N_O) { transpose_item(p_wo + (size_t)layer * DM * DM, DM, DM, (bf16_t*)(ws + W_O), r, scr, F.lane, 1 << 30, 0); continue; } r -= N_O;
        if (r < N_UP) { transpose_item(p_fup + (size_t)layer * DM * 2 * DFF, DM, 2 * DFF, (bf16_t*)(ws + W_UP), r, scr, F.lane, 1 << 30, 0); continue; } r -= N_UP;
        if (r < N_DN) { transpose_item(p_fdn + (size_t)layer * DFF * DM, DFF, DM, (bf16_t*)(ws + W_DN), r, scr, F.lane, 1 << 30, 0); continue; } r -= N_DN;
        transpose_item(p_g2 + (size_t)layer * 128 * 512, 128, 512, (bf16_t*)(ws + W_G2T), r, scr, F.lane, 1 << 30, 0);
    }
    { u32x4* z = (u32x4*)(ws + W_IN + (size_t)5504 * DM * 2); const int n16 = 128 * DM * 2 / 16;
      unsigned zz = 0u; asm volatile("" : "+v"(zz));
      for (int i = blockIdx.x * NTHREADS + F.tid; i < n16; i += F.G * NTHREADS) z[i] = (u32x4){zz, zz, zz, zz}; }
}
__device__ __forceinline__ void build_tables(Frame F, const float* lamqk) {
    F.lane = fresh_lane(); F.tid = (F.wave << 6) | F.lane;
    const int gt = blockIdx.x * NTHREADS + F.tid, NT_ = F.G * NTHREADS;
    float* rope = (float*)(F.ws + TAB_ROPE); float* tw = (float*)(F.ws + TAB_TW);
    bf16_t* w0 = (bf16_t*)(F.ws + TAB_W0); bf16_t* f1 = (bf16_t*)(F.ws + TAB_F1); bf16_t* f2 = (bf16_t*)(F.ws + TAB_F2); bf16_t* dc = (bf16_t*)(F.ws + TAB_DC);
    for (int i = gt; i < 1024; i += NT_) { const int pos = i >> 4, f = i & 15; const float inv = powf(10000.f, -(float)f / 16.f); const float ang = (float)pos * inv;
        rope[2 * i] = (float)cos((double)ang); rope[2 * i + 1] = (float)sin((double)ang); }
    for (int i = gt; i < 4096; i += NT_) { const int kl = i >> 6, tl = i & 63; float s, c; sincospif(2.f * (float)(kl * tl) / 4096.f, &s, &c); tw[2 * i] = c; tw[2 * i + 1] = s; }
    for (int i = gt; i < 256 * 128; i += NT_) { const int r = i >> 7, c = i & 127, ri = r >> 7, m = r & 127; float s, co; sincospif(2.f * (float)((m * c) & 127) / 128.f, &s, &co);
        w0[i] = (bf16_t)f2bf((ri == 0 ? co : -s) * 0.088388347648318f); }
    for (int i = gt; i < 256 * 256; i += NT_) { const int r = i >> 8, k = i & 255; const int rip = r >> 7, p = (r >> 6) & 1, kl = r & 63, ri = k >> 7, p2 = (k >> 6) & 1, th = k & 63;
        float s, co; sincospif(2.f * (float)((kl * th) & 63) / 64.f, &s, &co);
        float v = 0.f; if (p == p2) v = (rip == ri) ? co : (rip == 0 ? s : -s);
        f1[i] = (bf16_t)f2bf(v * 0.125f); }
    for (int i = gt; i < 256 * 512; i += NT_) { const int r = i >> 9, k = i & 511; const int pp = r >> 6, kh = r & 63, rip = k >> 8, p2 = (k >> 6) & 3, tl = k & 63;
        float s, co; sincospif(2.f * (float)((kh * tl) & 63) / 64.f, &s, &co);
        const float v = (pp == p2) ? (rip == 0 ? co : s) : 0.f;
        f2[i] = (bf16_t)f2bf(v * 0.125f); }
    for (int i = gt; i < 256 * 512; i += NT_) { const int k = i >> 9, kk = i & 511, ri = kk >> 8, t = kk & 255;
        float s, co; sincospif(2.f * (float)((k * t) & 255) / 256.f, &s, &co);
        dc[i] = (bf16_t)f2bf((ri == 0 ? co : s) * 0.0625f); }
    if (gt < NLAYER) {
        const float* lq = lamqk + gt * 256; float s1 = 0.f, s2 = 0.f;
        for (int i = 0; i < 64; ++i) { s1 += lq[i] * lq[64 + i]; s2 += lq[128 + i] * lq[192 + i]; }
        const float lam_init = 0.8f - 0.6f * expf(-0.3f * (float)gt);
        float* lamv = (float*)(F.ws + TAB_LAM); lamv[2 * gt] = expf(s1) - expf(s2) + lam_init; lamv[2 * gt + 1] = 1.f - lam_init;
    }
}
__device__ __forceinline__ void build_mod(Frame F, const float* cvec, const float* cctx, const float* adaw, const float* adab) {
    F.lane = fresh_lane(); F.tid = (F.wave << 6) | F.lane;
    LAS float* sil = (LAS float*)F.lds;
    LAS float* part = sil + 5 * 1024;
    for (int i = F.tid; i < 5 * 1024; i += NTHREADS) { const int s = i >> 10, k = i & 1023; const float c = s < 4 ? cvec[s * 1024 + k] : cctx[k]; sil[i] = c / (1.f + expf(-c)); }
    __syncthreads();
    for (int cgid = blockIdx.x; cgid < 256; cgid += F.G) {
        const int l = cgid >> 7, j0 = (cgid & 127) * 48;
        if (F.tid < 384) { const int col = F.tid % 48, kg = F.tid / 48; const float* w = adaw + ((size_t)l * 1024 + 128 * kg) * 6144 + j0 + col;
            float a0 = 0.f, a1 = 0.f, a2 = 0.f, a3 = 0.f, a4 = 0.f;
            for (int k = 0; k < 128; ++k) { const float wv = w[(size_t)k * 6144]; const int kk = 128 * kg + k;
                a0 += sil[kk] * wv; a1 += sil[1024 + kk] * wv; a2 += sil[2048 + kk] * wv; a3 += sil[3072 + kk] * wv; a4 += sil[4096 + kk] * wv; }
            part[(kg * 5 + 0) * 48 + col] = a0; part[(kg * 5 + 1) * 48 + col] = a1; part[(kg * 5 + 2) * 48 + col] = a2; part[(kg * 5 + 3) * 48 + col] = a3; part[(kg * 5 + 4) * 48 + col] = a4; }
        __syncthreads();
        if (F.tid < 240) { const int s = F.tid / 48, col = F.tid % 48; float a = adab[l * 6144 + j0 + col];
            for (int kg = 0; kg < 8; ++kg) a += part[(kg * 5 + s) * 48 + col];
            ((float*)(F.ws + TAB_MOD))[((size_t)l * 5 + s) * 6144 + j0 + col] = a; }
        __syncthreads();
    }
}
#ifndef MK_PER_PHASE
#define MK_PER_PHASE 0
#endif
#ifndef TIME_SEL
#define TIME_SEL 0
#endif
constexpr int N_PHASES = 2 + 13 * NLAYER;
#ifndef SCAN_SEL
#define SCAN_SEL(bx) ((((bx) >> 3) & 3) == 0 && ((bx) >> 5) < 8)
#define SCAN_SID(bx) (((bx) >> 5) * 8 + ((bx) & 7))
#define SCAN_RANK(bx) ((bx) - 8 * (((bx) >> 5) + 1))
#endif
struct Args { const float* in[32]; float* out; unsigned char* ws; int ph_lo, ph_hi; };

__device__ __forceinline__ pg8::Operand opnd(const void* base, long tM, long tN, long rstride, long kstep) {
    pg8::Operand o; o.base = (const char*)base; o.tM = tM; o.tN = tN; o.tN2 = 0; o.nshift = 30; o.rstride = rstride; o.hstep = 128 * rstride; o.kstep = kstep; return o; }
constexpr int CW_SUB = 2048;
__device__ __forceinline__ void sub_arrive_wait(gu32* cnt, unsigned add, unsigned target, bool t0) {
    asm volatile("s_waitcnt vmcnt(0)" ::: "memory"); __syncthreads();
    if (t0) {
        __builtin_amdgcn_fence(__ATOMIC_RELEASE, "agent"); asm volatile("s_waitcnt vmcnt(0)" ::: "memory");
        if (add) (void)__hip_atomic_fetch_add(cnt, add, RLX_AGENT);
        unsigned sp = 0; while (__hip_atomic_load(cnt, RLX_AGENT) < target) { __builtin_amdgcn_s_sleep(2); if (++sp > (1u << 24)) break; }
        __builtin_amdgcn_fence(__ATOMIC_ACQUIRE, "agent"); asm volatile("s_waitcnt vmcnt(0)" ::: "memory");
    }
    __syncthreads();
}
struct RowF0 { __device__ __forceinline__ unsigned operator()(int R) const { return (unsigned)(((R & 63) * 64 + (R >> 6)) * 1024); } };

__global__ void __launch_bounds__(NTHREADS, 2) mk_fwd(Args args) {
    extern __shared__ __attribute__((aligned(16))) unsigned char lds[];
    Frame F;
    F.lds = (LAS unsigned char*)lds; F.ldsg = (char*)lds;
    F.MISC = (volatile LAS unsigned*)(F.lds + MISC_OFF);
    F.tid = threadIdx.x; F.lane = F.tid & 63; F.wave = __builtin_amdgcn_readfirstlane(F.tid >> 6);
    F.G = gridDim.x; F.gw = blockIdx.x * NWAVES + F.wave; F.NGW = F.G * NWAVES;
    F.x_in = args.in[I_X]; F.ctx_in = args.in[I_CTX];
    F.out = args.out; F.ws = args.ws; F.ctl = (gu32*)(args.ws + WS_CTL);
    unsigned char* ws0 = args.ws;
#define T0 (fresh_tid(F.wave) == 0)
#ifndef CH_WG
#define CH_WG 8
#endif
#define CH_T(k) do { if ((TIME_SEL >> 20) != 0) { if (blockIdx.x == CH_WG && T0) { const unsigned long long tn_ = __builtin_amdgcn_s_memrealtime(); const unsigned long long tp_ = ((unsigned long long)F.MISC[21] << 32) | F.MISC[20]; if ((TIME_SEL >> (20 + (k))) & 1) { const unsigned long long ac_ = (((unsigned long long)F.MISC[19] << 32) | F.MISC[18]) + (tn_ - tp_); F.MISC[18] = (unsigned)ac_; F.MISC[19] = (unsigned)(ac_ >> 32); } F.MISC[20] = (unsigned)tn_; F.MISC[21] = (unsigned)(tn_ >> 32); } } } while (0)
#define LWS size_t wo_ = 0; int bx = bx0, G = G0; asm volatile("" : "+s"(wo_), "+s"(bx), "+s"(G)); unsigned char* ws = ws0 + wo_
    for (int u = F.tid; u < (LDS_BYTES - LDSCTL_OFF) / 4; u += NTHREADS) ((LAS unsigned*)(F.lds + LDSCTL_OFF))[u] = 0u;
    __syncthreads();
    XcdBarrier bar; bar.bar = (unsigned*)(F.ctl + CW_BAR); bar.x = 0; bar.st = nullptr;
    if (!MK_PER_PHASE) bar = xcd_barrier_post((unsigned*)(F.ctl + CW_BAR), F.MISC + 8);
    const int lo = args.ph_lo, hi = args.ph_hi;
    if (TIME_SEL) { if (blockIdx.x == 0 && T0) { const unsigned long long tn_ = __builtin_amdgcn_s_memrealtime(); F.MISC[16] = (unsigned)tn_; F.MISC[17] = (unsigned)(tn_ >> 32); } }
#ifndef PHMASK
#define PHMASK 0x7fff
#endif
#define IN(k) (lo <= (k) && (k) < hi)
#define KIND(b) ((PHMASK >> (b)) & 1)
#define INP(i) (args.in[i])
#define SEAM(k) do { if (!MK_PER_PHASE && IN((k) + 1)) xcd_barrier(bar.bar, bar.x, bar.st, T0 ? 1u : 0u); \
    if (TIME_SEL) { if (blockIdx.x == 0 && T0) { const unsigned long long tn_ = __builtin_amdgcn_s_memrealtime(); const unsigned long long tp_ = ((unsigned long long)F.MISC[17] << 32) | F.MISC[16]; \
        const int kind_ = (k) < 2 ? (k) : 2 + ((k) - 2) % 13; if ((TIME_SEL >> kind_) & 1) { const unsigned long long ac_ = (((unsigned long long)F.MISC[19] << 32) | F.MISC[18]) + (tn_ - tp_); F.MISC[18] = (unsigned)ac_; F.MISC[19] = (unsigned)(ac_ >> 32); } \
        F.MISC[16] = (unsigned)tn_; F.MISC[17] = (unsigned)(tn_ >> 32); } } } while (0)
    const int bx0 = blockIdx.x, G0 = F.G;
    pg8::StaticOrder S; S.wave = F.wave;
    const pg8::RowLin rl2048{2048}, rl1024{1024}, rl128{128}, rl256{256}, rl11264{11264}, rl5632{5632};

    if (KIND(0) && IN(0)) { LWS; build_mod(F, INP(I_C), INP(I_CCTX), INP(I_ADAW), INP(I_ADAB)); __syncthreads(); build_tables(F, INP(I_LAMQK)); CONVERT_WEIGHTS(F, 0, INP); SEAM(0); }
    if (KIND(1) && IN(1)) { LWS; pass_modulate(F, 0, (bf16_t*)(ws + WS_HY), MT); SEAM(1); }

#pragma unroll 1
    for (int layer = 0; layer < NLAYER; ++layer) {
        const int pb = 2 + 13 * layer;
        const bool last = layer == NLAYER - 1;
        const int MR = last ? ML : MT;

        if (KIND(2) && IN(pb + 0)) { LWS;
            S.init(MT, NP, G, bx);
            pg8::EpiInProj E{ws, (const float*)(ws + TAB_ROPE)};
            pg8::gemm_phase<pg8::EpiInProj, pg8::RowLin, true>(F.lds, opnd(ws + WS_HY, 256 * 2048, 0, 2048, 128), opnd(ws + W_IN, 0, 256 * 2048, 2048, 128), rl2048, 16, S, E);
            SEAM(pb + 0);
        }
        if (KIND(3) && IN(pb + 1)) { LWS;
#ifndef DBG_NO_SCAN
            if (SCAN_SEL(bx)) {
                const int sid = SCAN_SID(bx);
                rwkv::Params P; P.cs = (const bf16_t*)(ws + P_CS); P.co = (bf16_t*)(ws + P_CO); P.y = (bf16_t*)(ws + WS_HY); P.bon = (float*)(ws + WS_BON);
                P.mu = INP(I_MU) + layer * 2 * 1920; P.w0 = INP(I_W0) + layer * 1024; P.w2 = INP(I_W2) + (size_t)layer * 2 * 64 * 512; P.a0 = INP(I_A0) + layer * 1024;
                P.a2 = INP(I_A2) + (size_t)layer * 2 * 64 * 512; P.kk = INP(I_KK) + layer * 512; P.ka = INP(I_KA) + layer * 512; P.rk = INP(I_RK) + layer * 512;
                unsigned long long ts0_ = 0; if ((TIME_SEL >> 16) & 1) ts0_ = __builtin_amdgcn_s_memrealtime();
                rwkv::scan_wg(P, sid >> 5, (sid >> 3) & 3, sid & 7, (LAS char*)F.lds, F.wave);
                if ((TIME_SEL >> 16) & 1) { if (blockIdx.x == 0 && T0) { const unsigned long long ac_ = (((unsigned long long)F.MISC[19] << 32) | F.MISC[18]) + (__builtin_amdgcn_s_memrealtime() - ts0_); F.MISC[18] = (unsigned)ac_; F.MISC[19] = (unsigned)(ac_ >> 32); } }
            }
#endif
            unsigned long long ta0_ = 0; if ((TIME_SEL >> 17) & 1) ta0_ = __builtin_amdgcn_s_memrealtime();
            if ((TIME_SEL >> 20) != 0) { if (blockIdx.x == CH_WG && T0) { const unsigned long long tn_ = __builtin_amdgcn_s_memrealtime(); F.MISC[20] = (unsigned)tn_; F.MISC[21] = (unsigned)(tn_ >> 32); } }
#if 0
#endif
            const float* tabf = (const float*)(ws + TAB_LAM); const float lam = tabf[2 * layer], osc = tabf[2 * layer + 1];
            const int x = bx & 7, nun = last ? 64 : 68;
            gu32* qw = F.ctl + CW_QUEUE + 64 * (layer * 8 + x);
#ifndef DBG_NO_ATTN
            unsigned ndone = 0;
            for (;;) {
                __syncthreads();
                if (T0) F.MISC[0] = __hip_atomic_fetch_add(qw, 1u, RLX_AGENT);
                __syncthreads();
                const int i = (int)F.MISC[0];
                if (i >= nun) break;
                ++ndone;
                const bf16_t* Q = (const bf16_t*)(ws + P_Q); const bf16_t* K = (const bf16_t*)(ws + P_K); const bf16_t* V = (const bf16_t*)(ws + P_V);
                const float* sub = INP(I_SUBLN) + layer * 128; const float* rope = (const float*)(ws + TAB_ROPE);
                if (i < 64) { const int pair = x + 8 * (i >> 4), qb = i & 15, b = pair >> 3, hh = pair & 7;
                    attn::attn_unit<true>(Q, K, V, (bf16_t*)(ws + P_Q), b * SEQ + 256 * qb, b, hh, lam, osc, sub, rope, (LAS char*)F.lds, F.wave); }
                else { const int pair = x + 8 * (i - 64), b = pair >> 3, hh = pair & 7;
#ifndef DBG_NO_ATTNC
                    attn::attn_unit<false>(Q, K, V, (bf16_t*)(ws + P_Q), ML + b * CTXL, b, hh, lam, osc, sub, rope, (LAS char*)F.lds, F.wave);
#endif
                }
            }
#endif
            CH_T(0);
            {
                const bool is_scan = SCAN_SEL(bx);
                gu32* dcnt = F.ctl + CW_SUB + 64 * (layer * 4 + 0);
                const unsigned total = 8u * (unsigned)nun;
                if (is_scan || G != 256) { sub_arrive_wait(dcnt, ndone, 0u, T0); }
                else {
                    const int rank = SCAN_RANK(bx), GF = 192;
                    { Frame F2 = F; F2.gw = rank * NWAVES + F.wave; F2.NGW = GF * NWAVES;
                      pass_sg(F2, (bf16_t*)(ws + P_CO), MR, INP(I_MU) + layer * 2 * 1920); }
                    sub_arrive_wait(dcnt, ndone, total, T0); CH_T(1);
                    { S.init(1024, ML, GF, rank); pg8::EpiF0 E{(bf16_t*)(ws + P_K)};
                      pg8::Operand B = opnd(ws + P_F, 256, 4 * 1024, 1024, 128); B.nshift = 4; B.tN2 = 4096L * 1024; B.hstep = 2 * 1024;
                      pg8::gemm_phase<pg8::EpiF0, RowF0, true>(F.lds, opnd(ws + TAB_W0, 0, 0, 256, 128), B, RowF0{}, 2, S, E); }
                    if (!last) { S.init(1024, MC, GF, (rank + GF - 64) % GF); pg8::EpiF0c E{(bf16_t*)(ws + P_K + 32 * MiB)};
                      pg8::gemm_phase<pg8::EpiF0c, pg8::RowLin, true>(F.lds, opnd(ws + TAB_W0, 0, 0, 256, 128), opnd(ws + P_F + (size_t)ML * 1024, 256, 256 * 1024, 1024, 128), rl1024, 2, S, E); }
                    sub_arrive_wait(F.ctl + CW_SUB + 64 * (layer * 4 + 1), 1u, (unsigned)GF, T0); CH_T(4);
                    { S.init(256, 65536, GF, rank); pg8::EpiF1 E{(bf16_t*)(ws + P_V), (const float*)(ws + TAB_TW)};
                      pg8::gemm_phase<pg8::EpiF1, pg8::RowLin, true>(F.lds, opnd(ws + TAB_F1, 0, 0, 512, 128), opnd(ws + P_K, 0, 256 * 128, 128, 8 * MiB), rl128, 4, S, E); }
                    if (!last) { S.init(256, 2048, GF, (rank + GF - 72) % GF); pg8::EpiFc E{(bf16_t*)(ws + P_F)};
                      pg8::gemm_phase<pg8::EpiFc, pg8::RowLin, true>(F.lds, opnd(ws + TAB_DC, 0, 0, 1024, 128), opnd(ws + P_K + 32 * MiB, 0, 256 * 1024, 1024, 128), rl1024, 8, S, E); }
                    sub_arrive_wait(F.ctl + CW_SUB + 64 * (layer * 4 + 2), 1u, (unsigned)GF, T0); CH_T(5);
                    { S.init(256, 32768, GF, rank); pg8::EpiF2 E{(bf16_t*)(ws + P_F)};
                      pg8::gemm_phase<pg8::EpiF2, pg8::RowLin, true>(F.lds, opnd(ws + TAB_F2, 0, 0, 1024, 128), opnd(ws + P_V, 0, 256 * 128, 128, 4 * MiB), rl128, 8, S, E); }
                    sub_arrive_wait(F.ctl + CW_SUB + 64 * (layer * 4 + 3), 1u, (unsigned)GF, T0); CH_T(2);
                    { S.init(MR, 512, GF, rank); pg8::EpiBf16 E{(bf16_t*)(ws + P_V), 512};
                      pg8::gemm_phase<pg8::EpiBf16, pg8::RowLin, true>(F.lds, opnd(ws + P_CO + DCO * 2, 256 * 1536, 0, 1536, 128), opnd(ws + W_G2T, 0, 256 * 256, 256, 128), rl256, 2, S, E); }
                    {
                        Frame F2 = F; F2.gw = rank * NWAVES + F.wave; F2.NGW = GF * NWAVES;
                        pass_modulate(F2, layer, (bf16_t*)(ws + P_K), MR); }
                    CH_T(3);
                }
            }
            if ((TIME_SEL >> 17) & 1) { if (blockIdx.x == 8 && T0) { const unsigned long long ac_ = (((unsigned long long)F.MISC[19] << 32) | F.MISC[18]) + (__builtin_amdgcn_s_memrealtime() - ta0_); F.MISC[18] = (unsigned)ac_; F.MISC[19] = (unsigned)(ac_ >> 32); } }
            SEAM(pb + 1); CH_T(6);
        }
        if (KIND(4) && IN(pb + 2)) { LWS;
          if (G != 256) {
            { S.init(1024, ML, G, bx); pg8::EpiF0 E{(bf16_t*)(ws + P_K)};
              pg8::Operand B = opnd(ws + P_F, 256, 4 * 1024, 1024, 128); B.nshift = 4; B.tN2 = 4096L * 1024; B.hstep = 2 * 1024;
              pg8::gemm_phase<pg8::EpiF0, RowF0, true>(F.lds, opnd(ws + TAB_W0, 0, 0, 256, 128), B, RowF0{}, 2, S, E); }
            if (!last) { S.init(1024, MC, G, (bx + G - 16) % G); pg8::EpiF0c E{(bf16_t*)(ws + P_K + 32 * MiB)};
              pg8::gemm_phase<pg8::EpiF0c, pg8::RowLin, true>(F.lds, opnd(ws + TAB_W0, 0, 0, 256, 128), opnd(ws + P_F + (size_t)ML * 1024, 256, 256 * 1024, 1024, 128), rl1024, 2, S, E); }
          }
            if (G != 256) { pass_sg(F, (bf16_t*)(ws + P_CO), MR, INP(I_MU) + layer * 2 * 1920); SEAM(pb + 2); }
        }
        if (KIND(5) && IN(pb + 3)) { LWS;
          if (G != 256) {
            { S.init(256, 65536, G, bx); pg8::EpiF1 E{(bf16_t*)(ws + P_V), (const float*)(ws + TAB_TW)};
              pg8::gemm_phase<pg8::EpiF1, pg8::RowLin, true>(F.lds, opnd(ws + TAB_F1, 0, 0, 512, 128), opnd(ws + P_K, 0, 256 * 128, 128, 8 * MiB), rl128, 4, S, E); }
            if (!last) { S.init(256, 2048, G, (bx + G - 8) % G); pg8::EpiFc E{(bf16_t*)(ws + P_F)};
              pg8::gemm_phase<pg8::EpiFc, pg8::RowLin, true>(F.lds, opnd(ws + TAB_DC, 0, 0, 1024, 128), opnd(ws + P_K + 32 * MiB, 0, 256 * 1024, 1024, 128), rl1024, 8, S, E); }
          }
            if (G != 256) SEAM(pb + 3);
        }
        if (KIND(6) && IN(pb + 4)) { LWS;
            if (G != 256) { S.init(256, 32768, G, bx); pg8::EpiF2 E{(bf16_t*)(ws + P_F)};
              pg8::gemm_phase<pg8::EpiF2, pg8::RowLin, true>(F.lds, opnd(ws + TAB_F2, 0, 0, 1024, 128), opnd(ws + P_V, 0, 256 * 128, 128, 4 * MiB), rl128, 8, S, E); }
            if (G != 256) { S.init(MR, 512, G, bx);
              pg8::EpiRwkvPost E{(const bf16_t*)(ws + WS_HY), (const bf16_t*)(ws + WS_HY) + (size_t)MT * 512, (const bf16_t*)(ws + P_CS), (const float*)(ws + WS_BON),
                                 INP(I_MU) + layer * 2 * 1920, INP(I_LNW) + layer * 512, INP(I_LNB) + layer * 512, (bf16_t*)(ws + WS_HY)};
              pg8::gemm_phase<pg8::EpiRwkvPost, pg8::RowLin, false>(F.lds, opnd(ws + P_CO + DCO * 2, 256 * 1536, 0, 1536, 128), opnd(ws + W_G2T, 0, 256 * 256, 256, 128), rl256, 2, S, E); }
            else pass_post(F, MR, (bf16_t*)(ws + WS_HY), (const bf16_t*)(ws + WS_HY) + (size_t)MT * 512, (const bf16_t*)(ws + P_V), (const bf16_t*)(ws + P_CS), (const float*)(ws + WS_BON),
                           INP(I_MU) + layer * 2 * 1920, INP(I_LNW) + layer * 512, INP(I_LNB) + layer * 512);
            if (G != 256) pass_modulate(F, layer, (bf16_t*)(ws + P_K), MR);
            SEAM(pb + 4);
        }
        if (KIND(7) && IN(pb + 5)) { LWS;
            S.init(MR, NGATE, G, bx); pg8::EpiGate E{(bf16_t*)(ws + P_V)};
            pg8::gemm_phase<pg8::EpiGate, pg8::RowLin, true>(F.lds, opnd(ws + P_K, 256 * 2048, 0, 2048, 128), opnd(ws + W_IN + (size_t)NP * 2048, 0, 256 * 2048, 2048, 128), rl2048, 16, S, E);
            SEAM(pb + 5);
        }
        if (KIND(8) && IN(pb + 6)) { LWS;
            S.init(MR, 1024, G, bx);
            { pg8::EpiBranch<true> E{(const bf16_t*)(ws + P_V), (bf16_t*)(ws + P_K), (DBG_BR & 1) ? 1.f : 0.f};
              pg8::gemm_phase<pg8::EpiBranch<true>, pg8::RowLin, true>(F.lds, opnd(ws + P_Q, 256 * 2048, 0, 2048, 128), opnd(ws + W_PA, 0, 256 * 2048, 2048, 128), rl2048, 16, S, E); }
            VM_WAIT();
            { pg8::EpiBranch<false> E{(const bf16_t*)(ws + P_V) + 1024, (bf16_t*)(ws + P_K), (DBG_BR & 2) ? 1.f : 0.f};
              pg8::gemm_phase<pg8::EpiBranch<false>, pg8::RowLin, true>(F.lds, opnd(ws + P_F, 256 * 1024, 0, 1024, 128), opnd(ws + W_PF, 0, 256 * 1024, 1024, 128), rl1024, 8, S, E); }
            VM_WAIT();
            { pg8::EpiBranch<false> E{(const bf16_t*)(ws + P_V) + 2048, (bf16_t*)(ws + P_K), (DBG_BR & 4) ? 1.f : 0.f};
              pg8::gemm_phase<pg8::EpiBranch<false>, pg8::RowLin, true>(F.lds, opnd(ws + WS_HY, 256 * 1024, 0, 1024, 128), opnd(ws + W_PC, 0, 256 * 1024, 1024, 128), rl1024, 8, S, E); }
            SEAM(pb + 6);
        }
        if (KIND(9) && IN(pb + 7)) { LWS;
            S.init(MR, 1024, G, bx); pg8::EpiBf16 E{(bf16_t*)(ws + P_V), 1024};
            pg8::gemm_phase<pg8::EpiBf16, pg8::RowLin, true>(F.lds, opnd(ws + P_K, 256 * 2048, 0, 2048, 128), opnd(ws + W_O, 0, 256 * 2048, 2048, 128), rl2048, 16, S, E);
            SEAM(pb + 7);
        }
        if (KIND(10) && IN(pb + 8)) { LWS; pass_ln1(F, layer, (const bf16_t*)(ws + P_V), (bf16_t*)(ws + WS_HY), MR, INP(I_LN1G) + layer * DM, INP(I_LN1B) + layer * DM); SEAM(pb + 8); }
        if (KIND(11) && IN(pb + 9)) { LWS;
            S.init(MR, NP, G, bx); pg8::EpiBf16 E{(bf16_t*)(ws + WS_P), NP};
            pg8::gemm_phase<pg8::EpiBf16, pg8::RowLin, true>(F.lds, opnd(ws + WS_HY, 256 * 2048, 0, 2048, 128), opnd(ws + W_UP, 0, 256 * 2048, 2048, 128), rl2048, 16, S, E);
            SEAM(pb + 9);
        }
        if (KIND(12) && IN(pb + 10)) { LWS; pass_conv(F, (bf16_t*)(ws + WS_P), MR, INP(I_FCONV) + (size_t)layer * 3 * DFF, INP(I_FCONVB) + (size_t)layer * DFF); SEAM(pb + 10); }
        if (KIND(13) && IN(pb + 11)) { LWS;
            S.init(MR, 1024, G, bx); pg8::EpiBf16 E{(bf16_t*)(ws + WS_HY), 1024};
            pg8::gemm_phase<pg8::EpiBf16, pg8::RowLin, true>(F.lds, opnd(ws + WS_P, 256 * 11264, 0, 11264, 128), opnd(ws + W_DN, 0, 256 * 5632, 5632, 128), rl5632, 44, S, E);
            SEAM(pb + 11);
        }
        if (KIND(14) && IN(pb + 12)) { LWS;
            pass_ln2(F, layer, (bf16_t*)(ws + WS_HY), MR, !last, INP(I_LN2G) + layer * DM, INP(I_LN2B) + layer * DM);
            if (!last) { __syncthreads(); CONVERT_WEIGHTS(F, layer + 1, INP); }
            SEAM(pb + 12);
        }
    }
    if (TIME_SEL || SCAN_TSEL != 0) { if ((blockIdx.x == 0 || blockIdx.x == 8 || blockIdx.x == CH_WG) && T0) { const unsigned long long ac_ = ((unsigned long long)F.MISC[19] << 32) | F.MISC[18]; const unsigned long long t0_ = __builtin_amdgcn_s_memrealtime(); while (__builtin_amdgcn_s_memrealtime() - t0_ < ac_) __builtin_amdgcn_s_sleep(8); } }
#undef IN
#undef SEAM
}

extern "C" void kernel_launch(void* const* d_in, const int* in_sizes, int n_in, void* d_out, int out_size, void* d_ws, size_t ws_size, hipStream_t stream) {
    static int grid = 0;
    if (grid == 0) {
        if (n_in != 32 || in_sizes[0] != ML * DM || out_size != ML * DM || ws_size < WS_END) { fprintf(stderr, "kernel_launch: unexpected shapes (n_in %d, ws %zu)\n", n_in, ws_size); grid = -1; return; }
        int dev = 0, cus = 0, per_cu = 0;
        if (hipGetDevice(&dev) != hipSuccess || hipDeviceGetAttribute(&cus, hipDeviceAttributeMultiprocessorCount, dev) != hipSuccess) { grid = -1; return; }
        if (hipFuncSetAttribute((const void*)mk_fwd, hipFuncAttributeMaxDynamicSharedMemorySize, LDS_BYTES) != hipSuccess) { fprintf(stderr, "kernel_launch: hipFuncSetAttribute failed\n"); grid = -1; return; }
        if (hipOccupancyMaxActiveBlocksPerMultiprocessor(&per_cu, (const void*)mk_fwd, NTHREADS, LDS_BYTES) != hipSuccess || per_cu < 1) { fprintf(stderr, "kernel_launch: occupancy query says %d\n", per_cu); per_cu = 1; }
        (void)hipGetLastError();
        grid = cus;
        if (grid < 256 || (grid % 8) != 0) fprintf(stderr, "kernel_launch: grid %d\n", grid);
    }
    if (grid < 0) return;
    (void)hipMemsetAsync((char*)d_ws + WS_CTL, 0, CTL_ZERO_BYTES, stream);
    Args a{};
    for (int i = 0; i < 32; ++i) a.in[i] = (const float*)d_in[i];
    a.out = (float*)d_out; a.ws = (unsigned char*)d_ws;
#if MK_PER_PHASE
    unsigned char* ws8 = (unsigned char*)d_ws; (void)ws8;
    for (int p = 0; p < N_PHASES; ++p) {
#if defined(DBG_CHECK)
        if (DBG_CHECK == 14 && p == 7 + 13 * DBG_LAYER) hipLaunchKernelGGL(dbg_fill, dim3(2048), dim3(256), 0, stream, (unsigned char*)d_ws);
        if (DBG_CHECK == 1 && p == 3 + 13 * DBG_LAYER) hipLaunchKernelGGL(dbg_pre, dim3(2048), dim3(256), 0, stream, (unsigned char*)d_ws, (float*)d_out);
#endif
        a.ph_lo = p; a.ph_hi = p + 1; hipLaunchKernelGGL(mk_fwd, dim3(grid), dim3(NTHREADS), LDS_BYTES, stream, a);
#if defined(DBG_CHECK)
#ifndef DBG_LAYER
#define DBG_LAYER 0
#endif
        if (DBG_CHECK == 2 && p == 2 + 13 * DBG_LAYER) hipLaunchKernelGGL(dbg_inproj, dim3(9), dim3(64), 0, stream, (unsigned char*)d_ws, (const float*)d_in[I_WIN] + (size_t)DBG_LAYER * 1024 * D_IN_SRC);
        if (DBG_CHECK == 3 && p == 4 + 13 * DBG_LAYER) hipLaunchKernelGGL(dbg_fourier_ref, dim3(128), dim3(512), 0, stream, (unsigned char*)d_ws);
        if (DBG_CHECK == 3 && p == 6 + 13 * DBG_LAYER) hipLaunchKernelGGL(dbg_fourier_cmp, dim3(1), dim3(128), 0, stream, (unsigned char*)d_ws);
        if (DBG_CHECK == 4 && p == 3 + 13 * DBG_LAYER) hipLaunchKernelGGL(dbg_scan, dim3(64), dim3(64), 0, stream, (unsigned char*)d_ws, (float*)d_out, (const float*)d_in[I_MU] + DBG_LAYER * 3840, (const float*)d_in[I_W0] + DBG_LAYER * 1024, (const float*)d_in[I_W2] + DBG_LAYER * 65536, (const float*)d_in[I_A0] + DBG_LAYER * 1024, (const float*)d_in[I_A2] + DBG_LAYER * 65536, (const float*)d_in[I_KK] + DBG_LAYER * 512, (const float*)d_in[I_KA] + DBG_LAYER * 512, (const float*)d_in[I_RK] + DBG_LAYER * 512); if (DBG_CHECK == 4 && DBG_SUB == 10 && p == 3 + 13 * DBG_LAYER) hipLaunchKernelGGL(dbg_scan_fin, dim3(1), dim3(1), 0, stream, (unsigned char*)d_ws);
        if (DBG_CHECK == 5 && p == 7 + 13 * DBG_LAYER) hipLaunchKernelGGL(dbg_merge_ref, dim3(48), dim3(512), 0, stream, (unsigned char*)d_ws, (float*)(ws8 + WS_DBG + 262144), (const float*)d_in[I_WIN] + (size_t)DBG_LAYER * 1024 * D_IN_SRC, (const float*)d_in[I_WPA] + DBG_LAYER * 1048576, (const float*)d_in[I_WPF] + DBG_LAYER * 524288, (const float*)d_in[I_WPC] + DBG_LAYER * 524288, (const float*)d_in[I_WO] + DBG_LAYER * 1048576);
        if (DBG_CHECK == 5 && p == 9 + 13 * DBG_LAYER) hipLaunchKernelGGL(dbg_merge_cmp, dim3(48), dim3(64), 0, stream, (unsigned char*)d_ws, (const float*)(ws8 + WS_DBG + 262144));
        if (DBG_CHECK == 6 && p == 5 + 13 * DBG_LAYER) hipLaunchKernelGGL(dbg_post_ref, dim3(96), dim3(512), 0, stream, (unsigned char*)d_ws, (float*)(ws8 + WS_DBG + 262144), (const float*)d_in[I_MU] + DBG_LAYER * 3840, (const float*)d_in[I_G2] + DBG_LAYER * 65536, (const float*)d_in[I_LNW] + DBG_LAYER * 512, (const float*)d_in[I_LNB] + DBG_LAYER * 512);
        if (DBG_CHECK == 6 && p == 6 + 13 * DBG_LAYER) hipLaunchKernelGGL(dbg_post_cmp, dim3(96), dim3(512), 0, stream, (unsigned char*)d_ws, (const float*)(ws8 + WS_DBG + 262144));
        if (DBG_CHECK == 7 && p == 1) hipLaunchKernelGGL(dbg_mod, dim3(10), dim3(64), 0, stream, (unsigned char*)d_ws, (const float*)d_in[I_C], (const float*)d_in[I_CCTX], (const float*)d_in[I_ADAW], (const float*)d_in[I_ADAB], (const float*)d_in[I_X], (const float*)d_in[I_CTX]);
        if (DBG_CHECK == 8 && p == 10 + 13 * DBG_LAYER) hipLaunchKernelGGL(dbg_ffn_ref, dim3(48), dim3(512), 0, stream, (unsigned char*)d_ws, (const float*)d_in[I_FUP] + (size_t)DBG_LAYER * 1024 * 5632, (const float*)d_in[I_FCONV] + DBG_LAYER * 3 * 2816, (const float*)d_in[I_FCONVB] + DBG_LAYER * 2816, (const float*)d_in[I_FDN] + (size_t)DBG_LAYER * 2816 * 1024);
        if (DBG_CHECK == 8 && p == 13 + 13 * DBG_LAYER) hipLaunchKernelGGL(dbg_ffn_cmp, dim3(48), dim3(64), 0, stream, (unsigned char*)d_ws);
        if (DBG_CHECK == 9 && p == 10) hipLaunchKernelGGL(dbg_ln1, dim3(6), dim3(64), 0, stream, (unsigned char*)d_ws, (const float*)d_in[I_X], (const float*)d_in[I_CTX], (const float*)d_out, (const float*)d_in[I_LN1G], (const float*)d_in[I_LN1B]);
        if (DBG_CHECK == 10 && p == 13 + 13 * DBG_LAYER) hipLaunchKernelGGL(dbg_ln2_ref, dim3(64), dim3(64), 0, stream, (unsigned char*)d_ws, (const float*)d_out, (const float*)d_in[I_LN2G] + DBG_LAYER * 1024, (const float*)d_in[I_LN2B] + DBG_LAYER * 1024, DBG_LAYER);
        if (DBG_CHECK == 10 && p == 14 + 13 * DBG_LAYER) hipLaunchKernelGGL(dbg_ln2_cmp, dim3(64), dim3(64), 0, stream, (unsigned char*)d_ws, (const float*)d_out, DBG_LAYER);
        if (DBG_CHECK == 11 && p == 7 + 13 * DBG_LAYER) { hipLaunchKernelGGL(dbg_gate, dim3(256), dim3(64), 0, stream, (unsigned char*)d_ws, (const float*)d_in[I_WIN] + (size_t)DBG_LAYER * 1024 * D_IN_SRC, 0); hipLaunchKernelGGL(dbg_gate, dim3(256), dim3(64), 0, stream, (unsigned char*)d_ws, (const float*)d_in[I_WIN] + (size_t)DBG_LAYER * 1024 * D_IN_SRC, 1); }
        if (DBG_CHECK == 12 && p == 7 + 13 * DBG_LAYER) { hipLaunchKernelGGL(dbg_gate2_init, dim3(1), dim3(1), 0, stream, (unsigned char*)d_ws); hipLaunchKernelGGL(dbg_gate2, dim3(13), dim3(64), 0, stream, (unsigned char*)d_ws, (const float*)d_in[I_WIN] + (size_t)DBG_LAYER * 1024 * D_IN_SRC); hipLaunchKernelGGL(dbg_gate2_fin, dim3(1), dim3(1), 0, stream, (unsigned char*)d_ws); }
        if ((DBG_CHECK == 13 || DBG_CHECK == 14) && p == 7 + 13 * DBG_LAYER) { hipLaunchKernelGGL(dbg_gate3_init, dim3(1), dim3(1), 0, stream, (unsigned char*)d_ws); hipLaunchKernelGGL(dbg_gate3, dim3(2048), dim3(256), 0, stream, (unsigned char*)d_ws); hipLaunchKernelGGL(dbg_gate3_fin, dim3(1), dim3(1), 0, stream, (unsigned char*)d_ws); }
        if (DBG_CHECK == 1 && p == 3 + 13 * DBG_LAYER) hipLaunchKernelGGL(dbg_attn, dim3(2048), dim3(512), 0, stream, (unsigned char*)d_ws, (const float*)d_in[I_SUBLN], DBG_LAYER, (const float*)d_out);
#endif
    }
#if defined(DBG_CHECK)
    hipLaunchKernelGGL(dbg_report, dim3(DBG_TWO ? 4096 : 1), dim3(DBG_TWO ? 256 : 1), 0, stream, (unsigned char*)d_ws, (float*)d_out);
#endif
#else
    a.ph_lo = 0; a.ph_hi = N_PHASES;
    hipLaunchKernelGGL(mk_fwd, dim3(grid), dim3(NTHREADS), LDS_BYTES, stream, a);
#endif
}
```

```cpp
#include <hip/hip_runtime.h>
#include <hip/hip_bf16.h>
#include <cstdio>
#include <cstdint>
#include <cmath>

#ifndef DBG_ZERO_MIX
#define DBG_ZERO_MIX 0
#endif
#ifndef DBG_ZERO_FFN
#define DBG_ZERO_FFN 0
#endif
#ifndef DBG_BR
#define DBG_BR 7
#endif
#define GAS __attribute__((address_space(1)))
#define LAS __attribute__((address_space(3)))
typedef unsigned short bf16_t;
typedef short bf16x8 __attribute__((ext_vector_type(8)));
typedef short s16x4 __attribute__((ext_vector_type(4)));
typedef float f32x4 __attribute__((ext_vector_type(4)));
typedef float f32x2 __attribute__((ext_vector_type(2)));
typedef float f32x16 __attribute__((ext_vector_type(16)));
typedef unsigned u32x4 __attribute__((ext_vector_type(4)));
typedef unsigned u32x2 __attribute__((ext_vector_type(2)));
typedef GAS unsigned gu32;

constexpr int DM = 1024, NBATCH = 4, SEQ = 4096, CTXL = 256, NLAYER = 2;
constexpr int ML = NBATCH * SEQ, MC = NBATCH * CTXL, MT = ML + MC;
constexpr int D_IN_SRC = 8576, NP = 5632, NGATE = 3072, DFF = 2816, DCS = 1280, DCO = 640, DCOP = 768;
constexpr float LN_EPS = 1e-5f, ALPHA = 1.4142135623730951f;
constexpr float QK_PRESCALE = 0.125f * 1.4426950408889634f;
constexpr int NWAVES = 8, NTHREADS = 512;

constexpr size_t MiB = 1u << 20;
constexpr size_t WS_CTL = 0, CTL_ZERO_BYTES = 1 * MiB;
constexpr size_t WS_TAB = 1 * MiB;
constexpr size_t TAB_MOD = WS_TAB + 0;
constexpr size_t TAB_LAM = WS_TAB + 256 * 1024;
constexpr size_t TAB_ROPE = WS_TAB + 260 * 1024;
constexpr size_t TAB_TW = WS_TAB + 272 * 1024;
constexpr size_t TAB_W0 = WS_TAB + 320 * 1024;
constexpr size_t TAB_F1 = WS_TAB + 384 * 1024;
constexpr size_t TAB_F2 = WS_TAB + 512 * 1024;
constexpr size_t TAB_DC = WS_TAB + 768 * 1024;
constexpr size_t WS_XC = 3 * MiB;
constexpr size_t WS_BON = 7 * MiB;
constexpr size_t WS_W = 9 * MiB;
constexpr size_t W_IN = WS_W, W_PA = WS_W + 17 * MiB, W_PF = WS_W + 19 * MiB, W_PC = WS_W + 20 * MiB, W_O = WS_W + 21 * MiB,
                 W_UP = WS_W + 23 * MiB, W_DN = WS_W + 34 * MiB, W_G2T = WS_W + 39 * MiB + 512 * 1024;
constexpr size_t WS_P = 49 * MiB;
constexpr size_t P_Q = WS_P, P_K = P_Q + (size_t)MT * 1024 * 2, P_F = P_K + (size_t)MT * 1024 * 2, P_V = P_F + (size_t)MT * 512 * 2,
                 P_CS = P_V + (size_t)MT * 1024 * 2, P_CO = P_CS + (size_t)MT * DCS * 2, P_END = P_CO + (size_t)MT * DCOP * 2;
constexpr size_t WS_HY = 236 * MiB, WS_END = 270 * MiB;
static_assert(P_END == WS_HY, "P region is exactly 187 MiB");
static_assert(P_END - P_V == (size_t)MT * NGATE * 2, "gate buffer == v|cs|co");
static_assert(WS_HY + (size_t)MT * 1024 * 2 == WS_END, "HY region 34 MiB");
constexpr int CW_TMO = 0, CW_QUEUE = 64  , CW_BAR = 4096;

constexpr int RING_BYTES = 131072, LDSCTL_OFF = RING_BYTES, MISC_OFF = LDSCTL_OFF + 320, LDS_BYTES = 147456;

#define LDS_WAIT() asm volatile("s_waitcnt lgkmcnt(0)" ::: "memory")
#define VM_WAIT() asm volatile("s_waitcnt vmcnt(0)" ::: "memory")
#define RLX_AGENT __ATOMIC_RELAXED, __HIP_MEMORY_SCOPE_AGENT

typedef __bf16 bf16x2_t __attribute__((ext_vector_type(2)));
__device__ __forceinline__ unsigned cvt_pk_bf16(float lo, float hi) { f32x2 v = {lo, hi}; bf16x2_t b = __builtin_convertvector(v, bf16x2_t); return __builtin_bit_cast(unsigned, b); }
__device__ __forceinline__ float bf2f(unsigned short h) { return __uint_as_float((unsigned)h << 16); }
__device__ __forceinline__ float bflo(unsigned w) { return __uint_as_float(w << 16); }
__device__ __forceinline__ float bfhi(unsigned w) { return __uint_as_float(w & 0xffff0000u); }
__device__ __forceinline__ float sigmoidf_(float x) { return __builtin_amdgcn_rcpf(1.f + __expf(-x)); }
__device__ __forceinline__ int fresh_lane() { unsigned z = 0u; asm volatile("" : "+v"(z)); return (int)__builtin_amdgcn_mbcnt_hi(~0u, __builtin_amdgcn_mbcnt_lo(~0u, z)); }
__device__ __forceinline__ int fresh_tid(int wave) { return (wave << 6) | fresh_lane(); }
__device__ __forceinline__ float wave_sum(float v) {
#pragma unroll
    for (int o = 1; o < 64; o <<= 1) v += __shfl_xor(v, o);
    return v;
}

#define XB_TMO      128
#define XB_XCNT(j)  (256  + 64 * (j))
#define XB_XSUB(j)  (1280 + 64 * (j))
#define XB_XGEN(j)  (2304 + 64 * (j))
#define XB_TOP      3328
#define XB_TOPGEN   3392
#define XCD_BAR_WORDS 3456
#define XB_SPIN_CAP (1u << 22)
__device__ __forceinline__ unsigned xb_ld(unsigned* p)              { return __hip_atomic_load(p, __ATOMIC_RELAXED, __HIP_MEMORY_SCOPE_AGENT); }
__device__ __forceinline__ unsigned xb_add(unsigned* p, unsigned v) { return __hip_atomic_fetch_add(p, v, __ATOMIC_RELAXED, __HIP_MEMORY_SCOPE_AGENT); }
__device__ __forceinline__ unsigned xb_xcc_id() { return (unsigned)__builtin_amdgcn_s_getreg((3 << 11) | 20) & 0xFu; }
#define XB_SPIN(cond, bar) do { unsigned _sp = 0; while (cond) { __builtin_amdgcn_s_sleep(1); \
    if ((++_sp & 255u) == 0u) { if (xb_ld(&(bar)[XB_TMO])) break; if (_sp > XB_SPIN_CAP) { atomicAdd(&(bar)[XB_TMO], 1u); break; } } } } while (0)
struct XcdBarrier { unsigned* bar; unsigned x; volatile LAS unsigned* st; };
__device__ __forceinline__ XcdBarrier xcd_barrier_post(unsigned* bar, volatile LAS unsigned* st) {
    XcdBarrier b; b.bar = bar; b.x = xb_xcc_id(); b.st = st;
    if (threadIdx.x == 0) (void)xb_add(&bar[XB_XCNT(b.x)], 1u);
    return b;
}
__device__ __forceinline__ void xcd_barrier_complete(unsigned* bar, unsigned x, unsigned& nloc, unsigned& nx) {
    const unsigned G = gridDim.x * gridDim.y * gridDim.z;
    unsigned sum, cnt, mine, sp = 0u;
    for (;;) {
        sum = 0u; cnt = 0u; mine = 0u;
#pragma unroll
        for (unsigned j = 0; j < 16; ++j) { const unsigned c = xb_ld(&bar[XB_XCNT(j)]); sum += c; cnt += (c > 0u) ? 1u : 0u; mine = (j == x) ? c : mine; }
        if (sum == G) break;
        __builtin_amdgcn_s_sleep(1);
        if ((++sp & 255u) == 0u) { if (xb_ld(&bar[XB_TMO])) break; if (sp > XB_SPIN_CAP) { atomicAdd(&bar[XB_TMO], 1u); break; } }
    }
    nloc = mine > 0u ? mine : 1u; nx = cnt > 0u ? cnt : 1u;
}
__device__ __attribute__((noinline)) void xcd_barrier(unsigned* bar_, unsigned bx_, volatile LAS unsigned* st_, unsigned t0_) {
    XcdBarrier b; b.bar = bar_; b.x = bx_; b.st = st_;
    asm volatile("s_waitcnt vmcnt(0)" ::: "memory");
    __syncthreads();
    if (t0_) {
        unsigned* bar = b.bar;
        __builtin_amdgcn_s_waitcnt(0);
        unsigned nloc = b.st[0], nx = b.st[1];
        if (nloc == 0u) { xcd_barrier_complete(bar, b.x, nloc, nx); b.st[0] = nloc; b.st[1] = nx; }
        const unsigned old = xb_add(&bar[XB_XSUB(b.x)], 1u);
        const unsigned gen = old / nloc;
        if (old + 1u == (gen + 1u) * nloc) {
            __builtin_amdgcn_fence(__ATOMIC_RELEASE, "agent");
            asm volatile("s_waitcnt vmcnt(0)" ::: "memory");
            const unsigned og = xb_add(&bar[XB_TOP], 1u);
            const unsigned tg = og / nx;
            if (og + 1u == (tg + 1u) * nx) xb_add(&bar[XB_TOPGEN], 1u);
            else XB_SPIN(xb_ld(&bar[XB_TOPGEN]) == tg, bar);
            __builtin_amdgcn_fence(__ATOMIC_ACQUIRE, "agent");
            xb_add(&bar[XB_XGEN(b.x)], 1u);
            asm volatile("s_waitcnt vmcnt(0)" ::: "memory");
        } else {
            XB_SPIN(xb_ld(&bar[XB_XGEN(b.x)]) == gen, bar);
            __builtin_amdgcn_fence(__ATOMIC_ACQUIRE, "agent");
            asm volatile("s_waitcnt vmcnt(0)" ::: "memory");
        }
    }
    __syncthreads();
}

namespace pg8 {
#define PG8_LAS __attribute__((address_space(3)))
constexpr int BM = 256, BK = 64, HALF = 128, HTB = HALF * BK * 2, STAGE_BYTES = 8 * HTB, NXCD = 8, WGM = 8;
__host__ __device__ __forceinline__ int lds_byte(int r, int c) { const int st = (r >> 4) * 2 + (c >> 5), rr = r & 15, cc = c & 31, ob = rr * 64 + cc * 2; return st * 1024 + (ob ^ (((ob >> 9) & 1) << 5)); }
__host__ __device__ __forceinline__ void stage_rc(int b, int& R, int& C) { const int st = b / 1024, sb = b % 1024, swz = sb ^ (((sb >> 9) & 1) << 5); R = (st >> 1) * 16 + swz / 64; C = (st & 1) * 32 + (swz % 64) / 2; }
__host__ __device__ __forceinline__ int perm32(int rho) { const int n = rho >> 4, i = rho & 15; return 8 * (i >> 2) + 4 * n + (i & 3); }
struct Unit { int pm, pn; };
struct Operand { const char* base; long tM, tN, tN2; int nshift; long rstride; long hstep; long kstep;
    __device__ __forceinline__ long tile(const Unit& u) const { return (long)u.pm * tM + (long)(u.pn & ((1 << nshift) - 1)) * tN + (long)(u.pn >> nshift) * tN2; }
    __device__ __forceinline__ unsigned row(int R) const { return (unsigned)((long)R * rstride); } };
struct StaticOrder {
    int nM, nN, nwg, G, c, wave;
    __host__ __device__ void init(int M, int N, int G_, int c_) { nM = M / BM; nN = N / BM; nwg = nM * nN; G = G_; c = c_; }
    __host__ __device__ bool next(int i, Unit& u) const {
        const long L = (long)i * G + c; if (L >= nwg) return false;
        int wgid = (int)L; { const int q = nwg / NXCD, r = nwg % NXCD, xcd = wgid % NXCD, off = wgid / NXCD; wgid = (xcd < r ? xcd * (q + 1) : r * (q + 1) + (xcd - r) * q) + off; }
        const int nig = WGM * nN, gid = wgid / nig, fm = gid * WGM, gsz = (nM - fm) < WGM ? (nM - fm) : WGM;
        u.pm = fm + ((wgid % nig) % gsz); u.pn = (wgid % nig) / gsz; return true;
    }
};

template <class Epi, class RowMapB, bool ALIGN_EPI>
__device__ __forceinline__ void gemm_phase(PG8_LAS unsigned char* lds, const Operand A, const Operand B, const RowMapB bmap, const int nt, const StaticOrder& S, const Epi& E) {
    int wid = S.wave; asm volatile("" : "+s"(wid));
    const int lane = fresh_lane(), tid = (wid << 6) | lane, wr = wid >> 2, wc = wid & 3, fr = lane & 15, fq = lane >> 4;
    unsigned voffA[2], voffB[2];
#pragma unroll
    for (int i = 0; i < 2; ++i) { int R, C; stage_rc(tid * 16 + i * 8192, R, C); const int Rb = Epi::PERM ? ((R & ~31) + perm32(R & 31)) : R;
        voffA[i] = A.row(R) + (unsigned)C * 2u; voffB[i] = bmap(Rb) + (unsigned)C * 2u; }
    const long kA = A.kstep, kB = B.kstep, hA = A.hstep, hB = B.hstep;
    const unsigned ldsw = (unsigned)wid * 1024u;
    const int aoff = lds_byte(wr * 64 + fr, fq * 8), boff = lds_byte(wc * 32 + fr, fq * 8);
#define PG8_SA(b, h) (((b) * 2 + (h)) * HTB)
#define PG8_SB(b, h) ((4 + (b) * 2 + (h)) * HTB)
#define PG8_STAGE(bufoff, gbase, voff) do { _Pragma("unroll") for (int _i = 0; _i < 2; ++_i) \
        __builtin_amdgcn_global_load_lds((const unsigned*)((const char*)(gbase) + (voff)[_i]), (PG8_LAS unsigned*)(lds + (bufoff) + ldsw + _i * 8192), 16, 0, 0); } while (0)
#define PG8_LDA(dst, b, h) do { _Pragma("unroll") for (int m = 0; m < 4; ++m) _Pragma("unroll") for (int k = 0; k < 2; ++k) dst[m][k] = *(const PG8_LAS bf16x8*)(lds + PG8_SA(b, h) + aoff + m * 2048 + k * 1024); } while (0)
#define PG8_LDB(dst, b, h) do { _Pragma("unroll") for (int n = 0; n < 2; ++n) _Pragma("unroll") for (int k = 0; k < 2; ++k) dst[n][k] = *(const PG8_LAS bf16x8*)(lds + PG8_SB(b, h) + boff + n * 2048 + k * 1024); } while (0)
#define PG8_MMA(ai, bj, At, Bt) do { __builtin_amdgcn_s_setprio(1); _Pragma("unroll") for (int m = 0; m < 4; ++m) _Pragma("unroll") for (int n = 0; n < 2; ++n) _Pragma("unroll") for (int k = 0; k < 2; ++k) \
        acc[ai][bj][m][n] = __builtin_amdgcn_mfma_f32_16x16x32_bf16(Bt[n][k], At[m][k], acc[ai][bj][m][n], 0, 0, 0); __builtin_amdgcn_s_setprio(0); } while (0)
#define PG8_WAIT_V(n) asm volatile("s_waitcnt vmcnt(" #n ")" ::: "memory")
#define PG8_WAIT_L(n) asm volatile("s_waitcnt lgkmcnt(" #n ")" ::: "memory")
#define PG8_BAR __builtin_amdgcn_s_barrier()
#define PG8_SCHED __builtin_amdgcn_sched_barrier(0)
    Unit cur, nxt; int ui = 0;
    if (!S.next(0, cur)) return;
    f32x4 acc[2][2][4][2];
#pragma unroll
    for (int a = 0; a < 2; ++a)
#pragma unroll
        for (int b = 0; b < 2; ++b)
#pragma unroll
            for (int m = 0; m < 4; ++m)
#pragma unroll
                for (int n = 0; n < 2; ++n) acc[a][b][m][n] = (f32x4){0.f, 0.f, 0.f, 0.f};
    bf16x8 At[4][2], B0[2][2], B1[2][2];
    const char* cA = A.base + A.tile(cur); const char* cB = B.base + B.tile(cur);
    PG8_STAGE(PG8_SB(0, 0), cB, voffB); PG8_STAGE(PG8_SB(0, 1), cB + hB, voffB); PG8_STAGE(PG8_SA(0, 0), cA, voffA); PG8_STAGE(PG8_SA(0, 1), cA + hA, voffA);
    if (wr == 1) PG8_BAR;
    PG8_WAIT_V(2); PG8_BAR;
    PG8_STAGE(PG8_SB(1, 0), cB + kB, voffB); PG8_STAGE(PG8_SA(1, 0), cA + kA, voffA); PG8_STAGE(PG8_SB(1, 1), cB + hB + kB, voffB);
    PG8_WAIT_V(6); PG8_BAR;
    for (;;) {
        const bool has_next = S.next(ui + 1, nxt);
        const char* nA = has_next ? A.base + A.tile(nxt) : cA; const char* nB = has_next ? B.base + B.tile(nxt) : cB;
        for (int t = 0; t < nt; t += 2) {
            const bool last = (t == nt - 2);
            asm volatile("" : "+v"(voffA[0]), "+v"(voffA[1]), "+v"(voffB[0]), "+v"(voffB[1]));
            const char* a1 = cA + (long)(t + 1) * kA;
            const char* a2 = last ? nA : cA + (long)(t + 2) * kA; const char* b2 = last ? nB : cB + (long)(t + 2) * kB;
            const char* a3 = a2 + kA; const char* b3 = b2 + kB;
            PG8_LDB(B0, 0, 0); PG8_LDB(B1, 0, 1); PG8_SCHED; PG8_LDA(At, 0, 0); PG8_STAGE(PG8_SA(1, 1), a1 + hA, voffA);
            PG8_WAIT_V(8); PG8_WAIT_L(0); PG8_BAR; PG8_MMA(0, 0, At, B0); PG8_MMA(0, 1, At, B1); PG8_BAR; PG8_SCHED;
            PG8_LDA(At, 0, 1); PG8_STAGE(PG8_SB(0, 0), b2, voffB); PG8_STAGE(PG8_SB(0, 1), b2 + hB, voffB); PG8_STAGE(PG8_SA(0, 0), a2, voffA);
            PG8_WAIT_V(8); PG8_WAIT_L(0); PG8_BAR; PG8_MMA(1, 0, At, B0); PG8_MMA(1, 1, At, B1); PG8_BAR; PG8_SCHED;
            PG8_LDB(B0, 1, 0); PG8_LDB(B1, 1, 1); PG8_SCHED; PG8_LDA(At, 1, 0); PG8_STAGE(PG8_SA(0, 1), a2 + hA, voffA);
            PG8_WAIT_V(8); PG8_WAIT_L(0); PG8_BAR; PG8_MMA(0, 0, At, B0); PG8_MMA(0, 1, At, B1); PG8_BAR; PG8_SCHED;
            PG8_LDA(At, 1, 1); PG8_STAGE(PG8_SB(1, 0), b3, voffB); PG8_STAGE(PG8_SB(1, 1), b3 + hB, voffB); PG8_STAGE(PG8_SA(1, 0), a3, voffA);
            PG8_WAIT_V(8); PG8_WAIT_L(0); PG8_BAR; PG8_MMA(1, 0, At, B0); PG8_MMA(1, 1, At, B1); PG8_BAR; PG8_SCHED;
        }
        if constexpr (ALIGN_EPI) { if (wr == 0) PG8_BAR; }
        if constexpr (!Epi::AFTER_DRAIN) { const int le = fresh_lane(); E(acc, cur, wr, wc, le & 15, le >> 4); }
        if (!has_next) break;
#pragma unroll
        for (int a = 0; a < 2; ++a)
#pragma unroll
            for (int b = 0; b < 2; ++b)
#pragma unroll
                for (int m = 0; m < 4; ++m)
#pragma unroll
                    for (int n = 0; n < 2; ++n) acc[a][b][m][n] = (f32x4){0.f, 0.f, 0.f, 0.f};
        cur = nxt; cA = nA; cB = nB; ++ui;
        if constexpr (ALIGN_EPI) { if (wr == 1) PG8_BAR; }
    }
    PG8_WAIT_V(0);
    if constexpr (!ALIGN_EPI) { if (wr == 0) PG8_BAR; }
    PG8_BAR;
    if constexpr (Epi::AFTER_DRAIN) { const int le = fresh_lane(); E.fused(acc, cur, wr, wc, le & 15, le >> 4, lds, wid, le); }
#undef PG8_SA
#undef PG8_SB
#undef PG8_STAGE
#undef PG8_LDA
#undef PG8_LDB
#undef PG8_MMA
#undef PG8_WAIT_V
#undef PG8_WAIT_L
#undef PG8_BAR
#undef PG8_SCHED
}
struct RowLin { long rstride; __device__ __forceinline__ unsigned operator()(int R) const { return (unsigned)((long)R * rstride); } };
}
namespace pg8 {
__device__ __forceinline__ u32x2 pk4(f32x4 v) { u32x2 w; w.x = cvt_pk_bf16(v[0], v[1]); w.y = cvt_pk_bf16(v[2], v[3]); return w; }
__device__ __forceinline__ f32x4 up4(u32x2 w) { return (f32x4){bflo(w.x), bfhi(w.x), bflo(w.y), bfhi(w.y)}; }
__device__ __forceinline__ float fast_sigmoid(float x) { return __builtin_amdgcn_rcpf(1.f + __expf(-x)); }
#define EPI_ROWS(ai, m) _Pragma("unroll") for (int ai = 0; ai < 2; ++ai) _Pragma("unroll") for (int m = 0; m < 4; ++m)

struct EpiInProj {
    static constexpr bool PERM = false, AFTER_DRAIN = false;
    unsigned char* ws; const float* rope;
    __device__ __forceinline__ void operator()(const f32x4 (&acc)[2][2][4][2], const Unit& u, int wr, int wc, int fr, int fq) const {
        asm volatile("" : "+v"(fr), "+v"(fq));
        const int pn = u.pn; size_t boff; int pitch, c0;
        if (pn < 4) { boff = P_Q; pitch = 1024; c0 = 256 * pn; }
        else if (pn < 8) { boff = P_K; pitch = 1024; c0 = 256 * (pn - 4); }
        else if (pn < 12) { boff = P_V; pitch = 1024; c0 = 256 * (pn - 8); }
        else if (pn < 14) { boff = P_F; pitch = 512; c0 = 256 * (pn - 12); }
        else if (pn < 19) { boff = P_CS; pitch = DCS; c0 = 256 * (pn - 14); }
        else { boff = P_CO; pitch = DCOP; c0 = 256 * (pn - 19); }
        bf16_t* base = (bf16_t*)(ws + boff);
        const bool dorope = (pn >= 4 && pn < 8 && u.pm < ML / 256);
        EPI_ROWS(ai, m) {
            const int R = 128 * ai + 64 * wr + 16 * m + fr; const size_t grow = (size_t)u.pm * 256 + R;
            const float qs = pn < 4 ? QK_PRESCALE : 1.f;
            f32x4 cc = (f32x4){qs, qs, qs, qs}, ss = (f32x4){0.f, 0.f, 0.f, 0.f};
            if (dorope) { const int t = (int)(grow & 4095); const int pos = (wc & 1) ? (t & 63) : (t >> 6);
                const f32x4 a = *(const f32x4*)(rope + (pos * 16 + 4 * fq) * 2), b = *(const f32x4*)(rope + (pos * 16 + 4 * fq) * 2 + 4);
                cc = (f32x4){a[0], a[2], b[0], b[2]}; ss = (f32x4){a[1], a[3], b[1], b[3]}; }
            bf16_t* rowp = base + grow * pitch + c0 + 32 * wc + 4 * fq;
#pragma unroll
            for (int bj = 0; bj < 2; ++bj) { const f32x4 x1 = acc[ai][bj][m][0], x2 = acc[ai][bj][m][1];
                const f32x4 y1 = x1 * cc - x2 * ss, y2 = x2 * cc + x1 * ss;
                *(u32x2*)(rowp + 128 * bj) = pk4(y1); *(u32x2*)(rowp + 128 * bj + 16) = pk4(y2); }
        }
    }
};
struct EpiGate {
    static constexpr bool PERM = true, AFTER_DRAIN = false;
    bf16_t* gate;
    __device__ __forceinline__ void operator()(const f32x4 (&acc)[2][2][4][2], const Unit& u, int wr, int wc, int fr, int fq) const {
        asm volatile("" : "+v"(fr), "+v"(fq));
        EPI_ROWS(ai, m) {
            const int R = 128 * ai + 64 * wr + 16 * m + fr; const size_t grow = (size_t)u.pm * 256 + R;
            bf16_t* rowp = gate + grow * NGATE + 256 * u.pn + 32 * wc + 8 * fq;
#pragma unroll
            for (int bj = 0; bj < 2; ++bj) { f32x4 v0 = acc[ai][bj][m][0], v1 = acc[ai][bj][m][1];
#pragma unroll
                for (int e = 0; e < 4; ++e) { v0[e] = fast_sigmoid(v0[e]); v1[e] = fast_sigmoid(v1[e]); }
                u32x4 w; w.x = cvt_pk_bf16(v0[0], v0[1]); w.y = cvt_pk_bf16(v0[2], v0[3]); w.z = cvt_pk_bf16(v1[0], v1[1]); w.w = cvt_pk_bf16(v1[2], v1[3]);
                *(u32x4*)(rowp + 128 * bj) = w; }
        }
    }
};
template <bool FIRST> struct EpiBranch {
    static constexpr bool PERM = true, AFTER_DRAIN = false;
    const bf16_t* gate; bf16_t* ym; float sc;
    __device__ __forceinline__ void operator()(const f32x4 (&acc)[2][2][4][2], const Unit& u, int wr, int wc, int fr, int fq) const {
        asm volatile("" : "+v"(fr), "+v"(fq));
        EPI_ROWS(ai, m) {
            const int R = 128 * ai + 64 * wr + 16 * m + fr; const size_t grow = (size_t)u.pm * 256 + R;
            const int col = 256 * u.pn + 32 * wc + 8 * fq;
#pragma unroll
            for (int bj = 0; bj < 2; ++bj) {
                const u32x4 g = *(const u32x4*)(gate + grow * NGATE + col + 128 * bj);
                f32x4 v0 = acc[ai][bj][m][0], v1 = acc[ai][bj][m][1];
                v0 = v0 * (f32x4){bflo(g.x), bfhi(g.x), bflo(g.y), bfhi(g.y)} * sc; v1 = v1 * (f32x4){bflo(g.z), bfhi(g.z), bflo(g.w), bfhi(g.w)} * sc;
                bf16_t* op = ym + grow * 1024 + col + 128 * bj;
                if (!FIRST) { const u32x4 o = *(const u32x4*)op; v0 = v0 + (f32x4){bflo(o.x), bfhi(o.x), bflo(o.y), bfhi(o.y)}; v1 = v1 + (f32x4){bflo(o.z), bfhi(o.z), bflo(o.w), bfhi(o.w)}; }
                u32x4 w; w.x = cvt_pk_bf16(v0[0], v0[1]); w.y = cvt_pk_bf16(v0[2], v0[3]); w.z = cvt_pk_bf16(v1[0], v1[1]); w.w = cvt_pk_bf16(v1[2], v1[3]);
                *(u32x4*)op = w; }
        }
    }
};
struct EpiF32 {
    static constexpr bool PERM = false, AFTER_DRAIN = false;
    float* out; int ldc;
    __device__ __forceinline__ void operator()(const f32x4 (&acc)[2][2][4][2], const Unit& u, int wr, int wc, int fr, int fq) const {
        asm volatile("" : "+v"(fr), "+v"(fq));
        EPI_ROWS(ai, m) {
            const int R = 128 * ai + 64 * wr + 16 * m + fr; const size_t grow = (size_t)u.pm * 256 + R;
            float* rowp = out + grow * ldc + 256 * u.pn + 32 * wc + 4 * fq;
#pragma unroll
            for (int bj = 0; bj < 2; ++bj)
#pragma unroll
                for (int n = 0; n < 2; ++n) *(f32x4*)(rowp + 128 * bj + 16 * n) = acc[ai][bj][m][n];
        }
    }
};
struct EpiBf16 {
    static constexpr bool PERM = true, AFTER_DRAIN = false;
    bf16_t* out; int ldc;
    __device__ __forceinline__ void operator()(const f32x4 (&acc)[2][2][4][2], const Unit& u, int wr, int wc, int fr, int fq) const {
        asm volatile("" : "+v"(fr), "+v"(fq));
        EPI_ROWS(ai, m) {
            const int R = 128 * ai + 64 * wr + 16 * m + fr; const size_t grow = (size_t)u.pm * 256 + R;
            bf16_t* rowp = out + grow * ldc + 256 * u.pn + 32 * wc + 8 * fq;
#pragma unroll
            for (int bj = 0; bj < 2; ++bj) { const f32x4 v0 = acc[ai][bj][m][0], v1 = acc[ai][bj][m][1];
                u32x4 w; w.x = cvt_pk_bf16(v0[0], v0[1]); w.y = cvt_pk_bf16(v0[2], v0[3]); w.z = cvt_pk_bf16(v1[0], v1[1]); w.w = cvt_pk_bf16(v1[2], v1[3]);
                *(u32x4*)(rowp + 128 * bj) = w; }
        }
    }
};
struct EpiF0 {
    static constexpr bool PERM = true, AFTER_DRAIN = false;
    bf16_t* yt;
    __device__ __forceinline__ void operator()(const f32x4 (&acc)[2][2][4][2], const Unit& u, int wr, int wc, int fr, int fq) const {
        asm volatile("" : "+v"(fr), "+v"(fq));
        EPI_ROWS(ai, m) {
            const int R = 128 * ai + 64 * wr + 16 * m + fr; const int ri = R >> 7, mch = R & 127;
            bf16_t* rowp = yt + (size_t)((ri * 4 + u.pm) * 128 + mch) * ML + 256 * u.pn + 32 * wc + 8 * fq;
#pragma unroll
            for (int bj = 0; bj < 2; ++bj) { const u32x2 lo = pk4(acc[ai][bj][m][0]), hi = pk4(acc[ai][bj][m][1]); *(u32x4*)(rowp + 128 * bj) = (u32x4){lo.x, lo.y, hi.x, hi.y}; }
        }
    }
};
struct EpiF0c {
    static constexpr bool PERM = true, AFTER_DRAIN = false;
    bf16_t* ytc;
    __device__ __forceinline__ void operator()(const f32x4 (&acc)[2][2][4][2], const Unit& u, int wr, int wc, int fr, int fq) const {
        asm volatile("" : "+v"(fr), "+v"(fq));
        EPI_ROWS(ai, m) {
            const int R = 128 * ai + 64 * wr + 16 * m + fr; const int ri = R >> 7, mch = R & 127;
            bf16_t* rowp = ytc + (size_t)((((u.pn * 4 + u.pm) * 128 + mch) * 2 + ri)) * 256 + 32 * wc + 8 * fq;
#pragma unroll
            for (int bj = 0; bj < 2; ++bj) { const u32x2 lo = pk4(acc[ai][bj][m][0]), hi = pk4(acc[ai][bj][m][1]); *(u32x4*)(rowp + 128 * bj) = (u32x4){lo.x, lo.y, hi.x, hi.y}; }
        }
    }
};
struct EpiF1 {
    static constexpr bool PERM = true, AFTER_DRAIN = false;
    bf16_t* x1; const float* tw;
    __device__ __forceinline__ void operator()(const f32x4 (&acc)[2][2][4][2], const Unit& u, int wr, int wc, int fr, int fq) const {
        asm volatile("" : "+v"(fr), "+v"(fq));
        const int gp = u.pn >> 7, mch = u.pn & 127, g = 2 * wr + gp;
#pragma unroll
        for (int m = 0; m < 4; ++m) {
            const int kl = 16 * m + fr;
#pragma unroll
            for (int bj = 0; bj < 2; ++bj) {
                const int colL = 128 * bj + 32 * wc + 8 * fq, tl = colL & 63, bb = colL >> 6;
                const float* tp = tw + (kl * 64 + tl) * 2;
                const f32x4 t0 = *(const f32x4*)(tp), t1 = *(const f32x4*)(tp + 4), t2 = *(const f32x4*)(tp + 8), t3 = *(const f32x4*)(tp + 12);
                const f32x4 c0 = (f32x4){t0[0], t0[2], t1[0], t1[2]}, s0 = (f32x4){t0[1], t0[3], t1[1], t1[3]}, c1 = (f32x4){t2[0], t2[2], t3[0], t3[2]}, s1 = (f32x4){t2[1], t2[3], t3[1], t3[3]};
                const f32x4 re0 = acc[0][bj][m][0], re1 = acc[0][bj][m][1], im0 = acc[1][bj][m][0], im1 = acc[1][bj][m][1];
                const u32x2 ra = pk4(re0 * c0 + im0 * s0), rb = pk4(re1 * c1 + im1 * s1), ia = pk4(im0 * c0 - re0 * s0), ib = pk4(im1 * c1 - re1 * s1);
                const size_t o = ((size_t)bb * 32768 + kl * 512 + g * 128 + mch) * 64 + tl;
                *(u32x4*)(x1 + o) = (u32x4){ra.x, ra.y, rb.x, rb.y}; *(u32x4*)(x1 + (size_t)4 * 32768 * 64 + o) = (u32x4){ia.x, ia.y, ib.x, ib.y};
            }
        }
    }
};
struct EpiF2 {
    static constexpr bool PERM = true, AFTER_DRAIN = false;
    bf16_t* of;
    __device__ __forceinline__ void operator()(const f32x4 (&acc)[2][2][4][2], const Unit& u, int wr, int wc, int fr, int fq) const {
        asm volatile("" : "+v"(fr), "+v"(fq));
        const int kl = u.pn >> 1, gm0 = (u.pn & 1) * 256;
        EPI_ROWS(ai, m) {
            const int R = 128 * ai + 64 * wr + 16 * m + fr; const int b = R >> 6, kh = R & 63;
            bf16_t* rowp = of + (size_t)(b * 4096 + 64 * kh + kl) * 512 + gm0 + 32 * wc + 8 * fq;
#pragma unroll
            for (int bj = 0; bj < 2; ++bj) { const u32x2 lo = pk4(acc[ai][bj][m][0]), hi = pk4(acc[ai][bj][m][1]); *(u32x4*)(rowp + 128 * bj) = (u32x4){lo.x, lo.y, hi.x, hi.y}; }
        }
    }
};
struct EpiFc {
    static constexpr bool PERM = true, AFTER_DRAIN = false;
    bf16_t* of;
    __device__ __forceinline__ void operator()(const f32x4 (&acc)[2][2][4][2], const Unit& u, int wr, int wc, int fr, int fq) const {
        asm volatile("" : "+v"(fr), "+v"(fq));
        const int b = u.pn >> 1, gm0 = (u.pn & 1) * 256;
        EPI_ROWS(ai, m) {
            const int R = 128 * ai + 64 * wr + 16 * m + fr;
            bf16_t* rowp = of + (size_t)(ML + b * 256 + R) * 512 + gm0 + 32 * wc + 8 * fq;
#pragma unroll
            for (int bj = 0; bj < 2; ++bj) { const u32x2 lo = pk4(acc[ai][bj][m][0]), hi = pk4(acc[ai][bj][m][1]); *(u32x4*)(rowp + 128 * bj) = (u32x4){lo.x, lo.y, hi.x, hi.y}; }
        }
    }
};
struct EpiRwkvPost {
    static constexpr bool PERM = false, AFTER_DRAIN = true;
    const bf16_t* y0; const bf16_t* y1; const bf16_t* cs; const float* bon; const float* mu; const float* lnw; const float* lnb; bf16_t* oc;
    __device__ __forceinline__ void fused(f32x4 (&acc)[2][2][4][2], const Unit& u, int wr, int wc, int fr, int fq, PG8_LAS unsigned char* lds, int wid, int lane) const {
        asm volatile("" : "+v"(fr), "+v"(fq));
        PG8_LAS f32x2* P = (PG8_LAS f32x2*)lds;
        EPI_ROWS(ai, m) {
            const int R = 128 * ai + 64 * wr + 16 * m + fr; const size_t grow = (size_t)u.pm * 256 + R;
#pragma unroll
            for (int bj = 0; bj < 2; ++bj) {
                const size_t o = grow * 512 + 256 * u.pn + 128 * bj + 32 * wc + 4 * fq;
                const f32x4 a = up4(*(const u32x2*)(y0 + o)) + up4(*(const u32x2*)(y1 + o)), b = up4(*(const u32x2*)(y0 + o + 16)) + up4(*(const u32x2*)(y1 + o + 16));
                float s = (a[0] + a[1]) + (a[2] + a[3]) + (b[0] + b[1]) + (b[2] + b[3]);
                s += __shfl_xor(s, 16); s += __shfl_xor(s, 32);
                const float mw = s * (1.f / 32.f); const f32x4 da = a - mw, db = b - mw;
                float q = (da[0] * da[0] + da[1] * da[1]) + (da[2] * da[2] + da[3] * da[3]) + (db[0] * db[0] + db[1] * db[1]) + (db[2] * db[2] + db[3] * db[3]);
                q += __shfl_xor(q, 16); q += __shfl_xor(q, 32);
                if (fq == 0) P[(R * 4 + 2 * bj + (wc >> 1)) * 2 + (wc & 1)] = (f32x2){mw, q};
            }
        }
        asm volatile("s_waitcnt lgkmcnt(0)" ::: "memory"); __builtin_amdgcn_s_barrier(); asm volatile("" ::: "memory");
        EPI_ROWS(ai, m) {
            const int R = 128 * ai + 64 * wr + 16 * m + fr; const size_t grow = (size_t)u.pm * 256 + R;
            int pos, len; if (grow < (size_t)ML) { pos = (int)(grow & 4095); len = SEQ; } else { pos = (int)((grow - ML) & 255); len = CTXL; }
            const bool hp = pos > 0, hn = pos < len - 1;
            const size_t rp = hp ? grow - 1 : grow, rn = hn ? grow + 1 : grow;
#pragma unroll
            for (int bj = 0; bj < 2; ++bj) {
                const int hl = 2 * bj + (wc >> 1), head = 4 * u.pn + hl;
                const f32x2 pa = P[(R * 4 + hl) * 2 + 0], pb = P[(R * 4 + hl) * 2 + 1];
                const float mean = 0.5f * (pa.x + pb.x), dm = pa.x - pb.x, var = (pa.y + pb.y + 16.f * dm * dm) * (1.f / 64.f);
                const float rstd = 1.0f / sqrtf(var + 64.f * 1e-5f);
                const float bsum = bon[grow * 8 + head] + bon[(size_t)MT * 8 + grow * 8 + head];
#pragma unroll
                for (int n = 0; n < 2; ++n) {
                    const int c = 256 * u.pn + 128 * bj + 32 * wc + 16 * n + 4 * fq;
                    const size_t o = grow * 512 + c;
                    const f32x4 yv = up4(*(const u32x2*)(y0 + o)) + up4(*(const u32x2*)(y1 + o));
                    const f32x4 w4 = *(const f32x4*)(lnw + c), b4 = *(const f32x4*)(lnb + c);
                    const f32x4 m0 = *(const f32x4*)(mu + 512 + c), m1 = *(const f32x4*)(mu + 1920 + 512 + c);
                    const f32x4 vc = up4(*(const u32x2*)(cs + grow * DCS + 512 + c));
                    f32x4 vp = up4(*(const u32x2*)(cs + rp * DCS + 512 + c)), vn = up4(*(const u32x2*)(cs + rn * DCS + 512 + c));
                    if (!hp) vp = (f32x4){0.f, 0.f, 0.f, 0.f}; if (!hn) vn = (f32x4){0.f, 0.f, 0.f, 0.f};
                    const f32x4 vs = vc + m0 * (vp - vc) + m1 * (vn - vc);
                    const f32x4 yn = (yv - mean) * rstd * w4 + b4;
                    const f32x4 r = (yn + bsum * vs) * acc[ai][bj][m][n];
                    *(u32x2*)(oc + o) = pk4(r);
                }
            }
        }
    }
};
}
namespace attn {
#define SBAR() __builtin_amdgcn_sched_barrier(0)
constexpr int QBLK = 32, KVBLK = 64;
#ifndef ATTN_THR
#define ATTN_THR 6.f
#endif
constexpr int SHM_V = KVBLK * 128 * 2, SHM_K = KVBLK * 64 * 2;
constexpr int LDS_V = 0, LDS_K = 2 * SHM_V, LDS_WS = LDS_K + 2 * SHM_K, LDS_STASH = LDS_WS + NWAVES * 64 * 4, LDS_END = LDS_STASH + NWAVES * 8192;
static_assert(LDS_END <= RING_BYTES, "attention LDS");
__device__ __forceinline__ int crow(int r, int hi) { return (r & 3) + 8 * (r >> 2) + 4 * hi; }
__device__ __forceinline__ int kswz(int row, int chunk) { return row * 128 + ((chunk ^ ((row >> 1) & 7)) << 4); }

__device__ __forceinline__ void partialSM(f32x16& p0, f32x16& p1, float& m_reg, f32x16& negm, bool first, float& alpha) {
    float pmax = p0[0];
#pragma unroll
    for (int r = 1; r < 16; ++r) pmax = fmaxf(pmax, p0[r]);
#pragma unroll
    for (int r = 0; r < 16; ++r) pmax = fmaxf(pmax, p1[r]);
    { auto rr = __builtin_amdgcn_permlane32_swap(__float_as_uint(pmax), __float_as_uint(pmax), false, false);
      pmax = fmaxf(__uint_as_float(rr[0]), __uint_as_float(rr[1])); }
    if (__builtin_expect(!first && __all(pmax <= ATTN_THR * 1.4426950408889634f), 1)) { alpha = 1.f; }
    else { const float d = first ? pmax : fmaxf(pmax, 0.f); alpha = __builtin_amdgcn_exp2f(-d); m_reg += d;
#pragma unroll
        for (int r = 0; r < 16; ++r) { p0[r] -= d; p1[r] -= d; negm[r] = -m_reg; } }
#pragma unroll
    for (int r = 0; r < 16; ++r) p0[r] = __builtin_amdgcn_exp2f(p0[r]);
}
__device__ __forceinline__ void finishSM(f32x16& p0, f32x16& p1, float alpha, float& l_reg, bf16x8& pa0, bf16x8& pa1, bf16x8& pa2, bf16x8& pa3) {
#pragma unroll
    for (int r = 0; r < 16; ++r) p1[r] = __builtin_amdgcn_exp2f(p1[r]);
    f32x2 ps2 = (f32x2){p0[0], p0[1]} + (f32x2){p1[0], p1[1]};
#pragma unroll
    for (int r = 2; r < 16; r += 2) { ps2 += (f32x2){p0[r], p0[r + 1]}; ps2 += (f32x2){p1[r], p1[r + 1]}; }
    float ps = ps2.x + ps2.y;
    { auto rr = __builtin_amdgcn_permlane32_swap(__float_as_uint(ps), __float_as_uint(ps), false, false);
      ps = __uint_as_float(rr[0]) + __uint_as_float(rr[1]); }
    l_reg = l_reg * alpha + ps;
#define PK4(P, BASE, OUT) do { unsigned a0 = cvt_pk_bf16(P[BASE + 0], P[BASE + 1]), a1 = cvt_pk_bf16(P[BASE + 2], P[BASE + 3]);   \
    unsigned b0 = cvt_pk_bf16(P[BASE + 4], P[BASE + 5]), b1 = cvt_pk_bf16(P[BASE + 6], P[BASE + 7]);                              \
    auto r0 = __builtin_amdgcn_permlane32_swap(a0, b0, false, false); auto r1 = __builtin_amdgcn_permlane32_swap(a1, b1, false, false); \
    u32x4 w = {r0[0], r1[0], r0[1], r1[1]}; OUT = *reinterpret_cast<bf16x8*>(&w); } while (0)
    PK4(p0, 0, pa0); PK4(p0, 8, pa1); PK4(p1, 0, pa2); PK4(p1, 8, pa3);
#undef PK4
}
__device__ __forceinline__ void qkt(f32x16& p0, f32x16& p1, const LAS char* Ks, const bf16x8 q0, const bf16x8 q1, const bf16x8 q2, const bf16x8 q3, int r32, int hi, const f32x16& negm) {
    p0 = negm; p1 = negm;
#define QK1(d0, Q) do { const bf16x8 b0 = *(const LAS bf16x8*)(Ks + kswz(r32, 2 * (d0) + hi)); const bf16x8 b1 = *(const LAS bf16x8*)(Ks + kswz(32 + r32, 2 * (d0) + hi)); \
    p0 = __builtin_amdgcn_mfma_f32_32x32x16_bf16(b0, Q, p0, 0, 0, 0); p1 = __builtin_amdgcn_mfma_f32_32x32x16_bf16(b1, Q, p1, 0, 0, 0); } while (0)
    QK1(0, q0); QK1(1, q1); QK1(2, q2); QK1(3, q3);
#undef QK1
}
__device__ __forceinline__ int v_st(int k, int c) { const int kk = (k & ~0xC) | ((k & 4) << 1) | ((k & 8) >> 1); return ((kk >> 3) * 4 + (c >> 5)) * 512 + ((kk & 7) * 32 + (c & 31)) * 2; }
__device__ __forceinline__ int v_rd_base(int lane) { return ((lane & 3) << 3) | (((lane >> 2) & 3) << 6) | (((lane >> 4) & 1) << 5) | (((lane >> 5) & 1) << 8); }
constexpr int v_rd_off(int d0, int ks, int half) { return d0 * 512 + ks * 4096 + half * 2048; }
template <int OFF> __device__ __forceinline__ s16x4 tr_read(int vb) {
    s16x4 r; asm volatile("ds_read_b64_tr_b16 %0, %1 offset:%2" : "=&v"(r) : "v"(vb), "i"(OFF) : "memory"); return r;
}
template <int D0> __device__ __forceinline__ void pv_one(f32x16& od, int vb, bf16x8 pa0, bf16x8 pa1, bf16x8 pa2, bf16x8 pa3) {
    const s16x4 l0 = tr_read<v_rd_off(D0, 0, 0)>(vb), h0 = tr_read<v_rd_off(D0, 0, 1)>(vb), l1 = tr_read<v_rd_off(D0, 1, 0)>(vb), h1 = tr_read<v_rd_off(D0, 1, 1)>(vb);
    const s16x4 l2 = tr_read<v_rd_off(D0, 2, 0)>(vb), h2 = tr_read<v_rd_off(D0, 2, 1)>(vb), l3 = tr_read<v_rd_off(D0, 3, 0)>(vb), h3 = tr_read<v_rd_off(D0, 3, 1)>(vb);
    asm volatile("s_waitcnt lgkmcnt(0)" ::: "memory"); SBAR();
#define PK(L, H) (bf16x8){L[0], L[1], L[2], L[3], H[0], H[1], H[2], H[3]}
    od = __builtin_amdgcn_mfma_f32_32x32x16_bf16(pa0, PK(l0, h0), od, 0, 0, 0);
    od = __builtin_amdgcn_mfma_f32_32x32x16_bf16(pa1, PK(l1, h1), od, 0, 0, 0);
    od = __builtin_amdgcn_mfma_f32_32x32x16_bf16(pa2, PK(l2, h2), od, 0, 0, 0);
    od = __builtin_amdgcn_mfma_f32_32x32x16_bf16(pa3, PK(l3, h3), od, 0, 0, 0);
#undef PK
}
__device__ __forceinline__ void pv_d0(f32x16* o, int vb, bf16x8 pa0, bf16x8 pa1, bf16x8 pa2, bf16x8 pa3) {
    pv_one<0>(o[0], vb, pa0, pa1, pa2, pa3); pv_one<1>(o[1], vb, pa0, pa1, pa2, pa3); pv_one<2>(o[2], vb, pa0, pa1, pa2, pa3); pv_one<3>(o[3], vb, pa0, pa1, pa2, pa3);
}

template <bool LATENT>
__device__ __forceinline__ void attn_unit(const bf16_t* Qb, const bf16_t* Kb, const bf16_t* Vb, bf16_t* Ob, int qrow0, int b, int hh,
                                          float lam, float oscale, const float* __restrict__ subln, const float* __restrict__ rope, LAS char* lds, int wave_) {
    int wid = wave_; asm volatile("" : "+s"(wid));
    const int lane = fresh_lane(), tid = (wid << 6) | lane, r32 = lane & 31, hi = lane >> 5;
    LAS char* V_lds = lds + LDS_V; LAS char* K_lds = lds + LDS_K;
    LAS float* wsf = (LAS float*)(lds + LDS_WS) + wid * 64; LAS float* li_l = wsf; LAS float* al_l = wsf + 32;
    LAS unsigned* stash = (LAS unsigned*)(lds + LDS_STASH + wid * 8192);
    constexpr int NT = 64;
    const int ctx0 = ML + b * CTXL, lat0 = b * SEQ;
    const int myrow = qrow0 + wid * QBLK + r32;
    const int ksr = tid >> 3, ksc = tid & 7, kst = kswz(ksr, ksc);
    const int sr = tid >> 4, sc = (tid & 15) * 8, vst0 = v_st(sr, sc), vst1 = v_st(32 + sr, sc);
    const int vb0 = (int)(uintptr_t)V_lds + v_rd_base(lane);
    f32x16 o[4];
#pragma unroll 1
    for (int c = 0; c < 2; ++c) {
        bf16x8 q0, q1, q2, q3;
        { const int lq = fresh_lane();
          const bf16_t* Qw = Qb + (size_t)(qrow0 + wid * QBLK + (lq & 31)) * 1024 + hh * 128 + c * 64 + (lq >> 5) * 8;
          q0 = *(const bf16x8*)(Qw); q1 = *(const bf16x8*)(Qw + 16); q2 = *(const bf16x8*)(Qw + 32); q3 = *(const bf16x8*)(Qw + 48); }
        const unsigned voV0 = (unsigned)(sr * 1024 + hh * 128 + sc) * 2u, voK = (unsigned)(ksr * 1024 + hh * 128 + c * 64 + ksc * 8) * 2u;
        float m_reg = 0.f, l_reg = 0.f; f32x16 negm = f32x16{};
#pragma unroll
        for (int d = 0; d < 4; ++d) o[d] = f32x16{};
        bf16x8 sv0[1], sv1[1], sk0[1];
#define SLOAD(i, kr) do { unsigned a_ = voV0, b_ = voV0 + 32u * 2048u, c_ = voK; asm volatile("" : "+v"(a_), "+v"(b_), "+v"(c_)); \
        const char* vb_ = (const char*)Vb + (size_t)(kr) * 2048; const char* kb_ = (const char*)Kb + (size_t)(kr) * 2048; \
        sv0[i] = *(const bf16x8*)(vb_ + a_); sv1[i] = *(const bf16x8*)(vb_ + b_); sk0[i] = *(const bf16x8*)(kb_ + c_); } while (0)
#define SWRITE(bb, i) do { *(LAS bf16x8*)(V_lds + (bb) * SHM_V + vst0) = sv0[i]; *(LAS bf16x8*)(V_lds + (bb) * SHM_V + vst1) = sv1[i]; *(LAS bf16x8*)(K_lds + (bb) * SHM_K + kst) = sk0[i]; } while (0)
#define SWAIT() asm volatile("s_waitcnt vmcnt(3)" ::: "memory")
#define RESC(a) do { if (__any((a) < 1.f)) { if (hi == 0) al_l[r32] = (a); asm volatile("s_waitcnt lgkmcnt(0)" ::: "memory"); \
        _Pragma("unroll") for (int d = 0; d < 4; ++d) _Pragma("unroll") for (int r = 0; r < 16; ++r) o[d][r] *= al_l[crow(r, hi)]; } } while (0)
        f32x16 pA0, pA1; float alA; bf16x8 pa0, pa1, pa2, pa3;
        SLOAD(0, ctx0);
#pragma unroll 1
        for (int j = 0; j < 4; ++j) {
            __syncthreads();
            asm volatile("s_waitcnt vmcnt(0)" ::: "memory"); SWRITE(0, 0);
            { const int nr = j < 3 ? ctx0 + 64 * (j + 1) : (LATENT ? lat0 : ctx0); SLOAD(0, nr); }
            __syncthreads();
            qkt(pA0, pA1, K_lds, q0, q1, q2, q3, r32, hi, negm); partialSM(pA0, pA1, m_reg, negm, j == 0, alA);
            RESC(alA);
            finishSM(pA0, pA1, alA, l_reg, pa0, pa1, pa2, pa3); SBAR();
            pv_d0(o, vb0, pa0, pa1, pa2, pa3);
        }
        if (LATENT) {
            {
                const int t = myrow & 4095, pos0 = t >> 6, pos1 = t & 63;
                const float* r0p = rope + (pos0 * 16 + 8 * hi) * 2; const float* r1p = rope + (pos1 * 16 + 8 * hi) * 2;
#pragma unroll
                for (int j = 0; j < 8; ++j) {
                    const float c0 = r0p[2 * j], s0 = r0p[2 * j + 1], c1 = r1p[2 * j], s1 = r1p[2 * j + 1];
                    const float x1 = bf2f((unsigned short)q0[j]), x2 = bf2f((unsigned short)q1[j]), z1 = bf2f((unsigned short)q2[j]), z2 = bf2f((unsigned short)q3[j]);
                    const unsigned w0 = cvt_pk_bf16(x1 * c0 - x2 * s0, x2 * c0 + x1 * s0), w1 = cvt_pk_bf16(z1 * c1 - z2 * s1, z2 * c1 + z1 * s1);
                    q0[j] = (short)(w0 & 0xffffu); q1[j] = (short)(w0 >> 16); q2[j] = (short)(w1 & 0xffffu); q3[j] = (short)(w1 >> 16);
                }
            }
            f32x16 pB0, pB1; float alB;
            __syncthreads();
            asm volatile("s_waitcnt vmcnt(0)" ::: "memory"); SWRITE(0, 0);
            SLOAD(0, lat0 + 64); __syncthreads();
            qkt(pA0, pA1, K_lds, q0, q1, q2, q3, r32, hi, negm); partialSM(pA0, pA1, m_reg, negm, false, alA);
            RESC(alA);
            asm volatile("s_waitcnt vmcnt(0)" ::: "memory"); SWRITE(1, 0); SLOAD(0, lat0 + 128); __syncthreads();
#pragma unroll 1
            for (int j = 1; j + 1 < NT; j += 2) {
                SBAR(); qkt(pB0, pB1, K_lds + SHM_K, q0, q1, q2, q3, r32, hi, negm);
                finishSM(pA0, pA1, alA, l_reg, pa0, pa1, pa2, pa3); SBAR();
                pv_d0(o, vb0, pa0, pa1, pa2, pa3); partialSM(pB0, pB1, m_reg, negm, false, alB);
                __syncthreads(); asm volatile("s_waitcnt vmcnt(0)" ::: "memory"); SWRITE(0, 0);
                SLOAD(0, lat0 + 64 * (j + 2 < NT ? j + 2 : NT - 1));
                RESC(alB); __syncthreads();
                SBAR(); qkt(pA0, pA1, K_lds, q0, q1, q2, q3, r32, hi, negm);
                finishSM(pB0, pB1, alB, l_reg, pa0, pa1, pa2, pa3); SBAR();
                pv_d0(o, vb0 + SHM_V, pa0, pa1, pa2, pa3); partialSM(pA0, pA1, m_reg, negm, false, alA);
                __syncthreads(); asm volatile("s_waitcnt vmcnt(0)" ::: "memory"); SWRITE(1, 0);
                SLOAD(0, lat0 + 64 * (j + 3 < NT ? j + 3 : NT - 1));
                RESC(alA); __syncthreads();
            }
            SBAR(); qkt(pB0, pB1, K_lds + SHM_K, q0, q1, q2, q3, r32, hi, negm);
            finishSM(pA0, pA1, alA, l_reg, pa0, pa1, pa2, pa3); SBAR();
            pv_d0(o, vb0, pa0, pa1, pa2, pa3); partialSM(pB0, pB1, m_reg, negm, false, alB);
            __syncthreads(); RESC(alB);
            finishSM(pB0, pB1, alB, l_reg, pa0, pa1, pa2, pa3); SBAR();
            pv_d0(o, vb0 + SHM_V, pa0, pa1, pa2, pa3);
        }
        const int le = fresh_lane(), r32e = le & 31, hie = le >> 5;
        if (hie == 0) li_l[r32e] = l_reg; asm volatile("s_waitcnt lgkmcnt(0)" ::: "memory");
        if (c == 0) {
#pragma unroll
            for (int r = 0; r < 16; ++r) { const float rl = 1.0f / li_l[crow(r, hie)];
#pragma unroll
                for (int d = 0; d < 4; d += 2) stash[(r * 2 + (d >> 1)) * 64 + le] = cvt_pk_bf16(o[d][r] * rl, o[d + 1][r] * rl); }
        } else {
            bf16_t* Ow = Ob + (size_t)(qrow0 + wid * QBLK) * 1024 + hh * 128;
            float gsub[4];
#pragma unroll
            for (int d = 0; d < 4; ++d) gsub[d] = subln[d * 32 + r32e] * oscale;
#pragma unroll
            for (int r = 0; r < 16; ++r) {
                const float rl = lam / li_l[crow(r, hie)]; float acc2 = 0.f;
#pragma unroll
                for (int d = 0; d < 4; d += 2) { const unsigned w = stash[(r * 2 + (d >> 1)) * 64 + le];
                    const float a0 = bflo(w) - o[d][r] * rl, a1 = bfhi(w) - o[d + 1][r] * rl;
                    o[d][r] = a0; o[d + 1][r] = a1; acc2 += a0 * a0 + a1 * a1; }
#pragma unroll
                for (int off = 1; off < 32; off <<= 1) acc2 += __shfl_xor(acc2, off);
                const float rs = 1.0f / sqrtf(acc2 * (1.f / 128.f) + 1e-5f);
                const int orow = crow(r, hie);
#pragma unroll
                for (int d = 0; d < 4; ++d) Ow[(size_t)orow * 1024 + d * 32 + r32e] = (bf16_t)(cvt_pk_bf16(o[d][r] * rs * gsub[d], 0.f) & 0xffffu);
            }
        }
    }
#undef SLOAD
#undef SWRITE
#undef SWAIT
#undef RESC
}
#undef SBAR
}
#ifndef SCAN_TSEL
#define SCAN_TSEL 0
#endif
namespace rwkv {
constexpr int A_W = 0, A_KK = 16384, A_B = 32768, A_KD = 49152, A_R = 65536, A_V = 81920, A_Y = 98304, A_TW = A_Y, A_TA = A_Y + 8192, A_PRM = 133120, A_GC = A_PRM + 15 * 256, A_GT = A_GC + 256, A_END = A_GT + 2048;
constexpr int C_AT = 0, C_RT = 8192, C_BT = 16384, C_KT = 24576, C_KHT = 32768, C_BHT = 40960, C_VT = 49152, C_LAK = 57344, C_LAB = 65536  , C_RHS = 82944  , C_MRK = 100352, C_MRB = 108544, C_ZN = 116736, C_S0B = 139264;
constexpr int RHSP = 68;
constexpr int LABP = 68;
static_assert(A_END <= C_S0B && C_S0B + 8192 <= LDS_BYTES && C_ZN + 8192 <= RING_BYTES && C_RHS >= C_LAB + 64 * LABP * 4 && C_MRK >= C_RHS + 64 * RHSP * 4 && A_END <= LDS_BYTES && A_PRM >= MISC_OFF + 512, "scan LDS");
struct Params { const bf16_t* cs; bf16_t* co; bf16_t* y; float* bon; const float* mu; const float* w0; const float* w2; const float* a0; const float* a2; const float* kk; const float* ka; const float* rk; };
__device__ __forceinline__ float dpp_ror_add(float x, int) { return x; }
#define ROR_ADD(x, n) do { const int t_ = __builtin_amdgcn_update_dpp(0, __builtin_bit_cast(int, x), 0x120 + (n), 0xf, 0xf, false); x += __builtin_bit_cast(float, t_); } while (0)
__device__ __forceinline__ float row16_sum(float x) { ROR_ADD(x, 8); ROR_ADD(x, 4); ROR_ADD(x, 2); ROR_ADD(x, 1); return x; }
__device__ __forceinline__ void ld8(const bf16_t* p, float (&o)[8]) { const u32x4 w = *(const u32x4*)p; o[0] = bflo(w.x); o[1] = bfhi(w.x); o[2] = bflo(w.y); o[3] = bfhi(w.y); o[4] = bflo(w.z); o[5] = bfhi(w.z); o[6] = bflo(w.w); o[7] = bfhi(w.w); }
template <class MP> __device__ __forceinline__ void shift8(const bf16_t* base, size_t pitch, size_t row, int col, bool hp, bool hn, MP m0, MP m1, float (&o)[8]) {
    float c[8], p[8], n[8]; ld8(base + row * pitch + col, c); ld8(base + (hp ? row - 1 : row) * pitch + col, p); ld8(base + (hn ? row + 1 : row) * pitch + col, n);
#pragma unroll
    for (int i = 0; i < 8; ++i) { const float pv = hp ? p[i] : 0.f, nv = hn ? n[i] : 0.f; o[i] = c[i] + m0[i] * (pv - c[i]) + m1[i] * (nv - c[i]); }
}
__device__ __forceinline__ void lds_ld8(const LAS float* p, float (&o)[8]) { const f32x4 a = *(const LAS f32x4*)p, b = *(const LAS f32x4*)(p + 4); o[0] = a[0]; o[1] = a[1]; o[2] = a[2]; o[3] = a[3]; o[4] = b[0]; o[5] = b[1]; o[6] = b[2]; o[7] = b[3]; }
__device__ __forceinline__ void lds_st8(LAS float* p, const float (&o)[8]) { *(LAS f32x4*)p = (f32x4){o[0], o[1], o[2], o[3]}; *(LAS f32x4*)(p + 4) = (f32x4){o[4], o[5], o[6], o[7]}; }
__device__ __forceinline__ void scan_wg(const Params& P, int d, int b, int hh, LAS char* lds, int wave_) {
    unsigned long long tprev_ = 0;
#define SC_T(k) do { if (SCAN_TSEL != 0) { if (blockIdx.x == 0 && tid == 0) { const unsigned long long tn_ = __builtin_amdgcn_s_memrealtime(); if ((SCAN_TSEL >> (k)) & 1) { volatile LAS unsigned* M_ = (volatile LAS unsigned*)(lds + MISC_OFF); const unsigned long long ac_ = (((unsigned long long)M_[19] << 32) | M_[18]) + (tn_ - tprev_); M_[18] = (unsigned)ac_; M_[19] = (unsigned)(ac_ >> 32); } tprev_ = tn_; } } } while (0)
    int wid = wave_; asm volatile("" : "+s"(wid));
    const int lane0 = fresh_lane(), tid = (wid << 6) | lane0, r32o = lane0 & 31, hio = lane0 >> 5;
    LAS float* W = (LAS float*)(lds + A_W); LAS float* KK = (LAS float*)(lds + A_KK); LAS float* Bv = (LAS float*)(lds + A_B); LAS float* KD = (LAS float*)(lds + A_KD);
    LAS float* Rv = (LAS float*)(lds + A_R); LAS float* Vv = (LAS float*)(lds + A_V); LAS float* Y = (LAS float*)(lds + A_Y);
    LAS bf16_t* TW = (LAS bf16_t*)(lds + A_TW); LAS bf16_t* TA = (LAS bf16_t*)(lds + A_TA); LAS float* PRM = (LAS float*)(lds + A_PRM);
    __syncthreads();
    for (int i = tid; i < 15 * 64; i += NTHREADS) { const int p = i >> 6, c = i & 63; float v;
        switch (p) {
            case 0: v = P.mu[hh * 64 + c]; break;             case 1: v = P.mu[1920 + hh * 64 + c]; break;
            case 2: v = P.mu[512 + hh * 64 + c]; break;       case 3: v = P.mu[1920 + 512 + hh * 64 + c]; break;
            case 4: v = P.mu[1024 + d * 64 + c]; break;       case 5: v = P.mu[1920 + 1024 + d * 64 + c]; break;
            case 6: v = P.mu[1152 + d * 64 + c]; break;       case 7: v = P.mu[1920 + 1152 + d * 64 + c]; break;
            case 8: v = P.mu[1280 + hh * 64 + c]; break;      case 9: v = P.mu[1920 + 1280 + hh * 64 + c]; break;
            case 10: v = P.w0[d * 512 + hh * 64 + c]; break;  case 11: v = P.a0[d * 512 + hh * 64 + c]; break;
            case 12: v = P.kk[hh * 64 + c]; break;            case 13: v = P.ka[hh * 64 + c]; break;
            default: v = P.rk[hh * 64 + c]; break; }
        PRM[i] = v; }
    const int mtx = wid >> 2, ti = (wid >> 1) & 1, tj = wid & 1;
    bf16x8 bw[4];
    { const int r32 = r32o, hi = hio; const float* src = (mtx == 0 ? P.w2 : P.a2) + (size_t)d * 64 * 512 + hh * 64 + 32 * tj + r32;
#pragma unroll
      for (int s = 0; s < 4; ++s) {
          u32x4 w;
          w.x = cvt_pk_bf16(src[(size_t)(16 * s + 8 * hi + 0) * 512], src[(size_t)(16 * s + 8 * hi + 1) * 512]);
          w.y = cvt_pk_bf16(src[(size_t)(16 * s + 8 * hi + 2) * 512], src[(size_t)(16 * s + 8 * hi + 3) * 512]);
          w.z = cvt_pk_bf16(src[(size_t)(16 * s + 8 * hi + 4) * 512], src[(size_t)(16 * s + 8 * hi + 5) * 512]);
          w.w = cvt_pk_bf16(src[(size_t)(16 * s + 8 * hi + 6) * 512], src[(size_t)(16 * s + 8 * hi + 7) * 512]);
          bw[s] = __builtin_bit_cast(bf16x8, w); } }
    LAS float* GC = (LAS float*)(lds + A_GC); LAS float* GT = (LAS float*)(lds + A_GT);
    f32x16 Sreg = f32x16{};
    for (int i = tid; i < 2048; i += NTHREADS) ((LAS unsigned*)(lds + C_S0B))[i] = 0u;
    __syncthreads();
    u32x4 rc[5], rpv[5], rnv[5];
#define LOADRAW(BLK) do { const bool ic_ = (BLK) < 4; const int bb_ = ic_ ? (BLK) : (BLK) - 4; const int sb_ = ic_ ? ML + b * CTXL : b * SEQ, sl_ = ic_ ? CTXL : SEQ; \
        const int r0_ = d == 0 ? sb_ + 64 * bb_ : sb_ + sl_ - 64 * (bb_ + 1); int tq_ = tid; asm volatile("" : "+v"(tq_)); const int pj_ = tq_ >> 3, cg_ = tq_ & 7; \
        const int row_ = d == 0 ? r0_ + pj_ : r0_ + 63 - pj_; const int pos_ = row_ - sb_; const size_t rp_ = pos_ > 0 ? row_ - 1 : row_, rn_ = pos_ < sl_ - 1 ? row_ + 1 : row_; \
        const int cs_[5] = {hh * 64 + 8 * cg_, 512 + hh * 64 + 8 * cg_, 1024 + d * 64 + 8 * cg_, 1152 + d * 64 + 8 * cg_, hh * 64 + 8 * cg_}; \
        _Pragma("unroll") for (int sgi = 0; sgi < 5; ++sgi) { const bf16_t* base_ = sgi < 4 ? P.cs : (const bf16_t*)P.co; const size_t pitch_ = sgi < 4 ? DCS : DCOP; \
            rc[sgi] = *(const u32x4*)(base_ + (size_t)row_ * pitch_ + cs_[sgi]); rpv[sgi] = *(const u32x4*)(base_ + rp_ * pitch_ + cs_[sgi]); rnv[sgi] = *(const u32x4*)(base_ + rn_ * pitch_ + cs_[sgi]); \
            } } while (0)
    LOADRAW(0);
#pragma unroll 1
    for (int blk = 0; blk < 68; ++blk) {
        const bool isctx = blk < 4; const int bb = isctx ? blk : blk - 4;
        const int segbase = isctx ? ML + b * CTXL : b * SEQ, seglen = isctx ? CTXL : SEQ;
        const int r0 = d == 0 ? segbase + 64 * bb : segbase + seglen - 64 * (bb + 1);
        int tl_ = tid; asm volatile("" : "+v"(tl_));
        const int lane = tl_ & 63, r32 = lane & 31, hi = lane >> 5, pj = tl_ >> 3, cg = tl_ & 7;
        SC_T(0);
        {
            const int row = d == 0 ? r0 + pj : r0 + 63 - pj; const int pos = row - segbase; const unsigned pmk = pos > 0 ? 0xffffffffu : 0u, nmk = pos < seglen - 1 ? 0xffffffffu : 0u;
#define SHIFT8(sgi, M0, M1, OUT) do { const unsigned cw_[4] = {rc[sgi].x, rc[sgi].y, rc[sgi].z, rc[sgi].w}, pw_[4] = {rpv[sgi].x & pmk, rpv[sgi].y & pmk, rpv[sgi].z & pmk, rpv[sgi].w & pmk}, nw_[4] = {rnv[sgi].x & nmk, rnv[sgi].y & nmk, rnv[sgi].z & nmk, rnv[sgi].w & nmk}; \
                _Pragma("unroll") for (int i = 0; i < 4; ++i) { const f32x2 c_ = {bflo(cw_[i]), bfhi(cw_[i])}, p_ = {bflo(pw_[i]), bfhi(pw_[i])}, n_ = {bflo(nw_[i]), bfhi(nw_[i])}; \
                    const f32x2 a0_ = {(M0)[2 * i], (M0)[2 * i + 1]}, a1_ = {(M1)[2 * i], (M1)[2 * i + 1]}; const f32x2 o_ = c_ + a0_ * (p_ - c_) + a1_ * (n_ - c_); OUT[2 * i] = o_.x; OUT[2 * i + 1] = o_.y; } } while (0)
            float ks[8], xs[8], ssq = 0.f;
            float m0[8], m1[8];
            lds_ld8(PRM + 0 * 64 + 8 * cg, m0); lds_ld8(PRM + 1 * 64 + 8 * cg, m1); SHIFT8(0, m0, m1, ks);
            lds_st8(KD + pj * 64 + 8 * cg, ks);
            lds_ld8(PRM + 12 * 64 + 8 * cg, m0);
#pragma unroll
            for (int i = 0; i < 8; ++i) { const float t = ks[i] * m0[i]; ks[i] = t; ssq += t * t; }
            ssq += __shfl_xor(ssq, 1); ssq += __shfl_xor(ssq, 2); ssq += __shfl_xor(ssq, 4);
            const float inv = __builtin_amdgcn_rcpf(fmaxf(sqrtf(ssq), 1e-12f));
#pragma unroll
            for (int i = 0; i < 8; ++i) ks[i] *= inv;
            lds_st8(KK + pj * 64 + 8 * cg, ks);
            lds_ld8(PRM + 2 * 64 + 8 * cg, m0); lds_ld8(PRM + 3 * 64 + 8 * cg, m1); SHIFT8(1, m0, m1, xs);
            lds_st8(Vv + pj * 64 + 8 * cg, xs);
            lds_ld8(PRM + 8 * 64 + 8 * cg, m0); lds_ld8(PRM + 9 * 64 + 8 * cg, m1); SHIFT8(4, m0, m1, xs);
            lds_st8(Rv + pj * 64 + 8 * cg, xs);
            lds_ld8(PRM + 4 * 64 + 8 * cg, m0); lds_ld8(PRM + 5 * 64 + 8 * cg, m1); SHIFT8(2, m0, m1, xs);
            { u32x4 w;
#pragma unroll
              for (int i = 0; i < 8; ++i) { const float e2 = __expf(2.f * xs[i]); xs[i] = 1.f - 2.f / (e2 + 1.f); }
              w.x = cvt_pk_bf16(xs[0], xs[1]); w.y = cvt_pk_bf16(xs[2], xs[3]); w.z = cvt_pk_bf16(xs[4], xs[5]); w.w = cvt_pk_bf16(xs[6], xs[7]);
              *(LAS u32x4*)(TW + pj * 64 + 8 * cg) = w; }
            lds_ld8(PRM + 6 * 64 + 8 * cg, m0); lds_ld8(PRM + 7 * 64 + 8 * cg, m1); SHIFT8(3, m0, m1, xs);
            { u32x4 w; w.x = cvt_pk_bf16(xs[0], xs[1]); w.y = cvt_pk_bf16(xs[2], xs[3]); w.z = cvt_pk_bf16(xs[4], xs[5]); w.w = cvt_pk_bf16(xs[6], xs[7]);
              *(LAS u32x4*)(TA + pj * 64 + 8 * cg) = w; }
#undef SHIFT8
        }
        if (blk + 1 < 68) LOADRAW(blk + 1);
        __syncthreads(); SC_T(1);
        {
            const LAS bf16_t* T = mtx == 0 ? TW : TA;
            f32x16 cacc = f32x16{};
#pragma unroll
            for (int s = 0; s < 4; ++s) { const bf16x8 af = *(const LAS bf16x8*)(T + (32 * ti + r32) * 64 + 16 * s + 8 * hi);
                cacc = __builtin_amdgcn_mfma_f32_32x32x16_bf16(af, bw[s], cacc, 0, 0, 0); }
            const int ch = 32 * tj + r32; const int eb = (32 * ti + 4 * hi) * 64 + ch;
            if (mtx == 0) { const float pw = PRM[10 * 64 + ch];
#pragma unroll
                for (int r = 0; r < 16; ++r) { const int e = eb + ((r & 3) + 8 * (r >> 2)) * 64; W[e] = __expf(-0.60653065971263342f * sigmoidf_(pw + cacc[r])); }
            } else { const float pa_ = PRM[11 * 64 + ch], pka = PRM[13 * 64 + ch];
                float kdv[16], kkv[16];
#pragma unroll
                for (int r = 0; r < 16; ++r) { const int e = eb + ((r & 3) + 8 * (r >> 2)) * 64; kdv[r] = KD[e]; kkv[r] = KK[e]; }
#pragma unroll
                for (int r = 0; r < 16; ++r) { const int e = eb + ((r & 3) + 8 * (r >> 2)) * 64; const float a = sigmoidf_(pa_ + cacc[r]);
                    KD[e] = kdv[r] * (1.f + (a - 1.f) * pka); Bv[e] = kkv[r] * a; }
            }
        }
        __syncthreads(); SC_T(3);
        {
            const int kcol = tl_ & 63, seg = wid; float p[8], run = 1.f;
#pragma unroll
            for (int i = 0; i < 8; ++i) { run *= W[(8 * seg + i) * 64 + kcol]; p[i] = run; }
            GT[seg * 64 + kcol] = run;
            __syncthreads();
            float pre = 1.f;
#pragma unroll
            for (int sg2 = 0; sg2 < 7; ++sg2) { const float tv = GT[sg2 * 64 + kcol]; if (sg2 < seg) pre *= tv; }
#pragma unroll
            for (int i = 0; i < 8; ++i) W[(8 * seg + i) * 64 + kcol] = pre * p[i];
        }
        __syncthreads();
        {
            const int o8 = pj * 64 + 8 * cg;
            float g[8], gx[8], kk[8], rr[8], bb[8], kd[8];
            lds_ld8(W + o8, g); if (pj > 0) lds_ld8(W + o8 - 64, gx); else {
#pragma unroll
                for (int i = 0; i < 8; ++i) gx[i] = 1.f; }
            lds_ld8(KK + o8, kk); lds_ld8(Rv + o8, rr); lds_ld8(Bv + o8, bb); lds_ld8(KD + o8, kd);
            {
                float p14[8]; lds_ld8(PRM + 14 * 64 + 8 * cg, p14); float bsum = 0.f;
#pragma unroll
                for (int i = 0; i < 8; ++i) bsum += rr[i] * kd[i] * p14[i];
                bsum += __shfl_xor(bsum, 1); bsum += __shfl_xor(bsum, 2); bsum += __shfl_xor(bsum, 4);
                const int row = d == 0 ? r0 + pj : r0 + 63 - pj;
                if (cg == 0) P.bon[(size_t)d * MT * 8 + (size_t)row * 8 + hh] = bsum; }
            const int kc2 = tl_ & 63, tc2 = wid;
            float g2[8], kd2[8], bb2[8], vv2[8]; const float gc2 = W[63 * 64 + kc2];
#pragma unroll
            for (int i = 0; i < 8; ++i) { const int o = (8 * tc2 + i) * 64 + kc2; g2[i] = W[o]; kd2[i] = KD[o]; bb2[i] = Bv[o]; vv2[i] = Vv[o]; }
            __syncthreads();
            u32x4 w;
#define PK8(EXPR) do { float e_[8]; _Pragma("unroll") for (int i = 0; i < 8; ++i) e_[i] = (EXPR); w.x = cvt_pk_bf16(e_[0], e_[1]); w.y = cvt_pk_bf16(e_[2], e_[3]); w.z = cvt_pk_bf16(e_[4], e_[5]); w.w = cvt_pk_bf16(e_[6], e_[7]); } while (0)
            const int ao = attn::kswz(pj, cg);
            PK8(kk[i] * gx[i]); *(LAS u32x4*)(lds + C_AT + ao) = w;
            PK8(rr[i] * g[i]);  *(LAS u32x4*)(lds + C_RT + ao) = w;
            float ig[8];
#pragma unroll
            for (int i = 0; i < 8; ++i) ig[i] = __builtin_amdgcn_rcpf(g[i]);
            PK8(bb[i] * ig[i]); *(LAS u32x4*)(lds + C_BT + ao) = w;
            PK8(kd[i] * ig[i]); *(LAS u32x4*)(lds + C_KT + ao) = w;
            const int ao2 = attn::kswz(kc2, tc2);
#pragma unroll
            for (int i = 0; i < 8; ++i) ig[i] = gc2 * __builtin_amdgcn_rcpf(g2[i]);
            PK8(kd2[i] * ig[i]); *(LAS u32x4*)(lds + C_KHT + ao2) = w;
            PK8(bb2[i] * ig[i]); *(LAS u32x4*)(lds + C_BHT + ao2) = w;
            PK8(vv2[i]);               *(LAS u32x4*)(lds + C_VT + ao2) = w;
            if (tc2 == 7) GC[kc2] = gc2;
#undef PK8
        }
        __syncthreads(); SC_T(4);
#define FRAG(ARR, ROW, CH) (*(const LAS bf16x8*)(lds + (ARR) + attn::kswz((ROW), (CH))))
        {
            const int tr = wid >> 1, ti = tr & 1; const int Aarr = tr < 2 ? C_AT : C_RT;
#pragma unroll
            for (int h2 = 0; h2 < 2; ++h2) { const int tc = 2 * (wid & 1) + h2, tj = tc & 1; const int Barr = tc < 2 ? C_BT : C_KT;
                f32x16 acc = f32x16{};
#pragma unroll
                for (int q = 0; q < 4; ++q) acc = __builtin_amdgcn_mfma_f32_32x32x16_bf16(FRAG(Barr, 32 * tj + r32, 2 * q + hi), FRAG(Aarr, 32 * ti + r32, 2 * q + hi), acc, 0, 0, 0);
                const int t = 32 * ti + r32;
                const int d0 = 32 * tj + 4 * hi - t - (tr < 2 ? 0 : 1);
                if (tr < 2 && tc < 2) {
                    LAS float* lp = (LAS float*)(lds + C_LAB) + (32 * tj + 4 * hi) * LABP + (t & 3) * 16 + (t >> 2);
#pragma unroll
                    for (int r = 0; r < 16; ++r) { const int e = (r & 3) + 8 * (r >> 2); const unsigned mk = (unsigned)((d0 + e) >> 31);
                        lp[e * LABP] = __uint_as_float(__float_as_uint(acc[r]) & mk); }
                } else {
                    const int dst = tr < 2 ? C_LAK : (tc < 2 ? C_MRB : C_MRK);
#pragma unroll
                    for (int gq = 0; gq < 4; ++gq) { const int tp0 = 32 * tj + 8 * gq + 4 * hi; float vv4[4];
#pragma unroll
                        for (int e = 0; e < 4; ++e) { const unsigned mk = (unsigned)((d0 + 8 * gq + e) >> 31); vv4[e] = __uint_as_float(__float_as_uint(acc[4 * gq + e]) & mk); }
                        u32x2 w2; w2.x = cvt_pk_bf16(vv4[0], vv4[1]); w2.y = cvt_pk_bf16(vv4[2], vv4[3]);
                        *(LAS u32x2*)(lds + dst + attn::kswz(t, tp0 >> 3) + (tp0 & 7) * 2) = w2; }
                }
            }
        }
        __syncthreads(); SC_T(5);
        if (wid < 4) {
            const int ti = wid >> 1, tj = wid & 1; f32x16 acc = f32x16{};
#pragma unroll
            for (int q = 0; q < 4; ++q) acc = __builtin_amdgcn_mfma_f32_32x32x16_bf16(FRAG(C_S0B, 32 * tj + r32, 2 * q + hi), FRAG(C_AT, 32 * ti + r32, 2 * q + hi), acc, 0, 0, 0);
#pragma unroll
            for (int q = 0; q < 4; ++q) acc = __builtin_amdgcn_mfma_f32_32x32x16_bf16(FRAG(C_VT, 32 * tj + r32, 2 * q + hi), FRAG(C_LAK, 32 * ti + r32, 2 * q + hi), acc, 0, 0, 0);
            const int t = 32 * ti + r32;
#pragma unroll
            for (int r = 0; r < 16; ++r) { const int v = 32 * tj + (r & 3) + 8 * (r >> 2) + 4 * hi; *(LAS float*)(lds + C_RHS + (v * RHSP + (t & 3) * 16 + (t >> 2)) * 4) = acc[r]; }
        }
        else {
                const int ti = (wid >> 1) & 1, tj = wid & 1; const float gcv = GC[32 * tj + r32];
#pragma unroll
                for (int r = 0; r < 16; ++r) Sreg[r] *= gcv;
#pragma unroll
                for (int q = 0; q < 4; ++q) Sreg = __builtin_amdgcn_mfma_f32_32x32x16_bf16(FRAG(C_VT, 32 * ti + r32, 2 * q + hi), FRAG(C_KHT, 32 * tj + r32, 2 * q + hi), Sreg, 0, 0, 0);
        }
        __syncthreads(); SC_T(6);
        f32x16 Yacc = f32x16{}; bf16x8 mrb[4] = {};
        if (wid >= 4) {
            const int q = lane & 3, v = 16 * (wid - 4) + (lane >> 2);
            const LAS float* LT = (const LAS float*)(lds + C_LAB) + q * 16;
            f32x2 sa[8]; float zo[16];
            { const LAS f32x4* rp = (const LAS f32x4*)(lds + C_RHS + (v * RHSP + q * 16) * 4);
#pragma unroll
              for (int g4 = 0; g4 < 4; ++g4) { const f32x4 x = rp[g4]; sa[2 * g4] = (f32x2){x[0], x[1]}; sa[2 * g4 + 1] = (f32x2){x[2], x[3]}; } }
#pragma unroll
            for (int i = 0; i < 16; ++i) zo[i] = 0.f;
            f32x4 la[4], lb[4];
#define LLOAD(t, A) do { const LAS f32x4* lp_ = (const LAS f32x4*)(LT + (t) * LABP); _Pragma("unroll") for (int g_ = (t) >> 4; g_ < 4; ++g_) A[g_] = lp_[g_]; } while (0)
#define SOLVE_STEP(t, A, N) do { if ((t) < 63) LLOAD((t) + 1, N); const float zown_ = (((t) >> 2) & 1) ? sa[(t) >> 3].y : sa[(t) >> 3].x; \
                const float zt_ = __builtin_bit_cast(float, __builtin_amdgcn_update_dpp(0, __builtin_bit_cast(int, zown_), ((t) & 3) * 0x55, 0xf, 0xf, true)); \
                if (q == ((t) & 3)) zo[(t) >> 2] = zt_; const f32x2 nz_ = {-zt_, -zt_}; \
                _Pragma("unroll") for (int p_ = (t) >> 3; p_ < 8; ++p_) { const f32x2 l2_ = (p_ & 1) ? (f32x2){A[p_ >> 1][2], A[p_ >> 1][3]} : (f32x2){A[p_ >> 1][0], A[p_ >> 1][1]}; sa[p_] = l2_ * nz_ + sa[p_]; } } while (0)
#define SOLVE2(t) SOLVE_STEP(t, la, lb); SOLVE_STEP((t) + 1, lb, la)
#define SOLVE8(t) SOLVE2(t); SOLVE2((t) + 2); SOLVE2((t) + 4); SOLVE2((t) + 6)
            LLOAD(0, la);
            SOLVE8(0); SOLVE8(8); SOLVE8(16); SOLVE8(24); SOLVE8(32); SOLVE8(40); SOLVE8(48); SOLVE8(56);
#undef SOLVE8
#undef SOLVE2
#undef SOLVE_STEP
#undef LLOAD
#pragma unroll
            for (int i = 0; i < 16; ++i) { const int t = 4 * i + q; *(LAS bf16_t*)(lds + C_ZN + attn::kswz(v, t >> 3) + (t & 7) * 2) = (bf16_t)(cvt_pk_bf16(-zo[i], 0.f) & 0xffffu); }
        } else {
            const int ti = wid >> 1, tj = wid & 1;
#pragma unroll
            for (int q = 0; q < 4; ++q) mrb[q] = FRAG(C_MRB, 32 * ti + r32, 2 * q + hi);
#pragma unroll
            for (int q = 0; q < 4; ++q) Yacc = __builtin_amdgcn_mfma_f32_32x32x16_bf16(FRAG(C_RT, 32 * ti + r32, 2 * q + hi), FRAG(C_S0B, 32 * tj + r32, 2 * q + hi), Yacc, 0, 0, 0);
#pragma unroll
            for (int q = 0; q < 4; ++q) Yacc = __builtin_amdgcn_mfma_f32_32x32x16_bf16(FRAG(C_MRK, 32 * ti + r32, 2 * q + hi), FRAG(C_VT, 32 * tj + r32, 2 * q + hi), Yacc, 0, 0, 0);
        }
        __syncthreads(); SC_T(7);
        if (wid < 4) {
            const int ti = wid >> 1, tj = wid & 1;
#pragma unroll
            for (int q = 0; q < 4; ++q) Yacc = __builtin_amdgcn_mfma_f32_32x32x16_bf16(mrb[q], FRAG(C_ZN, 32 * tj + r32, 2 * q + hi), Yacc, 0, 0, 0);
            bf16_t* yb = P.y + (size_t)d * MT * 512 + hh * 64 + 32 * tj + r32;
#pragma unroll
            for (int r = 0; r < 16; ++r) { const int t = 32 * ti + (r & 3) + 8 * (r >> 2) + 4 * hi; const int row = d == 0 ? r0 + t : r0 + 63 - t;
                yb[(size_t)row * 512] = (bf16_t)(cvt_pk_bf16(Yacc[r], 0.f) & 0xffffu); }
            SC_T(8);
        } else {
            const int ti = (wid >> 1) & 1, tj = wid & 1; const int k = 32 * tj + r32;
#pragma unroll
            for (int q = 0; q < 4; ++q) Sreg = __builtin_amdgcn_mfma_f32_32x32x16_bf16(FRAG(C_ZN, 32 * ti + r32, 2 * q + hi), FRAG(C_BHT, 32 * tj + r32, 2 * q + hi), Sreg, 0, 0, 0);
#pragma unroll
            for (int r = 0; r < 16; ++r) { const int v = 32 * ti + (r & 3) + 8 * (r >> 2) + 4 * hi;
                *(LAS bf16_t*)(lds + C_S0B + attn::kswz(v, k >> 3) + (k & 7) * 2) = (bf16_t)(cvt_pk_bf16(Sreg[r], 0.f) & 0xffffu); }
        }
#undef FRAG
    }
    __syncthreads();
}
#undef ROR_ADD
}
struct Frame {
    LAS unsigned char* lds; char* ldsg; volatile LAS unsigned* MISC; gu32* ctl;
    int tid, lane, wave, G, gw, NGW;
    const float* x_in; const float* ctx_in; float* out; unsigned char* ws;
};
enum { I_X = 0, I_C, I_CTX, I_CCTX, I_ADAW, I_ADAB, I_WIN, I_LAMQK, I_SUBLN, I_MU, I_W0, I_W2, I_A0, I_A2, I_G2, I_KK, I_KA, I_RK, I_LNW, I_LNB,
       I_WPA, I_WPF, I_WPC, I_WO, I_LN1G, I_LN1B, I_FUP, I_FCONV, I_FCONVB, I_FDN, I_LN2G, I_LN2B };

struct Row16 { f32x4 v[4]; };
__device__ __forceinline__ void row_load_f32(Row16& r, const float* p, int lane) {
#pragma unroll
    for (int j = 0; j < 4; ++j) r.v[j] = *(const f32x4*)(p + 256 * j + 4 * lane);
}
__device__ __forceinline__ void row_load_bf16(Row16& r, const bf16_t* p, int lane) {
#pragma unroll
    for (int j = 0; j < 4; ++j) { const u32x2 w = *(const u32x2*)(p + 256 * j + 4 * lane); r.v[j] = (f32x4){bflo(w.x), bfhi(w.x), bflo(w.y), bfhi(w.y)}; }
}
__device__ __forceinline__ void row_store_f32(const Row16& r, float* p, int lane) {
#pragma unroll
    for (int j = 0; j < 4; ++j) *(f32x4*)(p + 256 * j + 4 * lane) = r.v[j];
}
__device__ __forceinline__ void row_store_bf16(const Row16& r, bf16_t* p, int lane) {
#pragma unroll
    for (int j = 0; j < 4; ++j) { u32x2 w; w.x = cvt_pk_bf16(r.v[j][0], r.v[j][1]); w.y = cvt_pk_bf16(r.v[j][2], r.v[j][3]); *(u32x2*)(p + 256 * j + 4 * lane) = w; }
}
__device__ __forceinline__ void row_ln_plain(Row16& r) {
    float s = 0.f;
#pragma unroll
    for (int j = 0; j < 4; ++j) s += (r.v[j][0] + r.v[j][1]) + (r.v[j][2] + r.v[j][3]);
    const float mean = wave_sum(s) * (1.f / DM); float q = 0.f;
#pragma unroll
    for (int j = 0; j < 4; ++j) { r.v[j] = r.v[j] - mean; q += (r.v[j][0] * r.v[j][0] + r.v[j][1] * r.v[j][1]) + (r.v[j][2] * r.v[j][2] + r.v[j][3] * r.v[j][3]); }
    const float rstd = 1.0f / sqrtf(wave_sum(q) * (1.f / DM) + LN_EPS);
#pragma unroll
    for (int j = 0; j < 4; ++j) r.v[j] = r.v[j] * rstd;
}
__device__ __forceinline__ void row_affine(Row16& r, const float* g, const float* b, int lane, float gadd) {
#pragma unroll
    for (int j = 0; j < 4; ++j) { const f32x4 gg = *(const f32x4*)(g + 256 * j + 4 * lane), bb = *(const f32x4*)(b + 256 * j + 4 * lane); r.v[j] = r.v[j] * (gg + gadd) + bb; }
}
__device__ __forceinline__ const float* modrow(const Frame& F, int layer, int row) { return (const float*)(F.ws + TAB_MOD) + ((size_t)layer * 5 + (row < ML ? (row >> 12) : 4)) * 6144; }
__device__ __forceinline__ const float* xrow_in(const Frame& F, int layer, int row) {
    if (layer == 0) return row < ML ? F.x_in + (size_t)row * DM : F.ctx_in + (size_t)(row - ML) * DM;
    return row < ML ? F.out + (size_t)row * DM : (const float*)(F.ws + WS_XC) + (size_t)(row - ML) * DM;
}
__device__ __forceinline__ float* xrow_out(const Frame& F, int row) { return row < ML ? F.out + (size_t)row * DM : (float*)(F.ws + WS_XC) + (size_t)(row - ML) * DM; }

__device__ __forceinline__ void pass_modulate(const Frame& F0, int layer, bf16_t* dst, int nrows, int row_lo = 0) {
    Frame F = F0; F.lane = fresh_lane(); F.tid = (F.wave << 6) | F.lane;
    for (int row = row_lo + F.gw; row < nrows; row += F.NGW) {
        Row16 r; row_load_f32(r, xrow_in(F, layer, row), F.lane); row_ln_plain(r);
        const float* mv = modrow(F, layer, row); row_affine(r, mv + 1024, mv, F.lane, 1.f);
        row_store_bf16(r, dst + (size_t)row * DM, F.lane);
    }
}
__device__ __forceinline__ void pass_ln1(Frame F, int layer, const bf16_t* mix, bf16_t* h2, int nrows, const float* g, const float* bt) {
    F.lane = fresh_lane(); F.tid = (F.wave << 6) | F.lane;
    for (int row0 = F.gw; row0 < nrows; row0 += 2 * F.NGW) {
        const int row1 = row0 + F.NGW; const bool two = row1 < nrows; const int rowb = two ? row1 : row0;
        Row16 ra, ma, rb, mb; row_load_f32(ra, xrow_in(F, layer, row0), F.lane); row_load_bf16(ma, mix + (size_t)row0 * DM, F.lane);
        row_load_f32(rb, xrow_in(F, layer, rowb), F.lane); row_load_bf16(mb, mix + (size_t)rowb * DM, F.lane);
        const float* mva = modrow(F, layer, row0); const float* mvb = modrow(F, layer, rowb);
#pragma unroll
        for (int j = 0; j < 4; ++j) { f32x4 gt = *(const f32x4*)(mva + 2048 + 256 * j + 4 * F.lane); if (DBG_ZERO_MIX) gt = gt * 0.f; ra.v[j] = ra.v[j] * ALPHA + gt * ma.v[j];
            f32x4 gu = *(const f32x4*)(mvb + 2048 + 256 * j + 4 * F.lane); if (DBG_ZERO_MIX) gu = gu * 0.f; rb.v[j] = rb.v[j] * ALPHA + gu * mb.v[j]; }
        row_ln_plain(ra); row_ln_plain(rb); row_affine(ra, g, bt, F.lane, 0.f); row_affine(rb, g, bt, F.lane, 0.f);
        row_store_f32(ra, xrow_out(F, row0), F.lane); if (two) row_store_f32(rb, xrow_out(F, row1), F.lane);
        row_ln_plain(ra); row_ln_plain(rb); row_affine(ra, mva + 4096, mva + 3072, F.lane, 1.f); row_affine(rb, mvb + 4096, mvb + 3072, F.lane, 1.f);
        row_store_bf16(ra, h2 + (size_t)row0 * DM, F.lane); if (two) row_store_bf16(rb, h2 + (size_t)row1 * DM, F.lane);
    }
}
__device__ __forceinline__ void pass_ln2(Frame F, int layer, bf16_t* ffn_h, int nrows, bool next_h, const float* g, const float* bt) {
    F.lane = fresh_lane(); F.tid = (F.wave << 6) | F.lane;
    for (int row0 = F.gw; row0 < nrows; row0 += 2 * F.NGW) {
        const int row1 = row0 + F.NGW; const bool two = row1 < nrows; const int rowb = two ? row1 : row0;
        Row16 ra, ma, rb, mb; float* xa = xrow_out(F, row0); float* xb = xrow_out(F, rowb);
        row_load_f32(ra, xa, F.lane); row_load_bf16(ma, ffn_h + (size_t)row0 * DM, F.lane); row_load_f32(rb, xb, F.lane); row_load_bf16(mb, ffn_h + (size_t)rowb * DM, F.lane);
        const float* mva = modrow(F, layer, row0); const float* mvb = modrow(F, layer, rowb);
#pragma unroll
        for (int j = 0; j < 4; ++j) { f32x4 gt = *(const f32x4*)(mva + 5120 + 256 * j + 4 * F.lane); if (DBG_ZERO_FFN) gt = gt * 0.f; ra.v[j] = ra.v[j] * ALPHA + gt * ma.v[j];
            f32x4 gu = *(const f32x4*)(mvb + 5120 + 256 * j + 4 * F.lane); if (DBG_ZERO_FFN) gu = gu * 0.f; rb.v[j] = rb.v[j] * ALPHA + gu * mb.v[j]; }
        row_ln_plain(ra); row_ln_plain(rb); row_affine(ra, g, bt, F.lane, 0.f); row_affine(rb, g, bt, F.lane, 0.f);
        row_store_f32(ra, xa, F.lane); if (two) row_store_f32(rb, xb, F.lane);
        if (next_h) { const float* mna = modrow(F, layer + 1, row0); const float* mnb = modrow(F, layer + 1, rowb);
            row_ln_plain(ra); row_ln_plain(rb); row_affine(ra, mna + 1024, mna, F.lane, 1.f); row_affine(rb, mnb + 1024, mnb, F.lane, 1.f);
            row_store_bf16(ra, ffn_h + (size_t)row0 * DM, F.lane); if (two) row_store_bf16(rb, ffn_h + (size_t)row1 * DM, F.lane); }
    }
}
__device__ __forceinline__ float gelu_fast(float v) {
    const float av = fabsf(v), t = __builtin_amdgcn_rcpf(av * 0.2316418882f + 1.0f);
    float q = t * 0.5307027145f + (-0.7265760135f); q = q * t + 0.7107068705f; q = q * t + (-0.142248368f); q = q * t + 0.127414796f; q = q * t;
    const float e = __builtin_amdgcn_exp2f((v * v) * (-0.72134752044f)); const float m = v * (q * e);
    return v < 0.f ? m : v - m;
}
__device__ __forceinline__ void pass_conv(Frame F, bf16_t* ug, int nrows, const float* cw, const float* cb) {
    F.lane = fresh_lane(); F.tid = (F.wave << 6) | F.lane;
    const long total = (long)nrows * (DFF / 8), stride = (long)F.G * NTHREADS;
    for (long it = (long)blockIdx.x * NTHREADS + F.tid; it < total; it += stride) {
        const int row = (int)(it / (DFF / 8)), c = (int)(it % (DFF / 8)) * 8;
        int pos, len; if (row < ML) { pos = row & 4095; len = SEQ; } else { pos = (row - ML) & 255; len = CTXL; }
        const bool hp = pos > 0, hn = pos < len - 1;
        bf16_t* up = ug + (size_t)row * NP + c;
        float u[8], gc[8], gp[8], gn[8];
        rwkv::ld8(up, u); rwkv::ld8(up + DFF, gc); rwkv::ld8(up + DFF - (hp ? NP : 0), gp); rwkv::ld8(up + DFF + (hn ? NP : 0), gn);
        float o[8];
        float w0[8], w1[8], w2[8], bb[8];
        { const f32x4 a = *(const f32x4*)(cw + c), b = *(const f32x4*)(cw + c + 4); w0[0]=a[0];w0[1]=a[1];w0[2]=a[2];w0[3]=a[3];w0[4]=b[0];w0[5]=b[1];w0[6]=b[2];w0[7]=b[3]; }
        { const f32x4 a = *(const f32x4*)(cw + DFF + c), b = *(const f32x4*)(cw + DFF + c + 4); w1[0]=a[0];w1[1]=a[1];w1[2]=a[2];w1[3]=a[3];w1[4]=b[0];w1[5]=b[1];w1[6]=b[2];w1[7]=b[3]; }
        { const f32x4 a = *(const f32x4*)(cw + 2 * DFF + c), b = *(const f32x4*)(cw + 2 * DFF + c + 4); w2[0]=a[0];w2[1]=a[1];w2[2]=a[2];w2[3]=a[3];w2[4]=b[0];w2[5]=b[1];w2[6]=b[2];w2[7]=b[3]; }
        { const f32x4 a = *(const f32x4*)(cb + c), b = *(const f32x4*)(cb + c + 4); bb[0]=a[0];bb[1]=a[1];bb[2]=a[2];bb[3]=a[3];bb[4]=b[0];bb[5]=b[1];bb[6]=b[2];bb[7]=b[3]; }
#pragma unroll
        for (int i = 0; i < 8; ++i) {
            const float x = w0[i] * (hp ? gp[i] : 0.f) + w1[i] * gc[i] + w2[i] * (hn ? gn[i] : 0.f) + bb[i];
            o[i] = gelu_fast(x) * u[i];
        }
        u32x4 w; w.x = cvt_pk_bf16(o[0], o[1]); w.y = cvt_pk_bf16(o[2], o[3]); w.z = cvt_pk_bf16(o[4], o[5]); w.w = cvt_pk_bf16(o[6], o[7]);
        *(u32x4*)up = w;
    }
}

__device__ __forceinline__ void ldf8(const float* p, float (&o)[8]) { const f32x4 a = *(const f32x4*)p, b = *(const f32x4*)(p + 4); o[0]=a[0];o[1]=a[1];o[2]=a[2];o[3]=a[3];o[4]=b[0];o[5]=b[1];o[6]=b[2];o[7]=b[3]; }
__device__ __forceinline__ void pass_sg(Frame F, bf16_t* co, int nrows, const float* mu) {
    F.lane = fresh_lane(); F.tid = (F.wave << 6) | F.lane;
    const int sub = F.lane >> 4, cl = (F.lane & 15) * 8;
    float m0[8], m1[8]; ldf8(mu + 1280 + 512 + cl, m0); ldf8(mu + 1920 + 1280 + 512 + cl, m1);
    for (int row = 4 * F.gw + sub; row < nrows; row += 4 * F.NGW) {
        int pos, len; if (row < ML) { pos = row & 4095; len = SEQ; } else { pos = (row - ML) & 255; len = CTXL; }
        const bool hp = pos > 0, hn = pos < len - 1;
        bf16_t* p = co + (size_t)row * DCOP + 512 + cl;
        float c[8], pv[8], nv[8], o[8]; rwkv::ld8(p, c); rwkv::ld8(p - (hp ? DCOP : 0), pv); rwkv::ld8(p + (hn ? DCOP : 0), nv);
#pragma unroll
        for (int i = 0; i < 8; ++i) { const float a = hp ? pv[i] : 0.f, b = hn ? nv[i] : 0.f; o[i] = sigmoidf_(c[i] + m0[i] * (a - c[i]) + m1[i] * (b - c[i])); }
        u32x4 w; w.x = cvt_pk_bf16(o[0], o[1]); w.y = cvt_pk_bf16(o[2], o[3]); w.z = cvt_pk_bf16(o[4], o[5]); w.w = cvt_pk_bf16(o[6], o[7]);
        *(u32x4*)(p + (DCO - 512)) = w;
    }
}
struct PostRow { u32x4 a0, a1, gg, vc, vp, vn; float bsum; };
__device__ __forceinline__ void post_load(PostRow& R, int row, int c, int head, const bf16_t* y0, const bf16_t* y1, const bf16_t* g, const bf16_t* cs, const float* bon) {
    int pos, len; if (row < ML) { pos = row & 4095; len = SEQ; } else { pos = (row - ML) & 255; len = CTXL; }
    const bool hp = pos > 0, hn = pos < len - 1; const size_t o = (size_t)row * 512 + c;
    R.a0 = *(const u32x4*)(y0 + o); R.a1 = *(const u32x4*)(y1 + o); R.gg = *(const u32x4*)(g + o);
    const bf16_t* vq = cs + (size_t)row * DCS + 512 + c;
    R.vc = *(const u32x4*)vq; R.vp = *(const u32x4*)(vq - (hp ? DCS : 0)); R.vn = *(const u32x4*)(vq + (hn ? DCS : 0));
    if (!hp) R.vp = (u32x4){0u, 0u, 0u, 0u}; if (!hn) R.vn = (u32x4){0u, 0u, 0u, 0u};
    R.bsum = bon[(size_t)row * 8 + head] + bon[(size_t)MT * 8 + (size_t)row * 8 + head];
}
__device__ __forceinline__ void up8(const u32x4 w, float (&o)[8]) { o[0] = bflo(w.x); o[1] = bfhi(w.x); o[2] = bflo(w.y); o[3] = bfhi(w.y); o[4] = bflo(w.z); o[5] = bfhi(w.z); o[6] = bflo(w.w); o[7] = bfhi(w.w); }
__device__ __forceinline__ u32x4 post_finish(const PostRow& R, const float (&lw)[8], const float (&lb)[8], const float (&m0)[8], const float (&m1)[8]) {
    float y[8], t[8], gv[8], vc[8], vp[8], vn[8]; up8(R.a0, y); up8(R.a1, t); up8(R.gg, gv); up8(R.vc, vc); up8(R.vp, vp); up8(R.vn, vn);
    float s = 0.f;
#pragma unroll
    for (int i = 0; i < 8; ++i) { y[i] += t[i]; s += y[i]; }
    s += __shfl_xor(s, 1); s += __shfl_xor(s, 2); s += __shfl_xor(s, 4);
    const float mean = s * (1.f / 64.f); float q = 0.f;
#pragma unroll
    for (int i = 0; i < 8; ++i) { y[i] -= mean; q += y[i] * y[i]; }
    q += __shfl_xor(q, 1); q += __shfl_xor(q, 2); q += __shfl_xor(q, 4);
    const float rstd = 1.0f / sqrtf(q * (1.f / 64.f) + 64.f * 1e-5f);
#pragma unroll
    for (int i = 0; i < 8; ++i) { const float vs = vc[i] + m0[i] * (vp[i] - vc[i]) + m1[i] * (vn[i] - vc[i]); y[i] = (y[i] * rstd * lw[i] + lb[i] + R.bsum * vs) * gv[i]; }
    u32x4 w; w.x = cvt_pk_bf16(y[0], y[1]); w.y = cvt_pk_bf16(y[2], y[3]); w.z = cvt_pk_bf16(y[4], y[5]); w.w = cvt_pk_bf16(y[6], y[7]);
    return w;
}
__device__ __forceinline__ void pass_post(Frame F, int nrows, bf16_t* y0, const bf16_t* y1, const bf16_t* g, const bf16_t* cs, const float* bon, const float* mu, const float* lnw, const float* lnb) {
    F.lane = fresh_lane(); F.tid = (F.wave << 6) | F.lane;
    const int c = 8 * F.lane, head = F.lane >> 3;
    float lw[8], lb[8], m0[8], m1[8]; ldf8(lnw + c, lw); ldf8(lnb + c, lb); ldf8(mu + 512 + c, m0); ldf8(mu + 1920 + 512 + c, m1);
    for (int row0 = F.gw; row0 < nrows; row0 += 2 * F.NGW) {
        const int row1 = row0 + F.NGW; const bool two = row1 < nrows; const int rowb = two ? row1 : row0;
        PostRow A, B; post_load(A, row0, c, head, y0, y1, g, cs, bon); post_load(B, rowb, c, head, y0, y1, g, cs, bon);
        const u32x4 wa = post_finish(A, lw, lb, m0, m1), wb = post_finish(B, lw, lb, m0, m1);
        *(u32x4*)(y0 + (size_t)row0 * 512 + c) = wa; if (two) *(u32x4*)(y0 + (size_t)row1 * 512 + c) = wb;
    }
}

__device__ __forceinline__ unsigned f2bf(float f) { unsigned u = __builtin_bit_cast(unsigned, f); return (u + 0x7fffu + ((u >> 16) & 1u)) >> 16; }
__device__ __forceinline__ unsigned pk2(float lo, float hi) { return f2bf(lo) | (f2bf(hi) << 16); }
__device__ __forceinline__ void transpose_item(const float* W, int K, int N, bf16_t* WT, int item, LAS float* scr, int lane, int rowadd_from, int rowadd) {
    const int nblk = N / 32, kb = item / nblk, nb = item % nblk, k0 = 64 * kb, n0 = 32 * nb;
    const int row_off = n0 >= rowadd_from ? rowadd : 0;
    float wv[32];
#pragma unroll
    for (int i = 0; i < 32; ++i) { const int kk = 2 * i + (lane >> 5); wv[i] = W[(size_t)(k0 + kk) * N + n0 + (lane & 31)]; }
#pragma unroll
    for (int i = 0; i < 32; ++i) { const int kk = 2 * i + (lane >> 5); scr[kk * 33 + (lane & 31)] = wv[i]; }
    LDS_WAIT(); asm volatile("" ::: "memory");
    const int c = lane & 7;
#pragma unroll
    for (int j = 0; j < 4; ++j) { const int n = (lane >> 3) + 8 * j; const LAS float* s = scr + (8 * c) * 33 + n;
        u32x4 o; o.x = pk2(s[0 * 33], s[1 * 33]); o.y = pk2(s[2 * 33], s[3 * 33]); o.z = pk2(s[4 * 33], s[5 * 33]); o.w = pk2(s[6 * 33], s[7 * 33]);
        *(GAS u32x4*)(WT + (size_t)(row_off + n0 + n) * K + k0 + 8 * c) = o; }
    LDS_WAIT(); asm volatile("" ::: "memory");
}
#define CONVERT_WEIGHTS(F, layer, INP) do { \
    convert_weights_((F), (layer), INP(I_WIN), INP(I_WPA), INP(I_WPF), INP(I_WPC), INP(I_WO), INP(I_FUP), INP(I_FDN), INP(I_G2)); } while (0)
__device__ __forceinline__ void convert_weights_(const Frame& F_, int layer, const float* p_win, const float* p_wpa, const float* p_wpf, const float* p_wpc, const float* p_wo, const float* p_fup, const float* p_fdn, const float* p_g2) {
    Frame F = F_; F.lane = fresh_lane(); F.tid = (F.wave << 6) | F.lane;
    LAS float* scr = (LAS float*)(F.lds + F.wave * 16384);
    constexpr int N_IN = 16 * (D_IN_SRC / 32), N_PA = 16 * 32, N_PF = 8 * 32, N_PC = 8 * 32, N_O = 16 * 32, N_UP = 16 * (2 * DFF / 32), N_DN = (DFF / 64) * 32, N_G2 = 2 * 16;
    constexpr int NITEMS = N_IN + N_PA + N_PF + N_PC + N_O + N_UP + N_DN + N_G2;
    unsigned char* ws = F.ws;
    for (int it = F.gw; it < NITEMS; it += F.NGW) {
        int r = it;
        if (r < N_IN) { transpose_item(p_win + (size_t)layer * DM * D_IN_SRC, DM, D_IN_SRC, (bf16_t*)(ws + W_IN), r, scr, F.lane, 5504, 128); continue; } r -= N_IN;
        if (r < N_PA) { transpose_item(p_wpa + (size_t)layer * 1024 * DM, 1024, DM, (bf16_t*)(ws + W_PA), r, scr, F.lane, 1 << 30, 0); continue; } r -= N_PA;
        if (r < N_PF) { transpose_item(p_wpf + (size_t)layer * 512 * DM, 512, DM, (bf16_t*)(ws + W_PF), r, scr, F.lane, 1 << 30, 0); continue; } r -= N_PF;
        if (r < N_PC) { transpose_item(p_wpc + (size_t)layer * 512 * DM, 512, DM, (bf16_t*)(ws + W_PC), r, scr, F.lane, 1 << 30, 0); continue; } r -= N_PC;
        if (r < N_O) { transpose_item(p_wo + (size_t)layer * DM * DM, DM, DM, (bf16_t*)(ws + W_O), r, scr, F.lane, 1 << 30, 0); continue; } r -= N_O;
        if (r < N_UP) { transpose_item(p_fup + (size_t)layer * DM * 2 * DFF, DM, 2 * DFF, (bf16_t*)(ws + W_UP), r, scr, F.lane, 1 << 30, 0); continue; } r -= N_UP;
        if (r < N_DN) { transpose_item(p_fdn + (size_t)layer * DFF * DM, DFF, DM, (bf16_t*)(ws + W_DN), r, scr, F.lane, 1 << 30, 0); continue; } r -= N_DN;
        transpose_item(p_g2 + (size_t)layer * 128 * 512, 128, 512, (bf16_t*)(ws + W_G2T), r, scr, F.lane, 1 << 30, 0);
    }
    { u32x4* z = (u32x4*)(ws + W_IN + (size_t)5504 * DM * 2); const int n16 = 128 * DM * 2 / 16;
      unsigned zz = 0u; asm volatile("" : "+v"(zz));
      for (int i = blockIdx.x * NTHREADS + F.tid; i < n16; i += F.G * NTHREADS) z[i] = (u32x4){zz, zz, zz, zz}; }
}
__device__ __forceinline__ void build_tables(Frame F, const float* lamqk) {
    F.lane = fresh_lane(); F.tid = (F.wave << 6) | F.lane;
    const int gt = blockIdx.x * NTHREADS + F.tid, NT_ = F.G * NTHREADS;
    float* rope = (float*)(F.ws + TAB_ROPE); float* tw = (float*)(F.ws + TAB_TW);
    bf16_t* w0 = (bf16_t*)(F.ws + TAB_W0); bf16_t* f1 = (bf16_t*)(F.ws + TAB_F1); bf16_t* f2 = (bf16_t*)(F.ws + TAB_F2); bf16_t* dc = (bf16_t*)(F.ws + TAB_DC);
    for (int i = gt; i < 1024; i += NT_) { const int pos = i >> 4, f = i & 15; const float inv = powf(10000.f, -(float)f / 16.f); const float ang = (float)pos * inv;
        rope[2 * i] = (float)cos((double)ang); rope[2 * i + 1] = (float)sin((double)ang); }
    for (int i = gt; i < 4096; i += NT_) { const int kl = i >> 6, tl = i & 63; float s, c; sincospif(2.f * (float)(kl * tl) / 4096.f, &s, &c); tw[2 * i] = c; tw[2 * i + 1] = s; }
    for (int i = gt; i < 256 * 128; i += NT_) { const int r = i >> 7, c = i & 127, ri = r >> 7, m = r & 127; float s, co; sincospif(2.f * (float)((m * c) & 127) / 128.f, &s, &co);
        w0[i] = (bf16_t)f2bf((ri == 0 ? co : -s) * 0.088388347648318f); }
    for (int i = gt; i < 256 * 256; i += NT_) { const int r = i >> 8, k = i & 255; const int rip = r >> 7, p = (r >> 6) & 1, kl = r & 63, ri = k >> 7, p2 = (k >> 6) & 1, th = k & 63;
        float s, co; sincospif(2.f * (float)((kl * th) & 63) / 64.f, &s, &co);
        float v = 0.f; if (p == p2) v = (rip == ri) ? co : (rip == 0 ? s : -s);
        f1[i] = (bf16_t)f2bf(v * 0.125f); }
    for (int i = gt; i < 256 * 512; i += NT_) { const int r = i >> 9, k = i & 511; const int pp = r >> 6, kh = r & 63, rip = k >> 8, p2 = (k >> 6) & 3, tl = k & 63;
        float s, co; sincospif(2.f * (float)((kh * tl) & 63) / 64.f, &s, &co);
        const float v = (pp == p2) ? (rip == 0 ? co : s) : 0.f;
        f2[i] = (bf16_t)f2bf(v * 0.125f); }
    for (int i = gt; i < 256 * 512; i += NT_) { const int k = i >> 9, kk = i & 511, ri = kk >> 8, t = kk & 255;
        float s, co; sincospif(2.f * (float)((k * t) & 255) / 256.f, &s, &co);
        dc[i] = (bf16_t)f2bf((ri == 0 ? co : s) * 0.0625f); }
    if (gt < NLAYER) {
        const float* lq = lamqk + gt * 256; float s1 = 0.f, s2 = 0.f;
        for (int i = 0; i < 64; ++i) { s1 += lq[i] * lq[64 + i]; s2 += lq[128 + i] * lq[192 + i]; }
        const float lam_init = 0.8f - 0.6f * expf(-0.3f * (float)gt);
        float* lamv = (float*)(F.ws + TAB_LAM); lamv[2 * gt] = expf(s1) - expf(s2) + lam_init; lamv[2 * gt + 1] = 1.f - lam_init;
    }
}
__device__ __forceinline__ void build_mod(Frame F, const float* cvec, const float* cctx, const float* adaw, const float* adab) {
    F.lane = fresh_lane(); F.tid = (F.wave << 6) | F.lane;
    LAS float* sil = (LAS float*)F.lds;
    LAS float* part = sil + 5 * 1024;
    for (int i = F.tid; i < 5 * 1024; i += NTHREADS) { const int s = i >> 10, k = i & 1023; const float c = s < 4 ? cvec[s * 1024 + k] : cctx[k]; sil[i] = c / (1.f + expf(-c)); }
    __syncthreads();
    for (int cgid = blockIdx.x; cgid < 256; cgid += F.G) {
        const int l = cgid >> 7, j0 = (cgid & 127) * 48;
        if (F.tid < 384) { const int col = F.tid % 48, kg = F.tid / 48; const float* w = adaw + ((size_t)l * 1024 + 128 * kg) * 6144 + j0 + col;
            float a0 = 0.f, a1 = 0.f, a2 = 0.f, a3 = 0.f, a4 = 0.f;
            for (int k = 0; k < 128; ++k) { const float wv = w[(size_t)k * 6144]; const int kk = 128 * kg + k;
                a0 += sil[kk] * wv; a1 += sil[1024 + kk] * wv; a2 += sil[2048 + kk] * wv; a3 += sil[3072 + kk] * wv; a4 += sil[4096 + kk] * wv; }
            part[(kg * 5 + 0) * 48 + col] = a0; part[(kg * 5 + 1) * 48 + col] = a1; part[(kg * 5 + 2) * 48 + col] = a2; part[(kg * 5 + 3) * 48 + col] = a3; part[(kg * 5 + 4) * 48 + col] = a4; }
        __syncthreads();
        if (F.tid < 240) { const int s = F.tid / 48, col = F.tid % 48; float a = adab[l * 6144 + j0 + col];
            for (int kg = 0; kg < 8; ++kg) a += part[(kg * 5 + s) * 48 + col];
            ((float*)(F.ws + TAB_MOD))[((size_t)l * 5 + s) * 6144 + j0 + col] = a; }
        __syncthreads();
    }
}
#ifndef MK_PER_PHASE
#define MK_PER_PHASE 0
#endif
#ifndef TIME_SEL
#define TIME_SEL 0
#endif
constexpr int N_PHASES = 2 + 13 * NLAYER;
#ifndef SCAN_SEL
#define SCAN_SEL(bx) ((((bx) >> 3) & 3) == 0 && ((bx) >> 5) < 8)
#define SCAN_SID(bx) (((bx) >> 5) * 8 + ((bx) & 7))
#define SCAN_RANK(bx) ((bx) - 8 * (((bx) >> 5) + 1))
#endif
struct Args { const float* in[32]; float* out; unsigned char* ws; int ph_lo, ph_hi; };

__device__ __forceinline__ pg8::Operand opnd(const void* base, long tM, long tN, long rstride, long kstep) {
    pg8::Operand o; o.base = (const char*)base; o.tM = tM; o.tN = tN; o.tN2 = 0; o.nshift = 30; o.rstride = rstride; o.hstep = 128 * rstride; o.kstep = kstep; return o; }
constexpr int CW_SUB = 2048;
__device__ __forceinline__ void sub_arrive_wait(gu32* cnt, unsigned add, unsigned target, bool t0) {
    asm volatile("s_waitcnt vmcnt(0)" ::: "memory"); __syncthreads();
    if (t0) {
        __builtin_amdgcn_fence(__ATOMIC_RELEASE, "agent"); asm volatile("s_waitcnt vmcnt(0)" ::: "memory");
        if (add) (void)__hip_atomic_fetch_add(cnt, add, RLX_AGENT);
        unsigned sp = 0; while (__hip_atomic_load(cnt, RLX_AGENT) < target) { __builtin_amdgcn_s_sleep(2); if (++sp > (1u << 24)) break; }
        __builtin_amdgcn_fence(__ATOMIC_ACQUIRE, "agent"); asm volatile("s_waitcnt vmcnt(0)" ::: "memory");
    }
    __syncthreads();
}
struct RowF0 { __device__ __forceinline__ unsigned operator()(int R) const { return (unsigned)(((R & 63) * 64 + (R >> 6)) * 1024); } };

__global__ void __launch_bounds__(NTHREADS, 2) mk_fwd(Args args) {
    extern __shared__ __attribute__((aligned(16))) unsigned char lds[];
    Frame F;
    F.lds = (LAS unsigned char*)lds; F.ldsg = (char*)lds;
    F.MISC = (volatile LAS unsigned*)(F.lds + MISC_OFF);
    F.tid = threadIdx.x; F.lane = F.tid & 63; F.wave = __builtin_amdgcn_readfirstlane(F.tid >> 6);
    F.G = gridDim.x; F.gw = blockIdx.x * NWAVES + F.wave; F.NGW = F.G * NWAVES;
    F.x_in = args.in[I_X]; F.ctx_in = args.in[I_CTX];
    F.out = args.out; F.ws = args.ws; F.ctl = (gu32*)(args.ws + WS_CTL);
    unsigned char* ws0 = args.ws;
#define T0 (fresh_tid(F.wave) == 0)
#ifndef CH_WG
#define CH_WG 8
#endif
#ifndef SC_WG
#define SC_WG 0
#endif
#define CH_T(k) do { if ((TIME_SEL >> 20) != 0) { if (blockIdx.x == CH_WG && T0) { const unsigned long long tn_ = __builtin_amdgcn_s_memrealtime(); const unsigned long long tp_ = ((unsigned long long)F.MISC[21] << 32) | F.MISC[20]; if ((TIME_SEL >> (20 + (k))) & 1) { const unsigned long long ac_ = (((unsigned long long)F.MISC[19] << 32) | F.MISC[18]) + (tn_ - tp_); F.MISC[18] = (unsigned)ac_; F.MISC[19] = (unsigned)(ac_ >> 32); } F.MISC[20] = (unsigned)tn_; F.MISC[21] = (unsigned)(tn_ >> 32); } } } while (0)
#define LWS size_t wo_ = 0; int bx = bx0, G = G0; asm volatile("" : "+s"(wo_), "+s"(bx), "+s"(G)); unsigned char* ws = ws0 + wo_
    for (int u = F.tid; u < (LDS_BYTES - LDSCTL_OFF) / 4; u += NTHREADS) ((LAS unsigned*)(F.lds + LDSCTL_OFF))[u] = 0u;
    __syncthreads();
    XcdBarrier bar; bar.bar = (unsigned*)(F.ctl + CW_BAR); bar.x = 0; bar.st = nullptr;
    if (!MK_PER_PHASE) bar = xcd_barrier_post((unsigned*)(F.ctl + CW_BAR), F.MISC + 8);
    const int lo = args.ph_lo, hi = args.ph_hi;
    if (TIME_SEL) { if (blockIdx.x == 0 && T0) { const unsigned long long tn_ = __builtin_amdgcn_s_memrealtime(); F.MISC[16] = (unsigned)tn_; F.MISC[17] = (unsigned)(tn_ >> 32); } }
#ifndef PHMASK
#define PHMASK 0x7fff
#endif
#define IN(k) (lo <= (k) && (k) < hi)
#define KIND(b) ((PHMASK >> (b)) & 1)
#define INP(i) (args.in[i])
#define SEAM(k) do { if (!MK_PER_PHASE && IN((k) + 1)) xcd_barrier(bar.bar, bar.x, bar.st, T0 ? 1u : 0u); \
    if (TIME_SEL) { if (blockIdx.x == 0 && T0) { const unsigned long long tn_ = __builtin_amdgcn_s_memrealtime(); const unsigned long long tp_ = ((unsigned long long)F.MISC[17] << 32) | F.MISC[16]; \
        const int kind_ = (k) < 2 ? (k) : 2 + ((k) - 2) % 13; if ((TIME_SEL >> kind_) & 1) { const unsigned long long ac_ = (((unsigned long long)F.MISC[19] << 32) | F.MISC[18]) + (tn_ - tp_); F.MISC[18] = (unsigned)ac_; F.MISC[19] = (unsigned)(ac_ >> 32); } \
        F.MISC[16] = (unsigned)tn_; F.MISC[17] = (unsigned)(tn_ >> 32); } } } while (0)
    const int bx0 = blockIdx.x, G0 = F.G;
    pg8::StaticOrder S; S.wave = F.wave;
    const pg8::RowLin rl2048{2048}, rl1024{1024}, rl128{128}, rl256{256}, rl11264{11264}, rl5632{5632};

    if (KIND(0) && IN(0)) { LWS; build_mod(F, INP(I_C), INP(I_CCTX), INP(I_ADAW), INP(I_ADAB)); __syncthreads(); build_tables(F, INP(I_LAMQK)); CONVERT_WEIGHTS(F, 0, INP); SEAM(0); }
    if (KIND(1) && IN(1)) { LWS; pass_modulate(F, 0, (bf16_t*)(ws + WS_HY), MT); SEAM(1); }

#pragma unroll 1
    for (int layer = 0; layer < NLAYER; ++layer) {
        const int pb = 2 + 13 * layer;
        const bool last = layer == NLAYER - 1;
        const int MR = last ? ML : MT;

        if (KIND(2) && IN(pb + 0)) { LWS;
            S.init(MT, NP, G, bx);
            pg8::EpiInProj E{ws, (const float*)(ws + TAB_ROPE)};
            pg8::gemm_phase<pg8::EpiInProj, pg8::RowLin, true>(F.lds, opnd(ws + WS_HY, 256 * 2048, 0, 2048, 128), opnd(ws + W_IN, 0, 256 * 2048, 2048, 128), rl2048, 16, S, E);
            SEAM(pb + 0);
        }
        if (KIND(3) && IN(pb + 1)) { LWS;
#ifndef DBG_NO_SCAN
            if (SCAN_SEL(bx)) {
                const int sid = SCAN_SID(bx);
                rwkv::Params P; P.cs = (const bf16_t*)(ws + P_CS); P.co = (bf16_t*)(ws + P_CO); P.y = (bf16_t*)(ws + WS_HY); P.bon = (float*)(ws + WS_BON);
                P.mu = INP(I_MU) + layer * 2 * 1920; P.w0 = INP(I_W0) + layer * 1024; P.w2 = INP(I_W2) + (size_t)layer * 2 * 64 * 512; P.a0 = INP(I_A0) + layer * 1024;
                P.a2 = INP(I_A2) + (size_t)layer * 2 * 64 * 512; P.kk = INP(I_KK) + layer * 512; P.ka = INP(I_KA) + layer * 512; P.rk = INP(I_RK) + layer * 512;
                unsigned long long ts0_ = 0; if ((TIME_SEL >> 16) & 1) ts0_ = __builtin_amdgcn_s_memrealtime();
                rwkv::scan_wg(P, sid >> 5, (sid >> 3) & 3, sid & 7, (LAS char*)F.lds, F.wave);
                if ((TIME_SEL >> 16) & 1) { if (blockIdx.x == SC_WG && T0) { const unsigned long long ac_ = (((unsigned long long)F.MISC[19] << 32) | F.MISC[18]) + (__builtin_amdgcn_s_memrealtime() - ts0_); F.MISC[18] = (unsigned)ac_; F.MISC[19] = (unsigned)(ac_ >> 32); } }
            }
#endif
            unsigned long long ta0_ = 0; if ((TIME_SEL >> 17) & 1) ta0_ = __builtin_amdgcn_s_memrealtime();
            if ((TIME_SEL >> 20) != 0) { if (blockIdx.x == CH_WG && T0) { const unsigned long long tn_ = __builtin_amdgcn_s_memrealtime(); F.MISC[20] = (unsigned)tn_; F.MISC[21] = (unsigned)(tn_ >> 32); } }
#if 0
#endif
            const float* tabf = (const float*)(ws + TAB_LAM); const float lam = tabf[2 * layer], osc = tabf[2 * layer + 1];
            const int x = bx & 7, nun = last ? 64 : 68;
            gu32* qw = F.ctl + CW_QUEUE + 64 * (layer * 8 + x);
#ifndef DBG_NO_ATTN
            unsigned ndone = 0;
            for (;;) {
                __syncthreads();
                if (T0) F.MISC[0] = __hip_atomic_fetch_add(qw, 1u, RLX_AGENT);
                __syncthreads();
                const int i = (int)F.MISC[0];
                if (i >= nun) break;
                ++ndone;
                const bf16_t* Q = (const bf16_t*)(ws + P_Q); const bf16_t* K = (const bf16_t*)(ws + P_K); const bf16_t* V = (const bf16_t*)(ws + P_V);
                const float* sub = INP(I_SUBLN) + layer * 128; const float* rope = (const float*)(ws + TAB_ROPE);
                if (i < 64) { const int pair = x + 8 * (i >> 4), qb = i & 15, b = pair >> 3, hh = pair & 7;
                    attn::attn_unit<true>(Q, K, V, (bf16_t*)(ws + P_Q), b * SEQ + 256 * qb, b, hh, lam, osc, sub, rope, (LAS char*)F.lds, F.wave); }
                else { const int pair = x + 8 * (i - 64), b = pair >> 3, hh = pair & 7;
#ifndef DBG_NO_ATTNC
                    attn::attn_unit<false>(Q, K, V, (bf16_t*)(ws + P_Q), ML + b * CTXL, b, hh, lam, osc, sub, rope, (LAS char*)F.lds, F.wave);
#endif
                }
            }
#endif
            CH_T(0);
            {
                const bool is_scan = SCAN_SEL(bx);
                gu32* dcnt = F.ctl + CW_SUB + 64 * (layer * 4 + 0);
                const unsigned total = 8u * (unsigned)nun;
                if (is_scan || G != 256) { sub_arrive_wait(dcnt, ndone, 0u, T0); }
                else {
                    const int rank = SCAN_RANK(bx), GF = 192;
                    { Frame F2 = F; F2.gw = rank * NWAVES + F.wave; F2.NGW = GF * NWAVES;
                      pass_sg(F2, (bf16_t*)(ws + P_CO), MR, INP(I_MU) + layer * 2 * 1920); }
                    sub_arrive_wait(dcnt, ndone, total, T0); CH_T(1);
                    { S.init(1024, ML, GF, rank); pg8::EpiF0 E{(bf16_t*)(ws + P_K)};
                      pg8::Operand B = opnd(ws + P_F, 256, 4 * 1024, 1024, 128); B.nshift = 4; B.tN2 = 4096L * 1024; B.hstep = 2 * 1024;
                      pg8::gemm_phase<pg8::EpiF0, RowF0, true>(F.lds, opnd(ws + TAB_W0, 0, 0, 256, 128), B, RowF0{}, 2, S, E); }
                    if (!last) { S.init(1024, MC, GF, (rank + GF - 64) % GF); pg8::EpiF0c E{(bf16_t*)(ws + P_K + 32 * MiB)};
                      pg8::gemm_phase<pg8::EpiF0c, pg8::RowLin, true>(F.lds, opnd(ws + TAB_W0, 0, 0, 256, 128), opnd(ws + P_F + (size_t)ML * 1024, 256, 256 * 1024, 1024, 128), rl1024, 2, S, E); }
                    sub_arrive_wait(F.ctl + CW_SUB + 64 * (layer * 4 + 1), 1u, (unsigned)GF, T0); CH_T(4);
                    { S.init(256, 65536, GF, rank); pg8::EpiF1 E{(bf16_t*)(ws + P_V), (const float*)(ws + TAB_TW)};
                      pg8::gemm_phase<pg8::EpiF1, pg8::RowLin, true>(F.lds, opnd(ws + TAB_F1, 0, 0, 512, 128), opnd(ws + P_K, 0, 256 * 128, 128, 8 * MiB), rl128, 4, S, E); }
                    if (!last) { S.init(256, 2048, GF, (rank + GF - 72) % GF); pg8::EpiFc E{(bf16_t*)(ws + P_F)};
                      pg8::gemm_phase<pg8::EpiFc, pg8::RowLin, true>(F.lds, opnd(ws + TAB_DC, 0, 0, 1024, 128), opnd(ws + P_K + 32 * MiB, 0, 256 * 1024, 1024, 128), rl1024, 8, S, E); }
                    sub_arrive_wait(F.ctl + CW_SUB + 64 * (layer * 4 + 2), 1u, (unsigned)GF, T0); CH_T(5);
                    { S.init(256, 32768, GF, rank); pg8::EpiF2 E{(bf16_t*)(ws + P_F)};
                      pg8::gemm_phase<pg8::EpiF2, pg8::RowLin, true>(F.lds, opnd(ws + TAB_F2, 0, 0, 1024, 128), opnd(ws + P_V, 0, 256 * 128, 128, 4 * MiB), rl128, 8, S, E); }
                    sub_arrive_wait(F.ctl + CW_SUB + 64 * (layer * 4 + 3), 1u, (unsigned)GF, T0); CH_T(2);
                    { S.init(MR, 512, GF, rank); pg8::EpiBf16 E{(bf16_t*)(ws + P_V), 512};
                      pg8::gemm_phase<pg8::EpiBf16, pg8::RowLin, true>(F.lds, opnd(ws + P_CO + DCO * 2, 256 * 1536, 0, 1536, 128), opnd(ws + W_G2T, 0, 256 * 256, 256, 128), rl256, 2, S, E); }
                    {
                        Frame F2 = F; F2.gw = rank * NWAVES + F.wave; F2.NGW = GF * NWAVES;
                        pass_modulate(F2, layer, (bf16_t*)(ws + P_K), MR); }
                    CH_T(3);
                }
            }
            if ((TIME_SEL >> 17) & 1) { if (blockIdx.x == 8 && T0) { const unsigned long long ac_ = (((unsigned long long)F.MISC[19] << 32) | F.MISC[18]) + (__builtin_amdgcn_s_memrealtime() - ta0_); F.MISC[18] = (unsigned)ac_; F.MISC[19] = (unsigned)(ac_ >> 32); } }
            SEAM(pb + 1); CH_T(6);
        }
        if (KIND(4) && IN(pb + 2)) { LWS;
          if (G != 256) {
            { S.init(1024, ML, G, bx); pg8::EpiF0 E{(bf16_t*)(ws + P_K)};
              pg8::Operand B = opnd(ws + P_F, 256, 4 * 1024, 1024, 128); B.nshift = 4; B.tN2 = 4096L * 1024; B.hstep = 2 * 1024;
              pg8::gemm_phase<pg8::EpiF0, RowF0, true>(F.lds, opnd(ws + TAB_W0, 0, 0, 256, 128), B, RowF0{}, 2, S, E); }
            if (!last) { S.init(1024, MC, G, (bx + G - 16) % G); pg8::EpiF0c E{(bf16_t*)(ws + P_K + 32 * MiB)};
              pg8::gemm_phase<pg8::EpiF0c, pg8::RowLin, true>(F.lds, opnd(ws + TAB_W0, 0, 0, 256, 128), opnd(ws + P_F + (size_t)ML * 1024, 256, 256 * 1024, 1024, 128), rl1024, 2, S, E); }
          }
            if (G != 256) { pass_sg(F, (bf16_t*)(ws + P_CO), MR, INP(I_MU) + layer * 2 * 1920); SEAM(pb + 2); }
        }
        if (KIND(5) && IN(pb + 3)) { LWS;
          if (G != 256) {
            { S.init(256, 65536, G, bx); pg8::EpiF1 E{(bf16_t*)(ws + P_V), (const float*)(ws + TAB_TW)};
              pg8::gemm_phase<pg8::EpiF1, pg8::RowLin, true>(F.lds, opnd(ws + TAB_F1, 0, 0, 512, 128), opnd(ws + P_K, 0, 256 * 128, 128, 8 * MiB), rl128, 4, S, E); }
            if (!last) { S.init(256, 2048, G, (bx + G - 8) % G); pg8::EpiFc E{(bf16_t*)(ws + P_F)};
              pg8::gemm_phase<pg8::EpiFc, pg8::RowLin, true>(F.lds, opnd(ws + TAB_DC, 0, 0, 1024, 128), opnd(ws + P_K + 32 * MiB, 0, 256 * 1024, 1024, 128), rl1024, 8, S, E); }
          }
            if (G != 256) SEAM(pb + 3);
        }
        if (KIND(6) && IN(pb + 4)) { LWS;
            if (G != 256) { S.init(256, 32768, G, bx); pg8::EpiF2 E{(bf16_t*)(ws + P_F)};
              pg8::gemm_phase<pg8::EpiF2, pg8::RowLin, true>(F.lds, opnd(ws + TAB_F2, 0, 0, 1024, 128), opnd(ws + P_V, 0, 256 * 128, 128, 4 * MiB), rl128, 8, S, E); }
            if (G != 256) { S.init(MR, 512, G, bx);
              pg8::EpiRwkvPost E{(const bf16_t*)(ws + WS_HY), (const bf16_t*)(ws + WS_HY) + (size_t)MT * 512, (const bf16_t*)(ws + P_CS), (const float*)(ws + WS_BON),
                                 INP(I_MU) + layer * 2 * 1920, INP(I_LNW) + layer * 512, INP(I_LNB) + layer * 512, (bf16_t*)(ws + WS_HY)};
              pg8::gemm_phase<pg8::EpiRwkvPost, pg8::RowLin, false>(F.lds, opnd(ws + P_CO + DCO * 2, 256 * 1536, 0, 1536, 128), opnd(ws + W_G2T, 0, 256 * 256, 256, 128), rl256, 2, S, E); }
            else pass_post(F, MR, (bf16_t*)(ws + WS_HY), (const bf16_t*)(ws + WS_HY) + (size_t)MT * 512, (const bf16_t*)(ws + P_V), (const bf16_t*)(ws + P_CS), (const float*)(ws + WS_BON),
                           INP(I_MU) + layer * 2 * 1920, INP(I_LNW) + layer * 512, INP(I_LNB) + layer * 512);
            if (G != 256) pass_modulate(F, layer, (bf16_t*)(ws + P_K), MR);
            SEAM(pb + 4);
        }
        if (KIND(7) && IN(pb + 5)) { LWS;
            S.init(MR, NGATE, G, bx); pg8::EpiGate E{(bf16_t*)(ws + P_V)};
            pg8::gemm_phase<pg8::EpiGate, pg8::RowLin, true>(F.lds, opnd(ws + P_K, 256 * 2048, 0, 2048, 128), opnd(ws + W_IN + (size_t)NP * 2048, 0, 256 * 2048, 2048, 128), rl2048, 16, S, E);
            SEAM(pb + 5);
        }
        if (KIND(8) && IN(pb + 6)) { LWS;
            S.init(MR, 1024, G, bx);
            { pg8::EpiBranch<true> E{(const bf16_t*)(ws + P_V), (bf16_t*)(ws + P_K), (DBG_BR & 1) ? 1.f : 0.f};
              pg8::gemm_phase<pg8::EpiBranch<true>, pg8::RowLin, true>(F.lds, opnd(ws + P_Q, 256 * 2048, 0, 2048, 128), opnd(ws + W_PA, 0, 256 * 2048, 2048, 128), rl2048, 16, S, E); }
            VM_WAIT();
            { pg8::EpiBranch<false> E{(const bf16_t*)(ws + P_V) + 1024, (bf16_t*)(ws + P_K), (DBG_BR & 2) ? 1.f : 0.f};
              pg8::gemm_phase<pg8::EpiBranch<false>, pg8::RowLin, true>(F.lds, opnd(ws + P_F, 256 * 1024, 0, 1024, 128), opnd(ws + W_PF, 0, 256 * 1024, 1024, 128), rl1024, 8, S, E); }
            VM_WAIT();
            { pg8::EpiBranch<false> E{(const bf16_t*)(ws + P_V) + 2048, (bf16_t*)(ws + P_K), (DBG_BR & 4) ? 1.f : 0.f};
              pg8::gemm_phase<pg8::EpiBranch<false>, pg8::RowLin, true>(F.lds, opnd(ws + WS_HY, 256 * 1024, 0, 1024, 128), opnd(ws + W_PC, 0, 256 * 1024, 1024, 128), rl1024, 8, S, E); }
            SEAM(pb + 6);
        }
        if (KIND(9) && IN(pb + 7)) { LWS;
            S.init(MR, 1024, G, bx); pg8::EpiBf16 E{(bf16_t*)(ws + P_V), 1024};
            pg8::gemm_phase<pg8::EpiBf16, pg8::RowLin, true>(F.lds, opnd(ws + P_K, 256 * 2048, 0, 2048, 128), opnd(ws + W_O, 0, 256 * 2048, 2048, 128), rl2048, 16, S, E);
            SEAM(pb + 7);
        }
        if (KIND(10) && IN(pb + 8)) { LWS; pass_ln1(F, layer, (const bf16_t*)(ws + P_V), (bf16_t*)(ws + WS_HY), MR, INP(I_LN1G) + layer * DM, INP(I_LN1B) + layer * DM); SEAM(pb + 8); }
        if (KIND(11) && IN(pb + 9)) { LWS;
            S.init(MR, NP, G, bx); pg8::EpiBf16 E{(bf16_t*)(ws + WS_P), NP};
            pg8::gemm_phase<pg8::EpiBf16, pg8::RowLin, true>(F.lds, opnd(ws + WS_HY, 256 * 2048, 0, 2048, 128), opnd(ws + W_UP, 0, 256 * 2048, 2048, 128), rl2048, 16, S, E);
            SEAM(pb + 9);
        }
        if (KIND(12) && IN(pb + 10)) { LWS; pass_conv(F, (bf16_t*)(ws + WS_P), MR, INP(I_FCONV) + (size_t)layer * 3 * DFF, INP(I_FCONVB) + (size_t)layer * DFF); SEAM(pb + 10); }
        if (KIND(13) && IN(pb + 11)) { LWS;
            S.init(MR, 1024, G, bx); pg8::EpiBf16 E{(bf16_t*)(ws + WS_HY), 1024};
            pg8::gemm_phase<pg8::EpiBf16, pg8::RowLin, true>(F.lds, opnd(ws + WS_P, 256 * 11264, 0, 11264, 128), opnd(ws + W_DN, 0, 256 * 5632, 5632, 128), rl5632, 44, S, E);
            SEAM(pb + 11);
        }
        if (KIND(14) && IN(pb + 12)) { LWS;
            pass_ln2(F, layer, (bf16_t*)(ws + WS_HY), MR, !last, INP(I_LN2G) + layer * DM, INP(I_LN2B) + layer * DM);
            if (!last) { __syncthreads(); CONVERT_WEIGHTS(F, layer + 1, INP); }
            SEAM(pb + 12);
        }
    }
    if (TIME_SEL || SCAN_TSEL != 0) { if ((blockIdx.x == 0 || blockIdx.x == 8 || blockIdx.x == CH_WG || blockIdx.x == SC_WG) && T0) { const unsigned long long ac_ = ((unsigned long long)F.MISC[19] << 32) | F.MISC[18]; const unsigned long long t0_ = __builtin_amdgcn_s_memrealtime(); while (__builtin_amdgcn_s_memrealtime() - t0_ < ac_) __builtin_amdgcn_s_sleep(8); } }
#undef IN
#undef SEAM
}

extern "C" void kernel_launch(void* const* d_in, const int* in_sizes, int n_in, void* d_out, int out_size, void* d_ws, size_t ws_size, hipStream_t stream) {
    static int grid = 0;
    if (grid == 0) {
        if (n_in != 32 || in_sizes[0] != ML * DM || out_size != ML * DM || ws_size < WS_END) { fprintf(stderr, "kernel_launch: unexpected shapes (n_in %d, ws %zu)\n", n_in, ws_size); grid = -1; return; }
        int dev = 0, cus = 0, per_cu = 0;
        if (hipGetDevice(&dev) != hipSuccess || hipDeviceGetAttribute(&cus, hipDeviceAttributeMultiprocessorCount, dev) != hipSuccess) { grid = -1; return; }
        if (hipFuncSetAttribute((const void*)mk_fwd, hipFuncAttributeMaxDynamicSharedMemorySize, LDS_BYTES) != hipSuccess) { fprintf(stderr, "kernel_launch: hipFuncSetAttribute failed\n"); grid = -1; return; }
        if (hipOccupancyMaxActiveBlocksPerMultiprocessor(&per_cu, (const void*)mk_fwd, NTHREADS, LDS_BYTES) != hipSuccess || per_cu < 1) { fprintf(stderr, "kernel_launch: occupancy query says %d\n", per_cu); per_cu = 1; }
        (void)hipGetLastError();
        grid = cus;
        if (grid < 256 || (grid % 8) != 0) fprintf(stderr, "kernel_launch: grid %d\n", grid);
    }
    if (grid < 0) return;
    (void)hipMemsetAsync((char*)d_ws + WS_CTL, 0, CTL_ZERO_BYTES, stream);
    Args a{};
    for (int i = 0; i < 32; ++i) a.in[i] = (const float*)d_in[i];
    a.out = (float*)d_out; a.ws = (unsigned char*)d_ws;
#if MK_PER_PHASE
    unsigned char* ws8 = (unsigned char*)d_ws; (void)ws8;
    for (int p = 0; p < N_PHASES; ++p) {
#if defined(DBG_CHECK)
        if (DBG_CHECK == 14 && p == 7 + 13 * DBG_LAYER) hipLaunchKernelGGL(dbg_fill, dim3(2048), dim3(256), 0, stream, (unsigned char*)d_ws);
        if (DBG_CHECK == 1 && p == 3 + 13 * DBG_LAYER) hipLaunchKernelGGL(dbg_pre, dim3(2048), dim3(256), 0, stream, (unsigned char*)d_ws, (float*)d_out);
#endif
        a.ph_lo = p; a.ph_hi = p + 1; hipLaunchKernelGGL(mk_fwd, dim3(grid), dim3(NTHREADS), LDS_BYTES, stream, a);
#if defined(DBG_CHECK)
#ifndef DBG_LAYER
#define DBG_LAYER 0
#endif
        if (DBG_CHECK == 2 && p == 2 + 13 * DBG_LAYER) hipLaunchKernelGGL(dbg_inproj, dim3(9), dim3(64), 0, stream, (unsigned char*)d_ws, (const float*)d_in[I_WIN] + (size_t)DBG_LAYER * 1024 * D_IN_SRC);
        if (DBG_CHECK == 3 && p == 4 + 13 * DBG_LAYER) hipLaunchKernelGGL(dbg_fourier_ref, dim3(128), dim3(512), 0, stream, (unsigned char*)d_ws);
        if (DBG_CHECK == 3 && p == 6 + 13 * DBG_LAYER) hipLaunchKernelGGL(dbg_fourier_cmp, dim3(1), dim3(128), 0, stream, (unsigned char*)d_ws);
        if (DBG_CHECK == 4 && p == 3 + 13 * DBG_LAYER) hipLaunchKernelGGL(dbg_scan, dim3(64), dim3(64), 0, stream, (unsigned char*)d_ws, (float*)d_out, (const float*)d_in[I_MU] + DBG_LAYER * 3840, (const float*)d_in[I_W0] + DBG_LAYER * 1024, (const float*)d_in[I_W2] + DBG_LAYER * 65536, (const float*)d_in[I_A0] + DBG_LAYER * 1024, (const float*)d_in[I_A2] + DBG_LAYER * 65536, (const float*)d_in[I_KK] + DBG_LAYER * 512, (const float*)d_in[I_KA] + DBG_LAYER * 512, (const float*)d_in[I_RK] + DBG_LAYER * 512); if (DBG_CHECK == 4 && DBG_SUB == 10 && p == 3 + 13 * DBG_LAYER) hipLaunchKernelGGL(dbg_scan_fin, dim3(1), dim3(1), 0, stream, (unsigned char*)d_ws);
        if (DBG_CHECK == 5 && p == 7 + 13 * DBG_LAYER) hipLaunchKernelGGL(dbg_merge_ref, dim3(48), dim3(512), 0, stream, (unsigned char*)d_ws, (float*)(ws8 + WS_DBG + 262144), (const float*)d_in[I_WIN] + (size_t)DBG_LAYER * 1024 * D_IN_SRC, (const float*)d_in[I_WPA] + DBG_LAYER * 1048576, (const float*)d_in[I_WPF] + DBG_LAYER * 524288, (const float*)d_in[I_WPC] + DBG_LAYER * 524288, (const float*)d_in[I_WO] + DBG_LAYER * 1048576);
        if (DBG_CHECK == 5 && p == 9 + 13 * DBG_LAYER) hipLaunchKernelGGL(dbg_merge_cmp, dim3(48), dim3(64), 0, stream, (unsigned char*)d_ws, (const float*)(ws8 + WS_DBG + 262144));
        if (DBG_CHECK == 6 && p == 5 + 13 * DBG_LAYER) hipLaunchKernelGGL(dbg_post_ref, dim3(96), dim3(512), 0, stream, (unsigned char*)d_ws, (float*)(ws8 + WS_DBG + 262144), (const float*)d_in[I_MU] + DBG_LAYER * 3840, (const float*)d_in[I_G2] + DBG_LAYER * 65536, (const float*)d_in[I_LNW] + DBG_LAYER * 512, (const float*)d_in[I_LNB] + DBG_LAYER * 512);
        if (DBG_CHECK == 6 && p == 6 + 13 * DBG_LAYER) hipLaunchKernelGGL(dbg_post_cmp, dim3(96), dim3(512), 0, stream, (unsigned char*)d_ws, (const float*)(ws8 + WS_DBG + 262144));
        if (DBG_CHECK == 7 && p == 1) hipLaunchKernelGGL(dbg_mod, dim3(10), dim3(64), 0, stream, (unsigned char*)d_ws, (const float*)d_in[I_C], (const float*)d_in[I_CCTX], (const float*)d_in[I_ADAW], (const float*)d_in[I_ADAB], (const float*)d_in[I_X], (const float*)d_in[I_CTX]);
        if (DBG_CHECK == 8 && p == 10 + 13 * DBG_LAYER) hipLaunchKernelGGL(dbg_ffn_ref, dim3(48), dim3(512), 0, stream, (unsigned char*)d_ws, (const float*)d_in[I_FUP] + (size_t)DBG_LAYER * 1024 * 5632, (const float*)d_in[I_FCONV] + DBG_LAYER * 3 * 2816, (const float*)d_in[I_FCONVB] + DBG_LAYER * 2816, (const float*)d_in[I_FDN] + (size_t)DBG_LAYER * 2816 * 1024);
        if (DBG_CHECK == 8 && p == 13 + 13 * DBG_LAYER) hipLaunchKernelGGL(dbg_ffn_cmp, dim3(48), dim3(64), 0, stream, (unsigned char*)d_ws);
        if (DBG_CHECK == 9 && p == 10) hipLaunchKernelGGL(dbg_ln1, dim3(6), dim3(64), 0, stream, (unsigned char*)d_ws, (const float*)d_in[I_X], (const float*)d_in[I_CTX], (const float*)d_out, (const float*)d_in[I_LN1G], (const float*)d_in[I_LN1B]);
        if (DBG_CHECK == 10 && p == 13 + 13 * DBG_LAYER) hipLaunchKernelGGL(dbg_ln2_ref, dim3(64), dim3(64), 0, stream, (unsigned char*)d_ws, (const float*)d_out, (const float*)d_in[I_LN2G] + DBG_LAYER * 1024, (const float*)d_in[I_LN2B] + DBG_LAYER * 1024, DBG_LAYER);
        if (DBG_CHECK == 10 && p == 14 + 13 * DBG_LAYER) hipLaunchKernelGGL(dbg_ln2_cmp, dim3(64), dim3(64), 0, stream, (unsigned char*)d_ws, (const float*)d_out, DBG_LAYER);
        if (DBG_CHECK == 11 && p == 7 + 13 * DBG_LAYER) { hipLaunchKernelGGL(dbg_gate, dim3(256), dim3(64), 0, stream, (unsigned char*)d_ws, (const float*)d_in[I_WIN] + (size_t)DBG_LAYER * 1024 * D_IN_SRC, 0); hipLaunchKernelGGL(dbg_gate, dim3(256), dim3(64), 0, stream, (unsigned char*)d_ws, (const float*)d_in[I_WIN] + (size_t)DBG_LAYER * 1024 * D_IN_SRC, 1); }
        if (DBG_CHECK == 12 && p == 7 + 13 * DBG_LAYER) { hipLaunchKernelGGL(dbg_gate2_init, dim3(1), dim3(1), 0, stream, (unsigned char*)d_ws); hipLaunchKernelGGL(dbg_gate2, dim3(13), dim3(64), 0, stream, (unsigned char*)d_ws, (const float*)d_in[I_WIN] + (size_t)DBG_LAYER * 1024 * D_IN_SRC); hipLaunchKernelGGL(dbg_gate2_fin, dim3(1), dim3(1), 0, stream, (unsigned char*)d_ws); }
        if ((DBG_CHECK == 13 || DBG_CHECK == 14) && p == 7 + 13 * DBG_LAYER) { hipLaunchKernelGGL(dbg_gate3_init, dim3(1), dim3(1), 0, stream, (unsigned char*)d_ws); hipLaunchKernelGGL(dbg_gate3, dim3(2048), dim3(256), 0, stream, (unsigned char*)d_ws); hipLaunchKernelGGL(dbg_gate3_fin, dim3(1), dim3(1), 0, stream, (unsigned char*)d_ws); }
        if (DBG_CHECK == 1 && p == 3 + 13 * DBG_LAYER) hipLaunchKernelGGL(dbg_attn, dim3(2048), dim3(512), 0, stream, (unsigned char*)d_ws, (const float*)d_in[I_SUBLN], DBG_LAYER, (const float*)d_out);
#endif
    }
#if defined(DBG_CHECK)
    hipLaunchKernelGGL(dbg_report, dim3(DBG_TWO ? 4096 : 1), dim3(DBG_TWO ? 256 : 1), 0, stream, (unsigned char*)d_ws, (float*)d_out);
#endif
#else
    a.ph_lo = 0; a.ph_hi = N_PHASES;
    hipLaunchKernelGGL(mk_fwd, dim3(grid), dim3(NTHREADS), LDS_BYTES, stream, a);
#endif
}
```
